# Optimizing an MI355X kernel written in HIP

```python
import jax, jax.numpy as jnp
from jax import lax
import numpy as np

D_MODEL = 2048
BATCH = 1
SEQ = 16384
DEPTH = 2

D_MIX = D_MODEL
MLA_HEADS = 8
QK_NOPE_DIM = 128
QK_ROPE_DIM = 64
V_HEAD_DIM = 128
QK_HEAD_DIM = QK_NOPE_DIM + QK_ROPE_DIM
Q_LORA_RANK = 512
KV_LORA_RANK = 256
MLA_WIDTH = MLA_HEADS * V_HEAD_DIM
FNET_GROUPS = 8
FNET_WIDTH = D_MIX - MLA_WIDTH
FNET_GROUP_DIM = FNET_WIDTH // FNET_GROUPS
D_IN = Q_LORA_RANK + KV_LORA_RANK + QK_ROPE_DIM + FNET_WIDTH
ROPE_THETA = 10000.0
Q_BLOCK = 128
D_FF_DENSE = 5632
N_EXPERTS = 8
TOP_K = 2
D_FF_EXPERT = 7168
EXPERT_BLOCK = 512
N_DENSE = (DEPTH + 1) // 2
N_MOE = DEPTH // 2
N_MOD = 6
RMS_EPS = 1e-6

kernel_name = "hybrid_mla_fnet_adaln_moe_encoder"


def rms_norm(x, g):
    xf = x.astype(jnp.float32)
    y = xf * lax.rsqrt(jnp.mean(xf * xf, axis=-1, keepdims=True) + RMS_EPS)
    return (y * g.astype(jnp.float32)).astype(x.dtype)


def rope_tables(positions):
    half = QK_ROPE_DIM // 2
    inv_freq = ROPE_THETA ** (-jnp.arange(half, dtype=jnp.float32) / half)
    ang = positions.astype(jnp.float32)[..., None] * inv_freq
    return jnp.cos(ang), jnp.sin(ang)


def apply_rope(x, cos, sin):
    x1, x2 = jnp.split(x.astype(jnp.float32), 2, axis=-1)
    return jnp.concatenate([x1 * cos - x2 * sin, x2 * cos + x1 * sin], axis=-1).astype(x.dtype)


def swiglu(h, w_gate, w_up, w_down):
    return (jax.nn.silu(h @ w_gate) * (h @ w_up)) @ w_down


def bidir_attention(q, k, v):
    B, H, S, Dq = q.shape
    nb = S // Q_BLOCK
    qb = q.reshape(B, H, nb, Q_BLOCK, Dq).transpose(2, 0, 1, 3, 4)
    scale = QK_HEAD_DIM ** -0.5

    def one_block(qi):
        s = jnp.einsum('bhqd,bhkd->bhqk', qi, k, preferred_element_type=jnp.float32) * scale
        p = jax.nn.softmax(s, axis=-1)
        return jnp.einsum('bhqk,bhkd->bhqd', p.astype(v.dtype), v)

    o = lax.map(one_block, qb)
    return o.transpose(1, 2, 0, 3, 4).reshape(B, H, S, V_HEAD_DIM)


def mla_mix(c_q, c_kv, k_rope, cos, sin, cq_g, ckv_g, w_uq, w_ukv, q_g, k_g):
    B, S, _ = c_q.shape
    q = (rms_norm(c_q, cq_g) @ w_uq).reshape(B, S, MLA_HEADS, QK_HEAD_DIM)
    kv = (rms_norm(c_kv, ckv_g) @ w_ukv).reshape(B, S, MLA_HEADS, QK_NOPE_DIM + V_HEAD_DIM)
    k_nope, v = jnp.split(kv, [QK_NOPE_DIM], axis=-1)
    k_r = jnp.broadcast_to(k_rope[:, :, None, :], (B, S, MLA_HEADS, QK_ROPE_DIM))
    k = jnp.concatenate([k_nope, k_r], axis=-1)
    q = rms_norm(q, q_g)
    k = rms_norm(k, k_g)
    cos_h, sin_h = cos[:, :, None, :], sin[:, :, None, :]
    q = jnp.concatenate([q[..., :QK_NOPE_DIM], apply_rope(q[..., QK_NOPE_DIM:], cos_h, sin_h)], axis=-1)
    k = jnp.concatenate([k[..., :QK_NOPE_DIM], apply_rope(k[..., QK_NOPE_DIM:], cos_h, sin_h)], axis=-1)
    o = bidir_attention(q.transpose(0, 2, 1, 3), k.transpose(0, 2, 1, 3), v.transpose(0, 2, 1, 3))
    return o.transpose(0, 2, 1, 3).reshape(B, S, MLA_WIDTH)


def fourier_mix(u, w_f):
    B, S, _ = u.shape
    ug = u.reshape(B, S, FNET_GROUPS, FNET_GROUP_DIM).astype(jnp.float32)
    f = jnp.fft.fft2(ug, axes=(1, 3), norm='ortho').real.astype(u.dtype)
    return jnp.einsum('bsgc,gcd->bsgd', f, w_f).reshape(B, S, FNET_WIDTH)


def mixer_sublayer(x, shift, scale, gate, cos, sin, norm_g, w_in, cq_g, ckv_g, w_uq, w_ukv, q_g, k_g, w_f, out_g, w_out):
    h = rms_norm(x, norm_g) * (1.0 + scale) + shift
    z = h @ w_in
    s1 = Q_LORA_RANK
    s2 = s1 + KV_LORA_RANK
    s3 = s2 + QK_ROPE_DIM
    c_q, c_kv, k_rope, u = jnp.split(z, [s1, s2, s3], axis=-1)
    a = mla_mix(c_q, c_kv, k_rope, cos, sin, cq_g, ckv_g, w_uq, w_ukv, q_g, k_g)
    f = fourier_mix(u, w_f)
    o = jnp.concatenate([rms_norm(a, out_g[:MLA_WIDTH]), rms_norm(f, out_g[MLA_WIDTH:])], axis=-1) @ w_out
    return x + gate * o


def moe_swiglu(h, w_router, w_gate, w_up, w_down):
    B, S, D = h.shape
    T = B * S
    A = T * TOP_K
    hf = h.reshape(T, D)
    logits = jnp.dot(hf.astype(jnp.float32), w_router.astype(jnp.float32))
    top_logit, top_idx = lax.top_k(logits, TOP_K)
    top_w = jax.nn.softmax(top_logit, axis=-1)
    flat_e = top_idx.reshape(A)
    flat_tok = jnp.repeat(jnp.arange(T, dtype=jnp.int32), TOP_K)
    flat_w = top_w.reshape(A)
    order = jnp.argsort(flat_e)
    sorted_e = flat_e[order]
    counts = jnp.bincount(flat_e, length=N_EXPERTS).astype(jnp.int32)
    padded = (counts + EXPERT_BLOCK - 1) // EXPERT_BLOCK * EXPERT_BLOCK
    start = jnp.cumsum(counts) - counts
    pend = jnp.cumsum(padded)
    pstart = pend - padded
    dest = pstart[sorted_e] + jnp.arange(A, dtype=jnp.int32) - start[sorted_e]
    n_blocks = -(-A // EXPERT_BLOCK) + N_EXPERTS
    P = n_blocks * EXPERT_BLOCK
    row_tok = jnp.full((P,), T, jnp.int32).at[dest].set(flat_tok[order])
    row_w = jnp.zeros((P,), jnp.float32).at[dest].set(flat_w[order])
    block_start = jnp.arange(n_blocks, dtype=jnp.int32) * EXPERT_BLOCK
    block_e = jnp.minimum(jnp.searchsorted(pend, block_start, side='right'), N_EXPERTS - 1).astype(jnp.int32)
    h_pad = jnp.concatenate([hf, jnp.zeros((1, D), hf.dtype)], axis=0)
    xb = h_pad[row_tok].reshape(n_blocks, EXPERT_BLOCK, D)

    def expert_block(args):
        xi, e = args
        return swiglu(xi, w_gate[e], w_up[e], w_down[e])

    yb = lax.map(expert_block, (xb, block_e)).reshape(P, D)
    y = jnp.zeros((T + 1, D), jnp.float32).at[row_tok].add(yb.astype(jnp.float32) * row_w[:, None])
    return y[:T].astype(h.dtype).reshape(B, S, D)


def setup_inputs(seed: int = 0) -> dict:
    key = jax.random.key(seed)
    ks = jax.random.split(key, 32)
    f32 = jnp.float32

    def nrm(k, shape, fan_in, mult=1.0):
        return jax.random.normal(k, shape, f32) * (mult * fan_in ** -0.5)

    def gain(k, shape):
        return 1.0 + 0.05 * jax.random.normal(k, shape, f32)

    x = jax.random.normal(ks[0], (BATCH, SEQ, D_MODEL), f32)
    c = jax.random.normal(ks[1], (BATCH, D_MODEL), f32)
    offs = jax.random.randint(ks[2], (BATCH, 1), 0, 1024, dtype=jnp.int32)
    positions = offs + jnp.arange(SEQ, dtype=jnp.int32)[None, :]
    return {
        'x': x,
        'c': c,
        'positions': positions,
        'ada_w': nrm(ks[3], (DEPTH, D_MODEL, N_MOD * D_MODEL), D_MODEL, 0.5),
        'ada_b': 0.02 * jax.random.normal(ks[4], (DEPTH, N_MOD * D_MODEL), f32),
        'mix_norm': gain(ks[5], (DEPTH, D_MODEL)),
        'w_in': nrm(ks[6], (DEPTH, D_MODEL, D_IN), D_MODEL),
        'cq_norm': gain(ks[7], (DEPTH, Q_LORA_RANK)),
        'ckv_norm': gain(ks[8], (DEPTH, KV_LORA_RANK)),
        'w_uq': nrm(ks[9], (DEPTH, Q_LORA_RANK, MLA_HEADS * QK_HEAD_DIM), Q_LORA_RANK),
        'w_ukv': nrm(ks[10], (DEPTH, KV_LORA_RANK, MLA_HEADS * (QK_NOPE_DIM + V_HEAD_DIM)), KV_LORA_RANK),
        'q_norm': gain(ks[11], (DEPTH, QK_HEAD_DIM)),
        'k_norm': gain(ks[12], (DEPTH, QK_HEAD_DIM)),
        'w_fnet': nrm(ks[13], (DEPTH, FNET_GROUPS, FNET_GROUP_DIM, FNET_GROUP_DIM), FNET_GROUP_DIM),
        'out_norm': gain(ks[14], (DEPTH, D_MIX)),
        'w_out': nrm(ks[15], (DEPTH, D_MIX, D_MODEL), D_MIX),
        'ffn_norm': gain(ks[16], (DEPTH, D_MODEL)),
        'dense_w_gate': nrm(ks[17], (N_DENSE, D_MODEL, D_FF_DENSE), D_MODEL),
        'dense_w_up': nrm(ks[18], (N_DENSE, D_MODEL, D_FF_DENSE), D_MODEL),
        'dense_w_down': nrm(ks[19], (N_DENSE, D_FF_DENSE, D_MODEL), D_FF_DENSE),
        'router_w': nrm(ks[20], (N_MOE, D_MODEL, N_EXPERTS), D_MODEL),
        'moe_w_gate': nrm(ks[21], (N_MOE, N_EXPERTS, D_MODEL, D_FF_EXPERT), D_MODEL),
        'moe_w_up': nrm(ks[22], (N_MOE, N_EXPERTS, D_MODEL, D_FF_EXPERT), D_MODEL),
        'moe_w_down': nrm(ks[23], (N_MOE, N_EXPERTS, D_FF_EXPERT, D_MODEL), D_FF_EXPERT),
    }


def reference(x, c, positions, ada_w, ada_b, mix_norm, w_in, cq_norm, ckv_norm, w_uq, w_ukv, q_norm, k_norm,
              w_fnet, out_norm, w_out, ffn_norm, dense_w_gate, dense_w_up, dense_w_down,
              router_w, moe_w_gate, moe_w_up, moe_w_down):
    cos, sin = rope_tables(positions)
    cond = jax.nn.silu(c)
    for l in range(DEPTH):
        mod = (cond @ ada_w[l] + ada_b[l])[:, None, :]
        sh1, sc1, g1, sh2, sc2, g2 = jnp.split(mod, N_MOD, axis=-1)
        x = mixer_sublayer(x, sh1, sc1, g1, cos, sin, mix_norm[l], w_in[l], cq_norm[l], ckv_norm[l],
                           w_uq[l], w_ukv[l], q_norm[l], k_norm[l], w_fnet[l], out_norm[l], w_out[l])
        h = rms_norm(x, ffn_norm[l]) * (1.0 + sc2) + sh2
        if l % 2 == 0:
            j = l // 2
            f = swiglu(h, dense_w_gate[j], dense_w_up[j], dense_w_down[j])
        else:
            j = l // 2
            f = moe_swiglu(h, router_w[j], moe_w_gate[j], moe_w_up[j], moe_w_down[j])
        x = x + g2 * f
    return x
```

```cpp
#include <hip/hip_runtime.h>
#include <cstdio>
#include <cstdint>

#ifndef MK_MULTI
#define MK_MULTI 0
#endif

#define GAS __attribute__((address_space(1)))
#define LAS __attribute__((address_space(3)))
typedef unsigned short bf16_t;
typedef short bf16x8 __attribute__((ext_vector_type(8)));
typedef short s16x4 __attribute__((ext_vector_type(4)));
typedef float f32x4 __attribute__((ext_vector_type(4)));
typedef float f32x2 __attribute__((ext_vector_type(2)));
typedef float f32x16 __attribute__((ext_vector_type(16)));
typedef unsigned u32x4 __attribute__((ext_vector_type(4)));
typedef unsigned u32x2 __attribute__((ext_vector_type(2)));

constexpr int SEQ = 16384, DM = 2048, DIN = 1856, DINP = 2048;
constexpr int QLR = 512, KVLR = 256, ROPE = 64, NOPE = 128, VHD = 128, QKD = 192, NH = 8;
constexpr int ZQ = 0, ZKV = 512, ZKR = 768, ZU = 832;
constexpr int FNW = 1024, FG = 8;
constexpr int DFF = 5632, NE = 8, DFE = 7168;
constexpr int MAXT = 136;
constexpr float RMS_EPS = 1e-6f;
constexpr float S8_H = 8.f, S8_WGU = 64.f, S8_HID = 8.f, S8_WDN = 128.f;
constexpr int NWAVES = 8, NTHR = 512;

constexpr size_t MiB = 1u << 20;
constexpr size_t WS_CTL = 0, CTL_BYTES = 1 * MiB;
constexpr int CW_BAR = 4096;
constexpr int CW_ECNT = 8192;
constexpr size_t CTL_ROWTOK = 256 * 1024;
constexpr size_t WS_MODP = 1 * MiB;
constexpr size_t WS_MODV = WS_MODP + 16 * 2 * 12288 * 4;
constexpr size_t WS_COS = 3 * MiB, WS_SIN = 5 * MiB;
constexpr size_t WS_TW = 7 * MiB;
constexpr size_t WS_FM = WS_TW + 131072;
constexpr size_t WS_GM = WS_FM + 65536;
constexpr size_t WS_M12 = 8 * MiB;
constexpr size_t WS_TOKINFO = 9 * MiB;
constexpr size_t WS_TOKPOS = WS_TOKINFO + (size_t)SEQ * 32;
constexpr size_t WS_WIN = 10 * MiB;
constexpr size_t WS_WUQ = WS_WIN + 2 * 8 * MiB;
constexpr size_t WS_WUKV = WS_WUQ + 2 * 1536 * 512 * 2;
constexpr size_t WS_WOUT = WS_WUKV + 2 * 2048 * 256 * 2;
constexpr size_t WS_WGUD = WS_WOUT + 2 * 8 * MiB;
constexpr size_t WS_WDND = WS_WGUD + (size_t)11264 * 2048 * 2;
constexpr size_t WS_WGUM = WS_WDND + (size_t)2048 * 5632 * 2;
constexpr size_t WS_WDNM = WS_WGUM + (size_t)8 * 14336 * 2048 * 2;
constexpr size_t WS_H = WS_WDNM + (size_t)8 * 2048 * 7168 * 2;
constexpr size_t WS_Y = WS_H + (size_t)SEQ * 2048 * 2;
constexpr size_t WS_ARENA = WS_Y + (size_t)MAXT * 256 * 2048 * 2;
constexpr size_t WS_Z = WS_ARENA;
constexpr size_t WS_QB = WS_Z + (size_t)SEQ * 2048 * 2;
constexpr size_t WS_KVB = WS_QB + (size_t)SEQ * 1536 * 2;
constexpr size_t WS_KB = WS_KVB + (size_t)SEQ * 2048 * 2;
constexpr size_t WS_A1 = WS_KB + (size_t)SEQ * 1536 * 2;
constexpr size_t WS_YC = WS_A1 + (size_t)SEQ * 2048 * 2;
constexpr size_t WS_HID = WS_ARENA;
constexpr size_t WS_END = WS_ARENA + (size_t)MAXT * 256 * 7168 * 2;
static_assert(WS_YC + (size_t)SEQ * 2048 * 2 <= WS_END, "arena");
static_assert(WS_END <= (size_t)1900 * MiB, "workspace budget");

constexpr int RING_BYTES = 133120;
constexpr int LDS_COND = RING_BYTES;
constexpr int LDS_TRIG = LDS_COND + 8192;
constexpr int LDS_MISC = LDS_TRIG + 1024;
constexpr int LDS_BYTES = 147456;
static_assert(LDS_MISC + 256 <= LDS_BYTES, "LDS map");

#define LDS_WAIT() asm volatile("s_waitcnt lgkmcnt(0)" ::: "memory")
#define VM_WAIT() asm volatile("s_waitcnt vmcnt(0)" ::: "memory")
#define RLX_AGENT __ATOMIC_RELAXED, __HIP_MEMORY_SCOPE_AGENT

__device__ __forceinline__ unsigned cvt_pk_bf16(float lo, float hi) { unsigned r; asm volatile("v_cvt_pk_bf16_f32 %0, %1, %2" : "=v"(r) : "v"(lo), "v"(hi)); return r; }
__device__ __forceinline__ float bf2f(unsigned short b) { return __uint_as_float(((unsigned)b) << 16); }
__device__ __forceinline__ bf16_t f2bf(float f) { return (bf16_t)(cvt_pk_bf16(f, 0.f) & 0xffffu); }
template <int XM> __device__ __forceinline__ float swz_xor(float v) { return __int_as_float(__builtin_amdgcn_ds_swizzle(__float_as_int(v), (XM << 10) | 0x1f)); }
__device__ __forceinline__ float wave_sum(float v) {
    v += swz_xor<1>(v); v += swz_xor<2>(v); v += swz_xor<4>(v); v += swz_xor<8>(v); v += swz_xor<16>(v);
    auto rr = __builtin_amdgcn_permlane32_swap(__float_as_uint(v), __float_as_uint(v), false, false);
    return __uint_as_float(rr[0]) + __uint_as_float(rr[1]);
}

#define XB_TMO      128
#define XB_XCNT(j)  (256  + 64 * (j))
#define XB_XSUB(j)  (1280 + 64 * (j))
#define XB_XGEN(j)  (2304 + 64 * (j))
#define XB_TOP      3328
#define XB_TOPGEN   3392
#define XCD_BAR_WORDS 3456
#define XB_SPIN_CAP (1u << 18)
__device__ __forceinline__ unsigned xb_ld(unsigned* p)              { return __hip_atomic_load(p, __ATOMIC_RELAXED, __HIP_MEMORY_SCOPE_AGENT); }
__device__ __forceinline__ unsigned xb_add(unsigned* p, unsigned v) { return __hip_atomic_fetch_add(p, v, __ATOMIC_RELAXED, __HIP_MEMORY_SCOPE_AGENT); }
__device__ __forceinline__ unsigned xb_xcc_id() { return (unsigned)__builtin_amdgcn_s_getreg((3 << 11) | 20) & 0xFu; }
#define XB_SPIN(cond, bar) do { unsigned _sp = 0; while (cond) { __builtin_amdgcn_s_sleep(1); \
    if ((++_sp & 255u) == 0u) { if (xb_ld(&(bar)[XB_TMO])) break; if (_sp > XB_SPIN_CAP) { atomicAdd(&(bar)[XB_TMO], 1u); break; } } } } while (0)
struct XcdBarrier { unsigned* bar; unsigned x; volatile LAS unsigned* st; };
__device__ __forceinline__ XcdBarrier xcd_barrier_post(unsigned* bar, volatile LAS unsigned* st) {
    XcdBarrier b; b.bar = bar; b.x = xb_xcc_id(); b.st = st;
    if (threadIdx.x == 0) (void)xb_add(&bar[XB_XCNT(b.x)], 1u);
    return b;
}
__device__ __forceinline__ void xcd_barrier_complete(unsigned* bar, unsigned x, unsigned& nloc, unsigned& nx) {
    const unsigned G = gridDim.x * gridDim.y * gridDim.z;
    unsigned sum, cnt, mine, sp = 0u;
    for (;;) {
        sum = 0u; cnt = 0u; mine = 0u;
#pragma unroll
        for (unsigned j = 0; j < 16; ++j) { const unsigned c = xb_ld(&bar[XB_XCNT(j)]); sum += c; cnt += (c > 0u) ? 1u : 0u; mine = (j == x) ? c : mine; }
        if (sum == G) break;
        __builtin_amdgcn_s_sleep(1);
        if ((++sp & 255u) == 0u) { if (xb_ld(&bar[XB_TMO])) break; if (sp > XB_SPIN_CAP) { atomicAdd(&bar[XB_TMO], 1u); break; } }
    }
    nloc = mine > 0u ? mine : 1u; nx = cnt > 0u ? cnt : 1u;
}
__device__ __forceinline__ void xcd_barrier(const XcdBarrier& b) {
    asm volatile("s_waitcnt vmcnt(0)" ::: "memory");
    __syncthreads();
    if (threadIdx.x == 0) {
        unsigned* bar = b.bar;
        __builtin_amdgcn_s_waitcnt(0);
        unsigned nloc = b.st[0], nx = b.st[1];
        if (nloc == 0u) { xcd_barrier_complete(bar, b.x, nloc, nx); b.st[0] = nloc; b.st[1] = nx; }
        const unsigned old = xb_add(&bar[XB_XSUB(b.x)], 1u);
        const unsigned gen = old / nloc;
        if (old + 1u == (gen + 1u) * nloc) {
            __builtin_amdgcn_fence(__ATOMIC_RELEASE, "agent");
            asm volatile("s_waitcnt vmcnt(0)" ::: "memory");
            const unsigned og = xb_add(&bar[XB_TOP], 1u);
            const unsigned tg = og / nx;
            if (og + 1u == (tg + 1u) * nx) xb_add(&bar[XB_TOPGEN], 1u);
            else XB_SPIN(xb_ld(&bar[XB_TOPGEN]) == tg, bar);
            __builtin_amdgcn_fence(__ATOMIC_ACQUIRE, "agent");
            xb_add(&bar[XB_XGEN(b.x)], 1u);
            asm volatile("s_waitcnt vmcnt(0)" ::: "memory");
        } else {
            XB_SPIN(xb_ld(&bar[XB_XGEN(b.x)]) == gen, bar);
            __builtin_amdgcn_fence(__ATOMIC_ACQUIRE, "agent");
            asm volatile("s_waitcnt vmcnt(0)" ::: "memory");
        }
    }
    __syncthreads();
}

namespace pg8 {
constexpr int BM = 256, BK = 64, HALF = 128, HTB = HALF * BK * 2, STAGE_BYTES = 8 * HTB, NXCD = 8, WGM = 8;
__host__ __device__ __forceinline__ int lds_byte(int r, int c) { const int st = (r >> 4) * 2 + (c >> 5), rr = r & 15, cc = c & 31, ob = rr * 64 + cc * 2; return st * 1024 + (ob ^ (((ob >> 9) & 1) << 5)); }
__host__ __device__ __forceinline__ void stage_rc(int b, int& R, int& C) { const int st = b / 1024, sb = b % 1024, swz = sb ^ (((sb >> 9) & 1) << 5); R = (st >> 1) * 16 + swz / 64; C = (st & 1) * 32 + (swz % 64) / 2; }
__host__ __device__ __forceinline__ int perm32(int rho) { const int n = rho >> 4, i = rho & 15; return 8 * (i >> 2) + 4 * n + (i & 3); }

struct Unit { int pm, pn, e, kq; };
struct Gemm { const void* A; const void* Bt; int lda, ldb, K; size_t estrideB; const int* rowmap; int ktB = 0; };

struct TileOrder {
    int nM, nN, nwg, G, c; int ts[9]; bool moe;
    __device__ __forceinline__ void init(int nM_, int nN_, int G_, int c_) { nM = nM_; nN = nN_; nwg = nM * nN; G = G_; c = c_; moe = false; }
    __device__ __forceinline__ bool next(int i, Unit& u) const {
        const long L = (long)i * G + c; if (L >= nwg) return false;
        int wgid = (int)L; { const int q = nwg / NXCD, r = nwg % NXCD, xcd = wgid % NXCD, off = wgid / NXCD; wgid = (xcd < r ? xcd * (q + 1) : r * (q + 1) + (xcd - r) * q) + off; }
        const int nig = WGM * nN, gid = wgid / nig, fm = gid * WGM, gsz = (nM - fm) < WGM ? (nM - fm) : WGM;
        u.pm = fm + ((wgid % nig) % gsz); u.pn = (wgid % nig) / gsz; u.e = 0; u.kq = 0;
        if (moe) {
#pragma unroll
            for (int j = 1; j < 8; ++j) if (u.pm >= ts[j]) u.e = j;
        }
        return true;
    }
};

struct TailOrder {
    int nsub, G, c, pm0; int ts[9];
    __device__ __forceinline__ bool next(int i, Unit& u) const {
        const int L = i * G + c; if (L >= nsub) return false;
        u.kq = L & 3; u.pn = (L >> 2) & 7; u.pm = pm0 + (L >> 5); u.e = 0;
#pragma unroll
        for (int j = 1; j < 8; ++j) if (u.pm >= ts[j]) u.e = j;
        return true;
    }
};
struct EpiBf16 {
    static constexpr bool PERM = true;
    bf16_t* O; int ldc; float scale; bf16_t* O2 = nullptr; size_t kqstride = 0;
    __device__ __forceinline__ void operator()(const f32x4 (&acc)[2][2][4][2], const Unit& u, int wr, int wc, int fr, int fq) const {
        const int row0 = u.pm * BM + wr * 64 + fr, col0 = u.pn * BM + wc * 32 + 8 * fq;
        bf16_t* const Ob = u.kq ? O2 + (size_t)(u.kq - 1) * kqstride : O;
#pragma unroll
        for (int ai = 0; ai < 2; ++ai)
#pragma unroll
            for (int m = 0; m < 4; ++m) { bf16_t* rowp = Ob + (size_t)(row0 + ai * HALF + m * 16) * ldc + col0;
#pragma unroll
                for (int bj = 0; bj < 2; ++bj) { const f32x4 v0 = acc[ai][bj][m][0] * scale, v1 = acc[ai][bj][m][1] * scale;
                    u32x4 w; w.x = cvt_pk_bf16(v0[0], v0[1]); w.y = cvt_pk_bf16(v0[2], v0[3]); w.z = cvt_pk_bf16(v1[0], v1[1]); w.w = cvt_pk_bf16(v1[2], v1[3]);
                    *(u32x4*)(rowp + bj * HALF) = w; } }
    }
};
__device__ __forceinline__ float silu_f(float x) { return x * __builtin_amdgcn_rcpf(1.0f + __builtin_amdgcn_exp2f(-1.4426950408889634f * x)); }
struct EpiSwiGLU {
    static constexpr bool PERM = true;
    bf16_t* O; int ldc;
    __device__ __forceinline__ void operator()(const f32x4 (&acc)[2][2][4][2], const Unit& u, int wr, int wc, int fr, int fq) const {
        const int row0 = u.pm * BM + wr * 64 + fr, col0 = u.pn * HALF + wc * 32 + 8 * fq;
#pragma unroll
        for (int ai = 0; ai < 2; ++ai)
#pragma unroll
            for (int m = 0; m < 4; ++m) { bf16_t* rowp = O + (size_t)(row0 + ai * HALF + m * 16) * ldc + col0;
                f32x4 v0, v1;
#pragma unroll
                for (int j = 0; j < 4; ++j) { v0[j] = silu_f(acc[ai][0][m][0][j]) * acc[ai][1][m][0][j]; v1[j] = silu_f(acc[ai][0][m][1][j]) * acc[ai][1][m][1][j]; }
                u32x4 w; w.x = cvt_pk_bf16(v0[0], v0[1]); w.y = cvt_pk_bf16(v0[2], v0[3]); w.z = cvt_pk_bf16(v1[0], v1[1]); w.w = cvt_pk_bf16(v1[2], v1[3]);
                *(u32x4*)rowp = w; }
    }
};
__device__ __forceinline__ float clamp448(float x) { return __builtin_amdgcn_fmed3f(x, -448.f, 448.f); }
struct EpiSwiGLU8 {
    static constexpr bool PERM = true;
    unsigned char* O; int ldc; float iscale, oscale;
    __device__ __forceinline__ void operator()(const f32x4 (&acc)[2][2][4][2], const Unit& u, int wr, int wc, int fr, int fq) const {
        const int row0 = u.pm * BM + wr * 64 + fr, col0 = u.pn * HALF + wc * 32 + 8 * fq;
#pragma unroll
        for (int ai = 0; ai < 2; ++ai)
#pragma unroll
            for (int m = 0; m < 4; ++m) { unsigned char* rowp = O + (size_t)(row0 + ai * HALF + m * 16) * ldc + col0;
                f32x4 v0, v1;
#pragma unroll
                for (int j = 0; j < 4; ++j) { v0[j] = clamp448(silu_f(acc[ai][0][m][0][j] * iscale) * (acc[ai][1][m][0][j] * iscale) * oscale);
                                              v1[j] = clamp448(silu_f(acc[ai][0][m][1][j] * iscale) * (acc[ai][1][m][1][j] * iscale) * oscale); }
                int w0 = 0, w1 = 0;
                w0 = __builtin_amdgcn_cvt_pk_fp8_f32(v0[0], v0[1], w0, false); w0 = __builtin_amdgcn_cvt_pk_fp8_f32(v0[2], v0[3], w0, true);
                w1 = __builtin_amdgcn_cvt_pk_fp8_f32(v1[0], v1[1], w1, false); w1 = __builtin_amdgcn_cvt_pk_fp8_f32(v1[2], v1[3], w1, true);
                u32x2 w; w.x = (unsigned)w0; w.y = (unsigned)w1; *(u32x2*)rowp = w; }
    }
};
struct EpiRes {
    static constexpr bool PERM = false;
    const float* X; float* O; const float* gate; int ldc;
    __device__ __forceinline__ void operator()(const f32x4 (&acc)[2][2][4][2], const Unit& u, int wr, int wc, int fr, int fq) const {
        const int row0 = u.pm * BM + wr * 64 + fr, col0 = u.pn * BM + wc * 32 + 4 * fq;
        f32x4 gv[2][2];
#pragma unroll
        for (int bj = 0; bj < 2; ++bj)
#pragma unroll
            for (int n = 0; n < 2; ++n) gv[bj][n] = *(const f32x4*)(gate + col0 + bj * HALF + n * 16);
#pragma unroll
        for (int ai = 0; ai < 2; ++ai)
#pragma unroll
            for (int m = 0; m < 4; ++m) { const size_t off = (size_t)(row0 + ai * HALF + m * 16) * ldc + col0;
#pragma unroll
                for (int bj = 0; bj < 2; ++bj)
#pragma unroll
                    for (int n = 0; n < 2; ++n) { const f32x4 xv = *(const f32x4*)(X + off + bj * HALF + n * 16);
                        *(f32x4*)(O + off + bj * HALF + n * 16) = xv + gv[bj][n] * acc[ai][bj][m][n]; }
                asm volatile("" ::: "memory"); }
    }
};

typedef int v8i __attribute__((ext_vector_type(8)));
typedef unsigned u32x8 __attribute__((ext_vector_type(8)));
template <class Epi, class Sched, bool GATHER, bool FP8 = false, bool TILEDB = false>
__device__ __forceinline__ void gemm_phase(const int tid, LAS unsigned char* lds, const Gemm g, const Sched& S, const Epi& E) {
    const int wid = __builtin_amdgcn_readfirstlane(tid >> 6), lane = tid & 63, wr = wid >> 2, wc = wid & 3, fr = lane & 15, fq = lane >> 4;
    constexpr int ESZ = FP8 ? 1 : 2;
    const int nt = g.K * ESZ / (BK * 2);
    unsigned voffA[2], voffB[2];
#pragma unroll
    for (int i = 0; i < 2; ++i) { int R, C; stage_rc(tid * 16 + i * 8192, R, C); const int Rb = Epi::PERM ? ((R & ~31) + perm32(R & 31)) : R;
        voffA[i] = (unsigned)(R * g.lda * ESZ + C * 2); voffB[i] = TILEDB ? (unsigned)(Rb * 128 + C * 2) : (unsigned)(Rb * g.ldb * ESZ + C * 2); }
    const size_t kstep = (size_t)(BK * 2);
    const size_t hstepA = (size_t)HALF * g.lda * ESZ, tstepA = 2 * hstepA;
    const size_t kstepB = TILEDB ? (size_t)32768 : kstep;
    const size_t hstepB = TILEDB ? (size_t)16384 : (size_t)HALF * g.ldb * ESZ, tstepB = TILEDB ? (size_t)(g.ktB ? g.ktB : nt) * 32768 : 2 * hstepB;
    const size_t kqA = (size_t)nt * kstep, kqB = (size_t)nt * kstepB;
    const unsigned ldsw = (unsigned)wid * 1024u;
    const int aoff = lds_byte(wr * 64 + fr, fq * 8), boff = lds_byte(wc * 32 + fr, fq * 8);
#define PG8_SA(b, h) (((b) * 2 + (h)) * HTB)
#define PG8_SB(b, h) ((4 + (b) * 2 + (h)) * HTB)
#define PG8_STAGE(bufoff, gbase, voff) do { _Pragma("unroll") for (int _i = 0; _i < 2; ++_i) \
        __builtin_amdgcn_global_load_lds((const unsigned*)((const char*)(gbase) + (voff)[_i]), (LAS unsigned*)(lds + (bufoff) + ldsw + _i * 8192), 16, 0, 0); } while (0)
#define PG8_STAGE_A(bufoff, UB, h, kb, V0, V1) do { if constexpr (GATHER) { if (h) PG8_STAGE(bufoff, gA + (kb), V1); else PG8_STAGE(bufoff, gA + (kb), V0); } \
        else PG8_STAGE(bufoff, (UB) + (h) * hstepA + (kb), voffA); } while (0)
#define PG8_LD8(P) __builtin_shufflevector(*(const LAS u32x4*)(P), *(const LAS u32x4*)((P) + 1024), 0, 1, 2, 3, 4, 5, 6, 7)
#define PG8_LDA(dst, b, h) do { if constexpr (FP8) { _Pragma("unroll") for (int m = 0; m < 4; ++m) dst##8[m] = PG8_LD8(lds + PG8_SA(b, h) + aoff + m * 2048); } \
        else { _Pragma("unroll") for (int m = 0; m < 4; ++m) _Pragma("unroll") for (int k = 0; k < 2; ++k) dst[m][k] = *(const LAS bf16x8*)(lds + PG8_SA(b, h) + aoff + m * 2048 + k * 1024); } } while (0)
#define PG8_LDB(dst, b, h) do { if constexpr (FP8) { _Pragma("unroll") for (int n = 0; n < 2; ++n) dst##8[n] = PG8_LD8(lds + PG8_SB(b, h) + boff + n * 2048); } \
        else { _Pragma("unroll") for (int n = 0; n < 2; ++n) _Pragma("unroll") for (int k = 0; k < 2; ++k) dst[n][k] = *(const LAS bf16x8*)(lds + PG8_SB(b, h) + boff + n * 2048 + k * 1024); } } while (0)
#define PG8_MMA(ai, bj, At, Bt) do { __builtin_amdgcn_s_setprio(1); _Pragma("unroll") for (int m = 0; m < 4; ++m) _Pragma("unroll") for (int n = 0; n < 2; ++n) { \
        if constexpr (FP8) { asm("v_mfma_scale_f32_16x16x128_f8f6f4 %0, %1, %2, %0, %3, %3 op_sel_hi:[0,0,0]" : "+v"(acc[ai][bj][m][n]) : "v"(Bt##8[n]), "v"(At##8[m]), "v"(sc8)); } \
        else { _Pragma("unroll") for (int k = 0; k < 2; ++k) acc[ai][bj][m][n] = __builtin_amdgcn_mfma_f32_16x16x32_bf16(Bt[n][k], At[m][k], acc[ai][bj][m][n], 0, 0, 0); } } \
        __builtin_amdgcn_s_setprio(0); } while (0)
#define PG8_WAIT_V(n) asm volatile("s_waitcnt vmcnt(" #n ")" ::: "memory")
#define PG8_WAIT_L(n) asm volatile("s_waitcnt lgkmcnt(" #n ")" ::: "memory")
#define PG8_BAR __builtin_amdgcn_s_barrier()
#define PG8_SCHED __builtin_amdgcn_sched_barrier(0)
#define PG8_AOFFS(U, V0, V1) do { _Pragma("unroll") for (int _i = 0; _i < 2; ++_i) { int R_, C_; stage_rc(tid * 16 + _i * 8192, R_, C_); \
        const int r0 = g.rowmap[(U).pm * BM + R_], r1 = g.rowmap[(U).pm * BM + HALF + R_]; \
        V0[_i] = (unsigned)(r0 * g.lda * ESZ + C_ * 2); V1[_i] = (unsigned)(r1 * g.lda * ESZ + C_ * 2); } } while (0)
    Unit cur, nxt; int ui = 0;
    if (!S.next(0, cur)) return;
    f32x4 acc[2][2][4][2];
#pragma unroll
    for (int a = 0; a < 2; ++a)
#pragma unroll
        for (int b = 0; b < 2; ++b)
#pragma unroll
            for (int m = 0; m < 4; ++m)
#pragma unroll
                for (int n = 0; n < 2; ++n) acc[a][b][m][n] = (f32x4){0.f, 0.f, 0.f, 0.f};
    const unsigned sc8 = 0x7f7f7f7fu; (void)sc8;
    bf16x8 At[4][2], B0[2][2], B1[2][2]; u32x8 At8[4], B08[2], B18[2]; (void)At; (void)B0; (void)B1; (void)At8; (void)B08; (void)B18;
    unsigned vc0[2] = {0u, 0u}, vc1[2] = {0u, 0u}, vn0[2] = {0u, 0u}, vn1[2] = {0u, 0u};
    if constexpr (GATHER) PG8_AOFFS(cur, vc0, vc1);
    const char* gA = (const char*)g.A;
    const char* cA = gA + (size_t)cur.pm * tstepA + (size_t)cur.kq * kqA;
    const char* cB = (const char*)g.Bt + (size_t)cur.e * g.estrideB * ESZ + (size_t)cur.pn * tstepB + (size_t)cur.kq * kqB;
    PG8_STAGE(PG8_SB(0, 0), cB, voffB); PG8_STAGE(PG8_SB(0, 1), cB + hstepB, voffB); PG8_STAGE_A(PG8_SA(0, 0), cA, 0, 0, vc0, vc1); PG8_STAGE_A(PG8_SA(0, 1), cA, 1, 0, vc0, vc1);
    if (wr == 1) PG8_BAR;
    PG8_WAIT_V(2); PG8_BAR;
    PG8_STAGE(PG8_SB(1, 0), cB + kstepB, voffB); PG8_STAGE_A(PG8_SA(1, 0), cA, 0, kstep, vc0, vc1); PG8_STAGE(PG8_SB(1, 1), cB + hstepB + kstepB, voffB);
    PG8_WAIT_V(6); PG8_BAR;
    for (;;) {
        const bool has_next = S.next(ui + 1, nxt);
        const char* nA = cA; const char* nB = cB;
        if (has_next) { nA = gA + (size_t)nxt.pm * tstepA + (size_t)nxt.kq * kqA; nB = (const char*)g.Bt + (size_t)nxt.e * g.estrideB * ESZ + (size_t)nxt.pn * tstepB + (size_t)nxt.kq * kqB; }
        if constexpr (GATHER) { if (has_next) PG8_AOFFS(nxt, vn0, vn1); else {
#pragma unroll
            for (int _i = 0; _i < 2; ++_i) { vn0[_i] = vc0[_i]; vn1[_i] = vc1[_i]; } } }
        for (int t = 0; t < nt; t += 2) {
            const bool last = (t == nt - 2);
            const size_t k1 = (size_t)(t + 1) * kstep, k2 = last ? 0 : (size_t)(t + 2) * kstep, k3 = k2 + kstep;
            const char* u2 = last ? nA : cA; const char* b2 = (last ? nB : cB) + (last ? 0 : (size_t)(t + 2) * kstepB); const char* b3 = b2 + kstepB;
            unsigned va0[2] = {0u, 0u}, va1[2] = {0u, 0u};
            if constexpr (GATHER) {
#pragma unroll
                for (int _i = 0; _i < 2; ++_i) { va0[_i] = last ? vn0[_i] : vc0[_i]; va1[_i] = last ? vn1[_i] : vc1[_i]; } }
            PG8_LDB(B0, 0, 0); PG8_LDB(B1, 0, 1); PG8_SCHED; PG8_LDA(At, 0, 0); PG8_STAGE_A(PG8_SA(1, 1), cA, 1, k1, vc0, vc1);
            PG8_WAIT_V(8); PG8_WAIT_L(0); PG8_BAR; PG8_MMA(0, 0, At, B0); PG8_MMA(0, 1, At, B1); PG8_BAR; PG8_SCHED;
            PG8_LDA(At, 0, 1); PG8_STAGE(PG8_SB(0, 0), b2, voffB); PG8_STAGE(PG8_SB(0, 1), b2 + hstepB, voffB); PG8_STAGE_A(PG8_SA(0, 0), u2, 0, k2, va0, va1);
            PG8_WAIT_V(8); PG8_WAIT_L(0); PG8_BAR; PG8_MMA(1, 0, At, B0); PG8_MMA(1, 1, At, B1); PG8_BAR; PG8_SCHED;
            PG8_LDB(B0, 1, 0); PG8_LDB(B1, 1, 1); PG8_SCHED; PG8_LDA(At, 1, 0); PG8_STAGE_A(PG8_SA(0, 1), u2, 1, k2, va0, va1);
            PG8_WAIT_V(8); PG8_WAIT_L(0); PG8_BAR; PG8_MMA(0, 0, At, B0); PG8_MMA(0, 1, At, B1); PG8_BAR; PG8_SCHED;
            PG8_LDA(At, 1, 1); PG8_STAGE(PG8_SB(1, 0), b3, voffB); PG8_STAGE(PG8_SB(1, 1), b3 + hstepB, voffB); PG8_STAGE_A(PG8_SA(1, 0), u2, 0, k3, va0, va1);
            PG8_WAIT_V(8); PG8_WAIT_L(0); PG8_BAR; PG8_MMA(1, 0, At, B0); PG8_MMA(1, 1, At, B1); PG8_BAR; PG8_SCHED;
        }
        if constexpr (FP8) asm volatile("s_nop 15\n\ts_nop 15" ::: "memory");
        if (wr == 0) PG8_BAR;
        { int fr_ = fr, fq_ = fq; asm volatile("" : "+v"(fr_), "+v"(fq_)); E(acc, cur, wr, wc, fr_, fq_); }
        if (!has_next) break;
#pragma unroll
        for (int a = 0; a < 2; ++a)
#pragma unroll
            for (int b = 0; b < 2; ++b)
#pragma unroll
                for (int m = 0; m < 4; ++m)
#pragma unroll
                    for (int n = 0; n < 2; ++n) acc[a][b][m][n] = (f32x4){0.f, 0.f, 0.f, 0.f};
        cur = nxt; cA = nA; cB = nB; ++ui;
        if constexpr (GATHER) {
#pragma unroll
            for (int _i = 0; _i < 2; ++_i) { vc0[_i] = vn0[_i]; vc1[_i] = vn1[_i]; } }
        if (wr == 1) PG8_BAR;
    }
    PG8_WAIT_V(0);
    PG8_BAR;
#undef PG8_SA
#undef PG8_SB
#undef PG8_STAGE
#undef PG8_STAGE_A
#undef PG8_LDA
#undef PG8_LD8
#undef PG8_LDB
#undef PG8_MMA
#undef PG8_WAIT_V
#undef PG8_WAIT_L
#undef PG8_BAR
#undef PG8_SCHED
#undef PG8_AOFFS
}
}

namespace att {
constexpr int NW = 8, QBLK = 32, KVBLK = 64, DQ = QKD, DV = VHD;
constexpr float SCALE = 0.07216878364870322f;
constexpr float THR = 8.f;
constexpr int LDQ = 1536, LDK = 1536, LDV = 2048, LDO = 2048;
constexpr int SHM_V = KVBLK * DV * 2, SHM_K = KVBLK * DQ * 2, SHM_ATTN = 2 * SHM_V + 2 * SHM_K + NW * 64 * 4;
#define KSWZ(row, colB) ((row) * 384 + ((colB) ^ ((((row) >> 1) & 7) << 4)))
#define SBAR() __builtin_amdgcn_sched_barrier(0)
__device__ __forceinline__ int crow(int r, int hi) { return (r & 3) + 8 * (r >> 2) + 4 * hi; }
__device__ __forceinline__ void partialSM(f32x16& p0, f32x16& p1, float& m_reg, float& mn, float& alpha) {
  constexpr float C = SCALE * 1.4426950408889634f;
  float pmax = p0[0];
#pragma unroll
  for (int r = 1; r < 16; ++r) pmax = fmaxf(pmax, p0[r]);
#pragma unroll
  for (int r = 0; r < 16; ++r) pmax = fmaxf(pmax, p1[r]);
  { auto rr = __builtin_amdgcn_permlane32_swap(__float_as_uint(pmax), __float_as_uint(pmax), false, false);
    pmax = fmaxf(__uint_as_float(rr[0]), __uint_as_float(rr[1])); }
  if (__builtin_expect(__all(pmax - m_reg <= THR / SCALE), 1)) { mn = m_reg; alpha = 1.f; }
  else { mn = fmaxf(m_reg, pmax); alpha = __builtin_amdgcn_exp2f((m_reg - mn) * C); m_reg = mn; }
  float mnC = -mn * C;
#pragma unroll
  for (int r = 0; r < 16; ++r) p0[r] = fmaf(p0[r], C, mnC);
#pragma unroll
  for (int r = 0; r < 16; ++r) p1[r] = fmaf(p1[r], C, mnC);
#pragma unroll
  for (int r = 0; r < 16; ++r) p0[r] = __builtin_amdgcn_exp2f(p0[r]);
}
__device__ __forceinline__ void finishSM(f32x16& p0, f32x16& p1, float alpha, float& l_reg, bf16x8& pa0, bf16x8& pa1, bf16x8& pa2, bf16x8& pa3) {
#pragma unroll
  for (int r = 0; r < 16; ++r) p1[r] = __builtin_amdgcn_exp2f(p1[r]);
  float ps = 0;
#pragma unroll
  for (int r = 0; r < 16; ++r) ps += p0[r];
#pragma unroll
  for (int r = 0; r < 16; ++r) ps += p1[r];
  { auto rr = __builtin_amdgcn_permlane32_swap(__float_as_uint(ps), __float_as_uint(ps), false, false);
    ps = __uint_as_float(rr[0]) + __uint_as_float(rr[1]); }
  l_reg = l_reg * alpha + ps;
#define PK4(P, BASE, OUT) do { unsigned a0 = cvt_pk_bf16(P[BASE + 0], P[BASE + 1]), a1 = cvt_pk_bf16(P[BASE + 2], P[BASE + 3]);   \
    unsigned b0 = cvt_pk_bf16(P[BASE + 4], P[BASE + 5]), b1 = cvt_pk_bf16(P[BASE + 6], P[BASE + 7]);                              \
    auto r0 = __builtin_amdgcn_permlane32_swap(a0, b0, false, false); auto r1 = __builtin_amdgcn_permlane32_swap(a1, b1, false, false); \
    u32x4 w = {r0[0], r1[0], r0[1], r1[1]}; OUT = *reinterpret_cast<bf16x8*>(&w); } while (0)
  PK4(p0, 0, pa0); PK4(p0, 8, pa1); PK4(p1, 0, pa2); PK4(p1, 8, pa3);
#undef PK4
}
__device__ __forceinline__ void qkt(f32x16& p0, f32x16& p1, const char* Ks, const bf16x8* qr, int r32, int hi) {
  p0 = f32x16{}; p1 = f32x16{};
#pragma unroll
  for (int d0 = 0; d0 < DQ / 16; ++d0) { int cb = (d0 * 16 + hi * 8) * 2;
    bf16x8 b0 = *reinterpret_cast<const bf16x8*>(Ks + KSWZ(r32, cb));
    bf16x8 b1 = *reinterpret_cast<const bf16x8*>(Ks + KSWZ(32 + r32, cb));
    p0 = __builtin_amdgcn_mfma_f32_32x32x16_bf16(b0, qr[d0], p0, 0, 0, 0);
    p1 = __builtin_amdgcn_mfma_f32_32x32x16_bf16(b1, qr[d0], p1, 0, 0, 0);
    if ((d0 & 3) == 3) SBAR(); }
}
__device__ __forceinline__ int v_st(int k, int c) { const int kk = (k & ~0xC) | ((k & 4) << 1) | ((k & 8) >> 1); return ((kk >> 3) * 4 + (c >> 5)) * 512 + ((kk & 7) * 32 + (c & 31)) * 2; }
__device__ __forceinline__ int v_rd_base(int lane) { return ((lane & 3) << 3) | (((lane >> 2) & 3) << 6) | (((lane >> 4) & 1) << 5) | (((lane >> 5) & 1) << 8); }
constexpr int v_rd_off(int d0, int ks, int half) { return d0 * 512 + ks * 4096 + half * 2048; }
template <int OFF> __device__ __forceinline__ s16x4 tr_read(int vb) {
  s16x4 r; asm volatile("ds_read_b64_tr_b16 %0, %1 offset:%2" : "=&v"(r) : "v"(vb), "i"(OFF) : "memory"); return r;
}
template <int D0> __device__ __forceinline__ void pv_one(f32x16& od, int vb, bf16x8 pa0, bf16x8 pa1, bf16x8 pa2, bf16x8 pa3) {
  const s16x4 l0 = tr_read<v_rd_off(D0, 0, 0)>(vb), h0 = tr_read<v_rd_off(D0, 0, 1)>(vb), l1 = tr_read<v_rd_off(D0, 1, 0)>(vb), h1 = tr_read<v_rd_off(D0, 1, 1)>(vb);
  const s16x4 l2 = tr_read<v_rd_off(D0, 2, 0)>(vb), h2 = tr_read<v_rd_off(D0, 2, 1)>(vb), l3 = tr_read<v_rd_off(D0, 3, 0)>(vb), h3 = tr_read<v_rd_off(D0, 3, 1)>(vb);
  asm volatile("s_waitcnt lgkmcnt(0)" ::: "memory"); SBAR();
#define PK(L, H) (bf16x8){L[0], L[1], L[2], L[3], H[0], H[1], H[2], H[3]}
  od = __builtin_amdgcn_mfma_f32_32x32x16_bf16(pa0, PK(l0, h0), od, 0, 0, 0);
  od = __builtin_amdgcn_mfma_f32_32x32x16_bf16(pa1, PK(l1, h1), od, 0, 0, 0);
  od = __builtin_amdgcn_mfma_f32_32x32x16_bf16(pa2, PK(l2, h2), od, 0, 0, 0);
  od = __builtin_amdgcn_mfma_f32_32x32x16_bf16(pa3, PK(l3, h3), od, 0, 0, 0);
#undef PK
}
__device__ __forceinline__ void pv_d0(f32x16* o, int vb, bf16x8 pa0, bf16x8 pa1, bf16x8 pa2, bf16x8 pa3) {
  pv_one<0>(o[0], vb, pa0, pa1, pa2, pa3); pv_one<1>(o[1], vb, pa0, pa1, pa2, pa3); pv_one<2>(o[2], vb, pa0, pa1, pa2, pa3); pv_one<3>(o[3], vb, pa0, pa1, pa2, pa3);
}


constexpr int K_OFF = 0, V_OFF = 3 * SHM_K, WS_OFF = V_OFF + 3 * SHM_V, SHM_ATTN2 = WS_OFF + NW * 64 * 4;
__device__ __forceinline__ void qkt_l(f32x16& p0, f32x16& p1, LAS const char* Ks, const bf16x8* qr, int r32, int hi) {
  p0 = f32x16{}; p1 = f32x16{};
  __builtin_amdgcn_s_setprio(1);
  const int swz = ((r32 >> 1) & 7) << 4, rowb = r32 * 384;
  LAS const char* ar[4];
#pragma unroll
  for (int r = 0; r < 4; ++r) ar[r] = Ks + rowb + ((32 * r + 16 * hi) ^ swz);
#pragma unroll
  for (int q = 0; q < DQ / 64; ++q)
#pragma unroll
    for (int r = 0; r < 4; ++r) { const int d0 = 4 * q + r;
      bf16x8 b0 = *reinterpret_cast<LAS const bf16x8*>(ar[r] + 128 * q);
      bf16x8 b1 = *reinterpret_cast<LAS const bf16x8*>(ar[r] + 128 * q + 32 * 384);
      p0 = __builtin_amdgcn_mfma_f32_32x32x16_bf16(b0, qr[d0], p0, 0, 0, 0);
      p1 = __builtin_amdgcn_mfma_f32_32x32x16_bf16(b1, qr[d0], p1, 0, 0, 0);
      if (r == 3 && d0 != DQ / 16 - 1) SBAR(); }
  __builtin_amdgcn_s_setprio(0);
}
__device__ __forceinline__ float psm_max(const f32x16& p) { float m = p[0];
#pragma unroll
  for (int r = 1; r < 16; ++r) m = fmaxf(m, p[r]);
  return m; }
__device__ __forceinline__ void psm_decide(float pmax, float& m_reg, float& mnC, float& alpha) {
  constexpr float C = SCALE * 1.4426950408889634f;
  { auto rr = __builtin_amdgcn_permlane32_swap(__float_as_uint(pmax), __float_as_uint(pmax), false, false);
    pmax = fmaxf(__uint_as_float(rr[0]), __uint_as_float(rr[1])); }
  float mn;
  if (__builtin_expect(__all(pmax - m_reg <= THR / SCALE), 1)) { mn = m_reg; alpha = 1.f; }
  else { mn = fmaxf(m_reg, pmax); alpha = __builtin_amdgcn_exp2f((m_reg - mn) * C); m_reg = mn; }
  mnC = -mn * C;
}
__device__ __forceinline__ void psm_scale(f32x16& p, float mnC) { constexpr float C = SCALE * 1.4426950408889634f;
#pragma unroll
  for (int r = 0; r < 16; ++r) p[r] = fmaf(p[r], C, mnC); }
__device__ __forceinline__ void psm_exp(f32x16& p) {
#pragma unroll
  for (int r = 0; r < 16; ++r) p[r] = __builtin_amdgcn_exp2f(p[r]); }

__device__ __forceinline__ void attn_unit2(const bf16_t* __restrict__ Qb, const bf16_t* __restrict__ Kh, const bf16_t* __restrict__ Vh, bf16_t* __restrict__ Ob, int seq, LAS unsigned char* lds, const int tid) {
  const int wid = __builtin_amdgcn_readfirstlane(tid >> 6), lane = tid & 63, r32 = lane & 31, hi = lane >> 5;
  LAS float* ws = (LAS float*)(lds + WS_OFF) + wid * 64; LAS float* li_l = ws; LAS float* al_l = ws + 32;
  float m_reg = -1e30f, l_reg = 0; f32x16 o[4] = {}; bf16x8 qr[DQ / 16];
  const bf16_t* Qw = Qb + (long)(wid * QBLK + r32) * LDQ + hi * 8;
#pragma unroll
  for (int d0 = 0; d0 < DQ / 16; ++d0) qr[d0] = *reinterpret_cast<const bf16x8*>(Qw + d0 * 16);
  unsigned koff[3], voff[2];
#pragma unroll
  for (int i = 0; i < 3; ++i) { const int b = 1024 * (wid + 8 * i) + 16 * lane, row = b / 384, x = b % 384, cb = x ^ (((row >> 1) & 7) << 4); koff[i] = (unsigned)(row * LDK * 2 + cb); }
#pragma unroll
  for (int i = 0; i < 2; ++i) { const int b = 1024 * (wid + 8 * i) + 16 * lane, st = b >> 9, off = b & 511, kk = (st >> 2) * 8 + (off >> 6), c = (st & 3) * 32 + ((off & 63) >> 1);
    const int k = (kk & ~0xC) | ((kk & 4) << 1) | ((kk & 8) >> 1); voff[i] = (unsigned)(k * LDV * 2 + c * 2); }
  const int NT = seq / KVBLK;
#define DMA_K(t, slot) do { const int t_ = (t) < NT ? (t) : NT - 1; const char* g_ = (const char*)Kh + (size_t)t_ * (KVBLK * LDK * 2); _Pragma("unroll") for (int i_ = 0; i_ < 3; ++i_) \
    __builtin_amdgcn_global_load_lds((const unsigned*)(g_ + koff[i_]), (LAS unsigned*)(lds + K_OFF + (slot) * SHM_K + (wid + 8 * i_) * 1024), 16, 0, 0); } while (0)
#define DMA_V(t, slot) do { const int t_ = (t) < NT ? (t) : NT - 1; const char* g_ = (const char*)Vh + (size_t)t_ * (KVBLK * LDV * 2); _Pragma("unroll") for (int i_ = 0; i_ < 2; ++i_) \
    __builtin_amdgcn_global_load_lds((const unsigned*)(g_ + voff[i_]), (LAS unsigned*)(lds + V_OFF + (slot) * SHM_V + (wid + 8 * i_) * 1024), 16, 0, 0); } while (0)
#define WAITBAR() do { asm volatile("s_waitcnt vmcnt(5) lgkmcnt(0)" ::: "memory"); __builtin_amdgcn_s_barrier(); asm volatile("" ::: "memory"); } while (0)
#define RESC2(a) do { if (__any((a) < 1.f)) { if (hi == 0) al_l[r32] = (a); asm volatile("s_waitcnt lgkmcnt(0)" ::: "memory"); \
    _Pragma("unroll") for (int d = 0; d < 4; ++d) _Pragma("unroll") for (int r = 0; r < 16; ++r) o[d][r] *= al_l[crow(r, hi)]; } } while (0)
  const int vbase = (int)(uintptr_t)(lds + V_OFF) + v_rd_base(lane);
  f32x16 pA0, pA1, pB0, pB1; float mnA, mnB, alA, alB; bf16x8 pa0, pa1, pa2, pa3; (void)mnA; (void)mnB;
  DMA_K(0, 0); DMA_K(1, 1); DMA_V(0, 0);
  WAITBAR();
  DMA_K(2, 2); DMA_V(1, 1);
  qkt_l(pA0, pA1, (LAS const char*)(lds + K_OFF), qr, r32, hi); partialSM(pA0, pA1, m_reg, mnA, alA);
  WAITBAR();
  int a = 1;
  for (int t = 1; t + 1 < NT; t += 2) {
    { const int kd = (a + 2) % 3, vd = (a + 1) % 3;
      DMA_K(t + 2, kd); DMA_V(t + 1, vd);
      SBAR(); qkt_l(pB0, pB1, (LAS const char*)(lds + K_OFF + a * SHM_K), qr, r32, hi);
      finishSM(pA0, pA1, alA, l_reg, pa0, pa1, pa2, pa3); SBAR();
      pv_d0(o, vbase + kd * SHM_V, pa0, pa1, pa2, pa3); partialSM(pB0, pB1, m_reg, mnB, alB);
      RESC2(alB); WAITBAR(); a = (a + 1) % 3; }
    { const int kd = (a + 2) % 3, vd = (a + 1) % 3;
      DMA_K(t + 3, kd); DMA_V(t + 2, vd);
      SBAR(); qkt_l(pA0, pA1, (LAS const char*)(lds + K_OFF + a * SHM_K), qr, r32, hi);
      finishSM(pB0, pB1, alB, l_reg, pa0, pa1, pa2, pa3); SBAR();
      pv_d0(o, vbase + kd * SHM_V, pa0, pa1, pa2, pa3); partialSM(pA0, pA1, m_reg, mnA, alA);
      RESC2(alA); WAITBAR(); a = (a + 1) % 3; }
  }
  { const int kd = (a + 2) % 3, vd = (a + 1) % 3;
    DMA_K(NT - 1, kd); DMA_V(NT - 1, vd);
    SBAR(); qkt_l(pB0, pB1, (LAS const char*)(lds + K_OFF + a * SHM_K), qr, r32, hi);
    finishSM(pA0, pA1, alA, l_reg, pa0, pa1, pa2, pa3); SBAR();
    pv_d0(o, vbase + kd * SHM_V, pa0, pa1, pa2, pa3); partialSM(pB0, pB1, m_reg, mnB, alB);
    RESC2(alB); WAITBAR(); a = (a + 1) % 3; }
  { const int kd = (a + 2) % 3;
    finishSM(pB0, pB1, alB, l_reg, pa0, pa1, pa2, pa3); SBAR();
    pv_d0(o, vbase + kd * SHM_V, pa0, pa1, pa2, pa3); }
  if (hi == 0) li_l[r32] = l_reg; asm volatile("s_waitcnt lgkmcnt(0)" ::: "memory");
  float rli[16];
#pragma unroll
  for (int r = 0; r < 16; ++r) rli[r] = __builtin_amdgcn_rcpf(li_l[crow(r, hi)]);
  bf16_t* Ow = Ob + (long)(wid * QBLK) * LDO;
#pragma unroll
  for (int r = 0; r < 16; ++r) { int orow = crow(r, hi);
#pragma unroll
    for (int d0 = 0; d0 < 4; ++d0) Ow[(long)orow * LDO + d0 * 32 + r32] = f2bf(o[d0][r] * rli[r]); }
  asm volatile("s_waitcnt vmcnt(0) lgkmcnt(0)" ::: "memory"); __builtin_amdgcn_s_barrier(); asm volatile("" ::: "memory");
#undef DMA_K
#undef DMA_V
#undef WAITBAR
#undef RESC2
}
}

namespace sg {
using att::v_st; using att::v_rd_base; using att::pv_d0; using att::crow;
template <int KK> __device__ __forceinline__ void load_b(bf16x8* v, const bf16_t* Bsrc, size_t ldb, const int tid) {
    const int n = (tid & 15) * 8;
#pragma unroll
    for (int i = 0; i < KK / 32; ++i) { const int k = (tid >> 4) + 32 * i; v[i] = *(const bf16x8*)(Bsrc + (size_t)k * ldb + n); }
}
template <int KK> __device__ __forceinline__ void write_b(const bf16x8* v, char* lds, const int tid) {
    const int n = (tid & 15) * 8;
#pragma unroll
    for (int i = 0; i < KK / 32; ++i) { const int k = (tid >> 4) + 32 * i; *(bf16x8*)(lds + (k >> 6) * 16384 + v_st(k & 63, n)) = v[i]; }
}
template <int KK> __device__ __forceinline__ void stage_b(const bf16_t* Bsrc, size_t ldb, char* lds, const int tid) { bf16x8 v[KK / 32]; load_b<KK>(v, Bsrc, ldb, tid); write_b<KK>(v, lds, tid); }
constexpr int OST_PITCH = 272, OST_WAVE = 32 * OST_PITCH, OST_OFF = 65536;
template <class RowPtr>
__device__ __forceinline__ void store_tile(const f32x16* o, LAS unsigned char* ost, int lane, const RowPtr& rowptr) {
    const int r32 = lane & 31, hi = lane >> 5; const bool odd = lane & 1;
#pragma unroll
    for (int pr = 0; pr < 8; ++pr)
#pragma unroll
        for (int d0 = 0; d0 < 4; ++d0) { const float a = o[d0][2 * pr], b = o[d0][2 * pr + 1];
            const float x = odd ? a : b;
            const float y = __int_as_float(__builtin_amdgcn_mov_dpp(__float_as_int(x), 0xB1, 0xf, 0xf, true));
            const unsigned w = odd ? cvt_pk_bf16(y, b) : cvt_pk_bf16(a, y);
            const int row = crow(odd ? 2 * pr + 1 : 2 * pr, hi);
            *(LAS unsigned*)(ost + row * OST_PITCH + (32 * d0 + (r32 & ~1)) * 2) = w; }
    asm volatile("s_waitcnt lgkmcnt(0)" ::: "memory");
#pragma unroll
    for (int j = 0; j < 8; ++j) { const int i = (lane >> 4) + 4 * j; const u32x4 v = *(const LAS u32x4*)(ost + i * OST_PITCH + (lane & 15) * 16);
        *(u32x4*)(rowptr(i) + (lane & 15) * 8) = v; }
    asm volatile("s_waitcnt lgkmcnt(0)" ::: "memory");
}
struct RowF1 { bf16_t* a1; int wave, s2, cc; __device__ __forceinline__ bf16_t* operator()(int i) const { return a1 + ((size_t)(32 * wave + i) * 128 + s2) * 1024 + cc * 128; } };
struct RowF2 { bf16_t* yc; int wave, k1, g; __device__ __forceinline__ bf16_t* operator()(int i) const { const int m = 32 * wave + i; return yc + (size_t)(k1 + 128 * (m & 127)) * 2048 + g * 256 + (m >> 7) * 128; } };
struct RowF3 { bf16_t* hb; int wave, tt, g; __device__ __forceinline__ bf16_t* operator()(int i) const { return hb + (size_t)(256 * tt + 32 * wave + i) * 2048 + 1024 + g * 128; } };
template <int KK> __device__ __forceinline__ void mm(f32x16* o, const bf16x8* A, char* lds, int lane) {
    const int vb0 = (int)(uintptr_t)lds + v_rd_base(lane);
#pragma unroll
    for (int t = 0; t < KK / 64; ++t) pv_d0(o, vb0 + t * 16384, A[4 * t], A[4 * t + 1], A[4 * t + 2], A[4 * t + 3]);
}
}

struct Args { const void* in[24]; float* out; unsigned char* ws; int ph_lo, ph_hi; };

__device__ __forceinline__ u32x2 pack4(f32x4 v) { u32x2 w; w.x = cvt_pk_bf16(v[0], v[1]); w.y = cvt_pk_bf16(v[2], v[3]); return w; }

template <bool FP8, bool TILED = false>
__device__ __forceinline__ void cvt_pair(const float* W, int N, void* WT, int ldd, int k0, int n0, int drow0, float scale, LAS float* scr, int lane) {
    const int lr = lane >> 4, lc = (lane & 15) * 4;
    f32x4 v[2][16];
#pragma unroll
    for (int t = 0; t < 2; ++t)
#pragma unroll
        for (int i = 0; i < 16; ++i) v[t][i] = *(const f32x4*)(W + (size_t)(k0 + 64 * t + 4 * i + lr) * N + n0 + lc);
    const int c = lane & 7;
#pragma unroll
    for (int t = 0; t < 2; ++t) {
#pragma unroll
        for (int i = 0; i < 16; ++i) { LAS float* s = scr + (4 * i + lr) * 65 + lc; s[0] = v[t][i][0]; s[1] = v[t][i][1]; s[2] = v[t][i][2]; s[3] = v[t][i][3]; }
        LDS_WAIT(); asm volatile("" ::: "memory");
#pragma unroll
        for (int j = 0; j < 8; ++j) { const int n = (lane >> 3) + 8 * j; const LAS float* s = scr + (8 * c) * 65 + n;
            if constexpr (!FP8) { u32x4 o; o.x = cvt_pk_bf16(s[0 * 65], s[1 * 65]); o.y = cvt_pk_bf16(s[2 * 65], s[3 * 65]); o.z = cvt_pk_bf16(s[4 * 65], s[5 * 65]); o.w = cvt_pk_bf16(s[6 * 65], s[7 * 65]);
                *(u32x4*)((bf16_t*)WT + (size_t)(drow0 + n) * ldd + k0 + 64 * t + 8 * c) = o; }
            else { int w0 = 0, w1 = 0;
                w0 = __builtin_amdgcn_cvt_pk_fp8_f32(pg8::clamp448(s[0 * 65] * scale), pg8::clamp448(s[1 * 65] * scale), w0, false); w0 = __builtin_amdgcn_cvt_pk_fp8_f32(pg8::clamp448(s[2 * 65] * scale), pg8::clamp448(s[3 * 65] * scale), w0, true);
                w1 = __builtin_amdgcn_cvt_pk_fp8_f32(pg8::clamp448(s[4 * 65] * scale), pg8::clamp448(s[5 * 65] * scale), w1, false); w1 = __builtin_amdgcn_cvt_pk_fp8_f32(pg8::clamp448(s[6 * 65] * scale), pg8::clamp448(s[7 * 65] * scale), w1, true);
                u32x2 o; o.x = (unsigned)w0; o.y = (unsigned)w1;
                if constexpr (TILED) { const int dr = drow0 + n;
                    *(u32x2*)((unsigned char*)WT + ((size_t)(dr >> 8) * (ldd >> 7) + (k0 >> 7)) * 32768 + (dr & 255) * 128 + 64 * t + 8 * c) = o; }
                else *(u32x2*)((unsigned char*)WT + (size_t)(drow0 + n) * ldd + k0 + 64 * t + 8 * c) = o; } }
        LDS_WAIT(); asm volatile("" ::: "memory");
    }
}

typedef __attribute__((address_space(4))) const char* karg_cptr;
__device__ __forceinline__ void* karg_ptr(int k) {
    karg_cptr p = (karg_cptr)__builtin_amdgcn_kernarg_segment_ptr();
    asm volatile("" : "+s"(p));
    typedef void* voidp_t; typedef __attribute__((address_space(4))) const voidp_t* karg_vpp;
    return *(karg_vpp)(p + 8 * k);
}
__global__ void __launch_bounds__(NTHR, 2) mk_fwd(Args args) {
    extern __shared__ __attribute__((aligned(16))) unsigned char lds_raw[];
    LAS unsigned char* lds = (LAS unsigned char*)lds_raw;
    volatile LAS unsigned* MISC = (volatile LAS unsigned*)(lds + LDS_MISC);
    const int wave0 = __builtin_amdgcn_readfirstlane((int)threadIdx.x >> 6);
    const int G = gridDim.x, bx0 = blockIdx.x, NGW = G * NWAVES;
#define PHASE_IDS() int lane_; asm volatile("v_mbcnt_lo_u32_b32 %0, -1, 0\n\tv_mbcnt_hi_u32_b32 %0, -1, %0" : "=v"(lane_)); int wave_ = wave0; asm volatile("" : "+s"(wave_)); \
    int bx = bx0; asm volatile("" : "+s"(bx)); int tid = wave_ * 64 + lane_; \
    const int lane = lane_, wave = wave_; \
    const int vcu = (G % 8 == 0) ? (bx % 8) * (G / 8) + bx / 8 : bx; const int gw = vcu * NWAVES + wave; (void)lane; (void)gw
    for (int u = threadIdx.x; u < 64; u += NTHR) MISC[u] = 0u;
    __syncthreads();
    unsigned* const barw = (unsigned*)((unsigned char*)karg_ptr(25) + WS_CTL) + CW_BAR;
    XcdBarrier bar; bar.bar = barw; bar.x = 0; bar.st = nullptr;
#if !MK_MULTI
    bar = xcd_barrier_post(barw, MISC + 8);
#endif
    const int lo = args.ph_lo, hi = args.ph_hi;
#ifndef PH_MASK
#define PH_MASK 0xffffffffu
#endif
#define IN(k) (lo <= (k) && (k) < hi && ((PH_MASK >> ((k) > 15 ? (k) - 16 : (k))) & 1u))
#if MK_MULTI
#define SEAM(k) do { } while (0)
#else
#define SEAM(k) do { if ((k) + 1 < hi) xcd_barrier(bar); } while (0)
#endif
#define KARG(k) (karg_ptr(k))
#define x_in ((const float*)KARG(0))
#define c_in ((const float*)KARG(1))
#define pos_in ((const int*)KARG(2))
#define ada_w ((const float*)KARG(3))
#define ada_b ((const float*)KARG(4))
#define mix_norm ((const float*)KARG(5))
#define w_in ((const float*)KARG(6))
#define cq_norm ((const float*)KARG(7))
#define ckv_norm ((const float*)KARG(8))
#define w_uq ((const float*)KARG(9))
#define w_ukv ((const float*)KARG(10))
#define q_norm ((const float*)KARG(11))
#define k_norm ((const float*)KARG(12))
#define w_fnet ((const float*)KARG(13))
#define out_norm ((const float*)KARG(14))
#define w_out ((const float*)KARG(15))
#define ffn_norm ((const float*)KARG(16))
#define dw_gate ((const float*)KARG(17))
#define dw_up ((const float*)KARG(18))
#define dw_down ((const float*)KARG(19))
#define router_w ((const float*)KARG(20))
#define mw_gate ((const float*)KARG(21))
#define mw_up ((const float*)KARG(22))
#define mw_down ((const float*)KARG(23))
#define out ((float*)KARG(24))
#define WSB ((unsigned char*)KARG(25))
#define ctl ((unsigned*)(WSB + WS_CTL))
#define MODP ((float*)(WSB + WS_ARENA))
#define MODV ((float*)(WSB + WS_MODV))
#define COS ((float*)(WSB + WS_COS))
#define SIN ((float*)(WSB + WS_SIN))
#define TW ((f32x2*)(WSB + WS_TW))
#define FM ((bf16_t*)(WSB + WS_FM))
#define GM ((bf16_t*)(WSB + WS_GM))
#define M12 ((bf16_t*)(WSB + WS_M12))
#define TOKINFO ((int*)(WSB + WS_TOKINFO))
#define TOKPOS ((int*)(WSB + WS_TOKPOS))
#define BLKCNT ((int*)(WSB + WS_TOKPOS + (size_t)SEQ * 8))
#define ROWTOK ((int*)(WSB + CTL_ROWTOK))
#define WIN ((bf16_t*)(WSB + WS_WIN))
#define WUQ ((bf16_t*)(WSB + WS_WUQ))
#define WUKV ((bf16_t*)(WSB + WS_WUKV))
#define WOUT ((bf16_t*)(WSB + WS_WOUT))
#define WGUD ((bf16_t*)(WSB + WS_WGUD))
#define WDND ((bf16_t*)(WSB + WS_WDND))
#define WGUM ((bf16_t*)(WSB + WS_WGUM))
#define WDNM ((bf16_t*)(WSB + WS_WDNM))
#define HB ((bf16_t*)(WSB + WS_H))
#define YB ((bf16_t*)(WSB + WS_Y))
#define ZB ((bf16_t*)(WSB + WS_Z))
#define QB ((bf16_t*)(WSB + WS_QB))
#define KVB ((bf16_t*)(WSB + WS_KVB))
#define KB ((bf16_t*)(WSB + WS_KB))
#define A1 ((bf16_t*)(WSB + WS_A1))
#define YC ((bf16_t*)(WSB + WS_YC))
#define HID ((bf16_t*)(WSB + WS_HID))
#define YPART ((bf16_t*)(WSB + WS_ARENA + 256 * MiB))

    if (IN(0)) {
        PHASE_IDS();
        LAS float* cond = (LAS float*)(lds + LDS_COND); LAS float* trig = (LAS float*)(lds + LDS_TRIG);
        for (int i = tid; i < DM; i += NTHR) { const float c = c_in[i]; cond[i] = c / (1.0f + __expf(-c)); }
        if (tid < 128) { trig[tid] = (float)cospi(2.0 * tid / 128.0); trig[128 + tid] = (float)sinpi(2.0 * tid / 128.0); }
        __syncthreads();
        LAS float* scr = (LAS float*)(lds + wave * 16640);
        constexpr int I_GEMV = 2 * 48 * 64;
        constexpr int I_WIN = 16 * 29, I_WUQ = 4 * 24, I_WUKV = 2 * 32, I_WOUT = 16 * 32;
        constexpr int I_DGU = 16 * 88, I_DDN = 44 * 32, I_MGU = 16 * 112, I_MDN = 56 * 32;
        constexpr int I_ZERO = 2 * 192;
        constexpr int I_ROPE = SEQ * 32 / 64;
        constexpr int I_TW = 16384 / 64, I_FM = 32768 / 64, I_GM = 65536 / 64, I_M12 = 2 * 8 * 256 * 128 / 64;
        constexpr int NITEMS = I_GEMV + 2 * (I_WIN + I_WUQ + I_WUKV + I_WOUT) + 2 * I_DGU + I_DDN + 16 * I_MGU + 8 * I_MDN + I_ZERO + I_ROPE + I_TW + I_FM + I_GM + I_M12;
        for (int it = gw; it < NITEMS; it += NGW) {
            int r = it;
            if (r < I_GEMV) {
                const int kc = r & 63, cb = r >> 6, l = cb / 48, n0 = (cb % 48) * 256 + 4 * lane;
                const float* W = ada_w + ((size_t)l * DM + kc * 32) * 12288 + n0;
                f32x4 a = {0.f, 0.f, 0.f, 0.f};
                f32x4 v[32];
#pragma unroll
                for (int k = 0; k < 32; ++k) v[k] = *(const f32x4*)(W + (size_t)k * 12288);
#pragma unroll
                for (int k = 0; k < 32; ++k) a += v[k] * cond[kc * 32 + k];
                *(f32x4*)(MODP + ((size_t)kc * 2 + l) * 12288 + n0) = a;
                continue;
            } r -= I_GEMV;
            bool done = false;
#pragma unroll 1
            for (int l = 0; l < 2 && !done; ++l) {
                if (r < I_WIN) { const int kb = r / 29, nb = r % 29; cvt_pair<false>(w_in + (size_t)l * DM * DIN, DIN, WIN + (size_t)l * DINP * DM, DM, 128 * kb, 64 * nb, 64 * nb, 1.f, scr, lane); done = true; break; } r -= I_WIN;
                if (r < I_WUQ) { const int kb = r / 24, nb = r % 24; cvt_pair<false>(w_uq + (size_t)l * QLR * 1536, 1536, WUQ + (size_t)l * 1536 * QLR, QLR, 128 * kb, 64 * nb, 64 * nb, 1.f, scr, lane); done = true; break; } r -= I_WUQ;
                if (r < I_WUKV) { const int kb = r / 32, nb = r % 32; cvt_pair<false>(w_ukv + (size_t)l * KVLR * 2048, 2048, WUKV + (size_t)l * 2048 * KVLR, KVLR, 128 * kb, 64 * nb, 64 * nb, 1.f, scr, lane); done = true; break; } r -= I_WUKV;
                if (r < I_WOUT) { const int kb = r / 32, nb = r % 32; cvt_pair<false>(w_out + (size_t)l * DM * DM, DM, WOUT + (size_t)l * DM * DM, DM, 128 * kb, 64 * nb, 64 * nb, 1.f, scr, lane); done = true; break; } r -= I_WOUT;
            }
            if (done) continue;
            if (r < 2 * I_DGU) { const int up = r / I_DGU, rr = r % I_DGU, kb = rr / 88, nb = rr % 88, n0 = 64 * nb;
                cvt_pair<false>(up ? dw_up : dw_gate, DFF, WGUD, DM, 128 * kb, n0, (n0 >> 7) * 256 + (n0 & 127) + up * 128, 1.f, scr, lane); continue; } r -= 2 * I_DGU;
            if (r < I_DDN) { const int kb = r / 32, nb = r % 32; cvt_pair<false>(dw_down, DM, WDND, DFF, 128 * kb, 64 * nb, 64 * nb, 1.f, scr, lane); continue; } r -= I_DDN;
            if (r < 16 * I_MGU) { const int e = r / (2 * I_MGU), r2 = r % (2 * I_MGU), up = r2 / I_MGU, rr = r2 % I_MGU, kb = rr / 112, nb = rr % 112, n0 = 64 * nb;
                cvt_pair<true, true>((up ? mw_up : mw_gate) + (size_t)e * DM * DFE, DFE, (unsigned char*)WGUM + (size_t)e * 14336 * DM, DM, 128 * kb, n0, (n0 >> 7) * 256 + (n0 & 127) + up * 128, S8_WGU, scr, lane); continue; } r -= 16 * I_MGU;
            if (r < 8 * I_MDN) { const int e = r / I_MDN, rr = r % I_MDN, kb = rr / 32, nb = rr % 32;
                cvt_pair<true, true>(mw_down + (size_t)e * DFE * DM, DM, (unsigned char*)WDNM + (size_t)e * DM * DFE, DFE, 128 * kb, 64 * nb, 64 * nb, S8_WDN, scr, lane); continue; } r -= 8 * I_MDN;
            if (r < I_ZERO) { const int l = r / 192, row = 1856 + r % 192; u32x4 z = {0u, 0u, 0u, 0u};
#pragma unroll
                for (int j = 0; j < 4; ++j) *(u32x4*)(WIN + ((size_t)l * DINP + row) * DM + (lane + 64 * j) * 8) = z;
                continue; } r -= I_ZERO;
            if (r < I_ROPE) { const int idx = r * 64 + lane, t = idx >> 5, i = idx & 31;
                const double inv = exp2(-(double)i * (13.287712379549449 / 32.0));
                const double ang = (double)pos_in[t] * inv; double sn, cs; sincos(ang, &sn, &cs);
                COS[idx] = (float)cs; SIN[idx] = (float)sn; continue; } r -= I_ROPE;
            if (r < I_TW) { const int idx = r * 64 + lane, s2 = idx >> 7, k1 = idx & 127; const int m = (s2 * k1) & 16383;
                double sn, cs; sincospi(2.0 * (double)m / 16384.0, &sn, &cs); TW[idx] = (f32x2){(float)cs, (float)(-sn)}; continue; } r -= I_TW;
            if (r < I_FM) { const int idx = r * 64 + lane, m = idx >> 7, s1 = idx & 127, k1 = m >> 1, ri = m & 1; const int ph = (k1 * s1) & 127;
                const float v = (ri ? -trig[128 + ph] : trig[ph]) * 0.08838834764831845f; FM[idx] = f2bf(v); continue; } r -= I_FM;
            if (r < I_GM) { const int idx = r * 64 + lane, m = idx >> 8, k = idx & 255, ro = m >> 7, k2 = m & 127, rin = k >> 7, s2 = k & 127; const int ph = (k2 * s2) & 127;
                float v = (ro == rin) ? trig[ph] : (ro == 0 ? trig[128 + ph] : -trig[128 + ph]);
                GM[idx] = f2bf(v * 0.08838834764831845f); continue; } r -= I_GM;
            {
                const int idx = r * 64 + lane, d = idx & 127, kk = (idx >> 7) & 255, lg = idx >> 15, ri = kk >> 7, c = kk & 127;
                const float* Wf = w_fnet + (size_t)lg * 128 * 128 + d; float a = 0.f;
                for (int m = 0; m < 128; ++m) a += trig[ri * 128 + ((m * c) & 127)] * Wf[m * 128];
                M12[idx] = f2bf(a * 0.08838834764831845f);
            }
        }
        SEAM(0);
    }
    if (IN(1)) {
        PHASE_IDS();
        for (int i = (bx * NTHR + tid); i < 2 * 12288; i += G * NTHR) { float a = ada_b[i];
#pragma unroll
            for (int k = 0; k < 64; ++k) a += MODP[(size_t)k * 2 * 12288 + i];
            MODV[i] = a; }
        SEAM(1);
    }

#pragma unroll 1
    for (int l = 0; l < 2; ++l) {
        const int pb = 2 + 16 * l;
#define modv (MODV + (size_t)l * 12288)
#define xcur ((l == 0) ? x_in : (const float*)out)
#pragma unroll 1
        for (int sub = 0; sub < 2; ++sub) {
            const int ph = pb + (sub ? 8 : 0);
            if (IN(ph)) {
                PHASE_IDS();
                const float* xs = sub ? (const float*)out : xcur;
                const float* gain = (sub ? ffn_norm : mix_norm) + (size_t)l * DM;
                const float* shv = modv + (sub ? 3 : 0) * DM; const float* scv = modv + (sub ? 4 : 1) * DM;
                const bool router = (sub == 1 && l == 1);
                LAS float* wr_l = (LAS float*)lds;
                LAS int* etab = (LAS int*)(lds + 65536); LAS int* rtab = (LAS int*)(lds + 65536 + 4096);
                if (router) { etab[tid] = 0xffff;
                    for (int i = tid; i < DM * NE / 4; i += NTHR) ((LAS f32x4*)wr_l)[i] = ((const f32x4*)router_w)[i]; }
                __syncthreads();
                f32x4 av[8], bv[8];
#pragma unroll
                for (int j = 0; j < 8; ++j) { const f32x4 g4 = ((const f32x4*)gain)[lane + 64 * j], s4 = ((const f32x4*)scv)[lane + 64 * j]; av[j] = g4 * (1.0f + s4); bv[j] = ((const f32x4*)shv)[lane + 64 * j]; }
                int my_e0 = 0, my_e1 = 0, my_tok = -1; float my_w0 = 0.f, my_w1 = 0.f; int itn = 0;
                for (int m = gw; m < SEQ; m += NGW, ++itn) {
                    f32x4 v[8]; float ss = 0.f;
#pragma unroll
                    for (int j = 0; j < 8; ++j) { v[j] = ((const f32x4*)(xs + (size_t)m * DM))[lane + 64 * j]; ss += (v[j][0] * v[j][0] + v[j][1] * v[j][1]) + (v[j][2] * v[j][2] + v[j][3] * v[j][3]); }
                    const float rstd = 1.0f / sqrtf(wave_sum(ss) * (1.0f / DM) + RMS_EPS);
#pragma unroll
                    for (int j = 0; j < 8; ++j) { v[j] = v[j] * rstd * av[j] + bv[j];
                        if (router) { int w8 = 0; w8 = __builtin_amdgcn_cvt_pk_fp8_f32(pg8::clamp448(v[j][0] * S8_H), pg8::clamp448(v[j][1] * S8_H), w8, false); w8 = __builtin_amdgcn_cvt_pk_fp8_f32(pg8::clamp448(v[j][2] * S8_H), pg8::clamp448(v[j][3] * S8_H), w8, true);
                            *(unsigned*)((unsigned char*)HB + (size_t)m * DM + 4 * lane + 256 * j) = (unsigned)w8; }
                        else *(u32x2*)(HB + (size_t)m * DM + 4 * lane + 256 * j) = pack4(v[j]); }
                    if (router) {
                        float lg[8] = {0.f, 0.f, 0.f, 0.f, 0.f, 0.f, 0.f, 0.f};
#pragma unroll
                        for (int j = 0; j < 8; ++j)
#pragma unroll
                            for (int q = 0; q < 4; ++q) { const int k = 4 * lane + 256 * j + q; const f32x4 w0 = *(const LAS f32x4*)(wr_l + k * 8), w1 = *(const LAS f32x4*)(wr_l + k * 8 + 4); const float hv = v[j][q];
                                lg[0] += hv * w0[0]; lg[1] += hv * w0[1]; lg[2] += hv * w0[2]; lg[3] += hv * w0[3]; lg[4] += hv * w1[0]; lg[5] += hv * w1[1]; lg[6] += hv * w1[2]; lg[7] += hv * w1[3]; }
#pragma unroll
                        for (int e = 0; e < 8; ++e) lg[e] = wave_sum(lg[e]);
                        int e0 = 0; float l0 = lg[0];
#pragma unroll
                        for (int e = 1; e < 8; ++e) if (lg[e] > l0) { l0 = lg[e]; e0 = e; }
                        int e1 = -1; float l1 = -3.0e38f;
#pragma unroll
                        for (int e = 0; e < 8; ++e) if (e != e0 && lg[e] > l1) { l1 = lg[e]; e1 = e; }
                        const float w1 = 1.0f / (1.0f + __expf(l0 - l1)), w0 = 1.0f - w1;
                        if (lane == 0) etab[itn * NWAVES + wave] = e0 | (e1 << 8);
                        if (lane == itn) { my_e0 = e0; my_e1 = e1; my_w0 = w0; my_w1 = w1; my_tok = m; }
                    }
                }
                if (router) {
                    __syncthreads();
                    const int nent = ((SEQ + NGW - 1) / NGW) * NWAVES;
                    if (tid < nent) {
                        const int me = etab[tid], a0 = me & 255, a1 = me >> 8; int c0 = 0, c1 = 0;
                        for (int q = 0; q < tid; ++q) { const int o = etab[q], b0 = o & 255, b1 = o >> 8; c0 += (b0 == a0) + (b1 == a0); c1 += (b0 == a1) + (b1 == a1); }
                        rtab[2 * tid] = c0; rtab[2 * tid + 1] = c1; }
                    if (tid >= 512 - 8) { const int e = tid - (512 - 8); int c = 0;
                        for (int q = 0; q < nent; ++q) { const int o = etab[q]; c += ((o & 255) == e) + ((o >> 8) == e); }
                        BLKCNT[bx * 8 + e] = c; }
                    __syncthreads();
                    if (my_tok >= 0) { int* ti = TOKINFO + (size_t)my_tok * 8; ti[0] = my_e0; ti[1] = my_e1; ti[2] = __float_as_int(my_w0); ti[3] = __float_as_int(my_w1);
                        ti[4] = rtab[2 * (lane * NWAVES + wave)]; ti[5] = rtab[2 * (lane * NWAVES + wave) + 1]; ti[6] = bx; }
                }
                __syncthreads();
                SEAM(ph);
            }
            if (sub == 0) {
            if (IN(pb + 1)) {
                PHASE_IDS();
                pg8::Gemm g{HB, WIN + (size_t)l * DINP * DM, DM, DM, DM, 0, nullptr}; pg8::TileOrder S; S.init(SEQ / 256, DINP / 256, G, bx);
                pg8::EpiBf16 E{ZB, DINP, 1.0f};
                pg8::gemm_phase<pg8::EpiBf16, pg8::TileOrder, false>(tid, lds, g, S, E);
                SEAM(pb + 1);
            }
            if (IN(pb + 2)) {
                PHASE_IDS();
                f32x4 gq0 = ((const f32x4*)(cq_norm + (size_t)l * QLR))[2 * lane], gq1 = ((const f32x4*)(cq_norm + (size_t)l * QLR))[2 * lane + 1];
                f32x4 gk = ((const f32x4*)(ckv_norm + (size_t)l * KVLR))[lane];
                for (int m = gw; m < SEQ; m += NGW) {
                    bf16_t* zr = ZB + (size_t)m * DINP;
                    const bf16x8 q8 = *(const bf16x8*)(zr + ZQ + 8 * lane); const s16x4 k4 = *(const s16x4*)(zr + ZKV + 4 * lane);
                    float qf[8], kf[4], sq = 0.f, sk = 0.f;
#pragma unroll
                    for (int j = 0; j < 8; ++j) { qf[j] = bf2f((unsigned short)q8[j]); sq += qf[j] * qf[j]; }
#pragma unroll
                    for (int j = 0; j < 4; ++j) { kf[j] = bf2f((unsigned short)k4[j]); sk += kf[j] * kf[j]; }
                    const float rq = 1.0f / sqrtf(wave_sum(sq) * (1.0f / QLR) + RMS_EPS), rk = 1.0f / sqrtf(wave_sum(sk) * (1.0f / KVLR) + RMS_EPS);
                    u32x4 wq; wq.x = cvt_pk_bf16(qf[0] * rq * gq0[0], qf[1] * rq * gq0[1]); wq.y = cvt_pk_bf16(qf[2] * rq * gq0[2], qf[3] * rq * gq0[3]);
                    wq.z = cvt_pk_bf16(qf[4] * rq * gq1[0], qf[5] * rq * gq1[1]); wq.w = cvt_pk_bf16(qf[6] * rq * gq1[2], qf[7] * rq * gq1[3]);
                    u32x2 wk; wk.x = cvt_pk_bf16(kf[0] * rk * gk[0], kf[1] * rk * gk[1]); wk.y = cvt_pk_bf16(kf[2] * rk * gk[2], kf[3] * rk * gk[3]);
                    *(u32x4*)(zr + ZQ + 8 * lane) = wq; *(u32x2*)(zr + ZKV + 4 * lane) = wk;
                }
                {   PHASE_IDS();
                    const int r32 = lane & 31, hi = lane >> 5;
                    LAS unsigned char* ost = lds + sg::OST_OFF + wave * sg::OST_WAVE;
                    bf16x8 Af[8];
#pragma unroll
                    for (int s = 0; s < 8; ++s) Af[s] = *(const bf16x8*)(FM + (size_t)(32 * wave + r32) * 128 + 16 * s + 8 * hi);
                    for (int it = bx; it < 1024; it += G) {
                        const int s2 = it >> 3, cc = it & 7;
                        __syncthreads();
                        sg::stage_b<128>(ZB + (size_t)s2 * DINP + ZU + cc * 128, (size_t)128 * DINP, (char*)lds_raw, tid);
                        __syncthreads();
                        f32x16 o[4] = {};
                        sg::mm<128>(o, Af, (char*)lds_raw, lane);
#pragma unroll
                        for (int p = 0; p < 8; ++p) { const int k1 = 16 * wave + (p & 1) + 4 * (p >> 1) + 2 * hi; const f32x2 tw = TW[s2 * 128 + k1];
#pragma unroll
                            for (int d0 = 0; d0 < 4; ++d0) { const float re = o[d0][2 * p], im = o[d0][2 * p + 1];
                                o[d0][2 * p] = re * tw[0] - im * tw[1]; o[d0][2 * p + 1] = re * tw[1] + im * tw[0]; } }
                        sg::store_tile(o, ost, lane, sg::RowF1{A1, wave, s2, cc});
                    }
                    __syncthreads();
                }
                SEAM(pb + 2);
            }
            if (IN(pb + 3)) {
                PHASE_IDS();
                { pg8::Gemm g{ZB + ZQ, WUQ + (size_t)l * 1536 * QLR, DINP, QLR, QLR, 0, nullptr}; pg8::TileOrder S; S.init(SEQ / 256, 1536 / 256, G, bx);
                  pg8::EpiBf16 E{QB, 1536, 1.0f}; pg8::gemm_phase<pg8::EpiBf16, pg8::TileOrder, false>(tid, lds, g, S, E); }
                { pg8::Gemm g{ZB + ZKV, WUKV + (size_t)l * 2048 * KVLR, DINP, KVLR, KVLR, 0, nullptr}; pg8::TileOrder S; S.init(SEQ / 256, 2048 / 256, G, bx);
                  pg8::EpiBf16 E{KVB, 2048, 1.0f}; pg8::gemm_phase<pg8::EpiBf16, pg8::TileOrder, false>(tid, lds, g, S, E); }
                {   PHASE_IDS();
                    const int r32 = lane & 31, hi = lane >> 5;
                    LAS unsigned char* ost = lds + sg::OST_OFF + wave * sg::OST_WAVE;
                    bf16x8 Af[16];
#pragma unroll
                    for (int s = 0; s < 16; ++s) Af[s] = *(const bf16x8*)(GM + (size_t)(32 * wave + r32) * 256 + 16 * s + 8 * hi);
                    for (int it = bx; it < 1024; it += G) {
                        const int k1 = it >> 3, gidx = it & 7;
                        __syncthreads();
                        sg::stage_b<256>(A1 + (size_t)k1 * 256 * 1024 + gidx * 128, 1024, (char*)lds_raw, tid);
                        __syncthreads();
                        f32x16 o[4] = {};
                        sg::mm<256>(o, Af, (char*)lds_raw, lane);
                        sg::store_tile(o, ost, lane, sg::RowF2{YC, wave, k1, gidx});
                    }
                    __syncthreads();
                }
                SEAM(pb + 3);
            }
            if (IN(pb + 4)) {
                PHASE_IDS();
                {
                    const int hd = lane >> 3, j8 = lane & 7;
                    const float* qg = q_norm + (size_t)l * QKD; const float* kg = k_norm + (size_t)l * QKD;
                    f32x4 qgn[4], kgn[4], qgr[2], kgr[2];
#pragma unroll
                    for (int j = 0; j < 4; ++j) { qgn[j] = *(const f32x4*)(qg + 16 * j8 + 4 * j); kgn[j] = *(const f32x4*)(kg + 16 * j8 + 4 * j); }
                    qgr[0] = *(const f32x4*)(qg + NOPE + 4 * j8); qgr[1] = *(const f32x4*)(qg + NOPE + 32 + 4 * j8);
                    kgr[0] = *(const f32x4*)(kg + NOPE + 4 * j8); kgr[1] = *(const f32x4*)(kg + NOPE + 32 + 4 * j8);
                    for (int m = gw; m < SEQ; m += NGW) {
                        const f32x4 cs = *(const f32x4*)(COS + (size_t)m * 32 + 4 * j8), sn = *(const f32x4*)(SIN + (size_t)m * 32 + 4 * j8);
                        {
                            bf16_t* qp = QB + (size_t)m * 1536 + hd * QKD;
                            const bf16x8 n0 = *(const bf16x8*)(qp + 16 * j8), n1 = *(const bf16x8*)(qp + 16 * j8 + 8);
                            const s16x4 ra = *(const s16x4*)(qp + NOPE + 4 * j8), rb = *(const s16x4*)(qp + NOPE + 32 + 4 * j8);
                            float f[16], x1[4], x2[4], ss = 0.f;
#pragma unroll
                            for (int j = 0; j < 8; ++j) { f[j] = bf2f((unsigned short)n0[j]); f[8 + j] = bf2f((unsigned short)n1[j]); }
#pragma unroll
                            for (int j = 0; j < 16; ++j) ss += f[j] * f[j];
#pragma unroll
                            for (int j = 0; j < 4; ++j) { x1[j] = bf2f((unsigned short)ra[j]); x2[j] = bf2f((unsigned short)rb[j]); ss += x1[j] * x1[j] + x2[j] * x2[j]; }
                            ss += swz_xor<1>(ss); ss += swz_xor<2>(ss); ss += swz_xor<4>(ss);
                            const float rs = 1.0f / sqrtf(ss * (1.0f / QKD) + RMS_EPS);
                            u32x4 w0, w1;
                            w0.x = cvt_pk_bf16(f[0] * rs * qgn[0][0], f[1] * rs * qgn[0][1]); w0.y = cvt_pk_bf16(f[2] * rs * qgn[0][2], f[3] * rs * qgn[0][3]);
                            w0.z = cvt_pk_bf16(f[4] * rs * qgn[1][0], f[5] * rs * qgn[1][1]); w0.w = cvt_pk_bf16(f[6] * rs * qgn[1][2], f[7] * rs * qgn[1][3]);
                            w1.x = cvt_pk_bf16(f[8] * rs * qgn[2][0], f[9] * rs * qgn[2][1]); w1.y = cvt_pk_bf16(f[10] * rs * qgn[2][2], f[11] * rs * qgn[2][3]);
                            w1.z = cvt_pk_bf16(f[12] * rs * qgn[3][0], f[13] * rs * qgn[3][1]); w1.w = cvt_pk_bf16(f[14] * rs * qgn[3][2], f[15] * rs * qgn[3][3]);
                            float o1[4], o2[4];
#pragma unroll
                            for (int j = 0; j < 4; ++j) { const float a = x1[j] * rs * qgr[0][j], b = x2[j] * rs * qgr[1][j]; o1[j] = a * cs[j] - b * sn[j]; o2[j] = b * cs[j] + a * sn[j]; }
                            u32x2 wa, wb; wa.x = cvt_pk_bf16(o1[0], o1[1]); wa.y = cvt_pk_bf16(o1[2], o1[3]); wb.x = cvt_pk_bf16(o2[0], o2[1]); wb.y = cvt_pk_bf16(o2[2], o2[3]);
                            *(u32x4*)(qp + 16 * j8) = w0; *(u32x4*)(qp + 16 * j8 + 8) = w1; *(u32x2*)(qp + NOPE + 4 * j8) = wa; *(u32x2*)(qp + NOPE + 32 + 4 * j8) = wb;
                        }
                        {
                            const bf16_t* kp = KVB + (size_t)m * 2048 + hd * 256; const bf16_t* krp = ZB + (size_t)m * DINP + ZKR;
                            bf16_t* ko = KB + (size_t)m * 1536 + hd * QKD;
                            const bf16x8 n0 = *(const bf16x8*)(kp + 16 * j8), n1 = *(const bf16x8*)(kp + 16 * j8 + 8);
                            const s16x4 ra = *(const s16x4*)(krp + 4 * j8), rb = *(const s16x4*)(krp + 32 + 4 * j8);
                            float f[16], x1[4], x2[4], ss = 0.f;
#pragma unroll
                            for (int j = 0; j < 8; ++j) { f[j] = bf2f((unsigned short)n0[j]); f[8 + j] = bf2f((unsigned short)n1[j]); }
#pragma unroll
                            for (int j = 0; j < 16; ++j) ss += f[j] * f[j];
#pragma unroll
                            for (int j = 0; j < 4; ++j) { x1[j] = bf2f((unsigned short)ra[j]); x2[j] = bf2f((unsigned short)rb[j]); ss += x1[j] * x1[j] + x2[j] * x2[j]; }
                            ss += swz_xor<1>(ss); ss += swz_xor<2>(ss); ss += swz_xor<4>(ss);
                            const float rs = 1.0f / sqrtf(ss * (1.0f / QKD) + RMS_EPS);
                            u32x4 w0, w1;
                            w0.x = cvt_pk_bf16(f[0] * rs * kgn[0][0], f[1] * rs * kgn[0][1]); w0.y = cvt_pk_bf16(f[2] * rs * kgn[0][2], f[3] * rs * kgn[0][3]);
                            w0.z = cvt_pk_bf16(f[4] * rs * kgn[1][0], f[5] * rs * kgn[1][1]); w0.w = cvt_pk_bf16(f[6] * rs * kgn[1][2], f[7] * rs * kgn[1][3]);
                            w1.x = cvt_pk_bf16(f[8] * rs * kgn[2][0], f[9] * rs * kgn[2][1]); w1.y = cvt_pk_bf16(f[10] * rs * kgn[2][2], f[11] * rs * kgn[2][3]);
                            w1.z = cvt_pk_bf16(f[12] * rs * kgn[3][0], f[13] * rs * kgn[3][1]); w1.w = cvt_pk_bf16(f[14] * rs * kgn[3][2], f[15] * rs * kgn[3][3]);
                            float o1[4], o2[4];
#pragma unroll
                            for (int j = 0; j < 4; ++j) { const float a = x1[j] * rs * kgr[0][j], b = x2[j] * rs * kgr[1][j]; o1[j] = a * cs[j] - b * sn[j]; o2[j] = b * cs[j] + a * sn[j]; }
                            u32x2 wa, wb; wa.x = cvt_pk_bf16(o1[0], o1[1]); wa.y = cvt_pk_bf16(o1[2], o1[3]); wb.x = cvt_pk_bf16(o2[0], o2[1]); wb.y = cvt_pk_bf16(o2[2], o2[3]);
                            *(u32x4*)(ko + 16 * j8) = w0; *(u32x4*)(ko + 16 * j8 + 8) = w1; *(u32x2*)(ko + NOPE + 4 * j8) = wa; *(u32x2*)(ko + NOPE + 32 + 4 * j8) = wb;
                        }
                    }
                }
                {   PHASE_IDS();
                    const int r32 = lane & 31, hi = lane >> 5;
                    LAS unsigned char* ost = lds + sg::OST_OFF + wave * sg::OST_WAVE;
                    for (int it = bx; it < 512; it += G) {
                        const int tt = it >> 3, gidx = it & 7;
                        bf16x8 Af[16];
                        const bf16_t* ar = YC + (size_t)(256 * tt + 32 * wave + r32) * 2048 + gidx * 256 + 8 * hi;
#pragma unroll
                        for (int s = 0; s < 16; ++s) Af[s] = *(const bf16x8*)(ar + 16 * s);
                        __syncthreads();
                        sg::stage_b<256>(M12 + (size_t)(l * 8 + gidx) * 256 * 128, 128, (char*)lds_raw, tid);
                        __syncthreads();
                        f32x16 o[4] = {};
                        sg::mm<256>(o, Af, (char*)lds_raw, lane);
                        sg::store_tile(o, ost, lane, sg::RowF3{HB, wave, tt, gidx});
                    }
                    __syncthreads();
                }
                SEAM(pb + 4);
            }
            if (IN(pb + 5)) {
                PHASE_IDS();
                for (int u = bx; u < NH * (SEQ / 256); u += G) {
                    const int h = u & 7, qb = u >> 3;
                    att::attn_unit2(QB + (size_t)(qb * 256) * 1536 + h * QKD, KB + h * QKD, KVB + h * 256 + NOPE, HB + (size_t)(qb * 256) * DM + h * VHD, SEQ, lds, tid);
                }
                SEAM(pb + 5);
            }
            if (IN(pb + 6)) {
                PHASE_IDS();
                const float* og = out_norm + (size_t)l * DM;
                f32x4 ga[4], gf[4];
#pragma unroll
                for (int j = 0; j < 4; ++j) { ga[j] = *(const f32x4*)(og + 16 * lane + 4 * j); gf[j] = *(const f32x4*)(og + 1024 + 16 * lane + 4 * j); }
                for (int m = gw; m < SEQ; m += NGW) {
                    bf16_t* rp = HB + (size_t)m * DM;
#pragma unroll
                    for (int half = 0; half < 2; ++half) {
                        bf16_t* p = rp + half * 1024 + 16 * lane;
                        const bf16x8 a0 = *(const bf16x8*)p, a1 = *(const bf16x8*)(p + 8);
                        float f[16], ss = 0.f;
#pragma unroll
                        for (int j = 0; j < 8; ++j) { f[j] = bf2f((unsigned short)a0[j]); f[8 + j] = bf2f((unsigned short)a1[j]); }
#pragma unroll
                        for (int j = 0; j < 16; ++j) ss += f[j] * f[j];
                        const float rs = 1.0f / sqrtf(wave_sum(ss) * (1.0f / 1024) + RMS_EPS);
                        u32x4 w0, w1;
#define GG(j) (half ? gf[(j) >> 2][(j) & 3] : ga[(j) >> 2][(j) & 3])
                        w0.x = cvt_pk_bf16(f[0] * rs * GG(0), f[1] * rs * GG(1)); w0.y = cvt_pk_bf16(f[2] * rs * GG(2), f[3] * rs * GG(3));
                        w0.z = cvt_pk_bf16(f[4] * rs * GG(4), f[5] * rs * GG(5)); w0.w = cvt_pk_bf16(f[6] * rs * GG(6), f[7] * rs * GG(7));
                        w1.x = cvt_pk_bf16(f[8] * rs * GG(8), f[9] * rs * GG(9)); w1.y = cvt_pk_bf16(f[10] * rs * GG(10), f[11] * rs * GG(11));
                        w1.z = cvt_pk_bf16(f[12] * rs * GG(12), f[13] * rs * GG(13)); w1.w = cvt_pk_bf16(f[14] * rs * GG(14), f[15] * rs * GG(15));
#undef GG
                        *(u32x4*)p = w0; *(u32x4*)(p + 8) = w1;
                    }
                }
                SEAM(pb + 6);
            }
            if (IN(pb + 7)) {
                PHASE_IDS();
                pg8::Gemm g{HB, WOUT + (size_t)l * DM * DM, DM, DM, DM, 0, nullptr}; pg8::TileOrder S; S.init(SEQ / 256, DM / 256, G, bx);
                pg8::EpiRes E{xcur, out, modv + 2 * DM, DM};
                pg8::gemm_phase<pg8::EpiRes, pg8::TileOrder, false>(tid, lds, g, S, E);
                SEAM(pb + 7);
            }
            }
        }
        if (l == 0) {
            if (IN(pb + 9)) {
                PHASE_IDS();
                pg8::Gemm g{HB, WGUD, DM, DM, DM, 0, nullptr}; pg8::TileOrder S; S.init(SEQ / 256, 2 * DFF / 256, G, bx);
                pg8::EpiSwiGLU E{HID, DFF};
                pg8::gemm_phase<pg8::EpiSwiGLU, pg8::TileOrder, false>(tid, lds, g, S, E);
                SEAM(pb + 9);
            }
            if (IN(pb + 10)) {
                PHASE_IDS();
                pg8::Gemm g{HID, WDND, DFF, DFF, DFF, 0, nullptr}; pg8::TileOrder S; S.init(SEQ / 256, DM / 256, G, bx);
                pg8::EpiRes E{out, out, modv + 5 * DM, DM};
                pg8::gemm_phase<pg8::EpiRes, pg8::TileOrder, false>(tid, lds, g, S, E);
                SEAM(pb + 10);
            }
        } else {
#define LOAD_TS() int ts[9]; ts[0] = 0; _Pragma("unroll") for (int e = 0; e < 8; ++e) { const int c = __builtin_amdgcn_readfirstlane((int)__hip_atomic_load(ctl + CW_ECNT + 64 * e, RLX_AGENT)); ts[e + 1] = ts[e] + ((c + 255) >> 8); }
            if (IN(pb + 9)) {
                PHASE_IDS();
                LAS int* pref = (LAS int*)lds; LAS int* tot = pref + G * 8;
                for (int i = tid; i < G * 8; i += NTHR) pref[i] = BLKCNT[i];
                __syncthreads();
                if (tid < 8) { int run = 0; for (int b = 0; b < G; ++b) { const int c = pref[b * 8 + tid]; pref[b * 8 + tid] = run; run += c; } tot[tid] = run;
                    if (bx == 0) __hip_atomic_store(ctl + CW_ECNT + 64 * tid, (unsigned)run, RLX_AGENT); }
                __syncthreads();
                int ts[9]; ts[0] = 0;
#pragma unroll
                for (int e = 0; e < 8; ++e) ts[e + 1] = ts[e] + ((tot[e] + 255) >> 8);
                for (int t = bx * NTHR + tid; t < SEQ; t += G * NTHR) {
                    const int* ti = TOKINFO + (size_t)t * 8; const int e0 = ti[0], e1 = ti[1], b = ti[6];
                    int p0 = ti[4] + pref[b * 8 + e0], p1 = ti[5] + pref[b * 8 + e1];
#pragma unroll
                    for (int e = 0; e < 8; ++e) { if (e0 == e) p0 += 256 * ts[e]; if (e1 == e) p1 += 256 * ts[e]; }
                    ROWTOK[p0] = t; ROWTOK[p1] = t; TOKPOS[2 * t] = p0; TOKPOS[2 * t + 1] = p1;
                }
                __syncthreads();
                SEAM(pb + 9);
            }
            if (IN(pb + 10)) {
                PHASE_IDS(); LOAD_TS();
                pg8::Gemm g{HB, WGUM, DM, DM, DM, (size_t)14336 * DM, ROWTOK}; pg8::TileOrder S; S.init(ts[8], 2 * DFE / 256, G, bx); S.moe = true;
#pragma unroll
                for (int e = 0; e < 9; ++e) S.ts[e] = ts[e];
                pg8::EpiSwiGLU8 E{(unsigned char*)HID, DFE, 1.0f / (S8_H * S8_WGU), S8_HID};
                pg8::gemm_phase<pg8::EpiSwiGLU8, pg8::TileOrder, true, true, true>(tid, lds, g, S, E);
                SEAM(pb + 10);
            }
            if (IN(pb + 11)) {
                PHASE_IDS(); LOAD_TS();
                const int nmain = ts[8] < 128 ? ts[8] : 128;
                pg8::EpiBf16 E{YB, DM, 1.0f / (S8_HID * S8_WDN), YPART - (size_t)32768 * DM, (size_t)2048 * DM};
                { pg8::Gemm g{HID, WDNM, DFE, DFE, DFE, (size_t)DM * DFE, nullptr}; pg8::TileOrder S; S.init(nmain, DM / 256, G, bx); S.moe = true;
#pragma unroll
                  for (int e = 0; e < 9; ++e) S.ts[e] = ts[e];
                  pg8::gemm_phase<pg8::EpiBf16, pg8::TileOrder, false, true, true>(tid, lds, g, S, E); }
                if (ts[8] > 128) { asm volatile("" : "+v"(tid));
                  pg8::Gemm g{HID, WDNM, DFE, DFE, DFE / 4, (size_t)DM * DFE, nullptr, DFE / 128}; pg8::TailOrder S; S.nsub = (ts[8] - 128) * 32; S.G = G; S.c = bx; S.pm0 = 128;
#pragma unroll
                  for (int e = 0; e < 9; ++e) S.ts[e] = ts[e];
                  pg8::gemm_phase<pg8::EpiBf16, pg8::TailOrder, false, true, true>(tid, lds, g, S, E); }
                SEAM(pb + 11);
            }
            if (IN(pb + 12)) {
                PHASE_IDS();
                const float* g2 = modv + 5 * DM;
                f32x4 gv[8];
#pragma unroll
                for (int j = 0; j < 8; ++j) gv[j] = ((const f32x4*)g2)[lane + 64 * j];
                for (int m = gw; m < SEQ; m += NGW) {
                    const int* ti = TOKINFO + (size_t)m * 8; const float w0 = __int_as_float(ti[2]), w1 = __int_as_float(ti[3]);
                    const int p0 = TOKPOS[2 * m], p1 = TOKPOS[2 * m + 1];
                    const bf16_t* y0 = YB + (size_t)p0 * DM; const bf16_t* y1 = YB + (size_t)p1 * DM; float* op = out + (size_t)m * DM;
                    const bool t0 = p0 >= 32768, t1 = p1 >= 32768;
#pragma unroll
                    for (int j = 0; j < 8; ++j) { const s16x4 a = *(const s16x4*)(y0 + 4 * lane + 256 * j), b = *(const s16x4*)(y1 + 4 * lane + 256 * j);
                        f32x4 ya, yb;
#pragma unroll
                        for (int q = 0; q < 4; ++q) { ya[q] = bf2f((unsigned short)a[q]); yb[q] = bf2f((unsigned short)b[q]); }
                        if (t0) {
#pragma unroll
                            for (int kq = 0; kq < 3; ++kq) { const s16x4 e = *(const s16x4*)(YPART + ((size_t)kq * 2048 + (p0 - 32768)) * DM + 4 * lane + 256 * j);
#pragma unroll
                                for (int q = 0; q < 4; ++q) ya[q] += bf2f((unsigned short)e[q]); } }
                        if (t1) {
#pragma unroll
                            for (int kq = 0; kq < 3; ++kq) { const s16x4 e = *(const s16x4*)(YPART + ((size_t)kq * 2048 + (p1 - 32768)) * DM + 4 * lane + 256 * j);
#pragma unroll
                                for (int q = 0; q < 4; ++q) yb[q] += bf2f((unsigned short)e[q]); } }
                        f32x4 xv = ((f32x4*)op)[lane + 64 * j];
#pragma unroll
                        for (int q = 0; q < 4; ++q) xv[q] += gv[j][q] * (w0 * ya[q] + w1 * yb[q]);
                        ((f32x4*)op)[lane + 64 * j] = xv; }
                }
            }
        }
    }
#undef IN
#undef SEAM
#undef LOAD_TS
#undef modv
#undef xcur
#undef out
#undef ctl
}

extern "C" void kernel_launch(void* const* d_in, const int* in_sizes, int n_in, void* d_out, int out_size, void* d_ws, size_t ws_size, hipStream_t stream) {
    static int grid = 0;
    if (grid == 0) {
        if (n_in != 24 || out_size != SEQ * DM || ws_size < WS_END) { fprintf(stderr, "kernel_launch: unexpected shapes n_in %d out %d ws %zu (need %zu)\n", n_in, out_size, ws_size, (size_t)WS_END); grid = -1; return; }
        int dev = 0, cus = 0, per_cu = 0;
        if (hipGetDevice(&dev) != hipSuccess || hipDeviceGetAttribute(&cus, hipDeviceAttributeMultiprocessorCount, dev) != hipSuccess) { grid = -1; return; }
        if (hipFuncSetAttribute((const void*)mk_fwd, hipFuncAttributeMaxDynamicSharedMemorySize, LDS_BYTES) != hipSuccess) { fprintf(stderr, "kernel_launch: hipFuncSetAttribute failed\n"); grid = -1; return; }
        if (hipOccupancyMaxActiveBlocksPerMultiprocessor(&per_cu, (const void*)mk_fwd, NTHR, LDS_BYTES) != hipSuccess || per_cu < 1) fprintf(stderr, "kernel_launch: occupancy query says %d\n", per_cu);
        (void)hipGetLastError();
        grid = cus;
    }
    if (grid < 0) return;
    (void)hipMemsetAsync((char*)d_ws + WS_CTL, 0, CTL_BYTES, stream);
    Args a{};
    for (int i = 0; i < 24; ++i) a.in[i] = d_in[i];
    a.out = (float*)d_out; a.ws = (unsigned char*)d_ws;
#if MK_MULTI
    static const int phases[] = {0, 1, 2, 3, 4, 5, 6, 7, 8, 9, 10, 11, 12, 18, 19, 20, 21, 22, 23, 24, 25, 26, 27, 28, 29, 30};
    for (int p : phases) { a.ph_lo = p; a.ph_hi = p + 1; hipLaunchKernelGGL(mk_fwd, dim3(grid), dim3(NTHR), LDS_BYTES, stream, a); }
#else
    a.ph_lo = 0; a.ph_hi = 31;
    hipLaunchKernelGGL(mk_fwd, dim3(grid), dim3(NTHR), LDS_BYTES, stream, a);
#endif
    const hipError_t le = hipPeekAtLastError();
    if (le != hipSuccess) fprintf(stderr, "kernel_launch: launch failed: %s\n", hipGetErrorName(le));
}
```

```cpp
#include <hip/hip_runtime.h>
#include <cstdio>
#include <cstdint>

#ifndef MK_MULTI
#define MK_MULTI 0
#endif

#define GAS __attribute__((address_space(1)))
#define LAS __attribute__((address_space(3)))
typedef unsigned short bf16_t;
typedef short bf16x8 __attribute__((ext_vector_type(8)));
typedef short s16x4 __attribute__((ext_vector_type(4)));
typedef float f32x4 __attribute__((ext_vector_type(4)));
typedef float f32x2 __attribute__((ext_vector_type(2)));
typedef float f32x16 __attribute__((ext_vector_type(16)));
typedef unsigned u32x4 __attribute__((ext_vector_type(4)));
typedef unsigned u32x2 __attribute__((ext_vector_type(2)));

constexpr int SEQ = 16384, DM = 2048, DIN = 1856, DINP = 2048;
constexpr int QLR = 512, KVLR = 256, ROPE = 64, NOPE = 128, VHD = 128, QKD = 192, NH = 8;
constexpr int ZQ = 0, ZKV = 512, ZKR = 768, ZU = 832;
constexpr int FNW = 1024, FG = 8;
constexpr int DFF = 5632, NE = 8, DFE = 7168;
constexpr int MAXT = 136;
constexpr float RMS_EPS = 1e-6f;
constexpr float S8_H = 8.f, S8_WGU = 64.f, S8_HID = 8.f, S8_WDN = 128.f;
constexpr int NWAVES = 8, NTHR = 512;

constexpr size_t MiB = 1u << 20;
constexpr size_t WS_CTL = 0, CTL_BYTES = 1 * MiB;
constexpr int CW_BAR = 4096;
constexpr int CW_ECNT = 8192;
constexpr size_t CTL_ROWTOK = 256 * 1024;
constexpr size_t WS_MODP = 1 * MiB;
constexpr size_t WS_MODV = WS_MODP + 16 * 2 * 12288 * 4;
constexpr size_t WS_COS = 3 * MiB, WS_SIN = 5 * MiB;
constexpr size_t WS_TW = 7 * MiB;
constexpr size_t WS_FM = WS_TW + 131072;
constexpr size_t WS_GM = WS_FM + 65536;
constexpr size_t WS_M12 = 8 * MiB;
constexpr size_t WS_TOKINFO = 9 * MiB;
constexpr size_t WS_TOKPOS = WS_TOKINFO + (size_t)SEQ * 32;
constexpr size_t WS_WIN = 10 * MiB;
constexpr size_t WS_WUQ = WS_WIN + 2 * 8 * MiB;
constexpr size_t WS_WUKV = WS_WUQ + 2 * 1536 * 512 * 2;
constexpr size_t WS_WOUT = WS_WUKV + 2 * 2048 * 256 * 2;
constexpr size_t WS_WGUD = WS_WOUT + 2 * 8 * MiB;
constexpr size_t WS_WDND = WS_WGUD + (size_t)11264 * 2048 * 2;
constexpr size_t WS_WGUM = WS_WDND + (size_t)2048 * 5632 * 2;
constexpr size_t WS_WDNM = WS_WGUM + (size_t)8 * 14336 * 2048 * 2;
constexpr size_t WS_H = WS_WDNM + (size_t)8 * 2048 * 7168 * 2;
constexpr size_t WS_Y = WS_H + (size_t)SEQ * 2048 * 2;
constexpr size_t WS_ARENA = WS_Y + (size_t)MAXT * 256 * 2048 * 2;
constexpr size_t WS_Z = WS_ARENA;
constexpr size_t WS_QB = WS_Z + (size_t)SEQ * 2048 * 2;
constexpr size_t WS_KVB = WS_QB + (size_t)SEQ * 1536 * 2;
constexpr size_t WS_KB = WS_KVB + (size_t)SEQ * 2048 * 2;
constexpr size_t WS_A1 = WS_KB + (size_t)SEQ * 1536 * 2;
constexpr size_t WS_YC = WS_A1 + (size_t)SEQ * 2048 * 2;
constexpr size_t WS_HID = WS_ARENA;
constexpr size_t WS_END = WS_ARENA + (size_t)MAXT * 256 * 7168 * 2;
static_assert(WS_YC + (size_t)SEQ * 2048 * 2 <= WS_END, "arena");
static_assert(WS_END <= (size_t)1900 * MiB, "workspace budget");

constexpr int RING_BYTES = 133120;
constexpr int LDS_COND = RING_BYTES;
constexpr int LDS_TRIG = LDS_COND + 8192;
constexpr int LDS_MISC = LDS_TRIG + 1024;
constexpr int LDS_BYTES = 147456;
static_assert(LDS_MISC + 256 <= LDS_BYTES, "LDS map");

#define LDS_WAIT() asm volatile("s_waitcnt lgkmcnt(0)" ::: "memory")
#define VM_WAIT() asm volatile("s_waitcnt vmcnt(0)" ::: "memory")
#define RLX_AGENT __ATOMIC_RELAXED, __HIP_MEMORY_SCOPE_AGENT

__device__ __forceinline__ unsigned cvt_pk_bf16(float lo, float hi) { unsigned r; asm volatile("v_cvt_pk_bf16_f32 %0, %1, %2" : "=v"(r) : "v"(lo), "v"(hi)); return r; }
__device__ __forceinline__ float bf2f(unsigned short b) { return __uint_as_float(((unsigned)b) << 16); }
__device__ __forceinline__ bf16_t f2bf(float f) { return (bf16_t)(cvt_pk_bf16(f, 0.f) & 0xffffu); }
template <int XM> __device__ __forceinline__ float swz_xor(float v) { return __int_as_float(__builtin_amdgcn_ds_swizzle(__float_as_int(v), (XM << 10) | 0x1f)); }
__device__ __forceinline__ float wave_sum(float v) {
    v += swz_xor<1>(v); v += swz_xor<2>(v); v += swz_xor<4>(v); v += swz_xor<8>(v); v += swz_xor<16>(v);
    auto rr = __builtin_amdgcn_permlane32_swap(__float_as_uint(v), __float_as_uint(v), false, false);
    return __uint_as_float(rr[0]) + __uint_as_float(rr[1]);
}

#define XB_TMO      128
#define XB_XCNT(j)  (256  + 64 * (j))
#define XB_XSUB(j)  (1280 + 64 * (j))
#define XB_XGEN(j)  (2304 + 64 * (j))
#define XB_TOP      3328
#define XB_TOPGEN   3392
#define XCD_BAR_WORDS 3456
#define XB_SPIN_CAP (1u << 18)
__device__ __forceinline__ unsigned xb_ld(unsigned* p)              { return __hip_atomic_load(p, __ATOMIC_RELAXED, __HIP_MEMORY_SCOPE_AGENT); }
__device__ __forceinline__ unsigned xb_add(unsigned* p, unsigned v) { return __hip_atomic_fetch_add(p, v, __ATOMIC_RELAXED, __HIP_MEMORY_SCOPE_AGENT); }
__device__ __forceinline__ unsigned xb_xcc_id() { return (unsigned)__builtin_amdgcn_s_getreg((3 << 11) | 20) & 0xFu; }
#define XB_SPIN(cond, bar) do { unsigned _sp = 0; while (cond) { __builtin_amdgcn_s_sleep(1); \
    if ((++_sp & 255u) == 0u) { if (xb_ld(&(bar)[XB_TMO])) break; if (_sp > XB_SPIN_CAP) { atomicAdd(&(bar)[XB_TMO], 1u); break; } } } } while (0)
struct XcdBarrier { unsigned* bar; unsigned x; volatile LAS unsigned* st; };
__device__ __forceinline__ XcdBarrier xcd_barrier_post(unsigned* bar, volatile LAS unsigned* st) {
    XcdBarrier b; b.bar = bar; b.x = xb_xcc_id(); b.st = st;
    if (threadIdx.x == 0) (void)xb_add(&bar[XB_XCNT(b.x)], 1u);
    return b;
}
__device__ __forceinline__ void xcd_barrier_complete(unsigned* bar, unsigned x, unsigned& nloc, unsigned& nx) {
    const unsigned G = gridDim.x * gridDim.y * gridDim.z;
    unsigned sum, cnt, mine, sp = 0u;
    for (;;) {
        sum = 0u; cnt = 0u; mine = 0u;
#pragma unroll
        for (unsigned j = 0; j < 16; ++j) { const unsigned c = xb_ld(&bar[XB_XCNT(j)]); sum += c; cnt += (c > 0u) ? 1u : 0u; mine = (j == x) ? c : mine; }
        if (sum == G) break;
        __builtin_amdgcn_s_sleep(1);
        if ((++sp & 255u) == 0u) { if (xb_ld(&bar[XB_TMO])) break; if (sp > XB_SPIN_CAP) { atomicAdd(&bar[XB_TMO], 1u); break; } }
    }
    nloc = mine > 0u ? mine : 1u; nx = cnt > 0u ? cnt : 1u;
}
__device__ __forceinline__ void xcd_barrier(const XcdBarrier& b) {
    asm volatile("s_waitcnt vmcnt(0)" ::: "memory");
    __syncthreads();
    if (threadIdx.x == 0) {
        unsigned* bar = b.bar;
        __builtin_amdgcn_s_waitcnt(0);
        unsigned nloc = b.st[0], nx = b.st[1];
        if (nloc == 0u) { xcd_barrier_complete(bar, b.x, nloc, nx); b.st[0] = nloc; b.st[1] = nx; }
        const unsigned old = xb_add(&bar[XB_XSUB(b.x)], 1u);
        const unsigned gen = old / nloc;
        if (old + 1u == (gen + 1u) * nloc) {
            __builtin_amdgcn_fence(__ATOMIC_RELEASE, "agent");
            asm volatile("s_waitcnt vmcnt(0)" ::: "memory");
            const unsigned og = xb_add(&bar[XB_TOP], 1u);
            const unsigned tg = og / nx;
            if (og + 1u == (tg + 1u) * nx) xb_add(&bar[XB_TOPGEN], 1u);
            else XB_SPIN(xb_ld(&bar[XB_TOPGEN]) == tg, bar);
            __builtin_amdgcn_fence(__ATOMIC_ACQUIRE, "agent");
            xb_add(&bar[XB_XGEN(b.x)], 1u);
            asm volatile("s_waitcnt vmcnt(0)" ::: "memory");
        } else {
            XB_SPIN(xb_ld(&bar[XB_XGEN(b.x)]) == gen, bar);
            __builtin_amdgcn_fence(__ATOMIC_ACQUIRE, "agent");
            asm volatile("s_waitcnt vmcnt(0)" ::: "memory");
        }
    }
    __syncthreads();
}

namespace pg8 {
constexpr int BM = 256, BK = 64, HALF = 128, HTB = HALF * BK * 2, STAGE_BYTES = 8 * HTB, NXCD = 8, WGM = 8;
__host__ __device__ __forceinline__ int lds_byte(int r, int c) { const int st = (r >> 4) * 2 + (c >> 5), rr = r & 15, cc = c & 31, ob = rr * 64 + cc * 2; return st * 1024 + (ob ^ (((ob >> 9) & 1) << 5)); }
__host__ __device__ __forceinline__ void stage_rc(int b, int& R, int& C) { const int st = b / 1024, sb = b % 1024, swz = sb ^ (((sb >> 9) & 1) << 5); R = (st >> 1) * 16 + swz / 64; C = (st & 1) * 32 + (swz % 64) / 2; }
__host__ __device__ __forceinline__ int perm32(int rho) { const int n = rho >> 4, i = rho & 15; return 8 * (i >> 2) + 4 * n + (i & 3); }

struct Unit { int pm, pn, e, kq; };
struct Gemm { const void* A; const void* Bt; int lda, ldb, K; size_t estrideB; const int* rowmap; int ktB = 0; };

struct TileOrder {
    int nM, nN, nwg, G, c; int ts[9]; bool moe;
    __device__ __forceinline__ void init(int nM_, int nN_, int G_, int c_) { nM = nM_; nN = nN_; nwg = nM * nN; G = G_; c = c_; moe = false; }
    __device__ __forceinline__ bool next(int i, Unit& u) const {
        const long L = (long)i * G + c; if (L >= nwg) return false;
        int wgid = (int)L; { const int q = nwg / NXCD, r = nwg % NXCD, xcd = wgid % NXCD, off = wgid / NXCD; wgid = (xcd < r ? xcd * (q + 1) : r * (q + 1) + (xcd - r) * q) + off; }
        const int nig = WGM * nN, gid = wgid / nig, fm = gid * WGM, gsz = (nM - fm) < WGM ? (nM - fm) : WGM;
        u.pm = fm + ((wgid % nig) % gsz); u.pn = (wgid % nig) / gsz; u.e = 0; u.kq = 0;
        if (moe) {
#pragma unroll
            for (int j = 1; j < 8; ++j) if (u.pm >= ts[j]) u.e = j;
        }
        return true;
    }
};

struct TailOrder {
    int nsub, G, c, pm0; int ts[9];
    __device__ __forceinline__ bool next(int i, Unit& u) const {
        const int L = i * G + c; if (L >= nsub) return false;
        u.kq = L & 3; u.pn = (L >> 2) & 7; u.pm = pm0 + (L >> 5); u.e = 0;
#pragma unroll
        for (int j = 1; j < 8; ++j) if (u.pm >= ts[j]) u.e = j;
        return true;
    }
};
struct EpiBf16 {
    static constexpr bool PERM = true;
    bf16_t* O; int ldc; float scale; bf16_t* O2 = nullptr; size_t kqstride = 0;
    __device__ __forceinline__ void operator()(const f32x4 (&acc)[2][2][4][2], const Unit& u, int wr, int wc, int fr, int fq) const {
        const int row0 = u.pm * BM + wr * 64 + fr, col0 = u.pn * BM + wc * 32 + 8 * fq;
        bf16_t* const Ob = u.kq ? O2 + (size_t)(u.kq - 1) * kqstride : O;
#pragma unroll
        for (int ai = 0; ai < 2; ++ai)
#pragma unroll
            for (int m = 0; m < 4; ++m) { bf16_t* rowp = Ob + (size_t)(row0 + ai * HALF + m * 16) * ldc + col0;
#pragma unroll
                for (int bj = 0; bj < 2; ++bj) { const f32x4 v0 = acc[ai][bj][m][0] * scale, v1 = acc[ai][bj][m][1] * scale;
                    u32x4 w; w.x = cvt_pk_bf16(v0[0], v0[1]); w.y = cvt_pk_bf16(v0[2], v0[3]); w.z = cvt_pk_bf16(v1[0], v1[1]); w.w = cvt_pk_bf16(v1[2], v1[3]);
                    *(u32x4*)(rowp + bj * HALF) = w; } }
    }
};
__device__ __forceinline__ float silu_f(float x) { return x * __builtin_amdgcn_rcpf(1.0f + __builtin_amdgcn_exp2f(-1.4426950408889634f * x)); }
struct EpiSwiGLU {
    static constexpr bool PERM = true;
    bf16_t* O; int ldc;
    __device__ __forceinline__ void operator()(const f32x4 (&acc)[2][2][4][2], const Unit& u, int wr, int wc, int fr, int fq) const {
        const int row0 = u.pm * BM + wr * 64 + fr, col0 = u.pn * HALF + wc * 32 + 8 * fq;
#pragma unroll
        for (int ai = 0; ai < 2; ++ai)
#pragma unroll
            for (int m = 0; m < 4; ++m) { bf16_t* rowp = O + (size_t)(row0 + ai * HALF + m * 16) * ldc + col0;
                f32x4 v0, v1;
#pragma unroll
                for (int j = 0; j < 4; ++j) { v0[j] = silu_f(acc[ai][0][m][0][j]) * acc[ai][1][m][0][j]; v1[j] = silu_f(acc[ai][0][m][1][j]) * acc[ai][1][m][1][j]; }
                u32x4 w; w.x = cvt_pk_bf16(v0[0], v0[1]); w.y = cvt_pk_bf16(v0[2], v0[3]); w.z = cvt_pk_bf16(v1[0], v1[1]); w.w = cvt_pk_bf16(v1[2], v1[3]);
                *(u32x4*)rowp = w; }
    }
};
__device__ __forceinline__ float clamp448(float x) { return __builtin_amdgcn_fmed3f(x, -448.f, 448.f); }
struct EpiSwiGLU8 {
    static constexpr bool PERM = true;
    unsigned char* O; int ldc; float iscale, oscale;
    __device__ __forceinline__ void operator()(const f32x4 (&acc)[2][2][4][2], const Unit& u, int wr, int wc, int fr, int fq) const {
        const int row0 = u.pm * BM + wr * 64 + fr, col0 = u.pn * HALF + wc * 32 + 8 * fq;
#pragma unroll
        for (int ai = 0; ai < 2; ++ai)
#pragma unroll
            for (int m = 0; m < 4; ++m) { unsigned char* rowp = O + (size_t)(row0 + ai * HALF + m * 16) * ldc + col0;
                f32x4 v0, v1;
#pragma unroll
                for (int j = 0; j < 4; ++j) { v0[j] = clamp448(silu_f(acc[ai][0][m][0][j] * iscale) * (acc[ai][1][m][0][j] * iscale) * oscale);
                                              v1[j] = clamp448(silu_f(acc[ai][0][m][1][j] * iscale) * (acc[ai][1][m][1][j] * iscale) * oscale); }
                int w0 = 0, w1 = 0;
                w0 = __builtin_amdgcn_cvt_pk_fp8_f32(v0[0], v0[1], w0, false); w0 = __builtin_amdgcn_cvt_pk_fp8_f32(v0[2], v0[3], w0, true);
                w1 = __builtin_amdgcn_cvt_pk_fp8_f32(v1[0], v1[1], w1, false); w1 = __builtin_amdgcn_cvt_pk_fp8_f32(v1[2], v1[3], w1, true);
                u32x2 w; w.x = (unsigned)w0; w.y = (unsigned)w1; *(u32x2*)rowp = w; }
    }
};
struct EpiRes {
    static constexpr bool PERM = false;
    const float* X; float* O; const float* gate; int ldc;
    __device__ __forceinline__ void operator()(const f32x4 (&acc)[2][2][4][2], const Unit& u, int wr, int wc, int fr, int fq) const {
        const int row0 = u.pm * BM + wr * 64 + fr, col0 = u.pn * BM + wc * 32 + 4 * fq;
        f32x4 gv[2][2];
#pragma unroll
        for (int bj = 0; bj < 2; ++bj)
#pragma unroll
            for (int n = 0; n < 2; ++n) gv[bj][n] = *(const f32x4*)(gate + col0 + bj * HALF + n * 16);
#pragma unroll
        for (int ai = 0; ai < 2; ++ai)
#pragma unroll
            for (int m = 0; m < 4; ++m) { const size_t off = (size_t)(row0 + ai * HALF + m * 16) * ldc + col0;
#pragma unroll
                for (int bj = 0; bj < 2; ++bj)
#pragma unroll
                    for (int n = 0; n < 2; ++n) { const f32x4 xv = *(const f32x4*)(X + off + bj * HALF + n * 16);
                        *(f32x4*)(O + off + bj * HALF + n * 16) = xv + gv[bj][n] * acc[ai][bj][m][n]; }
                asm volatile("" ::: "memory"); }
    }
};

typedef int v8i __attribute__((ext_vector_type(8)));
typedef unsigned u32x8 __attribute__((ext_vector_type(8)));
template <class Epi, class Sched, bool GATHER, bool FP8 = false, bool TILEDB = false>
__device__ __forceinline__ void gemm_phase(const int tid, LAS unsigned char* lds, const Gemm g, const Sched& S, const Epi& E) {
    const int wid = __builtin_amdgcn_readfirstlane(tid >> 6), lane = tid & 63, wr = wid >> 2, wc = wid & 3, fr = lane & 15, fq = lane >> 4;
    constexpr int ESZ = FP8 ? 1 : 2;
    const int nt = g.K * ESZ / (BK * 2);
    unsigned voffA[2], voffB[2];
#pragma unroll
    for (int i = 0; i < 2; ++i) { int R, C; stage_rc(tid * 16 + i * 8192, R, C); const int Rb = Epi::PERM ? ((R & ~31) + perm32(R & 31)) : R;
        voffA[i] = (unsigned)(R * g.lda * ESZ + C * 2); voffB[i] = TILEDB ? (unsigned)(Rb * 128 + C * 2) : (unsigned)(Rb * g.ldb * ESZ + C * 2); }
    const size_t kstep = (size_t)(BK * 2);
    const size_t hstepA = (size_t)HALF * g.lda * ESZ, tstepA = 2 * hstepA;
    const size_t kstepB = TILEDB ? (size_t)32768 : kstep;
    const size_t hstepB = TILEDB ? (size_t)16384 : (size_t)HALF * g.ldb * ESZ, tstepB = TILEDB ? (size_t)(g.ktB ? g.ktB : nt) * 32768 : 2 * hstepB;
    const size_t kqA = (size_t)nt * kstep, kqB = (size_t)nt * kstepB;
    const unsigned ldsw = (unsigned)wid * 1024u;
    const int aoff = lds_byte(wr * 64 + fr, fq * 8), boff = lds_byte(wc * 32 + fr, fq * 8);
#define PG8_SA(b, h) (((b) * 2 + (h)) * HTB)
#define PG8_SB(b, h) ((4 + (b) * 2 + (h)) * HTB)
#define PG8_STAGE(bufoff, gbase, voff) do { _Pragma("unroll") for (int _i = 0; _i < 2; ++_i) \
        __builtin_amdgcn_global_load_lds((const unsigned*)((const char*)(gbase) + (voff)[_i]), (LAS unsigned*)(lds + (bufoff) + ldsw + _i * 8192), 16, 0, 0); } while (0)
#define PG8_STAGE_A(bufoff, UB, h, kb, V0, V1) do { if constexpr (GATHER) { if (h) PG8_STAGE(bufoff, gA + (kb), V1); else PG8_STAGE(bufoff, gA + (kb), V0); } \
        else PG8_STAGE(bufoff, (UB) + (h) * hstepA + (kb), voffA); } while (0)
#define PG8_LD8(P) __builtin_shufflevector(*(const LAS u32x4*)(P), *(const LAS u32x4*)((P) + 1024), 0, 1, 2, 3, 4, 5, 6, 7)
#define PG8_LDA(dst, b, h) do { if constexpr (FP8) { _Pragma("unroll") for (int m = 0; m < 4; ++m) dst##8[m] = PG8_LD8(lds + PG8_SA(b, h) + aoff + m * 2048); } \
        else { _Pragma("unroll") for (int m = 0; m < 4; ++m) _Pragma("unroll") for (int k = 0; k < 2; ++k) dst[m][k] = *(const LAS bf16x8*)(lds + PG8_SA(b, h) + aoff + m * 2048 + k * 1024); } } while (0)
#define PG8_LDB(dst, b, h) do { if constexpr (FP8) { _Pragma("unroll") for (int n = 0; n < 2; ++n) dst##8[n] = PG8_LD8(lds + PG8_SB(b, h) + boff + n * 2048); } \
        else { _Pragma("unroll") for (int n = 0; n < 2; ++n) _Pragma("unroll") for (int k = 0; k < 2; ++k) dst[n][k] = *(const LAS bf16x8*)(lds + PG8_SB(b, h) + boff + n * 2048 + k * 1024); } } while (0)
#define PG8_MMA(ai, bj, At, Bt) do { __builtin_amdgcn_s_setprio(1); _Pragma("unroll") for (int m = 0; m < 4; ++m) _Pragma("unroll") for (int n = 0; n < 2; ++n) { \
        if constexpr (FP8) { asm("v_mfma_scale_f32_16x16x128_f8f6f4 %0, %1, %2, %0, %3, %3 op_sel_hi:[0,0,0]" : "+v"(acc[ai][bj][m][n]) : "v"(Bt##8[n]), "v"(At##8[m]), "v"(sc8)); } \
        else { _Pragma("unroll") for (int k = 0; k < 2; ++k) acc[ai][bj][m][n] = __builtin_amdgcn_mfma_f32_16x16x32_bf16(Bt[n][k], At[m][k], acc[ai][bj][m][n], 0, 0, 0); } } \
        __builtin_amdgcn_s_setprio(0); } while (0)
#define PG8_WAIT_V(n) asm volatile("s_waitcnt vmcnt(" #n ")" ::: "memory")
#define PG8_WAIT_L(n) asm volatile("s_waitcnt lgkmcnt(" #n ")" ::: "memory")
#define PG8_BAR __builtin_amdgcn_s_barrier()
#define PG8_SCHED __builtin_amdgcn_sched_barrier(0)
#define PG8_AOFFS(U, V0, V1) do { _Pragma("unroll") for (int _i = 0; _i < 2; ++_i) { int R_, C_; stage_rc(tid * 16 + _i * 8192, R_, C_); \
        const int r0 = g.rowmap[(U).pm * BM + R_], r1 = g.rowmap[(U).pm * BM + HALF + R_]; \
        V0[_i] = (unsigned)(r0 * g.lda * ESZ + C_ * 2); V1[_i] = (unsigned)(r1 * g.lda * ESZ + C_ * 2); } } while (0)
    Unit cur, nxt; int ui = 0;
    if (!S.next(0, cur)) return;
    f32x4 acc[2][2][4][2];
#pragma unroll
    for (int a = 0; a < 2; ++a)
#pragma unroll
        for (int b = 0; b < 2; ++b)
#pragma unroll
            for (int m = 0; m < 4; ++m)
#pragma unroll
                for (int n = 0; n < 2; ++n) acc[a][b][m][n] = (f32x4){0.f, 0.f, 0.f, 0.f};
    const unsigned sc8 = 0x7f7f7f7fu; (void)sc8;
    bf16x8 At[4][2], B0[2][2], B1[2][2]; u32x8 At8[4], B08[2], B18[2]; (void)At; (void)B0; (void)B1; (void)At8; (void)B08; (void)B18;
    unsigned vc0[2] = {0u, 0u}, vc1[2] = {0u, 0u}, vn0[2] = {0u, 0u}, vn1[2] = {0u, 0u};
    if constexpr (GATHER) PG8_AOFFS(cur, vc0, vc1);
    const char* gA = (const char*)g.A;
    const char* cA = gA + (size_t)cur.pm * tstepA + (size_t)cur.kq * kqA;
    const char* cB = (const char*)g.Bt + (size_t)cur.e * g.estrideB * ESZ + (size_t)cur.pn * tstepB + (size_t)cur.kq * kqB;
    PG8_STAGE(PG8_SB(0, 0), cB, voffB); PG8_STAGE(PG8_SB(0, 1), cB + hstepB, voffB); PG8_STAGE_A(PG8_SA(0, 0), cA, 0, 0, vc0, vc1); PG8_STAGE_A(PG8_SA(0, 1), cA, 1, 0, vc0, vc1);
    if (wr == 1) PG8_BAR;
    PG8_WAIT_V(2); PG8_BAR;
    PG8_STAGE(PG8_SB(1, 0), cB + kstepB, voffB); PG8_STAGE_A(PG8_SA(1, 0), cA, 0, kstep, vc0, vc1); PG8_STAGE(PG8_SB(1, 1), cB + hstepB + kstepB, voffB);
    PG8_WAIT_V(6); PG8_BAR;
    for (;;) {
        const bool has_next = S.next(ui + 1, nxt);
        const char* nA = cA; const char* nB = cB;
        if (has_next) { nA = gA + (size_t)nxt.pm * tstepA + (size_t)nxt.kq * kqA; nB = (const char*)g.Bt + (size_t)nxt.e * g.estrideB * ESZ + (size_t)nxt.pn * tstepB + (size_t)nxt.kq * kqB; }
        if constexpr (GATHER) { if (has_next) PG8_AOFFS(nxt, vn0, vn1); else {
#pragma unroll
            for (int _i = 0; _i < 2; ++_i) { vn0[_i] = vc0[_i]; vn1[_i] = vc1[_i]; } } }
        for (int t = 0; t < nt; t += 2) {
            const bool last = (t == nt - 2);
            const size_t k1 = (size_t)(t + 1) * kstep, k2 = last ? 0 : (size_t)(t + 2) * kstep, k3 = k2 + kstep;
            const char* u2 = last ? nA : cA; const char* b2 = (last ? nB : cB) + (last ? 0 : (size_t)(t + 2) * kstepB); const char* b3 = b2 + kstepB;
            unsigned va0[2] = {0u, 0u}, va1[2] = {0u, 0u};
            if constexpr (GATHER) {
#pragma unroll
                for (int _i = 0; _i < 2; ++_i) { va0[_i] = last ? vn0[_i] : vc0[_i]; va1[_i] = last ? vn1[_i] : vc1[_i]; } }
            PG8_LDB(B0, 0, 0); PG8_LDB(B1, 0, 1); PG8_SCHED; PG8_LDA(At, 0, 0); PG8_STAGE_A(PG8_SA(1, 1), cA, 1, k1, vc0, vc1);
            PG8_WAIT_V(8); PG8_WAIT_L(0); PG8_BAR; PG8_MMA(0, 0, At, B0); PG8_MMA(0, 1, At, B1); PG8_BAR; PG8_SCHED;
            PG8_LDA(At, 0, 1); PG8_STAGE(PG8_SB(0, 0), b2, voffB); PG8_STAGE(PG8_SB(0, 1), b2 + hstepB, voffB); PG8_STAGE_A(PG8_SA(0, 0), u2, 0, k2, va0, va1);
            PG8_WAIT_V(8); PG8_WAIT_L(0); PG8_BAR; PG8_MMA(1, 0, At, B0); PG8_MMA(1, 1, At, B1); PG8_BAR; PG8_SCHED;
            PG8_LDB(B0, 1, 0); PG8_LDB(B1, 1, 1); PG8_SCHED; PG8_LDA(At, 1, 0); PG8_STAGE_A(PG8_SA(0, 1), u2, 1, k2, va0, va1);
            PG8_WAIT_V(8); PG8_WAIT_L(0); PG8_BAR; PG8_MMA(0, 0, At, B0); PG8_MMA(0, 1, At, B1); PG8_BAR; PG8_SCHED;
            PG8_LDA(At, 1, 1); PG8_STAGE(PG8_SB(1, 0), b3, voffB); PG8_STAGE(PG8_SB(1, 1), b3 + hstepB, voffB); PG8_STAGE_A(PG8_SA(1, 0), u2, 0, k3, va0, va1);
            PG8_WAIT_V(8); PG8_WAIT_L(0); PG8_BAR; PG8_MMA(1, 0, At, B0); PG8_MMA(1, 1, At, B1); PG8_BAR; PG8_SCHED;
        }
        if constexpr (FP8) asm volatile("s_nop 15\n\ts_nop 15" ::: "memory");
        if (wr == 0) PG8_BAR;
        { int fr_ = fr, fq_ = fq; asm volatile("" : "+v"(fr_), "+v"(fq_)); E(acc, cur, wr, wc, fr_, fq_); }
        if (!has_next) break;
#pragma unroll
        for (int a = 0; a < 2; ++a)
#pragma unroll
            for (int b = 0; b < 2; ++b)
#pragma unroll
                for (int m = 0; m < 4; ++m)
#pragma unroll
                    for (int n = 0; n < 2; ++n) acc[a][b][m][n] = (f32x4){0.f, 0.f, 0.f, 0.f};
        cur = nxt; cA = nA; cB = nB; ++ui;
        if constexpr (GATHER) {
#pragma unroll
            for (int _i = 0; _i < 2; ++_i) { vc0[_i] = vn0[_i]; vc1[_i] = vn1[_i]; } }
        if (wr == 1) PG8_BAR;
    }
    PG8_WAIT_V(0);
    PG8_BAR;
#undef PG8_SA
#undef PG8_SB
#undef PG8_STAGE
#undef PG8_STAGE_A
#undef PG8_LDA
#undef PG8_LD8
#undef PG8_LDB
#undef PG8_MMA
#undef PG8_WAIT_V
#undef PG8_WAIT_L
#undef PG8_BAR
#undef PG8_SCHED
#undef PG8_AOFFS
}
}

namespace att {
constexpr int NW = 8, QBLK = 32, KVBLK = 64, DQ = QKD, DV = VHD;
constexpr float SCALE = 0.07216878364870322f;
constexpr float THR = 8.f;
constexpr int LDQ = 1536, LDK = 1536, LDV = 2048, LDO = 2048;
constexpr int SHM_V = KVBLK * DV * 2, SHM_K = KVBLK * DQ * 2, SHM_ATTN = 2 * SHM_V + 2 * SHM_K + NW * 64 * 4;
#define KSWZ(row, colB) ((row) * 384 + ((colB) ^ ((((row) >> 1) & 7) << 4)))
#define SBAR() __builtin_amdgcn_sched_barrier(0)
__device__ __forceinline__ int crow(int r, int hi) { return (r & 3) + 8 * (r >> 2) + 4 * hi; }
__device__ __forceinline__ void partialSM(f32x16& p0, f32x16& p1, float& m_reg, float& mn, float& alpha) {
  constexpr float C = SCALE * 1.4426950408889634f;
  float pmax = p0[0];
#pragma unroll
  for (int r = 1; r < 16; ++r) pmax = fmaxf(pmax, p0[r]);
#pragma unroll
  for (int r = 0; r < 16; ++r) pmax = fmaxf(pmax, p1[r]);
  { auto rr = __builtin_amdgcn_permlane32_swap(__float_as_uint(pmax), __float_as_uint(pmax), false, false);
    pmax = fmaxf(__uint_as_float(rr[0]), __uint_as_float(rr[1])); }
  if (__builtin_expect(__all(pmax - m_reg <= THR / SCALE), 1)) { mn = m_reg; alpha = 1.f; }
  else { mn = fmaxf(m_reg, pmax); alpha = __builtin_amdgcn_exp2f((m_reg - mn) * C); m_reg = mn; }
  float mnC = -mn * C;
#pragma unroll
  for (int r = 0; r < 16; ++r) p0[r] = fmaf(p0[r], C, mnC);
#pragma unroll
  for (int r = 0; r < 16; ++r) p1[r] = fmaf(p1[r], C, mnC);
#pragma unroll
  for (int r = 0; r < 16; ++r) p0[r] = __builtin_amdgcn_exp2f(p0[r]);
}
__device__ __forceinline__ void finishSM(f32x16& p0, f32x16& p1, float alpha, float& l_reg, bf16x8& pa0, bf16x8& pa1, bf16x8& pa2, bf16x8& pa3) {
#pragma unroll
  for (int r = 0; r < 16; ++r) p1[r] = __builtin_amdgcn_exp2f(p1[r]);
  float ps = 0;
#pragma unroll
  for (int r = 0; r < 16; ++r) ps += p0[r];
#pragma unroll
  for (int r = 0; r < 16; ++r) ps += p1[r];
  { auto rr = __builtin_amdgcn_permlane32_swap(__float_as_uint(ps), __float_as_uint(ps), false, false);
    ps = __uint_as_float(rr[0]) + __uint_as_float(rr[1]); }
  l_reg = l_reg * alpha + ps;
#define PK4(P, BASE, OUT) do { unsigned a0 = cvt_pk_bf16(P[BASE + 0], P[BASE + 1]), a1 = cvt_pk_bf16(P[BASE + 2], P[BASE + 3]);   \
    unsigned b0 = cvt_pk_bf16(P[BASE + 4], P[BASE + 5]), b1 = cvt_pk_bf16(P[BASE + 6], P[BASE + 7]);                              \
    auto r0 = __builtin_amdgcn_permlane32_swap(a0, b0, false, false); auto r1 = __builtin_amdgcn_permlane32_swap(a1, b1, false, false); \
    u32x4 w = {r0[0], r1[0], r0[1], r1[1]}; OUT = *reinterpret_cast<bf16x8*>(&w); } while (0)
  PK4(p0, 0, pa0); PK4(p0, 8, pa1); PK4(p1, 0, pa2); PK4(p1, 8, pa3);
#undef PK4
}
__device__ __forceinline__ void qkt(f32x16& p0, f32x16& p1, const char* Ks, const bf16x8* qr, int r32, int hi) {
  p0 = f32x16{}; p1 = f32x16{};
#pragma unroll
  for (int d0 = 0; d0 < DQ / 16; ++d0) { int cb = (d0 * 16 + hi * 8) * 2;
    bf16x8 b0 = *reinterpret_cast<const bf16x8*>(Ks + KSWZ(r32, cb));
    bf16x8 b1 = *reinterpret_cast<const bf16x8*>(Ks + KSWZ(32 + r32, cb));
    p0 = __builtin_amdgcn_mfma_f32_32x32x16_bf16(b0, qr[d0], p0, 0, 0, 0);
    p1 = __builtin_amdgcn_mfma_f32_32x32x16_bf16(b1, qr[d0], p1, 0, 0, 0);
    if ((d0 & 3) == 3) SBAR(); }
}
__device__ __forceinline__ int v_st(int k, int c) { const int kk = (k & ~0xC) | ((k & 4) << 1) | ((k & 8) >> 1); return ((kk >> 3) * 4 + (c >> 5)) * 512 + ((kk & 7) * 32 + (c & 31)) * 2; }
__device__ __forceinline__ int v_rd_base(int lane) { return ((lane & 3) << 3) | (((lane >> 2) & 3) << 6) | (((lane >> 4) & 1) << 5) | (((lane >> 5) & 1) << 8); }
constexpr int v_rd_off(int d0, int ks, int half) { return d0 * 512 + ks * 4096 + half * 2048; }
template <int OFF> __device__ __forceinline__ s16x4 tr_read(int vb) {
  s16x4 r; asm volatile("ds_read_b64_tr_b16 %0, %1 offset:%2" : "=&v"(r) : "v"(vb), "i"(OFF) : "memory"); return r;
}
template <int D0> __device__ __forceinline__ void pv_one(f32x16& od, int vb, bf16x8 pa0, bf16x8 pa1, bf16x8 pa2, bf16x8 pa3) {
  const s16x4 l0 = tr_read<v_rd_off(D0, 0, 0)>(vb), h0 = tr_read<v_rd_off(D0, 0, 1)>(vb), l1 = tr_read<v_rd_off(D0, 1, 0)>(vb), h1 = tr_read<v_rd_off(D0, 1, 1)>(vb);
  const s16x4 l2 = tr_read<v_rd_off(D0, 2, 0)>(vb), h2 = tr_read<v_rd_off(D0, 2, 1)>(vb), l3 = tr_read<v_rd_off(D0, 3, 0)>(vb), h3 = tr_read<v_rd_off(D0, 3, 1)>(vb);
  asm volatile("s_waitcnt lgkmcnt(0)" ::: "memory"); SBAR();
#define PK(L, H) (bf16x8){L[0], L[1], L[2], L[3], H[0], H[1], H[2], H[3]}
  od = __builtin_amdgcn_mfma_f32_32x32x16_bf16(pa0, PK(l0, h0), od, 0, 0, 0);
  od = __builtin_amdgcn_mfma_f32_32x32x16_bf16(pa1, PK(l1, h1), od, 0, 0, 0);
  od = __builtin_amdgcn_mfma_f32_32x32x16_bf16(pa2, PK(l2, h2), od, 0, 0, 0);
  od = __builtin_amdgcn_mfma_f32_32x32x16_bf16(pa3, PK(l3, h3), od, 0, 0, 0);
#undef PK
}
__device__ __forceinline__ void pv_d0(f32x16* o, int vb, bf16x8 pa0, bf16x8 pa1, bf16x8 pa2, bf16x8 pa3) {
  pv_one<0>(o[0], vb, pa0, pa1, pa2, pa3); pv_one<1>(o[1], vb, pa0, pa1, pa2, pa3); pv_one<2>(o[2], vb, pa0, pa1, pa2, pa3); pv_one<3>(o[3], vb, pa0, pa1, pa2, pa3);
}


constexpr int K_OFF = 0, V_OFF = 3 * SHM_K, WS_OFF = V_OFF + 3 * SHM_V, SHM_ATTN2 = WS_OFF + NW * 64 * 4;
__device__ __forceinline__ void qkt_l(f32x16& p0, f32x16& p1, LAS const char* Ks, const bf16x8* qr, int r32, int hi) {
  p0 = f32x16{}; p1 = f32x16{};
  __builtin_amdgcn_s_setprio(1);
  const int swz = ((r32 >> 1) & 7) << 4, rowb = r32 * 384;
  LAS const char* ar[4];
#pragma unroll
  for (int r = 0; r < 4; ++r) ar[r] = Ks + rowb + ((32 * r + 16 * hi) ^ swz);
#pragma unroll
  for (int q = 0; q < DQ / 64; ++q)
#pragma unroll
    for (int r = 0; r < 4; ++r) { const int d0 = 4 * q + r;
      bf16x8 b0 = *reinterpret_cast<LAS const bf16x8*>(ar[r] + 128 * q);
      bf16x8 b1 = *reinterpret_cast<LAS const bf16x8*>(ar[r] + 128 * q + 32 * 384);
      p0 = __builtin_amdgcn_mfma_f32_32x32x16_bf16(b0, qr[d0], p0, 0, 0, 0);
      p1 = __builtin_amdgcn_mfma_f32_32x32x16_bf16(b1, qr[d0], p1, 0, 0, 0);
      if (r == 3 && d0 != DQ / 16 - 1) SBAR(); }
  __builtin_amdgcn_s_setprio(0);
}
__device__ __forceinline__ float psm_max(const f32x16& p) { float m = p[0];
#pragma unroll
  for (int r = 1; r < 16; ++r) m = fmaxf(m, p[r]);
  return m; }
__device__ __forceinline__ void psm_decide(float pmax, float& m_reg, float& mnC, float& alpha) {
  constexpr float C = SCALE * 1.4426950408889634f;
  { auto rr = __builtin_amdgcn_permlane32_swap(__float_as_uint(pmax), __float_as_uint(pmax), false, false);
    pmax = fmaxf(__uint_as_float(rr[0]), __uint_as_float(rr[1])); }
  float mn;
  if (__builtin_expect(__all(pmax - m_reg <= THR / SCALE), 1)) { mn = m_reg; alpha = 1.f; }
  else { mn = fmaxf(m_reg, pmax); alpha = __builtin_amdgcn_exp2f((m_reg - mn) * C); m_reg = mn; }
  mnC = -mn * C;
}
__device__ __forceinline__ void psm_scale(f32x16& p, float mnC) { constexpr float C = SCALE * 1.4426950408889634f;
#pragma unroll
  for (int r = 0; r < 16; ++r) p[r] = fmaf(p[r], C, mnC); }
__device__ __forceinline__ void psm_exp(f32x16& p) {
#pragma unroll
  for (int r = 0; r < 16; ++r) p[r] = __builtin_amdgcn_exp2f(p[r]); }

__device__ __forceinline__ void fsm_first(f32x16& p0, f32x16& p1, int negMCbits) {
  constexpr float C = SCALE * 1.4426950408889634f;
  int nb_ = __builtin_amdgcn_readfirstlane(negMCbits); asm volatile("" : "+s"(nb_)); const float negMC = __builtin_bit_cast(float, nb_);
#pragma unroll
  for (int r = 0; r < 16; ++r) p0[r] = fmaf(p0[r], C, negMC);
#pragma unroll
  for (int r = 0; r < 16; ++r) p1[r] = fmaf(p1[r], C, negMC);
#pragma unroll
  for (int r = 0; r < 16; ++r) p0[r] = __builtin_amdgcn_exp2f(p0[r]);
}
__device__ __forceinline__ void fsm_finish(f32x16& p0, f32x16& p1, float& l_reg, bf16x8& pa0, bf16x8& pa1, bf16x8& pa2, bf16x8& pa3) {
#pragma unroll
  for (int r = 0; r < 16; ++r) p1[r] = __builtin_amdgcn_exp2f(p1[r]);
  float ps = 0;
#pragma unroll
  for (int r = 0; r < 16; ++r) ps += p0[r];
#pragma unroll
  for (int r = 0; r < 16; ++r) ps += p1[r];
  { auto rr = __builtin_amdgcn_permlane32_swap(__float_as_uint(ps), __float_as_uint(ps), false, false);
    ps = __uint_as_float(rr[0]) + __uint_as_float(rr[1]); }
  l_reg += ps;
#define PK4(P, BASE, OUT) do { unsigned a0 = cvt_pk_bf16(P[BASE + 0], P[BASE + 1]), a1 = cvt_pk_bf16(P[BASE + 2], P[BASE + 3]);   \
    unsigned b0 = cvt_pk_bf16(P[BASE + 4], P[BASE + 5]), b1 = cvt_pk_bf16(P[BASE + 6], P[BASE + 7]);                              \
    auto r0 = __builtin_amdgcn_permlane32_swap(a0, b0, false, false); auto r1 = __builtin_amdgcn_permlane32_swap(a1, b1, false, false); \
    u32x4 w = {r0[0], r1[0], r0[1], r1[1]}; OUT = *reinterpret_cast<bf16x8*>(&w); } while (0)
  PK4(p0, 0, pa0); PK4(p0, 8, pa1); PK4(p1, 0, pa2); PK4(p1, 8, pa3);
#undef PK4
}
__device__ __forceinline__ void attn_unit2(const bf16_t* __restrict__ Qb, const bf16_t* __restrict__ Kh, const bf16_t* __restrict__ Vh, bf16_t* __restrict__ Ob, int seq, LAS unsigned char* lds, const int tid, const int negMC) {
  const int wid = __builtin_amdgcn_readfirstlane(tid >> 6), lane = tid & 63, r32 = lane & 31, hi = lane >> 5;
  LAS float* ws = (LAS float*)(lds + WS_OFF) + wid * 64; LAS float* li_l = ws; LAS float* al_l = ws + 32;
  float l_reg = 0; f32x16 o[4] = {}; bf16x8 qr[DQ / 16];
  const bf16_t* Qw = Qb + (long)(wid * QBLK + r32) * LDQ + hi * 8;
#pragma unroll
  for (int d0 = 0; d0 < DQ / 16; ++d0) qr[d0] = *reinterpret_cast<const bf16x8*>(Qw + d0 * 16);
#define KOFF(i_, ln_) ({ const int b_ = 1024 * (wid + 8 * (i_)) + 16 * (ln_), row_ = b_ / 384, x_ = b_ % 384; (unsigned)(row_ * LDK * 2 + (x_ ^ (((row_ >> 1) & 7) << 4))); })
  unsigned voff[2];
#pragma unroll
  for (int i = 0; i < 2; ++i) { const int b = 1024 * (wid + 8 * i) + 16 * lane, st = b >> 9, off = b & 511, kk = (st >> 2) * 8 + (off >> 6), c = (st & 3) * 32 + ((off & 63) >> 1);
    const int k = (kk & ~0xC) | ((kk & 4) << 1) | ((kk & 8) >> 1); voff[i] = (unsigned)(k * LDV * 2 + c * 2); }
  const int NT = seq / KVBLK;
#define DMA_K(t, slot) do { const int t_ = (t) < NT ? (t) : NT - 1; const char* g_ = (const char*)Kh + (size_t)t_ * (KVBLK * LDK * 2); int ln_ = lane; asm volatile("" : "+v"(ln_)); _Pragma("unroll") for (int i_ = 0; i_ < 3; ++i_) \
    __builtin_amdgcn_global_load_lds((const unsigned*)(g_ + KOFF(i_, ln_)), (LAS unsigned*)(lds + K_OFF + (slot) * SHM_K + (wid + 8 * i_) * 1024), 16, 0, 0); } while (0)
#define DMA_V(t, slot) do { const int t_ = (t) < NT ? (t) : NT - 1; const char* g_ = (const char*)Vh + (size_t)t_ * (KVBLK * LDV * 2); _Pragma("unroll") for (int i_ = 0; i_ < 2; ++i_) \
    __builtin_amdgcn_global_load_lds((const unsigned*)(g_ + voff[i_]), (LAS unsigned*)(lds + V_OFF + (slot) * SHM_V + (wid + 8 * i_) * 1024), 16, 0, 0); } while (0)
#define WAITBAR() do { asm volatile("s_waitcnt vmcnt(5) lgkmcnt(0)" ::: "memory"); __builtin_amdgcn_s_barrier(); asm volatile("" ::: "memory"); } while (0)
  const int vbase = (int)(uintptr_t)(lds + V_OFF) + v_rd_base(lane);
  f32x16 pA0, pA1, pB0, pB1; bf16x8 pa0, pa1, pa2, pa3;
  DMA_K(0, 0); DMA_K(1, 1); DMA_V(0, 0);
  WAITBAR();
  DMA_K(2, 2); DMA_V(1, 1);
  qkt_l(pA0, pA1, (LAS const char*)(lds + K_OFF), qr, r32, hi); fsm_first(pA0, pA1, negMC);
  WAITBAR();
  int a = 1;
  for (int t = 1; t + 1 < NT; t += 2) {
    { const int kd = (a + 2) % 3, vd = (a + 1) % 3;
      DMA_K(t + 2, kd); DMA_V(t + 1, vd);
      SBAR(); qkt_l(pB0, pB1, (LAS const char*)(lds + K_OFF + a * SHM_K), qr, r32, hi);
      fsm_finish(pA0, pA1, l_reg, pa0, pa1, pa2, pa3); SBAR();
      pv_d0(o, vbase + kd * SHM_V, pa0, pa1, pa2, pa3); fsm_first(pB0, pB1, negMC);
      WAITBAR(); a = (a + 1) % 3; }
    { const int kd = (a + 2) % 3, vd = (a + 1) % 3;
      DMA_K(t + 3, kd); DMA_V(t + 2, vd);
      SBAR(); qkt_l(pA0, pA1, (LAS const char*)(lds + K_OFF + a * SHM_K), qr, r32, hi);
      fsm_finish(pB0, pB1, l_reg, pa0, pa1, pa2, pa3); SBAR();
      pv_d0(o, vbase + kd * SHM_V, pa0, pa1, pa2, pa3); fsm_first(pA0, pA1, negMC);
      WAITBAR(); a = (a + 1) % 3; }
  }
  { const int kd = (a + 2) % 3, vd = (a + 1) % 3;
    DMA_K(NT - 1, kd); DMA_V(NT - 1, vd);
    SBAR(); qkt_l(pB0, pB1, (LAS const char*)(lds + K_OFF + a * SHM_K), qr, r32, hi);
    fsm_finish(pA0, pA1, l_reg, pa0, pa1, pa2, pa3); SBAR();
    pv_d0(o, vbase + kd * SHM_V, pa0, pa1, pa2, pa3); fsm_first(pB0, pB1, negMC);
      WAITBAR(); a = (a + 1) % 3; }
  { const int kd = (a + 2) % 3;
    fsm_finish(pB0, pB1, l_reg, pa0, pa1, pa2, pa3); SBAR();
    pv_d0(o, vbase + kd * SHM_V, pa0, pa1, pa2, pa3); }
  if (hi == 0) li_l[r32] = l_reg; asm volatile("s_waitcnt lgkmcnt(0)" ::: "memory");
  int r32e = r32, hie = hi; asm volatile("" : "+v"(r32e), "+v"(hie));
  float rli[16];
#pragma unroll
  for (int r = 0; r < 16; ++r) rli[r] = __builtin_amdgcn_rcpf(li_l[crow(r, hie)]);
  bf16_t* Ow = Ob + (long)(wid * QBLK) * LDO;
#pragma unroll
  for (int r = 0; r < 16; ++r) { int orow = crow(r, hie);
#pragma unroll
    for (int d0 = 0; d0 < 4; ++d0) Ow[(long)orow * LDO + d0 * 32 + r32e] = f2bf(o[d0][r] * rli[r]); }
  asm volatile("s_waitcnt vmcnt(0) lgkmcnt(0)" ::: "memory"); __builtin_amdgcn_s_barrier(); asm volatile("" ::: "memory");
#undef DMA_K
#undef KOFF
#undef DMA_V
#undef WAITBAR
}
}

namespace sg {
using att::v_st; using att::v_rd_base; using att::pv_d0; using att::crow;
template <int KK> __device__ __forceinline__ void load_b(bf16x8* v, const bf16_t* Bsrc, size_t ldb, const int tid) {
    const int n = (tid & 15) * 8;
#pragma unroll
    for (int i = 0; i < KK / 32; ++i) { const int k = (tid >> 4) + 32 * i; v[i] = *(const bf16x8*)(Bsrc + (size_t)k * ldb + n); }
}
template <int KK> __device__ __forceinline__ void write_b(const bf16x8* v, char* lds, const int tid) {
    const int n = (tid & 15) * 8;
#pragma unroll
    for (int i = 0; i < KK / 32; ++i) { const int k = (tid >> 4) + 32 * i; *(bf16x8*)(lds + (k >> 6) * 16384 + v_st(k & 63, n)) = v[i]; }
}
template <int KK> __device__ __forceinline__ void stage_b(const bf16_t* Bsrc, size_t ldb, char* lds, const int tid) { bf16x8 v[KK / 32]; load_b<KK>(v, Bsrc, ldb, tid); write_b<KK>(v, lds, tid); }
constexpr int OST_PITCH = 272, OST_WAVE = 32 * OST_PITCH, OST_OFF = 65536;
template <class RowPtr>
__device__ __forceinline__ void store_tile(const f32x16* o, LAS unsigned char* ost, int lane, const RowPtr& rowptr) {
    const int r32 = lane & 31, hi = lane >> 5; const bool odd = lane & 1;
#pragma unroll
    for (int pr = 0; pr < 8; ++pr)
#pragma unroll
        for (int d0 = 0; d0 < 4; ++d0) { const float a = o[d0][2 * pr], b = o[d0][2 * pr + 1];
            const float x = odd ? a : b;
            const float y = __int_as_float(__builtin_amdgcn_mov_dpp(__float_as_int(x), 0xB1, 0xf, 0xf, true));
            const unsigned w = odd ? cvt_pk_bf16(y, b) : cvt_pk_bf16(a, y);
            const int row = crow(odd ? 2 * pr + 1 : 2 * pr, hi);
            *(LAS unsigned*)(ost + row * OST_PITCH + (32 * d0 + (r32 & ~1)) * 2) = w; }
    asm volatile("s_waitcnt lgkmcnt(0)" ::: "memory");
#pragma unroll
    for (int j = 0; j < 8; ++j) { const int i = (lane >> 4) + 4 * j; const u32x4 v = *(const LAS u32x4*)(ost + i * OST_PITCH + (lane & 15) * 16);
        *(u32x4*)(rowptr(i) + (lane & 15) * 8) = v; }
    asm volatile("s_waitcnt lgkmcnt(0)" ::: "memory");
}
struct RowF1 { bf16_t* a1; int wave, s2, cc; __device__ __forceinline__ bf16_t* operator()(int i) const { return a1 + ((size_t)(32 * wave + i) * 128 + s2) * 1024 + cc * 128; } };
struct RowF2 { bf16_t* yc; int wave, k1, g; __device__ __forceinline__ bf16_t* operator()(int i) const { const int m = 32 * wave + i; return yc + (size_t)(k1 + 128 * (m & 127)) * 2048 + g * 256 + (m >> 7) * 128; } };
struct RowF3 { bf16_t* hb; int wave, tt, g; __device__ __forceinline__ bf16_t* operator()(int i) const { return hb + (size_t)(256 * tt + 32 * wave + i) * 2048 + 1024 + g * 128; } };
template <int KK> __device__ __forceinline__ void mm(f32x16* o, const bf16x8* A, char* lds, int lane) {
    const int vb0 = (int)(uintptr_t)lds + v_rd_base(lane);
#pragma unroll
    for (int t = 0; t < KK / 64; ++t) pv_d0(o, vb0 + t * 16384, A[4 * t], A[4 * t + 1], A[4 * t + 2], A[4 * t + 3]);
}
}

struct Args { const void* in[24]; float* out; unsigned char* ws; int ph_lo, ph_hi; };

__device__ __forceinline__ u32x2 pack4(f32x4 v) { u32x2 w; w.x = cvt_pk_bf16(v[0], v[1]); w.y = cvt_pk_bf16(v[2], v[3]); return w; }

template <bool FP8, bool TILED = false>
__device__ __forceinline__ void cvt_pair(const float* W, int N, void* WT, int ldd, int k0, int n0, int drow0, float scale, LAS float* scr, int lane) {
    const int lr = lane >> 4, lc = (lane & 15) * 4;
    f32x4 v[2][16];
#pragma unroll
    for (int t = 0; t < 2; ++t)
#pragma unroll
        for (int i = 0; i < 16; ++i) v[t][i] = *(const f32x4*)(W + (size_t)(k0 + 64 * t + 4 * i + lr) * N + n0 + lc);
    const int c = lane & 7;
#pragma unroll
    for (int t = 0; t < 2; ++t) {
#pragma unroll
        for (int i = 0; i < 16; ++i) { LAS float* s = scr + (4 * i + lr) * 65 + lc; s[0] = v[t][i][0]; s[1] = v[t][i][1]; s[2] = v[t][i][2]; s[3] = v[t][i][3]; }
        LDS_WAIT(); asm volatile("" ::: "memory");
#pragma unroll
        for (int j = 0; j < 8; ++j) { const int n = (lane >> 3) + 8 * j; const LAS float* s = scr + (8 * c) * 65 + n;
            if constexpr (!FP8) { u32x4 o; o.x = cvt_pk_bf16(s[0 * 65], s[1 * 65]); o.y = cvt_pk_bf16(s[2 * 65], s[3 * 65]); o.z = cvt_pk_bf16(s[4 * 65], s[5 * 65]); o.w = cvt_pk_bf16(s[6 * 65], s[7 * 65]);
                *(u32x4*)((bf16_t*)WT + (size_t)(drow0 + n) * ldd + k0 + 64 * t + 8 * c) = o; }
            else { int w0 = 0, w1 = 0;
                w0 = __builtin_amdgcn_cvt_pk_fp8_f32(pg8::clamp448(s[0 * 65] * scale), pg8::clamp448(s[1 * 65] * scale), w0, false); w0 = __builtin_amdgcn_cvt_pk_fp8_f32(pg8::clamp448(s[2 * 65] * scale), pg8::clamp448(s[3 * 65] * scale), w0, true);
                w1 = __builtin_amdgcn_cvt_pk_fp8_f32(pg8::clamp448(s[4 * 65] * scale), pg8::clamp448(s[5 * 65] * scale), w1, false); w1 = __builtin_amdgcn_cvt_pk_fp8_f32(pg8::clamp448(s[6 * 65] * scale), pg8::clamp448(s[7 * 65] * scale), w1, true);
                u32x2 o; o.x = (unsigned)w0; o.y = (unsigned)w1;
                if constexpr (TILED) { const int dr = drow0 + n;
                    *(u32x2*)((unsigned char*)WT + ((size_t)(dr >> 8) * (ldd >> 7) + (k0 >> 7)) * 32768 + (dr & 255) * 128 + 64 * t + 8 * c) = o; }
                else *(u32x2*)((unsigned char*)WT + (size_t)(drow0 + n) * ldd + k0 + 64 * t + 8 * c) = o; } }
        LDS_WAIT(); asm volatile("" ::: "memory");
    }
}

typedef __attribute__((address_space(4))) const char* karg_cptr;
__device__ __forceinline__ void* karg_ptr(int k) {
    karg_cptr p = (karg_cptr)__builtin_amdgcn_kernarg_segment_ptr();
    asm volatile("" : "+s"(p));
    typedef void* voidp_t; typedef __attribute__((address_space(4))) const voidp_t* karg_vpp;
    return *(karg_vpp)(p + 8 * k);
}
__global__ void __launch_bounds__(NTHR, 2) mk_fwd(Args args) {
    extern __shared__ __attribute__((aligned(16))) unsigned char lds_raw[];
    LAS unsigned char* lds = (LAS unsigned char*)lds_raw;
    volatile LAS unsigned* MISC = (volatile LAS unsigned*)(lds + LDS_MISC);
    const int wave0 = __builtin_amdgcn_readfirstlane((int)threadIdx.x >> 6);
    const int G = gridDim.x, bx0 = blockIdx.x, NGW = G * NWAVES;
#define PHASE_IDS() int lane_; asm volatile("v_mbcnt_lo_u32_b32 %0, -1, 0\n\tv_mbcnt_hi_u32_b32 %0, -1, %0" : "=v"(lane_)); int wave_ = wave0; asm volatile("" : "+s"(wave_)); \
    int bx = bx0; asm volatile("" : "+s"(bx)); int tid = wave_ * 64 + lane_; \
    const int lane = lane_, wave = wave_; \
    const int vcu = (G % 8 == 0) ? (bx % 8) * (G / 8) + bx / 8 : bx; const int gw = vcu * NWAVES + wave; (void)lane; (void)gw
    for (int u = threadIdx.x; u < 64; u += NTHR) MISC[u] = 0u;
    __syncthreads();
    unsigned* const barw = (unsigned*)((unsigned char*)karg_ptr(25) + WS_CTL) + CW_BAR;
    XcdBarrier bar; bar.bar = barw; bar.x = 0; bar.st = nullptr;
#if !MK_MULTI
    bar = xcd_barrier_post(barw, MISC + 8);
#endif
    const int lo = args.ph_lo, hi = args.ph_hi;
#ifndef PH_MASK
#define PH_MASK 0xffffffffu
#endif
#define IN(k) (lo <= (k) && (k) < hi && ((PH_MASK >> ((k) > 15 ? (k) - 16 : (k))) & 1u))
#if MK_MULTI
#define SEAM(k) do { } while (0)
#else
#define SEAM(k) do { if ((k) + 1 < hi) xcd_barrier(bar); } while (0)
#endif
#define KARG(k) (karg_ptr(k))
#define x_in ((const float*)KARG(0))
#define c_in ((const float*)KARG(1))
#define pos_in ((const int*)KARG(2))
#define ada_w ((const float*)KARG(3))
#define ada_b ((const float*)KARG(4))
#define mix_norm ((const float*)KARG(5))
#define w_in ((const float*)KARG(6))
#define cq_norm ((const float*)KARG(7))
#define ckv_norm ((const float*)KARG(8))
#define w_uq ((const float*)KARG(9))
#define w_ukv ((const float*)KARG(10))
#define q_norm ((const float*)KARG(11))
#define k_norm ((const float*)KARG(12))
#define w_fnet ((const float*)KARG(13))
#define out_norm ((const float*)KARG(14))
#define w_out ((const float*)KARG(15))
#define ffn_norm ((const float*)KARG(16))
#define dw_gate ((const float*)KARG(17))
#define dw_up ((const float*)KARG(18))
#define dw_down ((const float*)KARG(19))
#define router_w ((const float*)KARG(20))
#define mw_gate ((const float*)KARG(21))
#define mw_up ((const float*)KARG(22))
#define mw_down ((const float*)KARG(23))
#define out ((float*)KARG(24))
#define WSB ((unsigned char*)KARG(25))
#define ctl ((unsigned*)(WSB + WS_CTL))
#define MODP ((float*)(WSB + WS_ARENA))
#define MODV ((float*)(WSB + WS_MODV))
#define COS ((float*)(WSB + WS_COS))
#define SIN ((float*)(WSB + WS_SIN))
#define TW ((f32x2*)(WSB + WS_TW))
#define FM ((bf16_t*)(WSB + WS_FM))
#define GM ((bf16_t*)(WSB + WS_GM))
#define M12 ((bf16_t*)(WSB + WS_M12))
#define TOKINFO ((int*)(WSB + WS_TOKINFO))
#define TOKPOS ((int*)(WSB + WS_TOKPOS))
#define BLKCNT ((int*)(WSB + WS_TOKPOS + (size_t)SEQ * 8))
#define ROWTOK ((int*)(WSB + CTL_ROWTOK))
#define WIN ((bf16_t*)(WSB + WS_WIN))
#define WUQ ((bf16_t*)(WSB + WS_WUQ))
#define WUKV ((bf16_t*)(WSB + WS_WUKV))
#define WOUT ((bf16_t*)(WSB + WS_WOUT))
#define WGUD ((bf16_t*)(WSB + WS_WGUD))
#define WDND ((bf16_t*)(WSB + WS_WDND))
#define WGUM ((bf16_t*)(WSB + WS_WGUM))
#define WDNM ((bf16_t*)(WSB + WS_WDNM))
#define HB ((bf16_t*)(WSB + WS_H))
#define YB ((bf16_t*)(WSB + WS_Y))
#define ZB ((bf16_t*)(WSB + WS_Z))
#define QB ((bf16_t*)(WSB + WS_QB))
#define KVB ((bf16_t*)(WSB + WS_KVB))
#define KB ((bf16_t*)(WSB + WS_KB))
#define A1 ((bf16_t*)(WSB + WS_A1))
#define YC ((bf16_t*)(WSB + WS_YC))
#define HID ((bf16_t*)(WSB + WS_HID))
#define YPART ((bf16_t*)(WSB + WS_ARENA + 256 * MiB))

    if (IN(0)) {
        PHASE_IDS();
        LAS float* cond = (LAS float*)(lds + LDS_COND); LAS float* trig = (LAS float*)(lds + LDS_TRIG);
        for (int i = tid; i < DM; i += NTHR) { const float c = c_in[i]; cond[i] = c / (1.0f + __expf(-c)); }
        if (tid < 128) { trig[tid] = (float)cospi(2.0 * tid / 128.0); trig[128 + tid] = (float)sinpi(2.0 * tid / 128.0); }
        __syncthreads();
        LAS float* scr = (LAS float*)(lds + wave * 16640);
        constexpr int I_GEMV = 2 * 48 * 64;
        constexpr int I_WIN = 16 * 29, I_WUQ = 4 * 24, I_WUKV = 2 * 32, I_WOUT = 16 * 32;
        constexpr int I_DGU = 16 * 88, I_DDN = 44 * 32, I_MGU = 16 * 112, I_MDN = 56 * 32;
        constexpr int I_ZERO = 2 * 192;
        constexpr int I_ROPE = SEQ * 32 / 64;
        constexpr int I_TW = 16384 / 64, I_FM = 32768 / 64, I_GM = 65536 / 64, I_M12 = 2 * 8 * 256 * 128 / 64;
        constexpr int NITEMS = I_GEMV + 2 * (I_WIN + I_WUQ + I_WUKV + I_WOUT) + 2 * I_DGU + I_DDN + 16 * I_MGU + 8 * I_MDN + I_ZERO + I_ROPE + I_TW + I_FM + I_GM + I_M12;
        for (int it = gw; it < NITEMS; it += NGW) {
            int r = it;
            if (r < I_GEMV) {
                const int kc = r & 63, cb = r >> 6, l = cb / 48, n0 = (cb % 48) * 256 + 4 * lane;
                const float* W = ada_w + ((size_t)l * DM + kc * 32) * 12288 + n0;
                f32x4 a = {0.f, 0.f, 0.f, 0.f};
                f32x4 v[32];
#pragma unroll
                for (int k = 0; k < 32; ++k) v[k] = *(const f32x4*)(W + (size_t)k * 12288);
#pragma unroll
                for (int k = 0; k < 32; ++k) a += v[k] * cond[kc * 32 + k];
                *(f32x4*)(MODP + ((size_t)kc * 2 + l) * 12288 + n0) = a;
                continue;
            } r -= I_GEMV;
            bool done = false;
#pragma unroll 1
            for (int l = 0; l < 2 && !done; ++l) {
                if (r < I_WIN) { const int kb = r / 29, nb = r % 29; cvt_pair<false>(w_in + (size_t)l * DM * DIN, DIN, WIN + (size_t)l * DINP * DM, DM, 128 * kb, 64 * nb, 64 * nb, 1.f, scr, lane); done = true; break; } r -= I_WIN;
                if (r < I_WUQ) { const int kb = r / 24, nb = r % 24; cvt_pair<false>(w_uq + (size_t)l * QLR * 1536, 1536, WUQ + (size_t)l * 1536 * QLR, QLR, 128 * kb, 64 * nb, 64 * nb, 1.f, scr, lane); done = true; break; } r -= I_WUQ;
                if (r < I_WUKV) { const int kb = r / 32, nb = r % 32; cvt_pair<false>(w_ukv + (size_t)l * KVLR * 2048, 2048, WUKV + (size_t)l * 2048 * KVLR, KVLR, 128 * kb, 64 * nb, 64 * nb, 1.f, scr, lane); done = true; break; } r -= I_WUKV;
                if (r < I_WOUT) { const int kb = r / 32, nb = r % 32; cvt_pair<false>(w_out + (size_t)l * DM * DM, DM, WOUT + (size_t)l * DM * DM, DM, 128 * kb, 64 * nb, 64 * nb, 1.f, scr, lane); done = true; break; } r -= I_WOUT;
            }
            if (done) continue;
            if (r < 2 * I_DGU) { const int up = r / I_DGU, rr = r % I_DGU, kb = rr / 88, nb = rr % 88, n0 = 64 * nb;
                cvt_pair<false>(up ? dw_up : dw_gate, DFF, WGUD, DM, 128 * kb, n0, (n0 >> 7) * 256 + (n0 & 127) + up * 128, 1.f, scr, lane); continue; } r -= 2 * I_DGU;
            if (r < I_DDN) { const int kb = r / 32, nb = r % 32; cvt_pair<false>(dw_down, DM, WDND, DFF, 128 * kb, 64 * nb, 64 * nb, 1.f, scr, lane); continue; } r -= I_DDN;
            if (r < 16 * I_MGU) { const int e = r / (2 * I_MGU), r2 = r % (2 * I_MGU), up = r2 / I_MGU, rr = r2 % I_MGU, kb = rr / 112, nb = rr % 112, n0 = 64 * nb;
                cvt_pair<true, true>((up ? mw_up : mw_gate) + (size_t)e * DM * DFE, DFE, (unsigned char*)WGUM + (size_t)e * 14336 * DM, DM, 128 * kb, n0, (n0 >> 7) * 256 + (n0 & 127) + up * 128, S8_WGU, scr, lane); continue; } r -= 16 * I_MGU;
            if (r < 8 * I_MDN) { const int e = r / I_MDN, rr = r % I_MDN, kb = rr / 32, nb = rr % 32;
                cvt_pair<true, true>(mw_down + (size_t)e * DFE * DM, DM, (unsigned char*)WDNM + (size_t)e * DM * DFE, DFE, 128 * kb, 64 * nb, 64 * nb, S8_WDN, scr, lane); continue; } r -= 8 * I_MDN;
            if (r < I_ZERO) { const int l = r / 192, row = 1856 + r % 192; u32x4 z = {0u, 0u, 0u, 0u};
#pragma unroll
                for (int j = 0; j < 4; ++j) *(u32x4*)(WIN + ((size_t)l * DINP + row) * DM + (lane + 64 * j) * 8) = z;
                continue; } r -= I_ZERO;
            if (r < I_ROPE) { const int idx = r * 64 + lane, t = idx >> 5, i = idx & 31;
                const double inv = exp2(-(double)i * (13.287712379549449 / 32.0));
                const double ang = (double)pos_in[t] * inv; double sn, cs; sincos(ang, &sn, &cs);
                COS[idx] = (float)cs; SIN[idx] = (float)sn; continue; } r -= I_ROPE;
            if (r < I_TW) { const int idx = r * 64 + lane, s2 = idx >> 7, k1 = idx & 127; const int m = (s2 * k1) & 16383;
                double sn, cs; sincospi(2.0 * (double)m / 16384.0, &sn, &cs); TW[idx] = (f32x2){(float)cs, (float)(-sn)}; continue; } r -= I_TW;
            if (r < I_FM) { const int idx = r * 64 + lane, m = idx >> 7, s1 = idx & 127, k1 = m >> 1, ri = m & 1; const int ph = (k1 * s1) & 127;
                const float v = (ri ? -trig[128 + ph] : trig[ph]) * 0.08838834764831845f; FM[idx] = f2bf(v); continue; } r -= I_FM;
            if (r < I_GM) { const int idx = r * 64 + lane, m = idx >> 8, k = idx & 255, ro = m >> 7, k2 = m & 127, rin = k >> 7, s2 = k & 127; const int ph = (k2 * s2) & 127;
                float v = (ro == rin) ? trig[ph] : (ro == 0 ? trig[128 + ph] : -trig[128 + ph]);
                GM[idx] = f2bf(v * 0.08838834764831845f); continue; } r -= I_GM;
            {
                const int idx = r * 64 + lane, d = idx & 127, kk = (idx >> 7) & 255, lg = idx >> 15, ri = kk >> 7, c = kk & 127;
                const float* Wf = w_fnet + (size_t)lg * 128 * 128 + d; float a = 0.f;
                for (int m = 0; m < 128; ++m) a += trig[ri * 128 + ((m * c) & 127)] * Wf[m * 128];
                M12[idx] = f2bf(a * 0.08838834764831845f);
            }
        }
        SEAM(0);
    }
    if (IN(1)) {
        PHASE_IDS();
        for (int i = (bx * NTHR + tid); i < 2 * 12288; i += G * NTHR) { float a = ada_b[i];
#pragma unroll
            for (int k = 0; k < 64; ++k) a += MODP[(size_t)k * 2 * 12288 + i];
            MODV[i] = a; }
        SEAM(1);
    }

#pragma unroll 1
    for (int l = 0; l < 2; ++l) {
        const int pb = 2 + 16 * l;
#define modv (MODV + (size_t)l * 12288)
#define xcur ((l == 0) ? x_in : (const float*)out)
#pragma unroll 1
        for (int sub = 0; sub < 2; ++sub) {
            const int ph = pb + (sub ? 8 : 0);
            if (IN(ph)) {
                PHASE_IDS();
                const float* xs = sub ? (const float*)out : xcur;
                const float* gain = (sub ? ffn_norm : mix_norm) + (size_t)l * DM;
                const float* shv = modv + (sub ? 3 : 0) * DM; const float* scv = modv + (sub ? 4 : 1) * DM;
                const bool router = (sub == 1 && l == 1);
                LAS float* wr_l = (LAS float*)lds;
                LAS int* etab = (LAS int*)(lds + 65536); LAS int* rtab = (LAS int*)(lds + 65536 + 4096);
                if (router) { etab[tid] = 0xffff;
                    for (int i = tid; i < DM * NE / 4; i += NTHR) ((LAS f32x4*)wr_l)[i] = ((const f32x4*)router_w)[i]; }
                __syncthreads();
                f32x4 av[8], bv[8];
#pragma unroll
                for (int j = 0; j < 8; ++j) { const f32x4 g4 = ((const f32x4*)gain)[lane + 64 * j], s4 = ((const f32x4*)scv)[lane + 64 * j]; av[j] = g4 * (1.0f + s4); bv[j] = ((const f32x4*)shv)[lane + 64 * j]; }
                int my_e0 = 0, my_e1 = 0, my_tok = -1; float my_w0 = 0.f, my_w1 = 0.f; int itn = 0;
                for (int m = gw; m < SEQ; m += NGW, ++itn) {
                    f32x4 v[8]; float ss = 0.f;
#pragma unroll
                    for (int j = 0; j < 8; ++j) { v[j] = ((const f32x4*)(xs + (size_t)m * DM))[lane + 64 * j]; ss += (v[j][0] * v[j][0] + v[j][1] * v[j][1]) + (v[j][2] * v[j][2] + v[j][3] * v[j][3]); }
                    const float rstd = 1.0f / sqrtf(wave_sum(ss) * (1.0f / DM) + RMS_EPS);
#pragma unroll
                    for (int j = 0; j < 8; ++j) { v[j] = v[j] * rstd * av[j] + bv[j];
                        if (router) { int w8 = 0; w8 = __builtin_amdgcn_cvt_pk_fp8_f32(pg8::clamp448(v[j][0] * S8_H), pg8::clamp448(v[j][1] * S8_H), w8, false); w8 = __builtin_amdgcn_cvt_pk_fp8_f32(pg8::clamp448(v[j][2] * S8_H), pg8::clamp448(v[j][3] * S8_H), w8, true);
                            *(unsigned*)((unsigned char*)HB + (size_t)m * DM + 4 * lane + 256 * j) = (unsigned)w8; }
                        else *(u32x2*)(HB + (size_t)m * DM + 4 * lane + 256 * j) = pack4(v[j]); }
                    if (router) {
                        float lg[8] = {0.f, 0.f, 0.f, 0.f, 0.f, 0.f, 0.f, 0.f};
#pragma unroll
                        for (int j = 0; j < 8; ++j)
#pragma unroll
                            for (int q = 0; q < 4; ++q) { const int k = 4 * lane + 256 * j + q; const f32x4 w0 = *(const LAS f32x4*)(wr_l + k * 8), w1 = *(const LAS f32x4*)(wr_l + k * 8 + 4); const float hv = v[j][q];
                                lg[0] += hv * w0[0]; lg[1] += hv * w0[1]; lg[2] += hv * w0[2]; lg[3] += hv * w0[3]; lg[4] += hv * w1[0]; lg[5] += hv * w1[1]; lg[6] += hv * w1[2]; lg[7] += hv * w1[3]; }
#pragma unroll
                        for (int e = 0; e < 8; ++e) lg[e] = wave_sum(lg[e]);
                        int e0 = 0; float l0 = lg[0];
#pragma unroll
                        for (int e = 1; e < 8; ++e) if (lg[e] > l0) { l0 = lg[e]; e0 = e; }
                        int e1 = -1; float l1 = -3.0e38f;
#pragma unroll
                        for (int e = 0; e < 8; ++e) if (e != e0 && lg[e] > l1) { l1 = lg[e]; e1 = e; }
                        const float w1 = 1.0f / (1.0f + __expf(l0 - l1)), w0 = 1.0f - w1;
                        if (lane == 0) etab[itn * NWAVES + wave] = e0 | (e1 << 8);
                        if (lane == itn) { my_e0 = e0; my_e1 = e1; my_w0 = w0; my_w1 = w1; my_tok = m; }
                    }
                }
                if (router) {
                    __syncthreads();
                    const int nent = ((SEQ + NGW - 1) / NGW) * NWAVES;
                    if (tid < nent) {
                        const int me = etab[tid], a0 = me & 255, a1 = me >> 8; int c0 = 0, c1 = 0;
                        for (int q = 0; q < tid; ++q) { const int o = etab[q], b0 = o & 255, b1 = o >> 8; c0 += (b0 == a0) + (b1 == a0); c1 += (b0 == a1) + (b1 == a1); }
                        rtab[2 * tid] = c0; rtab[2 * tid + 1] = c1; }
                    if (tid >= 512 - 8) { const int e = tid - (512 - 8); int c = 0;
                        for (int q = 0; q < nent; ++q) { const int o = etab[q]; c += ((o & 255) == e) + ((o >> 8) == e); }
                        BLKCNT[bx * 8 + e] = c; }
                    __syncthreads();
                    if (my_tok >= 0) { int* ti = TOKINFO + (size_t)my_tok * 8; ti[0] = my_e0; ti[1] = my_e1; ti[2] = __float_as_int(my_w0); ti[3] = __float_as_int(my_w1);
                        ti[4] = rtab[2 * (lane * NWAVES + wave)]; ti[5] = rtab[2 * (lane * NWAVES + wave) + 1]; ti[6] = bx; }
                }
                __syncthreads();
                SEAM(ph);
            }
            if (sub == 0) {
            if (IN(pb + 1)) {
                PHASE_IDS();
                pg8::Gemm g{HB, WIN + (size_t)l * DINP * DM, DM, DM, DM, 0, nullptr}; pg8::TileOrder S; S.init(SEQ / 256, DINP / 256, G, bx);
                pg8::EpiBf16 E{ZB, DINP, 1.0f};
                pg8::gemm_phase<pg8::EpiBf16, pg8::TileOrder, false>(tid, lds, g, S, E);
                SEAM(pb + 1);
            }
            if (IN(pb + 2)) {
                PHASE_IDS();
                f32x4 gq0 = ((const f32x4*)(cq_norm + (size_t)l * QLR))[2 * lane], gq1 = ((const f32x4*)(cq_norm + (size_t)l * QLR))[2 * lane + 1];
                f32x4 gk = ((const f32x4*)(ckv_norm + (size_t)l * KVLR))[lane];
                for (int m = gw; m < SEQ; m += NGW) {
                    bf16_t* zr = ZB + (size_t)m * DINP;
                    const bf16x8 q8 = *(const bf16x8*)(zr + ZQ + 8 * lane); const s16x4 k4 = *(const s16x4*)(zr + ZKV + 4 * lane);
                    float qf[8], kf[4], sq = 0.f, sk = 0.f;
#pragma unroll
                    for (int j = 0; j < 8; ++j) { qf[j] = bf2f((unsigned short)q8[j]); sq += qf[j] * qf[j]; }
#pragma unroll
                    for (int j = 0; j < 4; ++j) { kf[j] = bf2f((unsigned short)k4[j]); sk += kf[j] * kf[j]; }
                    const float rq = 1.0f / sqrtf(wave_sum(sq) * (1.0f / QLR) + RMS_EPS), rk = 1.0f / sqrtf(wave_sum(sk) * (1.0f / KVLR) + RMS_EPS);
                    u32x4 wq; wq.x = cvt_pk_bf16(qf[0] * rq * gq0[0], qf[1] * rq * gq0[1]); wq.y = cvt_pk_bf16(qf[2] * rq * gq0[2], qf[3] * rq * gq0[3]);
                    wq.z = cvt_pk_bf16(qf[4] * rq * gq1[0], qf[5] * rq * gq1[1]); wq.w = cvt_pk_bf16(qf[6] * rq * gq1[2], qf[7] * rq * gq1[3]);
                    u32x2 wk; wk.x = cvt_pk_bf16(kf[0] * rk * gk[0], kf[1] * rk * gk[1]); wk.y = cvt_pk_bf16(kf[2] * rk * gk[2], kf[3] * rk * gk[3]);
                    *(u32x4*)(zr + ZQ + 8 * lane) = wq; *(u32x2*)(zr + ZKV + 4 * lane) = wk;
                }
                {   PHASE_IDS();
                    const int r32 = lane & 31, hi = lane >> 5;
                    LAS unsigned char* ost = lds + sg::OST_OFF + wave * sg::OST_WAVE;
                    bf16x8 Af[8];
#pragma unroll
                    for (int s = 0; s < 8; ++s) Af[s] = *(const bf16x8*)(FM + (size_t)(32 * wave + r32) * 128 + 16 * s + 8 * hi);
                    for (int it = bx; it < 1024; it += G) {
                        const int s2 = it >> 3, cc = it & 7;
                        __syncthreads();
                        sg::stage_b<128>(ZB + (size_t)s2 * DINP + ZU + cc * 128, (size_t)128 * DINP, (char*)lds_raw, tid);
                        __syncthreads();
                        f32x16 o[4] = {};
                        sg::mm<128>(o, Af, (char*)lds_raw, lane);
#pragma unroll
                        for (int p = 0; p < 8; ++p) { const int k1 = 16 * wave + (p & 1) + 4 * (p >> 1) + 2 * hi; const f32x2 tw = TW[s2 * 128 + k1];
#pragma unroll
                            for (int d0 = 0; d0 < 4; ++d0) { const float re = o[d0][2 * p], im = o[d0][2 * p + 1];
                                o[d0][2 * p] = re * tw[0] - im * tw[1]; o[d0][2 * p + 1] = re * tw[1] + im * tw[0]; } }
                        sg::store_tile(o, ost, lane, sg::RowF1{A1, wave, s2, cc});
                    }
                    __syncthreads();
                }
                SEAM(pb + 2);
            }
            if (IN(pb + 3)) {
                PHASE_IDS();
                { pg8::Gemm g{ZB + ZQ, WUQ + (size_t)l * 1536 * QLR, DINP, QLR, QLR, 0, nullptr}; pg8::TileOrder S; S.init(SEQ / 256, 1536 / 256, G, bx);
                  pg8::EpiBf16 E{QB, 1536, 1.0f}; pg8::gemm_phase<pg8::EpiBf16, pg8::TileOrder, false>(tid, lds, g, S, E); }
                { pg8::Gemm g{ZB + ZKV, WUKV + (size_t)l * 2048 * KVLR, DINP, KVLR, KVLR, 0, nullptr}; pg8::TileOrder S; S.init(SEQ / 256, 2048 / 256, G, bx);
                  pg8::EpiBf16 E{KVB, 2048, 1.0f}; pg8::gemm_phase<pg8::EpiBf16, pg8::TileOrder, false>(tid, lds, g, S, E); }
                {   PHASE_IDS();
                    const int r32 = lane & 31, hi = lane >> 5;
                    LAS unsigned char* ost = lds + sg::OST_OFF + wave * sg::OST_WAVE;
                    bf16x8 Af[16];
#pragma unroll
                    for (int s = 0; s < 16; ++s) Af[s] = *(const bf16x8*)(GM + (size_t)(32 * wave + r32) * 256 + 16 * s + 8 * hi);
                    for (int it = bx; it < 1024; it += G) {
                        const int k1 = it >> 3, gidx = it & 7;
                        __syncthreads();
                        sg::stage_b<256>(A1 + (size_t)k1 * 256 * 1024 + gidx * 128, 1024, (char*)lds_raw, tid);
                        __syncthreads();
                        f32x16 o[4] = {};
                        sg::mm<256>(o, Af, (char*)lds_raw, lane);
                        sg::store_tile(o, ost, lane, sg::RowF2{YC, wave, k1, gidx});
                    }
                    __syncthreads();
                }
                SEAM(pb + 3);
            }
            if (IN(pb + 4)) {
                PHASE_IDS();
                {
                    const int hd = lane >> 3, j8 = lane & 7;
                    const float* qg = q_norm + (size_t)l * QKD; const float* kg = k_norm + (size_t)l * QKD;
                    f32x4 qgn[4], kgn[4], qgr[2], kgr[2];
#pragma unroll
                    for (int j = 0; j < 4; ++j) { qgn[j] = *(const f32x4*)(qg + 16 * j8 + 4 * j); kgn[j] = *(const f32x4*)(kg + 16 * j8 + 4 * j); }
                    qgr[0] = *(const f32x4*)(qg + NOPE + 4 * j8); qgr[1] = *(const f32x4*)(qg + NOPE + 32 + 4 * j8);
                    kgr[0] = *(const f32x4*)(kg + NOPE + 4 * j8); kgr[1] = *(const f32x4*)(kg + NOPE + 32 + 4 * j8);
                    for (int m = gw; m < SEQ; m += NGW) {
                        const f32x4 cs = *(const f32x4*)(COS + (size_t)m * 32 + 4 * j8), sn = *(const f32x4*)(SIN + (size_t)m * 32 + 4 * j8);
                        {
                            bf16_t* qp = QB + (size_t)m * 1536 + hd * QKD;
                            const bf16x8 n0 = *(const bf16x8*)(qp + 16 * j8), n1 = *(const bf16x8*)(qp + 16 * j8 + 8);
                            const s16x4 ra = *(const s16x4*)(qp + NOPE + 4 * j8), rb = *(const s16x4*)(qp + NOPE + 32 + 4 * j8);
                            float f[16], x1[4], x2[4], ss = 0.f;
#pragma unroll
                            for (int j = 0; j < 8; ++j) { f[j] = bf2f((unsigned short)n0[j]); f[8 + j] = bf2f((unsigned short)n1[j]); }
#pragma unroll
                            for (int j = 0; j < 16; ++j) ss += f[j] * f[j];
#pragma unroll
                            for (int j = 0; j < 4; ++j) { x1[j] = bf2f((unsigned short)ra[j]); x2[j] = bf2f((unsigned short)rb[j]); ss += x1[j] * x1[j] + x2[j] * x2[j]; }
                            ss += swz_xor<1>(ss); ss += swz_xor<2>(ss); ss += swz_xor<4>(ss);
                            const float rs = 1.0f / sqrtf(ss * (1.0f / QKD) + RMS_EPS);
                            u32x4 w0, w1;
                            w0.x = cvt_pk_bf16(f[0] * rs * qgn[0][0], f[1] * rs * qgn[0][1]); w0.y = cvt_pk_bf16(f[2] * rs * qgn[0][2], f[3] * rs * qgn[0][3]);
                            w0.z = cvt_pk_bf16(f[4] * rs * qgn[1][0], f[5] * rs * qgn[1][1]); w0.w = cvt_pk_bf16(f[6] * rs * qgn[1][2], f[7] * rs * qgn[1][3]);
                            w1.x = cvt_pk_bf16(f[8] * rs * qgn[2][0], f[9] * rs * qgn[2][1]); w1.y = cvt_pk_bf16(f[10] * rs * qgn[2][2], f[11] * rs * qgn[2][3]);
                            w1.z = cvt_pk_bf16(f[12] * rs * qgn[3][0], f[13] * rs * qgn[3][1]); w1.w = cvt_pk_bf16(f[14] * rs * qgn[3][2], f[15] * rs * qgn[3][3]);
                            float o1[4], o2[4];
#pragma unroll
                            for (int j = 0; j < 4; ++j) { const float a = x1[j] * rs * qgr[0][j], b = x2[j] * rs * qgr[1][j]; o1[j] = a * cs[j] - b * sn[j]; o2[j] = b * cs[j] + a * sn[j]; }
                            u32x2 wa, wb; wa.x = cvt_pk_bf16(o1[0], o1[1]); wa.y = cvt_pk_bf16(o1[2], o1[3]); wb.x = cvt_pk_bf16(o2[0], o2[1]); wb.y = cvt_pk_bf16(o2[2], o2[3]);
                            *(u32x4*)(qp + 16 * j8) = w0; *(u32x4*)(qp + 16 * j8 + 8) = w1; *(u32x2*)(qp + NOPE + 4 * j8) = wa; *(u32x2*)(qp + NOPE + 32 + 4 * j8) = wb;
                        }
                        {
                            const bf16_t* kp = KVB + (size_t)m * 2048 + hd * 256; const bf16_t* krp = ZB + (size_t)m * DINP + ZKR;
                            bf16_t* ko = KB + (size_t)m * 1536 + hd * QKD;
                            const bf16x8 n0 = *(const bf16x8*)(kp + 16 * j8), n1 = *(const bf16x8*)(kp + 16 * j8 + 8);
                            const s16x4 ra = *(const s16x4*)(krp + 4 * j8), rb = *(const s16x4*)(krp + 32 + 4 * j8);
                            float f[16], x1[4], x2[4], ss = 0.f;
#pragma unroll
                            for (int j = 0; j < 8; ++j) { f[j] = bf2f((unsigned short)n0[j]); f[8 + j] = bf2f((unsigned short)n1[j]); }
#pragma unroll
                            for (int j = 0; j < 16; ++j) ss += f[j] * f[j];
#pragma unroll
                            for (int j = 0; j < 4; ++j) { x1[j] = bf2f((unsigned short)ra[j]); x2[j] = bf2f((unsigned short)rb[j]); ss += x1[j] * x1[j] + x2[j] * x2[j]; }
                            ss += swz_xor<1>(ss); ss += swz_xor<2>(ss); ss += swz_xor<4>(ss);
                            const float rs = 1.0f / sqrtf(ss * (1.0f / QKD) + RMS_EPS);
                            u32x4 w0, w1;
                            w0.x = cvt_pk_bf16(f[0] * rs * kgn[0][0], f[1] * rs * kgn[0][1]); w0.y = cvt_pk_bf16(f[2] * rs * kgn[0][2], f[3] * rs * kgn[0][3]);
                            w0.z = cvt_pk_bf16(f[4] * rs * kgn[1][0], f[5] * rs * kgn[1][1]); w0.w = cvt_pk_bf16(f[6] * rs * kgn[1][2], f[7] * rs * kgn[1][3]);
                            w1.x = cvt_pk_bf16(f[8] * rs * kgn[2][0], f[9] * rs * kgn[2][1]); w1.y = cvt_pk_bf16(f[10] * rs * kgn[2][2], f[11] * rs * kgn[2][3]);
                            w1.z = cvt_pk_bf16(f[12] * rs * kgn[3][0], f[13] * rs * kgn[3][1]); w1.w = cvt_pk_bf16(f[14] * rs * kgn[3][2], f[15] * rs * kgn[3][3]);
                            float o1[4], o2[4];
#pragma unroll
                            for (int j = 0; j < 4; ++j) { const float a = x1[j] * rs * kgr[0][j], b = x2[j] * rs * kgr[1][j]; o1[j] = a * cs[j] - b * sn[j]; o2[j] = b * cs[j] + a * sn[j]; }
                            u32x2 wa, wb; wa.x = cvt_pk_bf16(o1[0], o1[1]); wa.y = cvt_pk_bf16(o1[2], o1[3]); wb.x = cvt_pk_bf16(o2[0], o2[1]); wb.y = cvt_pk_bf16(o2[2], o2[3]);
                            *(u32x4*)(ko + 16 * j8) = w0; *(u32x4*)(ko + 16 * j8 + 8) = w1; *(u32x2*)(ko + NOPE + 4 * j8) = wa; *(u32x2*)(ko + NOPE + 32 + 4 * j8) = wb;
                        }
                    }
                }
                {   PHASE_IDS();
                    const int r32 = lane & 31, hi = lane >> 5;
                    LAS unsigned char* ost = lds + sg::OST_OFF + wave * sg::OST_WAVE;
                    for (int it = bx; it < 512; it += G) {
                        const int tt = it >> 3, gidx = it & 7;
                        bf16x8 Af[16];
                        const bf16_t* ar = YC + (size_t)(256 * tt + 32 * wave + r32) * 2048 + gidx * 256 + 8 * hi;
#pragma unroll
                        for (int s = 0; s < 16; ++s) Af[s] = *(const bf16x8*)(ar + 16 * s);
                        __syncthreads();
                        sg::stage_b<256>(M12 + (size_t)(l * 8 + gidx) * 256 * 128, 128, (char*)lds_raw, tid);
                        __syncthreads();
                        f32x16 o[4] = {};
                        sg::mm<256>(o, Af, (char*)lds_raw, lane);
                        sg::store_tile(o, ost, lane, sg::RowF3{HB, wave, tt, gidx});
                    }
                    __syncthreads();
                }
                SEAM(pb + 4);
            }
            if (IN(pb + 5)) {
                PHASE_IDS();
                float gq = 0.f, gk = 0.f;
#pragma unroll
                for (int j = 0; j < 3; ++j) { gq = fmaxf(gq, fabsf(q_norm[(size_t)l * QKD + lane + 64 * j])); gk = fmaxf(gk, fabsf(k_norm[(size_t)l * QKD + lane + 64 * j])); }
                gq = fmaxf(gq, swz_xor<1>(gq)); gq = fmaxf(gq, swz_xor<2>(gq)); gq = fmaxf(gq, swz_xor<4>(gq)); gq = fmaxf(gq, swz_xor<8>(gq)); gq = fmaxf(gq, swz_xor<16>(gq));
                gk = fmaxf(gk, swz_xor<1>(gk)); gk = fmaxf(gk, swz_xor<2>(gk)); gk = fmaxf(gk, swz_xor<4>(gk)); gk = fmaxf(gk, swz_xor<8>(gk)); gk = fmaxf(gk, swz_xor<16>(gk));
                { auto rq = __builtin_amdgcn_permlane32_swap(__float_as_uint(gq), __float_as_uint(gq), false, false); gq = fmaxf(__uint_as_float(rq[0]), __uint_as_float(rq[1]));
                  auto rk = __builtin_amdgcn_permlane32_swap(__float_as_uint(gk), __float_as_uint(gk), false, false); gk = fmaxf(__uint_as_float(rk[0]), __uint_as_float(rk[1])); }
                const int negMC = __builtin_amdgcn_readfirstlane(__builtin_bit_cast(int, -(13.856406460551018f * gq * gk) * 1.4426950408889634f));
                for (int u = bx; u < NH * (SEQ / 256); u += G) {
                    const int h = u & 7, qb = u >> 3;
                    att::attn_unit2(QB + (size_t)(qb * 256) * 1536 + h * QKD, KB + h * QKD, KVB + h * 256 + NOPE, HB + (size_t)(qb * 256) * DM + h * VHD, SEQ, lds, tid, negMC);
                }
                SEAM(pb + 5);
            }
            if (IN(pb + 6)) {
                PHASE_IDS();
                const float* og = out_norm + (size_t)l * DM;
                f32x4 ga[4], gf[4];
#pragma unroll
                for (int j = 0; j < 4; ++j) { ga[j] = *(const f32x4*)(og + 16 * lane + 4 * j); gf[j] = *(const f32x4*)(og + 1024 + 16 * lane + 4 * j); }
                for (int m = gw; m < SEQ; m += NGW) {
                    bf16_t* rp = HB + (size_t)m * DM;
#pragma unroll
                    for (int half = 0; half < 2; ++half) {
                        bf16_t* p = rp + half * 1024 + 16 * lane;
                        const bf16x8 a0 = *(const bf16x8*)p, a1 = *(const bf16x8*)(p + 8);
                        float f[16], ss = 0.f;
#pragma unroll
                        for (int j = 0; j < 8; ++j) { f[j] = bf2f((unsigned short)a0[j]); f[8 + j] = bf2f((unsigned short)a1[j]); }
#pragma unroll
                        for (int j = 0; j < 16; ++j) ss += f[j] * f[j];
                        const float rs = 1.0f / sqrtf(wave_sum(ss) * (1.0f / 1024) + RMS_EPS);
                        u32x4 w0, w1;
#define GG(j) (half ? gf[(j) >> 2][(j) & 3] : ga[(j) >> 2][(j) & 3])
                        w0.x = cvt_pk_bf16(f[0] * rs * GG(0), f[1] * rs * GG(1)); w0.y = cvt_pk_bf16(f[2] * rs * GG(2), f[3] * rs * GG(3));
                        w0.z = cvt_pk_bf16(f[4] * rs * GG(4), f[5] * rs * GG(5)); w0.w = cvt_pk_bf16(f[6] * rs * GG(6), f[7] * rs * GG(7));
                        w1.x = cvt_pk_bf16(f[8] * rs * GG(8), f[9] * rs * GG(9)); w1.y = cvt_pk_bf16(f[10] * rs * GG(10), f[11] * rs * GG(11));
                        w1.z = cvt_pk_bf16(f[12] * rs * GG(12), f[13] * rs * GG(13)); w1.w = cvt_pk_bf16(f[14] * rs * GG(14), f[15] * rs * GG(15));
#undef GG
                        *(u32x4*)p = w0; *(u32x4*)(p + 8) = w1;
                    }
                }
                SEAM(pb + 6);
            }
            if (IN(pb + 7)) {
                PHASE_IDS();
                pg8::Gemm g{HB, WOUT + (size_t)l * DM * DM, DM, DM, DM, 0, nullptr}; pg8::TileOrder S; S.init(SEQ / 256, DM / 256, G, bx);
                pg8::EpiRes E{xcur, out, modv + 2 * DM, DM};
                pg8::gemm_phase<pg8::EpiRes, pg8::TileOrder, false>(tid, lds, g, S, E);
                SEAM(pb + 7);
            }
            }
        }
        if (l == 0) {
            if (IN(pb + 9)) {
                PHASE_IDS();
                pg8::Gemm g{HB, WGUD, DM, DM, DM, 0, nullptr}; pg8::TileOrder S; S.init(SEQ / 256, 2 * DFF / 256, G, bx);
                pg8::EpiSwiGLU E{HID, DFF};
                pg8::gemm_phase<pg8::EpiSwiGLU, pg8::TileOrder, false>(tid, lds, g, S, E);
                SEAM(pb + 9);
            }
            if (IN(pb + 10)) {
                PHASE_IDS();
                pg8::Gemm g{HID, WDND, DFF, DFF, DFF, 0, nullptr}; pg8::TileOrder S; S.init(SEQ / 256, DM / 256, G, bx);
                pg8::EpiRes E{out, out, modv + 5 * DM, DM};
                pg8::gemm_phase<pg8::EpiRes, pg8::TileOrder, false>(tid, lds, g, S, E);
                SEAM(pb + 10);
            }
        } else {
#define LOAD_TS() int ts[9]; ts[0] = 0; _Pragma("unroll") for (int e = 0; e < 8; ++e) { const int c = __builtin_amdgcn_readfirstlane((int)__hip_atomic_load(ctl + CW_ECNT + 64 * e, RLX_AGENT)); ts[e + 1] = ts[e] + ((c + 255) >> 8); }
            if (IN(pb + 9)) {
                PHASE_IDS();
                LAS int* pref = (LAS int*)lds; LAS int* tot = pref + G * 8;
                for (int i = tid; i < G * 8; i += NTHR) pref[i] = BLKCNT[i];
                __syncthreads();
                if (tid < 8) { int run = 0; for (int b = 0; b < G; ++b) { const int c = pref[b * 8 + tid]; pref[b * 8 + tid] = run; run += c; } tot[tid] = run;
                    if (bx == 0) __hip_atomic_store(ctl + CW_ECNT + 64 * tid, (unsigned)run, RLX_AGENT); }
                __syncthreads();
                int ts[9]; ts[0] = 0;
#pragma unroll
                for (int e = 0; e < 8; ++e) ts[e + 1] = ts[e] + ((tot[e] + 255) >> 8);
                for (int t = bx * NTHR + tid; t < SEQ; t += G * NTHR) {
                    const int* ti = TOKINFO + (size_t)t * 8; const int e0 = ti[0], e1 = ti[1], b = ti[6];
                    int p0 = ti[4] + pref[b * 8 + e0], p1 = ti[5] + pref[b * 8 + e1];
#pragma unroll
                    for (int e = 0; e < 8; ++e) { if (e0 == e) p0 += 256 * ts[e]; if (e1 == e) p1 += 256 * ts[e]; }
                    ROWTOK[p0] = t; ROWTOK[p1] = t; TOKPOS[2 * t] = p0; TOKPOS[2 * t + 1] = p1;
                }
                __syncthreads();
                SEAM(pb + 9);
            }
            if (IN(pb + 10)) {
                PHASE_IDS(); LOAD_TS();
                pg8::Gemm g{HB, WGUM, DM, DM, DM, (size_t)14336 * DM, ROWTOK}; pg8::TileOrder S; S.init(ts[8], 2 * DFE / 256, G, bx); S.moe = true;
#pragma unroll
                for (int e = 0; e < 9; ++e) S.ts[e] = ts[e];
                pg8::EpiSwiGLU8 E{(unsigned char*)HID, DFE, 1.0f / (S8_H * S8_WGU), S8_HID};
                pg8::gemm_phase<pg8::EpiSwiGLU8, pg8::TileOrder, true, true, true>(tid, lds, g, S, E);
                SEAM(pb + 10);
            }
            if (IN(pb + 11)) {
                PHASE_IDS(); LOAD_TS();
                const int nmain = ts[8] < 128 ? ts[8] : 128;
                pg8::EpiBf16 E{YB, DM, 1.0f / (S8_HID * S8_WDN), YPART - (size_t)32768 * DM, (size_t)2048 * DM};
                { pg8::Gemm g{HID, WDNM, DFE, DFE, DFE, (size_t)DM * DFE, nullptr}; pg8::TileOrder S; S.init(nmain, DM / 256, G, bx); S.moe = true;
#pragma unroll
                  for (int e = 0; e < 9; ++e) S.ts[e] = ts[e];
                  pg8::gemm_phase<pg8::EpiBf16, pg8::TileOrder, false, true, true>(tid, lds, g, S, E); }
                if (ts[8] > 128) { asm volatile("" : "+v"(tid));
                  pg8::Gemm g{HID, WDNM, DFE, DFE, DFE / 4, (size_t)DM * DFE, nullptr, DFE / 128}; pg8::TailOrder S; S.nsub = (ts[8] - 128) * 32; S.G = G; S.c = bx; S.pm0 = 128;
#pragma unroll
                  for (int e = 0; e < 9; ++e) S.ts[e] = ts[e];
                  pg8::gemm_phase<pg8::EpiBf16, pg8::TailOrder, false, true, true>(tid, lds, g, S, E); }
                SEAM(pb + 11);
            }
            if (IN(pb + 12)) {
                PHASE_IDS();
                const float* g2 = modv + 5 * DM;
                f32x4 gv[8];
#pragma unroll
                for (int j = 0; j < 8; ++j) gv[j] = ((const f32x4*)g2)[lane + 64 * j];
                for (int m = gw; m < SEQ; m += NGW) {
                    const int* ti = TOKINFO + (size_t)m * 8; const float w0 = __int_as_float(ti[2]), w1 = __int_as_float(ti[3]);
                    const int p0 = TOKPOS[2 * m], p1 = TOKPOS[2 * m + 1];
                    const bf16_t* y0 = YB + (size_t)p0 * DM; const bf16_t* y1 = YB + (size_t)p1 * DM; float* op = out + (size_t)m * DM;
                    const bool t0 = p0 >= 32768, t1 = p1 >= 32768;
#pragma unroll
                    for (int j = 0; j < 8; ++j) { const s16x4 a = *(const s16x4*)(y0 + 4 * lane + 256 * j), b = *(const s16x4*)(y1 + 4 * lane + 256 * j);
                        f32x4 ya, yb;
#pragma unroll
                        for (int q = 0; q < 4; ++q) { ya[q] = bf2f((unsigned short)a[q]); yb[q] = bf2f((unsigned short)b[q]); }
                        if (t0) {
#pragma unroll
                            for (int kq = 0; kq < 3; ++kq) { const s16x4 e = *(const s16x4*)(YPART + ((size_t)kq * 2048 + (p0 - 32768)) * DM + 4 * lane + 256 * j);
#pragma unroll
                                for (int q = 0; q < 4; ++q) ya[q] += bf2f((unsigned short)e[q]); } }
                        if (t1) {
#pragma unroll
                            for (int kq = 0; kq < 3; ++kq) { const s16x4 e = *(const s16x4*)(YPART + ((size_t)kq * 2048 + (p1 - 32768)) * DM + 4 * lane + 256 * j);
#pragma unroll
                                for (int q = 0; q < 4; ++q) yb[q] += bf2f((unsigned short)e[q]); } }
                        f32x4 xv = ((f32x4*)op)[lane + 64 * j];
#pragma unroll
                        for (int q = 0; q < 4; ++q) xv[q] += gv[j][q] * (w0 * ya[q] + w1 * yb[q]);
                        ((f32x4*)op)[lane + 64 * j] = xv; }
                }
            }
        }
    }
#undef IN
#undef SEAM
#undef LOAD_TS
#undef modv
#undef xcur
#undef out
#undef ctl
}

extern "C" void kernel_launch(void* const* d_in, const int* in_sizes, int n_in, void* d_out, int out_size, void* d_ws, size_t ws_size, hipStream_t stream) {
    static int grid = 0;
    if (grid == 0) {
        if (n_in != 24 || out_size != SEQ * DM || ws_size < WS_END) { fprintf(stderr, "kernel_launch: unexpected shapes n_in %d out %d ws %zu (need %zu)\n", n_in, out_size, ws_size, (size_t)WS_END); grid = -1; return; }
        int dev = 0, cus = 0, per_cu = 0;
        if (hipGetDevice(&dev) != hipSuccess || hipDeviceGetAttribute(&cus, hipDeviceAttributeMultiprocessorCount, dev) != hipSuccess) { grid = -1; return; }
        if (hipFuncSetAttribute((const void*)mk_fwd, hipFuncAttributeMaxDynamicSharedMemorySize, LDS_BYTES) != hipSuccess) { fprintf(stderr, "kernel_launch: hipFuncSetAttribute failed\n"); grid = -1; return; }
        if (hipOccupancyMaxActiveBlocksPerMultiprocessor(&per_cu, (const void*)mk_fwd, NTHR, LDS_BYTES) != hipSuccess || per_cu < 1) fprintf(stderr, "kernel_launch: occupancy query says %d\n", per_cu);
        (void)hipGetLastError();
        grid = cus;
    }
    if (grid < 0) return;
    (void)hipMemsetAsync((char*)d_ws + WS_CTL, 0, CTL_BYTES, stream);
    Args a{};
    for (int i = 0; i < 24; ++i) a.in[i] = d_in[i];
    a.out = (float*)d_out; a.ws = (unsigned char*)d_ws;
#if MK_MULTI
    static const int phases[] = {0, 1, 2, 3, 4, 5, 6, 7, 8, 9, 10, 11, 12, 18, 19, 20, 21, 22, 23, 24, 25, 26, 27, 28, 29, 30};
    for (int p : phases) { a.ph_lo = p; a.ph_hi = p + 1; hipLaunchKernelGGL(mk_fwd, dim3(grid), dim3(NTHR), LDS_BYTES, stream, a); }
#else
    a.ph_lo = 0; a.ph_hi = 31;
    hipLaunchKernelGGL(mk_fwd, dim3(grid), dim3(NTHR), LDS_BYTES, stream, a);
#endif
    const hipError_t le = hipPeekAtLastError();
    if (le != hipSuccess) fprintf(stderr, "kernel_launch: launch failed: %s\n", hipGetErrorName(le));
}
```

```cpp
#include <hip/hip_runtime.h>
#include <cstdio>
#include <cstdint>

#ifndef MK_MULTI
#define MK_MULTI 0
#endif

#define GAS __attribute__((address_space(1)))
#define LAS __attribute__((address_space(3)))
typedef unsigned short bf16_t;
typedef short bf16x8 __attribute__((ext_vector_type(8)));
typedef short s16x4 __attribute__((ext_vector_type(4)));
typedef float f32x4 __attribute__((ext_vector_type(4)));
typedef float f32x2 __attribute__((ext_vector_type(2)));
typedef float f32x16 __attribute__((ext_vector_type(16)));
typedef unsigned u32x4 __attribute__((ext_vector_type(4)));
typedef unsigned u32x2 __attribute__((ext_vector_type(2)));

constexpr int SEQ = 16384, DM = 2048, DIN = 1856, DINP = 2048;
constexpr int QLR = 512, KVLR = 256, ROPE = 64, NOPE = 128, VHD = 128, QKD = 192, NH = 8;
constexpr int ZQ = 0, ZKV = 512, ZKR = 768, ZU = 832;
constexpr int FNW = 1024, FG = 8;
constexpr int DFF = 5632, NE = 8, DFE = 7168;
constexpr int MAXT = 136;
constexpr float RMS_EPS = 1e-6f;
constexpr float S8_H = 8.f, S8_WGU = 64.f, S8_HID = 8.f, S8_WDN = 128.f;
constexpr int NWAVES = 8, NTHR = 512;

constexpr size_t MiB = 1u << 20;
constexpr size_t WS_CTL = 0, CTL_BYTES = 1 * MiB;
constexpr int CW_BAR = 4096;
constexpr int CW_ECNT = 8192;
constexpr size_t CTL_ROWTOK = 256 * 1024;
constexpr size_t WS_MODP = 1 * MiB;
constexpr size_t WS_MODV = WS_MODP + 16 * 2 * 12288 * 4;
constexpr size_t WS_COS = 3 * MiB, WS_SIN = 5 * MiB;
constexpr size_t WS_TW = 7 * MiB;
constexpr size_t WS_FM = WS_TW + 131072;
constexpr size_t WS_GM = WS_FM + 65536;
constexpr size_t WS_M12 = 8 * MiB;
constexpr size_t WS_TOKINFO = 9 * MiB;
constexpr size_t WS_TOKPOS = WS_TOKINFO + (size_t)SEQ * 32;
constexpr size_t WS_WIN = 10 * MiB;
constexpr size_t WS_WUQ = WS_WIN + 2 * 8 * MiB;
constexpr size_t WS_WUKV = WS_WUQ + 2 * 1536 * 512 * 2;
constexpr size_t WS_WOUT = WS_WUKV + 2 * 2048 * 256 * 2;
constexpr size_t WS_WGUD = WS_WOUT + 2 * 8 * MiB;
constexpr size_t WS_WDND = WS_WGUD + (size_t)11264 * 2048 * 2;
constexpr size_t WS_WGUM = WS_WDND + (size_t)2048 * 5632 * 2;
constexpr size_t WS_WDNM = WS_WGUM + (size_t)8 * 14336 * 2048 * 2;
constexpr size_t WS_H = WS_WDNM + (size_t)8 * 2048 * 7168 * 2;
constexpr size_t WS_Y = WS_H + (size_t)SEQ * 2048 * 2;
constexpr size_t WS_ARENA = WS_Y + (size_t)MAXT * 256 * 2048 * 2;
constexpr size_t WS_Z = WS_ARENA;
constexpr size_t WS_QB = WS_Z + (size_t)SEQ * 2048 * 2;
constexpr size_t WS_KVB = WS_QB + (size_t)SEQ * 1536 * 2;
constexpr size_t WS_KB = WS_KVB + (size_t)SEQ * 2048 * 2;
constexpr size_t WS_A1 = WS_KB + (size_t)SEQ * 1536 * 2;
constexpr size_t WS_YC = WS_A1 + (size_t)SEQ * 2048 * 2;
constexpr size_t WS_HID = WS_ARENA;
constexpr size_t WS_END = WS_ARENA + (size_t)MAXT * 256 * 7168 * 2;
static_assert(WS_YC + (size_t)SEQ * 2048 * 2 <= WS_END, "arena");
static_assert(WS_END <= (size_t)1900 * MiB, "workspace budget");

constexpr int RING_BYTES = 133120;
constexpr int LDS_COND = RING_BYTES;
constexpr int LDS_TRIG = LDS_COND + 8192;
constexpr int LDS_MISC = LDS_TRIG + 1024;
constexpr int LDS_BYTES = 147456;
static_assert(LDS_MISC + 256 <= LDS_BYTES, "LDS map");

#define LDS_WAIT() asm volatile("s_waitcnt lgkmcnt(0)" ::: "memory")
#define VM_WAIT() asm volatile("s_waitcnt vmcnt(0)" ::: "memory")
#define RLX_AGENT __ATOMIC_RELAXED, __HIP_MEMORY_SCOPE_AGENT

__device__ __forceinline__ unsigned cvt_pk_bf16(float lo, float hi) { unsigned r; asm volatile("v_cvt_pk_bf16_f32 %0, %1, %2" : "=v"(r) : "v"(lo), "v"(hi)); return r; }
__device__ __forceinline__ float bf2f(unsigned short b) { return __uint_as_float(((unsigned)b) << 16); }
__device__ __forceinline__ bf16_t f2bf(float f) { return (bf16_t)(cvt_pk_bf16(f, 0.f) & 0xffffu); }
template <int XM> __device__ __forceinline__ float swz_xor(float v) { return __int_as_float(__builtin_amdgcn_ds_swizzle(__float_as_int(v), (XM << 10) | 0x1f)); }
__device__ __forceinline__ float wave_sum(float v) {
    v += swz_xor<1>(v); v += swz_xor<2>(v); v += swz_xor<4>(v); v += swz_xor<8>(v); v += swz_xor<16>(v);
    auto rr = __builtin_amdgcn_permlane32_swap(__float_as_uint(v), __float_as_uint(v), false, false);
    return __uint_as_float(rr[0]) + __uint_as_float(rr[1]);
}

#define XB_TMO      128
#define XB_XCNT(j)  (256  + 64 * (j))
#define XB_XSUB(j)  (1280 + 64 * (j))
#define XB_XGEN(j)  (2304 + 64 * (j))
#define XB_TOP      3328
#define XB_TOPGEN   3392
#define XCD_BAR_WORDS 3456
#define XB_SPIN_CAP (1u << 18)
__device__ __forceinline__ unsigned xb_ld(unsigned* p)              { return __hip_atomic_load(p, __ATOMIC_RELAXED, __HIP_MEMORY_SCOPE_AGENT); }
__device__ __forceinline__ unsigned xb_add(unsigned* p, unsigned v) { return __hip_atomic_fetch_add(p, v, __ATOMIC_RELAXED, __HIP_MEMORY_SCOPE_AGENT); }
__device__ __forceinline__ unsigned xb_xcc_id() { return (unsigned)__builtin_amdgcn_s_getreg((3 << 11) | 20) & 0xFu; }
#define XB_SPIN(cond, bar) do { unsigned _sp = 0; while (cond) { __builtin_amdgcn_s_sleep(1); \
    if ((++_sp & 255u) == 0u) { if (xb_ld(&(bar)[XB_TMO])) break; if (_sp > XB_SPIN_CAP) { atomicAdd(&(bar)[XB_TMO], 1u); break; } } } } while (0)
struct XcdBarrier { unsigned* bar; unsigned x; volatile LAS unsigned* st; };
__device__ __forceinline__ XcdBarrier xcd_barrier_post(unsigned* bar, volatile LAS unsigned* st) {
    XcdBarrier b; b.bar = bar; b.x = xb_xcc_id(); b.st = st;
    if (threadIdx.x == 0) (void)xb_add(&bar[XB_XCNT(b.x)], 1u);
    return b;
}
__device__ __forceinline__ void xcd_barrier_complete(unsigned* bar, unsigned x, unsigned& nloc, unsigned& nx) {
    const unsigned G = gridDim.x * gridDim.y * gridDim.z;
    unsigned sum, cnt, mine, sp = 0u;
    for (;;) {
        sum = 0u; cnt = 0u; mine = 0u;
#pragma unroll
        for (unsigned j = 0; j < 16; ++j) { const unsigned c = xb_ld(&bar[XB_XCNT(j)]); sum += c; cnt += (c > 0u) ? 1u : 0u; mine = (j == x) ? c : mine; }
        if (sum == G) break;
        __builtin_amdgcn_s_sleep(1);
        if ((++sp & 255u) == 0u) { if (xb_ld(&bar[XB_TMO])) break; if (sp > XB_SPIN_CAP) { atomicAdd(&bar[XB_TMO], 1u); break; } }
    }
    nloc = mine > 0u ? mine : 1u; nx = cnt > 0u ? cnt : 1u;
}
__device__ __forceinline__ void xcd_barrier(const XcdBarrier& b) {
    asm volatile("s_waitcnt vmcnt(0)" ::: "memory");
    __syncthreads();
    if (threadIdx.x == 0) {
        unsigned* bar = b.bar;
        __builtin_amdgcn_s_waitcnt(0);
        unsigned nloc = b.st[0], nx = b.st[1];
        if (nloc == 0u) { xcd_barrier_complete(bar, b.x, nloc, nx); b.st[0] = nloc; b.st[1] = nx; }
        const unsigned old = xb_add(&bar[XB_XSUB(b.x)], 1u);
        const unsigned gen = old / nloc;
        if (old + 1u == (gen + 1u) * nloc) {
            __builtin_amdgcn_fence(__ATOMIC_RELEASE, "agent");
            asm volatile("s_waitcnt vmcnt(0)" ::: "memory");
            const unsigned og = xb_add(&bar[XB_TOP], 1u);
            const unsigned tg = og / nx;
            if (og + 1u == (tg + 1u) * nx) xb_add(&bar[XB_TOPGEN], 1u);
            else XB_SPIN(xb_ld(&bar[XB_TOPGEN]) == tg, bar);
            __builtin_amdgcn_fence(__ATOMIC_ACQUIRE, "agent");
            xb_add(&bar[XB_XGEN(b.x)], 1u);
            asm volatile("s_waitcnt vmcnt(0)" ::: "memory");
        } else {
            XB_SPIN(xb_ld(&bar[XB_XGEN(b.x)]) == gen, bar);
            __builtin_amdgcn_fence(__ATOMIC_ACQUIRE, "agent");
            asm volatile("s_waitcnt vmcnt(0)" ::: "memory");
        }
    }
    __syncthreads();
}

namespace pg8 {
constexpr int BM = 256, BK = 64, HALF = 128, HTB = HALF * BK * 2, STAGE_BYTES = 8 * HTB, NXCD = 8, WGM = 8;
__host__ __device__ __forceinline__ int lds_byte(int r, int c) { const int st = (r >> 4) * 2 + (c >> 5), rr = r & 15, cc = c & 31, ob = rr * 64 + cc * 2; return st * 1024 + (ob ^ (((ob >> 9) & 1) << 5)); }
__host__ __device__ __forceinline__ void stage_rc(int b, int& R, int& C) { const int st = b / 1024, sb = b % 1024, swz = sb ^ (((sb >> 9) & 1) << 5); R = (st >> 1) * 16 + swz / 64; C = (st & 1) * 32 + (swz % 64) / 2; }
__host__ __device__ __forceinline__ int perm32(int rho) { const int n = rho >> 4, i = rho & 15; return 8 * (i >> 2) + 4 * n + (i & 3); }

struct Unit { int pm, pn, e, kq; };
struct Gemm { const void* A; const void* Bt; int lda, ldb, K; size_t estrideB; const int* rowmap; int ktB = 0; };

struct TileOrder {
    int nM, nN, nwg, G, c; int ts[9]; bool moe;
    __device__ __forceinline__ void init(int nM_, int nN_, int G_, int c_) { nM = nM_; nN = nN_; nwg = nM * nN; G = G_; c = c_; moe = false; }
    __device__ __forceinline__ bool next(int i, Unit& u) const {
        const long L = (long)i * G + c; if (L >= nwg) return false;
        int wgid = (int)L; { const int q = nwg / NXCD, r = nwg % NXCD, xcd = wgid % NXCD, off = wgid / NXCD; wgid = (xcd < r ? xcd * (q + 1) : r * (q + 1) + (xcd - r) * q) + off; }
        const int nig = WGM * nN, gid = wgid / nig, fm = gid * WGM, gsz = (nM - fm) < WGM ? (nM - fm) : WGM;
        u.pm = fm + ((wgid % nig) % gsz); u.pn = (wgid % nig) / gsz; u.e = 0; u.kq = 0;
        if (moe) {
#pragma unroll
            for (int j = 1; j < 8; ++j) if (u.pm >= ts[j]) u.e = j;
        }
        return true;
    }
};

struct TailOrder {
    int nsub, G, c, pm0; int ts[9];
    __device__ __forceinline__ bool next(int i, Unit& u) const {
        const int L = i * G + c; if (L >= nsub) return false;
        u.kq = L & 3; u.pn = (L >> 2) & 7; u.pm = pm0 + (L >> 5); u.e = 0;
#pragma unroll
        for (int j = 1; j < 8; ++j) if (u.pm >= ts[j]) u.e = j;
        return true;
    }
};
struct EpiBf16 {
    static constexpr bool PERM = true;
    bf16_t* O; int ldc; float scale; bf16_t* O2 = nullptr; size_t kqstride = 0;
    __device__ __forceinline__ void operator()(const f32x4 (&acc)[2][2][4][2], const Unit& u, int wr, int wc, int fr, int fq) const {
        const int row0 = u.pm * BM + wr * 64 + fr, col0 = u.pn * BM + wc * 32 + 8 * fq;
        bf16_t* const Ob = u.kq ? O2 + (size_t)(u.kq - 1) * kqstride : O;
#pragma unroll
        for (int ai = 0; ai < 2; ++ai)
#pragma unroll
            for (int m = 0; m < 4; ++m) { bf16_t* rowp = Ob + (size_t)(row0 + ai * HALF + m * 16) * ldc + col0;
#pragma unroll
                for (int bj = 0; bj < 2; ++bj) { const f32x4 v0 = acc[ai][bj][m][0] * scale, v1 = acc[ai][bj][m][1] * scale;
                    u32x4 w; w.x = cvt_pk_bf16(v0[0], v0[1]); w.y = cvt_pk_bf16(v0[2], v0[3]); w.z = cvt_pk_bf16(v1[0], v1[1]); w.w = cvt_pk_bf16(v1[2], v1[3]);
                    *(u32x4*)(rowp + bj * HALF) = w; } }
    }
};
__device__ __forceinline__ float silu_f(float x) { return x * __builtin_amdgcn_rcpf(1.0f + __builtin_amdgcn_exp2f(-1.4426950408889634f * x)); }
struct EpiSwiGLU {
    static constexpr bool PERM = true;
    bf16_t* O; int ldc;
    __device__ __forceinline__ void operator()(const f32x4 (&acc)[2][2][4][2], const Unit& u, int wr, int wc, int fr, int fq) const {
        const int row0 = u.pm * BM + wr * 64 + fr, col0 = u.pn * HALF + wc * 32 + 8 * fq;
#pragma unroll
        for (int ai = 0; ai < 2; ++ai)
#pragma unroll
            for (int m = 0; m < 4; ++m) { bf16_t* rowp = O + (size_t)(row0 + ai * HALF + m * 16) * ldc + col0;
                f32x4 v0, v1;
#pragma unroll
                for (int j = 0; j < 4; ++j) { v0[j] = silu_f(acc[ai][0][m][0][j]) * acc[ai][1][m][0][j]; v1[j] = silu_f(acc[ai][0][m][1][j]) * acc[ai][1][m][1][j]; }
                u32x4 w; w.x = cvt_pk_bf16(v0[0], v0[1]); w.y = cvt_pk_bf16(v0[2], v0[3]); w.z = cvt_pk_bf16(v1[0], v1[1]); w.w = cvt_pk_bf16(v1[2], v1[3]);
                *(u32x4*)rowp = w; }
    }
};
__device__ __forceinline__ float clamp448(float x) { return __builtin_amdgcn_fmed3f(x, -448.f, 448.f); }
struct EpiSwiGLU8 {
    static constexpr bool PERM = true;
    unsigned char* O; int ldc; float iscale, oscale;
    __device__ __forceinline__ void operator()(const f32x4 (&acc)[2][2][4][2], const Unit& u, int wr, int wc, int fr, int fq) const {
        const int row0 = u.pm * BM + wr * 64 + fr, col0 = u.pn * HALF + wc * 32 + 8 * fq;
#pragma unroll
        for (int ai = 0; ai < 2; ++ai)
#pragma unroll
            for (int m = 0; m < 4; ++m) { unsigned char* rowp = O + (size_t)(row0 + ai * HALF + m * 16) * ldc + col0;
                f32x4 v0, v1;
#pragma unroll
                for (int j = 0; j < 4; ++j) { v0[j] = clamp448(silu_f(acc[ai][0][m][0][j] * iscale) * (acc[ai][1][m][0][j] * iscale) * oscale);
                                              v1[j] = clamp448(silu_f(acc[ai][0][m][1][j] * iscale) * (acc[ai][1][m][1][j] * iscale) * oscale); }
                int w0 = 0, w1 = 0;
                w0 = __builtin_amdgcn_cvt_pk_fp8_f32(v0[0], v0[1], w0, false); w0 = __builtin_amdgcn_cvt_pk_fp8_f32(v0[2], v0[3], w0, true);
                w1 = __builtin_amdgcn_cvt_pk_fp8_f32(v1[0], v1[1], w1, false); w1 = __builtin_amdgcn_cvt_pk_fp8_f32(v1[2], v1[3], w1, true);
                u32x2 w; w.x = (unsigned)w0; w.y = (unsigned)w1; *(u32x2*)rowp = w; }
    }
};
struct EpiRes {
    static constexpr bool PERM = false;
    const float* X; float* O; const float* gate; int ldc;
    __device__ __forceinline__ void operator()(const f32x4 (&acc)[2][2][4][2], const Unit& u, int wr, int wc, int fr, int fq) const {
        const int row0 = u.pm * BM + wr * 64 + fr, col0 = u.pn * BM + wc * 32 + 4 * fq;
        f32x4 gv[2][2];
#pragma unroll
        for (int bj = 0; bj < 2; ++bj)
#pragma unroll
            for (int n = 0; n < 2; ++n) gv[bj][n] = *(const f32x4*)(gate + col0 + bj * HALF + n * 16);
#pragma unroll
        for (int ai = 0; ai < 2; ++ai)
#pragma unroll
            for (int m = 0; m < 4; ++m) { const size_t off = (size_t)(row0 + ai * HALF + m * 16) * ldc + col0;
#pragma unroll
                for (int bj = 0; bj < 2; ++bj)
#pragma unroll
                    for (int n = 0; n < 2; ++n) { const f32x4 xv = *(const f32x4*)(X + off + bj * HALF + n * 16);
                        *(f32x4*)(O + off + bj * HALF + n * 16) = xv + gv[bj][n] * acc[ai][bj][m][n]; }
                asm volatile("" ::: "memory"); }
    }
};

typedef int v8i __attribute__((ext_vector_type(8)));
typedef unsigned u32x8 __attribute__((ext_vector_type(8)));
template <class Epi, class Sched, bool GATHER, bool FP8 = false, bool TILEDB = false>
__device__ __forceinline__ void gemm_phase(const int tid, LAS unsigned char* lds, const Gemm g, const Sched& S, const Epi& E) {
    const int wid = __builtin_amdgcn_readfirstlane(tid >> 6), lane = tid & 63, wr = wid >> 2, wc = wid & 3, fr = lane & 15, fq = lane >> 4;
    constexpr int ESZ = FP8 ? 1 : 2;
    const int nt = g.K * ESZ / (BK * 2);
    unsigned voffA[2], voffB[2];
#pragma unroll
    for (int i = 0; i < 2; ++i) { int R, C; stage_rc(tid * 16 + i * 8192, R, C); const int Rb = Epi::PERM ? ((R & ~31) + perm32(R & 31)) : R;
        voffA[i] = (unsigned)(R * g.lda * ESZ + C * 2); voffB[i] = TILEDB ? (unsigned)(Rb * 128 + C * 2) : (unsigned)(Rb * g.ldb * ESZ + C * 2); }
    const size_t kstep = (size_t)(BK * 2);
    const size_t hstepA = (size_t)HALF * g.lda * ESZ, tstepA = 2 * hstepA;
    const size_t kstepB = TILEDB ? (size_t)32768 : kstep;
    const size_t hstepB = TILEDB ? (size_t)16384 : (size_t)HALF * g.ldb * ESZ, tstepB = TILEDB ? (size_t)(g.ktB ? g.ktB : nt) * 32768 : 2 * hstepB;
    const size_t kqA = (size_t)nt * kstep, kqB = (size_t)nt * kstepB;
    const unsigned ldsw = (unsigned)wid * 1024u;
    const int aoff = lds_byte(wr * 64 + fr, fq * 8), boff = lds_byte(wc * 32 + fr, fq * 8);
#define PG8_SA(b, h) (((b) * 2 + (h)) * HTB)
#define PG8_SB(b, h) ((4 + (b) * 2 + (h)) * HTB)
#define PG8_STAGE(bufoff, gbase, voff) do { _Pragma("unroll") for (int _i = 0; _i < 2; ++_i) \
        __builtin_amdgcn_global_load_lds((const unsigned*)((const char*)(gbase) + (voff)[_i]), (LAS unsigned*)(lds + (bufoff) + ldsw + _i * 8192), 16, 0, 0); } while (0)
#define PG8_STAGE_A(bufoff, UB, h, kb, V0, V1) do { if constexpr (GATHER) { if (h) PG8_STAGE(bufoff, gA + (kb), V1); else PG8_STAGE(bufoff, gA + (kb), V0); } \
        else PG8_STAGE(bufoff, (UB) + (h) * hstepA + (kb), voffA); } while (0)
#define PG8_LD8(P) __builtin_shufflevector(*(const LAS u32x4*)(P), *(const LAS u32x4*)((P) + 1024), 0, 1, 2, 3, 4, 5, 6, 7)
#define PG8_LDA(dst, b, h) do { if constexpr (FP8) { _Pragma("unroll") for (int m = 0; m < 4; ++m) dst##8[m] = PG8_LD8(lds + PG8_SA(b, h) + aoff + m * 2048); } \
        else { _Pragma("unroll") for (int m = 0; m < 4; ++m) _Pragma("unroll") for (int k = 0; k < 2; ++k) dst[m][k] = *(const LAS bf16x8*)(lds + PG8_SA(b, h) + aoff + m * 2048 + k * 1024); } } while (0)
#define PG8_LDB(dst, b, h) do { if constexpr (FP8) { _Pragma("unroll") for (int n = 0; n < 2; ++n) dst##8[n] = PG8_LD8(lds + PG8_SB(b, h) + boff + n * 2048); } \
        else { _Pragma("unroll") for (int n = 0; n < 2; ++n) _Pragma("unroll") for (int k = 0; k < 2; ++k) dst[n][k] = *(const LAS bf16x8*)(lds + PG8_SB(b, h) + boff + n * 2048 + k * 1024); } } while (0)
#define PG8_MMA(ai, bj, At, Bt) do { __builtin_amdgcn_s_setprio(1); _Pragma("unroll") for (int m = 0; m < 4; ++m) _Pragma("unroll") for (int n = 0; n < 2; ++n) { \
        if constexpr (FP8) { asm("v_mfma_scale_f32_16x16x128_f8f6f4 %0, %1, %2, %0, %3, %3 op_sel_hi:[0,0,0]" : "+v"(acc[ai][bj][m][n]) : "v"(Bt##8[n]), "v"(At##8[m]), "v"(sc8)); } \
        else { _Pragma("unroll") for (int k = 0; k < 2; ++k) acc[ai][bj][m][n] = __builtin_amdgcn_mfma_f32_16x16x32_bf16(Bt[n][k], At[m][k], acc[ai][bj][m][n], 0, 0, 0); } } \
        __builtin_amdgcn_s_setprio(0); } while (0)
#define PG8_WAIT_V(n) asm volatile("s_waitcnt vmcnt(" #n ")" ::: "memory")
#define PG8_WAIT_L(n) asm volatile("s_waitcnt lgkmcnt(" #n ")" ::: "memory")
#define PG8_BAR __builtin_amdgcn_s_barrier()
#define PG8_SCHED __builtin_amdgcn_sched_barrier(0)
#define PG8_AOFFS(U, V0, V1) do { _Pragma("unroll") for (int _i = 0; _i < 2; ++_i) { int R_, C_; stage_rc(tid * 16 + _i * 8192, R_, C_); \
        const int r0 = g.rowmap[(U).pm * BM + R_], r1 = g.rowmap[(U).pm * BM + HALF + R_]; \
        V0[_i] = (unsigned)(r0 * g.lda * ESZ + C_ * 2); V1[_i] = (unsigned)(r1 * g.lda * ESZ + C_ * 2); } } while (0)
    Unit cur, nxt; int ui = 0;
    if (!S.next(0, cur)) return;
    f32x4 acc[2][2][4][2];
#pragma unroll
    for (int a = 0; a < 2; ++a)
#pragma unroll
        for (int b = 0; b < 2; ++b)
#pragma unroll
            for (int m = 0; m < 4; ++m)
#pragma unroll
                for (int n = 0; n < 2; ++n) acc[a][b][m][n] = (f32x4){0.f, 0.f, 0.f, 0.f};
    const unsigned sc8 = 0x7f7f7f7fu; (void)sc8;
    bf16x8 At[4][2], B0[2][2], B1[2][2]; u32x8 At8[4], B08[2], B18[2]; (void)At; (void)B0; (void)B1; (void)At8; (void)B08; (void)B18;
    unsigned vc0[2] = {0u, 0u}, vc1[2] = {0u, 0u}, vn0[2] = {0u, 0u}, vn1[2] = {0u, 0u};
    if constexpr (GATHER) PG8_AOFFS(cur, vc0, vc1);
    const char* gA = (const char*)g.A;
    const char* cA = gA + (size_t)cur.pm * tstepA + (size_t)cur.kq * kqA;
    const char* cB = (const char*)g.Bt + (size_t)cur.e * g.estrideB * ESZ + (size_t)cur.pn * tstepB + (size_t)cur.kq * kqB;
    PG8_STAGE(PG8_SB(0, 0), cB, voffB); PG8_STAGE(PG8_SB(0, 1), cB + hstepB, voffB); PG8_STAGE_A(PG8_SA(0, 0), cA, 0, 0, vc0, vc1); PG8_STAGE_A(PG8_SA(0, 1), cA, 1, 0, vc0, vc1);
    if (wr == 1) PG8_BAR;
    PG8_WAIT_V(2); PG8_BAR;
    PG8_STAGE(PG8_SB(1, 0), cB + kstepB, voffB); PG8_STAGE_A(PG8_SA(1, 0), cA, 0, kstep, vc0, vc1); PG8_STAGE(PG8_SB(1, 1), cB + hstepB + kstepB, voffB);
    PG8_WAIT_V(6); PG8_BAR;
    for (;;) {
        const bool has_next = S.next(ui + 1, nxt);
        const char* nA = cA; const char* nB = cB;
        if (has_next) { nA = gA + (size_t)nxt.pm * tstepA + (size_t)nxt.kq * kqA; nB = (const char*)g.Bt + (size_t)nxt.e * g.estrideB * ESZ + (size_t)nxt.pn * tstepB + (size_t)nxt.kq * kqB; }
        if constexpr (GATHER) { if (has_next) PG8_AOFFS(nxt, vn0, vn1); else {
#pragma unroll
            for (int _i = 0; _i < 2; ++_i) { vn0[_i] = vc0[_i]; vn1[_i] = vc1[_i]; } } }
        for (int t = 0; t < nt; t += 2) {
            const bool last = (t == nt - 2);
            const size_t k1 = (size_t)(t + 1) * kstep, k2 = last ? 0 : (size_t)(t + 2) * kstep, k3 = k2 + kstep;
            const char* u2 = last ? nA : cA; const char* b2 = (last ? nB : cB) + (last ? 0 : (size_t)(t + 2) * kstepB); const char* b3 = b2 + kstepB;
            unsigned va0[2] = {0u, 0u}, va1[2] = {0u, 0u};
            if constexpr (GATHER) {
#pragma unroll
                for (int _i = 0; _i < 2; ++_i) { va0[_i] = last ? vn0[_i] : vc0[_i]; va1[_i] = last ? vn1[_i] : vc1[_i]; } }
            PG8_LDB(B0, 0, 0); PG8_LDB(B1, 0, 1); PG8_SCHED; PG8_LDA(At, 0, 0); PG8_STAGE_A(PG8_SA(1, 1), cA, 1, k1, vc0, vc1);
            PG8_WAIT_V(8); PG8_WAIT_L(0); PG8_BAR; PG8_MMA(0, 0, At, B0); PG8_MMA(0, 1, At, B1); PG8_BAR; PG8_SCHED;
            PG8_LDA(At, 0, 1); PG8_STAGE(PG8_SB(0, 0), b2, voffB); PG8_STAGE(PG8_SB(0, 1), b2 + hstepB, voffB); PG8_STAGE_A(PG8_SA(0, 0), u2, 0, k2, va0, va1);
            PG8_WAIT_V(8); PG8_WAIT_L(0); PG8_BAR; PG8_MMA(1, 0, At, B0); PG8_MMA(1, 1, At, B1); PG8_BAR; PG8_SCHED;
            PG8_LDB(B0, 1, 0); PG8_LDB(B1, 1, 1); PG8_SCHED; PG8_LDA(At, 1, 0); PG8_STAGE_A(PG8_SA(0, 1), u2, 1, k2, va0, va1);
            PG8_WAIT_V(8); PG8_WAIT_L(0); PG8_BAR; PG8_MMA(0, 0, At, B0); PG8_MMA(0, 1, At, B1); PG8_BAR; PG8_SCHED;
            PG8_LDA(At, 1, 1); PG8_STAGE(PG8_SB(1, 0), b3, voffB); PG8_STAGE(PG8_SB(1, 1), b3 + hstepB, voffB); PG8_STAGE_A(PG8_SA(1, 0), u2, 0, k3, va0, va1);
            PG8_WAIT_V(8); PG8_WAIT_L(0); PG8_BAR; PG8_MMA(1, 0, At, B0); PG8_MMA(1, 1, At, B1); PG8_BAR; PG8_SCHED;
        }
        if constexpr (FP8) asm volatile("s_nop 15\n\ts_nop 15" ::: "memory");
        if (wr == 0) PG8_BAR;
        { int fr_ = fr, fq_ = fq; asm volatile("" : "+v"(fr_), "+v"(fq_)); E(acc, cur, wr, wc, fr_, fq_); }
        if (!has_next) break;
#pragma unroll
        for (int a = 0; a < 2; ++a)
#pragma unroll
            for (int b = 0; b < 2; ++b)
#pragma unroll
                for (int m = 0; m < 4; ++m)
#pragma unroll
                    for (int n = 0; n < 2; ++n) acc[a][b][m][n] = (f32x4){0.f, 0.f, 0.f, 0.f};
        cur = nxt; cA = nA; cB = nB; ++ui;
        if constexpr (GATHER) {
#pragma unroll
            for (int _i = 0; _i < 2; ++_i) { vc0[_i] = vn0[_i]; vc1[_i] = vn1[_i]; } }
        if (wr == 1) PG8_BAR;
    }
    PG8_WAIT_V(0);
    PG8_BAR;
#undef PG8_SA
#undef PG8_SB
#undef PG8_STAGE
#undef PG8_STAGE_A
#undef PG8_LDA
#undef PG8_LD8
#undef PG8_LDB
#undef PG8_MMA
#undef PG8_WAIT_V
#undef PG8_WAIT_L
#undef PG8_BAR
#undef PG8_SCHED
#undef PG8_AOFFS
}
}

namespace att {
constexpr int NW = 8, QBLK = 32, KVBLK = 64, DQ = QKD, DV = VHD;
constexpr float SCALE = 0.07216878364870322f;
constexpr float THR = 8.f;
constexpr int LDQ = 1536, LDK = 1536, LDV = 2048, LDO = 2048;
constexpr int SHM_V = KVBLK * DV * 2, SHM_K = KVBLK * DQ * 2, SHM_ATTN = 2 * SHM_V + 2 * SHM_K + NW * 64 * 4;
#define KSWZ(row, colB) ((row) * 384 + ((colB) ^ ((((row) >> 1) & 7) << 4)))
#define SBAR() __builtin_amdgcn_sched_barrier(0)
__device__ __forceinline__ int crow(int r, int hi) { return (r & 3) + 8 * (r >> 2) + 4 * hi; }
__device__ __forceinline__ void partialSM(f32x16& p0, f32x16& p1, float& m_reg, float& mn, float& alpha) {
  constexpr float C = SCALE * 1.4426950408889634f;
  float pmax = p0[0];
#pragma unroll
  for (int r = 1; r < 16; ++r) pmax = fmaxf(pmax, p0[r]);
#pragma unroll
  for (int r = 0; r < 16; ++r) pmax = fmaxf(pmax, p1[r]);
  { auto rr = __builtin_amdgcn_permlane32_swap(__float_as_uint(pmax), __float_as_uint(pmax), false, false);
    pmax = fmaxf(__uint_as_float(rr[0]), __uint_as_float(rr[1])); }
  if (__builtin_expect(__all(pmax - m_reg <= THR / SCALE), 1)) { mn = m_reg; alpha = 1.f; }
  else { mn = fmaxf(m_reg, pmax); alpha = __builtin_amdgcn_exp2f((m_reg - mn) * C); m_reg = mn; }
  float mnC = -mn * C;
#pragma unroll
  for (int r = 0; r < 16; ++r) p0[r] = fmaf(p0[r], C, mnC);
#pragma unroll
  for (int r = 0; r < 16; ++r) p1[r] = fmaf(p1[r], C, mnC);
#pragma unroll
  for (int r = 0; r < 16; ++r) p0[r] = __builtin_amdgcn_exp2f(p0[r]);
}
__device__ __forceinline__ void finishSM(f32x16& p0, f32x16& p1, float alpha, float& l_reg, bf16x8& pa0, bf16x8& pa1, bf16x8& pa2, bf16x8& pa3) {
#pragma unroll
  for (int r = 0; r < 16; ++r) p1[r] = __builtin_amdgcn_exp2f(p1[r]);
  float ps = 0;
#pragma unroll
  for (int r = 0; r < 16; ++r) ps += p0[r];
#pragma unroll
  for (int r = 0; r < 16; ++r) ps += p1[r];
  { auto rr = __builtin_amdgcn_permlane32_swap(__float_as_uint(ps), __float_as_uint(ps), false, false);
    ps = __uint_as_float(rr[0]) + __uint_as_float(rr[1]); }
  l_reg = l_reg * alpha + ps;
#define PK4(P, BASE, OUT) do { unsigned a0 = cvt_pk_bf16(P[BASE + 0], P[BASE + 1]), a1 = cvt_pk_bf16(P[BASE + 2], P[BASE + 3]);   \
    unsigned b0 = cvt_pk_bf16(P[BASE + 4], P[BASE + 5]), b1 = cvt_pk_bf16(P[BASE + 6], P[BASE + 7]);                              \
    auto r0 = __builtin_amdgcn_permlane32_swap(a0, b0, false, false); auto r1 = __builtin_amdgcn_permlane32_swap(a1, b1, false, false); \
    u32x4 w = {r0[0], r1[0], r0[1], r1[1]}; OUT = *reinterpret_cast<bf16x8*>(&w); } while (0)
  PK4(p0, 0, pa0); PK4(p0, 8, pa1); PK4(p1, 0, pa2); PK4(p1, 8, pa3);
#undef PK4
}
__device__ __forceinline__ void qkt(f32x16& p0, f32x16& p1, const char* Ks, const bf16x8* qr, int r32, int hi) {
  p0 = f32x16{}; p1 = f32x16{};
#pragma unroll
  for (int d0 = 0; d0 < DQ / 16; ++d0) { int cb = (d0 * 16 + hi * 8) * 2;
    bf16x8 b0 = *reinterpret_cast<const bf16x8*>(Ks + KSWZ(r32, cb));
    bf16x8 b1 = *reinterpret_cast<const bf16x8*>(Ks + KSWZ(32 + r32, cb));
    p0 = __builtin_amdgcn_mfma_f32_32x32x16_bf16(b0, qr[d0], p0, 0, 0, 0);
    p1 = __builtin_amdgcn_mfma_f32_32x32x16_bf16(b1, qr[d0], p1, 0, 0, 0);
    if ((d0 & 3) == 3) SBAR(); }
}
__device__ __forceinline__ int v_st(int k, int c) { const int kk = (k & ~0xC) | ((k & 4) << 1) | ((k & 8) >> 1); return ((kk >> 3) * 4 + (c >> 5)) * 512 + ((kk & 7) * 32 + (c & 31)) * 2; }
__device__ __forceinline__ int v_rd_base(int lane) { return ((lane & 3) << 3) | (((lane >> 2) & 3) << 6) | (((lane >> 4) & 1) << 5) | (((lane >> 5) & 1) << 8); }
constexpr int v_rd_off(int d0, int ks, int half) { return d0 * 512 + ks * 4096 + half * 2048; }
template <int OFF> __device__ __forceinline__ s16x4 tr_read(int vb) {
  s16x4 r; asm volatile("ds_read_b64_tr_b16 %0, %1 offset:%2" : "=&v"(r) : "v"(vb), "i"(OFF) : "memory"); return r;
}
template <int D0> __device__ __forceinline__ void pv_one(f32x16& od, int vb, bf16x8 pa0, bf16x8 pa1, bf16x8 pa2, bf16x8 pa3) {
  const s16x4 l0 = tr_read<v_rd_off(D0, 0, 0)>(vb), h0 = tr_read<v_rd_off(D0, 0, 1)>(vb), l1 = tr_read<v_rd_off(D0, 1, 0)>(vb), h1 = tr_read<v_rd_off(D0, 1, 1)>(vb);
  const s16x4 l2 = tr_read<v_rd_off(D0, 2, 0)>(vb), h2 = tr_read<v_rd_off(D0, 2, 1)>(vb), l3 = tr_read<v_rd_off(D0, 3, 0)>(vb), h3 = tr_read<v_rd_off(D0, 3, 1)>(vb);
  asm volatile("s_waitcnt lgkmcnt(0)" ::: "memory"); SBAR();
#define PK(L, H) (bf16x8){L[0], L[1], L[2], L[3], H[0], H[1], H[2], H[3]}
  od = __builtin_amdgcn_mfma_f32_32x32x16_bf16(pa0, PK(l0, h0), od, 0, 0, 0);
  od = __builtin_amdgcn_mfma_f32_32x32x16_bf16(pa1, PK(l1, h1), od, 0, 0, 0);
  od = __builtin_amdgcn_mfma_f32_32x32x16_bf16(pa2, PK(l2, h2), od, 0, 0, 0);
  od = __builtin_amdgcn_mfma_f32_32x32x16_bf16(pa3, PK(l3, h3), od, 0, 0, 0);
#undef PK
}
__device__ __forceinline__ void pv_d0(f32x16* o, int vb, bf16x8 pa0, bf16x8 pa1, bf16x8 pa2, bf16x8 pa3) {
  pv_one<0>(o[0], vb, pa0, pa1, pa2, pa3); pv_one<1>(o[1], vb, pa0, pa1, pa2, pa3); pv_one<2>(o[2], vb, pa0, pa1, pa2, pa3); pv_one<3>(o[3], vb, pa0, pa1, pa2, pa3);
}


constexpr int K_OFF = 0, V_OFF = 3 * SHM_K, WS_OFF = V_OFF + 3 * SHM_V, SHM_ATTN2 = WS_OFF + NW * 64 * 4;
__device__ __forceinline__ void qkt_l(f32x16& p0, f32x16& p1, LAS const char* Ks, const bf16x8* qr, int r32, int hi) {
  p0 = f32x16{}; p1 = f32x16{};
  __builtin_amdgcn_s_setprio(1);
  const int swz = ((r32 >> 1) & 7) << 4, rowb = r32 * 384;
  LAS const char* ar[4];
#pragma unroll
  for (int r = 0; r < 4; ++r) ar[r] = Ks + rowb + ((32 * r + 16 * hi) ^ swz);
#pragma unroll
  for (int q = 0; q < DQ / 64; ++q)
#pragma unroll
    for (int r = 0; r < 4; ++r) { const int d0 = 4 * q + r;
      bf16x8 b0 = *reinterpret_cast<LAS const bf16x8*>(ar[r] + 128 * q);
      bf16x8 b1 = *reinterpret_cast<LAS const bf16x8*>(ar[r] + 128 * q + 32 * 384);
      p0 = __builtin_amdgcn_mfma_f32_32x32x16_bf16(b0, qr[d0], p0, 0, 0, 0);
      p1 = __builtin_amdgcn_mfma_f32_32x32x16_bf16(b1, qr[d0], p1, 0, 0, 0);
      if (r == 3 && d0 != DQ / 16 - 1) SBAR(); }
  __builtin_amdgcn_s_setprio(0);
}
__device__ __forceinline__ void qkt_l2(f32x16& p0, f32x16& p1, LAS const char* Ks, const bf16x8* qr, int r32, int hi) {
  p0 = f32x16{}; p1 = f32x16{};
  const int swz = ((r32 >> 1) & 7) << 4, rowb = r32 * 384;
  LAS const char* ar[4];
#pragma unroll
  for (int r = 0; r < 4; ++r) ar[r] = Ks + rowb + ((32 * r + 16 * hi) ^ swz);
#pragma unroll
  for (int q = 0; q < DQ / 64; ++q)
#pragma unroll
    for (int r = 0; r < 4; ++r) { const int d0 = 4 * q + r;
      bf16x8 b0 = *reinterpret_cast<LAS const bf16x8*>(ar[r] + 128 * q);
      bf16x8 b1 = *reinterpret_cast<LAS const bf16x8*>(ar[r] + 128 * q + 32 * 384);
      p0 = __builtin_amdgcn_mfma_f32_32x32x16_bf16(b0, qr[d0], p0, 0, 0, 0);
      p1 = __builtin_amdgcn_mfma_f32_32x32x16_bf16(b1, qr[d0], p1, 0, 0, 0);
    }
}
__device__ __forceinline__ float psm_max(const f32x16& p) { float m = p[0];
#pragma unroll
  for (int r = 1; r < 16; ++r) m = fmaxf(m, p[r]);
  return m; }
__device__ __forceinline__ void psm_decide(float pmax, float& m_reg, float& mnC, float& alpha) {
  constexpr float C = SCALE * 1.4426950408889634f;
  { auto rr = __builtin_amdgcn_permlane32_swap(__float_as_uint(pmax), __float_as_uint(pmax), false, false);
    pmax = fmaxf(__uint_as_float(rr[0]), __uint_as_float(rr[1])); }
  float mn;
  if (__builtin_expect(__all(pmax - m_reg <= THR / SCALE), 1)) { mn = m_reg; alpha = 1.f; }
  else { mn = fmaxf(m_reg, pmax); alpha = __builtin_amdgcn_exp2f((m_reg - mn) * C); m_reg = mn; }
  mnC = -mn * C;
}
__device__ __forceinline__ void psm_scale(f32x16& p, float mnC) { constexpr float C = SCALE * 1.4426950408889634f;
#pragma unroll
  for (int r = 0; r < 16; ++r) p[r] = fmaf(p[r], C, mnC); }
__device__ __forceinline__ void psm_exp(f32x16& p) {
#pragma unroll
  for (int r = 0; r < 16; ++r) p[r] = __builtin_amdgcn_exp2f(p[r]); }

__device__ __forceinline__ void fsm_first(f32x16& p0, f32x16& p1, int negMCbits) {
  constexpr float C = SCALE * 1.4426950408889634f;
  int nb_ = __builtin_amdgcn_readfirstlane(negMCbits); asm volatile("" : "+s"(nb_)); const float negMC = __builtin_bit_cast(float, nb_);
#pragma unroll
  for (int r = 0; r < 16; ++r) p0[r] = fmaf(p0[r], C, negMC);
#pragma unroll
  for (int r = 0; r < 16; ++r) p1[r] = fmaf(p1[r], C, negMC);
#pragma unroll
  for (int r = 0; r < 16; ++r) p0[r] = __builtin_amdgcn_exp2f(p0[r]);
}
__device__ __forceinline__ void fsm_finish(f32x16& p0, f32x16& p1, float& l_reg, bf16x8& pa0, bf16x8& pa1, bf16x8& pa2, bf16x8& pa3) {
#pragma unroll
  for (int r = 0; r < 16; ++r) p1[r] = __builtin_amdgcn_exp2f(p1[r]);
  float ps = 0;
#pragma unroll
  for (int r = 0; r < 16; ++r) ps += p0[r];
#pragma unroll
  for (int r = 0; r < 16; ++r) ps += p1[r];
  { auto rr = __builtin_amdgcn_permlane32_swap(__float_as_uint(ps), __float_as_uint(ps), false, false);
    ps = __uint_as_float(rr[0]) + __uint_as_float(rr[1]); }
  l_reg += ps;
#define PK4(P, BASE, OUT) do { unsigned a0 = cvt_pk_bf16(P[BASE + 0], P[BASE + 1]), a1 = cvt_pk_bf16(P[BASE + 2], P[BASE + 3]);   \
    unsigned b0 = cvt_pk_bf16(P[BASE + 4], P[BASE + 5]), b1 = cvt_pk_bf16(P[BASE + 6], P[BASE + 7]);                              \
    auto r0 = __builtin_amdgcn_permlane32_swap(a0, b0, false, false); auto r1 = __builtin_amdgcn_permlane32_swap(a1, b1, false, false); \
    u32x4 w = {r0[0], r1[0], r0[1], r1[1]}; OUT = *reinterpret_cast<bf16x8*>(&w); } while (0)
  PK4(p0, 0, pa0); PK4(p0, 8, pa1); PK4(p1, 0, pa2); PK4(p1, 8, pa3);
#undef PK4
}
__device__ __forceinline__ void attn_unit2(const bf16_t* __restrict__ Qb, const bf16_t* __restrict__ Kh, const bf16_t* __restrict__ Vh, bf16_t* __restrict__ Ob, int seq, LAS unsigned char* lds, const int tid, const int negMC) {
  const int wid = __builtin_amdgcn_readfirstlane(tid >> 6), lane = tid & 63, r32 = lane & 31, hi = lane >> 5;
  LAS float* ws = (LAS float*)(lds + WS_OFF) + wid * 64; LAS float* li_l = ws; LAS float* al_l = ws + 32;
  float l_reg = 0; f32x16 o[4] = {}; bf16x8 qr[DQ / 16];
  const bf16_t* Qw = Qb + (long)(wid * QBLK + r32) * LDQ + hi * 8;
#pragma unroll
  for (int d0 = 0; d0 < DQ / 16; ++d0) qr[d0] = *reinterpret_cast<const bf16x8*>(Qw + d0 * 16);
#define KOFF(i_, ln_) ({ const int b_ = 1024 * (wid + 8 * (i_)) + 16 * (ln_), row_ = b_ / 384, x_ = b_ % 384; (unsigned)(row_ * LDK * 2 + (x_ ^ (((row_ >> 1) & 7) << 4))); })
  unsigned voff[2];
#pragma unroll
  for (int i = 0; i < 2; ++i) { const int b = 1024 * (wid + 8 * i) + 16 * lane, st = b >> 9, off = b & 511, kk = (st >> 2) * 8 + (off >> 6), c = (st & 3) * 32 + ((off & 63) >> 1);
    const int k = (kk & ~0xC) | ((kk & 4) << 1) | ((kk & 8) >> 1); voff[i] = (unsigned)(k * LDV * 2 + c * 2); }
  const int NT = seq / KVBLK;
#define DMA_K(t, slot) do { const int t_ = (t) < NT ? (t) : NT - 1; const char* g_ = (const char*)Kh + (size_t)t_ * (KVBLK * LDK * 2); int ln_ = lane; asm volatile("" : "+v"(ln_)); _Pragma("unroll") for (int i_ = 0; i_ < 3; ++i_) \
    __builtin_amdgcn_global_load_lds((const unsigned*)(g_ + KOFF(i_, ln_)), (LAS unsigned*)(lds + K_OFF + (slot) * SHM_K + (wid + 8 * i_) * 1024), 16, 0, 0); } while (0)
#define DMA_V(t, slot) do { const int t_ = (t) < NT ? (t) : NT - 1; const char* g_ = (const char*)Vh + (size_t)t_ * (KVBLK * LDV * 2); _Pragma("unroll") for (int i_ = 0; i_ < 2; ++i_) \
    __builtin_amdgcn_global_load_lds((const unsigned*)(g_ + voff[i_]), (LAS unsigned*)(lds + V_OFF + (slot) * SHM_V + (wid + 8 * i_) * 1024), 16, 0, 0); } while (0)
#define QK_PACE() do { _Pragma("unroll") for (int g_ = 0; g_ < 12; ++g_) { __builtin_amdgcn_sched_group_barrier(0x100, 2, 0); __builtin_amdgcn_sched_group_barrier(0x008, 2, 0); __builtin_amdgcn_sched_group_barrier(0x002, 8, 0); } } while (0)
#define WAITBAR() do { asm volatile("s_waitcnt vmcnt(5) lgkmcnt(0)" ::: "memory"); __builtin_amdgcn_s_barrier(); asm volatile("" ::: "memory"); } while (0)
  const int vbase = (int)(uintptr_t)(lds + V_OFF) + v_rd_base(lane);
  f32x16 pA0, pA1, pB0, pB1; bf16x8 pa0, pa1, pa2, pa3;
  DMA_K(0, 0); DMA_K(1, 1); DMA_V(0, 0);
  WAITBAR();
  DMA_K(2, 2); DMA_V(1, 1);
  qkt_l(pA0, pA1, (LAS const char*)(lds + K_OFF), qr, r32, hi); fsm_first(pA0, pA1, negMC);
  WAITBAR();
  int a = 1;
  for (int t = 1; t + 1 < NT; t += 2) {
    { const int kd = (a + 2) % 3, vd = (a + 1) % 3;
      DMA_K(t + 2, kd); DMA_V(t + 1, vd);
      SBAR(); __builtin_amdgcn_s_setprio(1); qkt_l2(pB0, pB1, (LAS const char*)(lds + K_OFF + a * SHM_K), qr, r32, hi);
      fsm_finish(pA0, pA1, l_reg, pa0, pa1, pa2, pa3);
      QK_PACE(); __builtin_amdgcn_s_setprio(0); SBAR();
      pv_d0(o, vbase + kd * SHM_V, pa0, pa1, pa2, pa3); fsm_first(pB0, pB1, negMC);
      WAITBAR(); a = (a + 1) % 3; }
    { const int kd = (a + 2) % 3, vd = (a + 1) % 3;
      DMA_K(t + 3, kd); DMA_V(t + 2, vd);
      SBAR(); __builtin_amdgcn_s_setprio(1); qkt_l2(pA0, pA1, (LAS const char*)(lds + K_OFF + a * SHM_K), qr, r32, hi);
      fsm_finish(pB0, pB1, l_reg, pa0, pa1, pa2, pa3);
      QK_PACE(); __builtin_amdgcn_s_setprio(0); SBAR();
      pv_d0(o, vbase + kd * SHM_V, pa0, pa1, pa2, pa3); fsm_first(pA0, pA1, negMC);
      WAITBAR(); a = (a + 1) % 3; }
  }
  { const int kd = (a + 2) % 3, vd = (a + 1) % 3;
    DMA_K(NT - 1, kd); DMA_V(NT - 1, vd);
    SBAR(); __builtin_amdgcn_s_setprio(1); qkt_l2(pB0, pB1, (LAS const char*)(lds + K_OFF + a * SHM_K), qr, r32, hi);
    fsm_finish(pA0, pA1, l_reg, pa0, pa1, pa2, pa3);
    QK_PACE(); __builtin_amdgcn_s_setprio(0); SBAR();
    pv_d0(o, vbase + kd * SHM_V, pa0, pa1, pa2, pa3); fsm_first(pB0, pB1, negMC);
      WAITBAR(); a = (a + 1) % 3; }
  { const int kd = (a + 2) % 3;
    fsm_finish(pB0, pB1, l_reg, pa0, pa1, pa2, pa3); SBAR();
    pv_d0(o, vbase + kd * SHM_V, pa0, pa1, pa2, pa3); }
  if (hi == 0) li_l[r32] = l_reg; asm volatile("s_waitcnt lgkmcnt(0)" ::: "memory");
  int r32e = r32, hie = hi; asm volatile("" : "+v"(r32e), "+v"(hie));
  float rli[16];
#pragma unroll
  for (int r = 0; r < 16; ++r) rli[r] = __builtin_amdgcn_rcpf(li_l[crow(r, hie)]);
  bf16_t* Ow = Ob + (long)(wid * QBLK) * LDO;
#pragma unroll
  for (int r = 0; r < 16; ++r) { int orow = crow(r, hie);
#pragma unroll
    for (int d0 = 0; d0 < 4; ++d0) Ow[(long)orow * LDO + d0 * 32 + r32e] = f2bf(o[d0][r] * rli[r]); }
  asm volatile("s_waitcnt vmcnt(0) lgkmcnt(0)" ::: "memory"); __builtin_amdgcn_s_barrier(); asm volatile("" ::: "memory");
#undef DMA_K
#undef KOFF
#undef DMA_V
#undef WAITBAR
}
}

namespace sg {
using att::v_st; using att::v_rd_base; using att::pv_d0; using att::crow;
template <int KK> __device__ __forceinline__ void load_b(bf16x8* v, const bf16_t* Bsrc, size_t ldb, const int tid) {
    const int n = (tid & 15) * 8;
#pragma unroll
    for (int i = 0; i < KK / 32; ++i) { const int k = (tid >> 4) + 32 * i; v[i] = *(const bf16x8*)(Bsrc + (size_t)k * ldb + n); }
}
template <int KK> __device__ __forceinline__ void write_b(const bf16x8* v, char* lds, const int tid) {
    const int n = (tid & 15) * 8;
#pragma unroll
    for (int i = 0; i < KK / 32; ++i) { const int k = (tid >> 4) + 32 * i; *(bf16x8*)(lds + (k >> 6) * 16384 + v_st(k & 63, n)) = v[i]; }
}
template <int KK> __device__ __forceinline__ void stage_b(const bf16_t* Bsrc, size_t ldb, char* lds, const int tid) { bf16x8 v[KK / 32]; load_b<KK>(v, Bsrc, ldb, tid); write_b<KK>(v, lds, tid); }
constexpr int OST_PITCH = 272, OST_WAVE = 32 * OST_PITCH, OST_OFF = 65536;
template <class RowPtr>
__device__ __forceinline__ void store_tile(const f32x16* o, LAS unsigned char* ost, int lane, const RowPtr& rowptr) {
    const int r32 = lane & 31, hi = lane >> 5; const bool odd = lane & 1;
#pragma unroll
    for (int pr = 0; pr < 8; ++pr)
#pragma unroll
        for (int d0 = 0; d0 < 4; ++d0) { const float a = o[d0][2 * pr], b = o[d0][2 * pr + 1];
            const float x = odd ? a : b;
            const float y = __int_as_float(__builtin_amdgcn_mov_dpp(__float_as_int(x), 0xB1, 0xf, 0xf, true));
            const unsigned w = odd ? cvt_pk_bf16(y, b) : cvt_pk_bf16(a, y);
            const int row = crow(odd ? 2 * pr + 1 : 2 * pr, hi);
            *(LAS unsigned*)(ost + row * OST_PITCH + (32 * d0 + (r32 & ~1)) * 2) = w; }
    asm volatile("s_waitcnt lgkmcnt(0)" ::: "memory");
#pragma unroll
    for (int j = 0; j < 8; ++j) { const int i = (lane >> 4) + 4 * j; const u32x4 v = *(const LAS u32x4*)(ost + i * OST_PITCH + (lane & 15) * 16);
        *(u32x4*)(rowptr(i) + (lane & 15) * 8) = v; }
    asm volatile("s_waitcnt lgkmcnt(0)" ::: "memory");
}
struct RowF1 { bf16_t* a1; int wave, s2, cc; __device__ __forceinline__ bf16_t* operator()(int i) const { return a1 + ((size_t)(32 * wave + i) * 128 + s2) * 1024 + cc * 128; } };
struct RowF2 { bf16_t* yc; int wave, k1, g; __device__ __forceinline__ bf16_t* operator()(int i) const { const int m = 32 * wave + i; return yc + (size_t)(k1 + 128 * (m & 127)) * 2048 + g * 256 + (m >> 7) * 128; } };
struct RowF3 { bf16_t* hb; int wave, tt, g; __device__ __forceinline__ bf16_t* operator()(int i) const { return hb + (size_t)(256 * tt + 32 * wave + i) * 2048 + 1024 + g * 128; } };
template <int KK> __device__ __forceinline__ void mm(f32x16* o, const bf16x8* A, char* lds, int lane) {
    const int vb0 = (int)(uintptr_t)lds + v_rd_base(lane);
#pragma unroll
    for (int t = 0; t < KK / 64; ++t) pv_d0(o, vb0 + t * 16384, A[4 * t], A[4 * t + 1], A[4 * t + 2], A[4 * t + 3]);
}
}

struct Args { const void* in[24]; float* out; unsigned char* ws; int ph_lo, ph_hi; };

__device__ __forceinline__ u32x2 pack4(f32x4 v) { u32x2 w; w.x = cvt_pk_bf16(v[0], v[1]); w.y = cvt_pk_bf16(v[2], v[3]); return w; }

template <bool FP8, bool TILED = false>
__device__ __forceinline__ void cvt_pair(const float* W, int N, void* WT, int ldd, int k0, int n0, int drow0, float scale, LAS float* scr, int lane) {
    const int lr = lane >> 4, lc = (lane & 15) * 4;
    f32x4 v[2][16];
#pragma unroll
    for (int t = 0; t < 2; ++t)
#pragma unroll
        for (int i = 0; i < 16; ++i) v[t][i] = *(const f32x4*)(W + (size_t)(k0 + 64 * t + 4 * i + lr) * N + n0 + lc);
    const int c = lane & 7;
#pragma unroll
    for (int t = 0; t < 2; ++t) {
#pragma unroll
        for (int i = 0; i < 16; ++i) { LAS float* s = scr + (4 * i + lr) * 65 + lc; s[0] = v[t][i][0]; s[1] = v[t][i][1]; s[2] = v[t][i][2]; s[3] = v[t][i][3]; }
        LDS_WAIT(); asm volatile("" ::: "memory");
#pragma unroll
        for (int j = 0; j < 8; ++j) { const int n = (lane >> 3) + 8 * j; const LAS float* s = scr + (8 * c) * 65 + n;
            if constexpr (!FP8) { u32x4 o; o.x = cvt_pk_bf16(s[0 * 65], s[1 * 65]); o.y = cvt_pk_bf16(s[2 * 65], s[3 * 65]); o.z = cvt_pk_bf16(s[4 * 65], s[5 * 65]); o.w = cvt_pk_bf16(s[6 * 65], s[7 * 65]);
                *(u32x4*)((bf16_t*)WT + (size_t)(drow0 + n) * ldd + k0 + 64 * t + 8 * c) = o; }
            else { int w0 = 0, w1 = 0;
                w0 = __builtin_amdgcn_cvt_pk_fp8_f32(pg8::clamp448(s[0 * 65] * scale), pg8::clamp448(s[1 * 65] * scale), w0, false); w0 = __builtin_amdgcn_cvt_pk_fp8_f32(pg8::clamp448(s[2 * 65] * scale), pg8::clamp448(s[3 * 65] * scale), w0, true);
                w1 = __builtin_amdgcn_cvt_pk_fp8_f32(pg8::clamp448(s[4 * 65] * scale), pg8::clamp448(s[5 * 65] * scale), w1, false); w1 = __builtin_amdgcn_cvt_pk_fp8_f32(pg8::clamp448(s[6 * 65] * scale), pg8::clamp448(s[7 * 65] * scale), w1, true);
                u32x2 o; o.x = (unsigned)w0; o.y = (unsigned)w1;
                if constexpr (TILED) { const int dr = drow0 + n;
                    *(u32x2*)((unsigned char*)WT + ((size_t)(dr >> 8) * (ldd >> 7) + (k0 >> 7)) * 32768 + (dr & 255) * 128 + 64 * t + 8 * c) = o; }
                else *(u32x2*)((unsigned char*)WT + (size_t)(drow0 + n) * ldd + k0 + 64 * t + 8 * c) = o; } }
        LDS_WAIT(); asm volatile("" ::: "memory");
    }
}

typedef __attribute__((address_space(4))) const char* karg_cptr;
__device__ __forceinline__ void* karg_ptr(int k) {
    karg_cptr p = (karg_cptr)__builtin_amdgcn_kernarg_segment_ptr();
    asm volatile("" : "+s"(p));
    typedef void* voidp_t; typedef __attribute__((address_space(4))) const voidp_t* karg_vpp;
    return *(karg_vpp)(p + 8 * k);
}
__global__ void __launch_bounds__(NTHR, 2) mk_fwd(Args args) {
    extern __shared__ __attribute__((aligned(16))) unsigned char lds_raw[];
    LAS unsigned char* lds = (LAS unsigned char*)lds_raw;
    volatile LAS unsigned* MISC = (volatile LAS unsigned*)(lds + LDS_MISC);
    const int wave0 = __builtin_amdgcn_readfirstlane((int)threadIdx.x >> 6);
    const int G = gridDim.x, bx0 = blockIdx.x, NGW = G * NWAVES;
#define PHASE_IDS() int lane_; asm volatile("v_mbcnt_lo_u32_b32 %0, -1, 0\n\tv_mbcnt_hi_u32_b32 %0, -1, %0" : "=v"(lane_)); int wave_ = wave0; asm volatile("" : "+s"(wave_)); \
    int bx = bx0; asm volatile("" : "+s"(bx)); int tid = wave_ * 64 + lane_; \
    const int lane = lane_, wave = wave_; \
    const int vcu = (G % 8 == 0) ? (bx % 8) * (G / 8) + bx / 8 : bx; const int gw = vcu * NWAVES + wave; (void)lane; (void)gw
    for (int u = threadIdx.x; u < 64; u += NTHR) MISC[u] = 0u;
    __syncthreads();
    unsigned* const barw = (unsigned*)((unsigned char*)karg_ptr(25) + WS_CTL) + CW_BAR;
    XcdBarrier bar; bar.bar = barw; bar.x = 0; bar.st = nullptr;
#if !MK_MULTI
    bar = xcd_barrier_post(barw, MISC + 8);
#endif
    const int lo = args.ph_lo, hi = args.ph_hi;
#ifndef PH_MASK
#define PH_MASK 0xffffffffu
#endif
#define IN(k) (lo <= (k) && (k) < hi && ((PH_MASK >> ((k) > 15 ? (k) - 16 : (k))) & 1u))
#if MK_MULTI
#define SEAM(k) do { } while (0)
#else
#define SEAM(k) do { if ((k) + 1 < hi) xcd_barrier(bar); } while (0)
#endif
#define KARG(k) (karg_ptr(k))
#define x_in ((const float*)KARG(0))
#define c_in ((const float*)KARG(1))
#define pos_in ((const int*)KARG(2))
#define ada_w ((const float*)KARG(3))
#define ada_b ((const float*)KARG(4))
#define mix_norm ((const float*)KARG(5))
#define w_in ((const float*)KARG(6))
#define cq_norm ((const float*)KARG(7))
#define ckv_norm ((const float*)KARG(8))
#define w_uq ((const float*)KARG(9))
#define w_ukv ((const float*)KARG(10))
#define q_norm ((const float*)KARG(11))
#define k_norm ((const float*)KARG(12))
#define w_fnet ((const float*)KARG(13))
#define out_norm ((const float*)KARG(14))
#define w_out ((const float*)KARG(15))
#define ffn_norm ((const float*)KARG(16))
#define dw_gate ((const float*)KARG(17))
#define dw_up ((const float*)KARG(18))
#define dw_down ((const float*)KARG(19))
#define router_w ((const float*)KARG(20))
#define mw_gate ((const float*)KARG(21))
#define mw_up ((const float*)KARG(22))
#define mw_down ((const float*)KARG(23))
#define out ((float*)KARG(24))
#define WSB ((unsigned char*)KARG(25))
#define ctl ((unsigned*)(WSB + WS_CTL))
#define MODP ((float*)(WSB + WS_ARENA))
#define MODV ((float*)(WSB + WS_MODV))
#define COS ((float*)(WSB + WS_COS))
#define SIN ((float*)(WSB + WS_SIN))
#define TW ((f32x2*)(WSB + WS_TW))
#define FM ((bf16_t*)(WSB + WS_FM))
#define GM ((bf16_t*)(WSB + WS_GM))
#define M12 ((bf16_t*)(WSB + WS_M12))
#define TOKINFO ((int*)(WSB + WS_TOKINFO))
#define TOKPOS ((int*)(WSB + WS_TOKPOS))
#define BLKCNT ((int*)(WSB + WS_TOKPOS + (size_t)SEQ * 8))
#define ROWTOK ((int*)(WSB + CTL_ROWTOK))
#define WIN ((bf16_t*)(WSB + WS_WIN))
#define WUQ ((bf16_t*)(WSB + WS_WUQ))
#define WUKV ((bf16_t*)(WSB + WS_WUKV))
#define WOUT ((bf16_t*)(WSB + WS_WOUT))
#define WGUD ((bf16_t*)(WSB + WS_WGUD))
#define WDND ((bf16_t*)(WSB + WS_WDND))
#define WGUM ((bf16_t*)(WSB + WS_WGUM))
#define WDNM ((bf16_t*)(WSB + WS_WDNM))
#define HB ((bf16_t*)(WSB + WS_H))
#define YB ((bf16_t*)(WSB + WS_Y))
#define ZB ((bf16_t*)(WSB + WS_Z))
#define QB ((bf16_t*)(WSB + WS_QB))
#define KVB ((bf16_t*)(WSB + WS_KVB))
#define KB ((bf16_t*)(WSB + WS_KB))
#define A1 ((bf16_t*)(WSB + WS_A1))
#define YC ((bf16_t*)(WSB + WS_YC))
#define HID ((bf16_t*)(WSB + WS_HID))
#define YPART ((bf16_t*)(WSB + WS_ARENA + 256 * MiB))

    if (IN(0)) {
        PHASE_IDS();
        LAS float* cond = (LAS float*)(lds + LDS_COND); LAS float* trig = (LAS float*)(lds + LDS_TRIG);
        for (int i = tid; i < DM; i += NTHR) { const float c = c_in[i]; cond[i] = c / (1.0f + __expf(-c)); }
        if (tid < 128) { trig[tid] = (float)cospi(2.0 * tid / 128.0); trig[128 + tid] = (float)sinpi(2.0 * tid / 128.0); }
        __syncthreads();
        LAS float* scr = (LAS float*)(lds + wave * 16640);
        constexpr int I_GEMV = 2 * 48 * 64;
        constexpr int I_WIN = 16 * 29, I_WUQ = 4 * 24, I_WUKV = 2 * 32, I_WOUT = 16 * 32;
        constexpr int I_DGU = 16 * 88, I_DDN = 44 * 32, I_MGU = 16 * 112, I_MDN = 56 * 32;
        constexpr int I_ZERO = 2 * 192;
        constexpr int I_ROPE = SEQ * 32 / 64;
        constexpr int I_TW = 16384 / 64, I_FM = 32768 / 64, I_GM = 65536 / 64, I_M12 = 2 * 8 * 256 * 128 / 64;
        constexpr int NITEMS = I_GEMV + 2 * (I_WIN + I_WUQ + I_WUKV + I_WOUT) + 2 * I_DGU + I_DDN + 16 * I_MGU + 8 * I_MDN + I_ZERO + I_ROPE + I_TW + I_FM + I_GM + I_M12;
        for (int it = gw; it < NITEMS; it += NGW) {
            int r = it;
            if (r < I_GEMV) {
                const int kc = r & 63, cb = r >> 6, l = cb / 48, n0 = (cb % 48) * 256 + 4 * lane;
                const float* W = ada_w + ((size_t)l * DM + kc * 32) * 12288 + n0;
                f32x4 a = {0.f, 0.f, 0.f, 0.f};
                f32x4 v[32];
#pragma unroll
                for (int k = 0; k < 32; ++k) v[k] = *(const f32x4*)(W + (size_t)k * 12288);
#pragma unroll
                for (int k = 0; k < 32; ++k) a += v[k] * cond[kc * 32 + k];
                *(f32x4*)(MODP + ((size_t)kc * 2 + l) * 12288 + n0) = a;
                continue;
            } r -= I_GEMV;
            bool done = false;
#pragma unroll 1
            for (int l = 0; l < 2 && !done; ++l) {
                if (r < I_WIN) { const int kb = r / 29, nb = r % 29; cvt_pair<false>(w_in + (size_t)l * DM * DIN, DIN, WIN + (size_t)l * DINP * DM, DM, 128 * kb, 64 * nb, 64 * nb, 1.f, scr, lane); done = true; break; } r -= I_WIN;
                if (r < I_WUQ) { const int kb = r / 24, nb = r % 24; cvt_pair<false>(w_uq + (size_t)l * QLR * 1536, 1536, WUQ + (size_t)l * 1536 * QLR, QLR, 128 * kb, 64 * nb, 64 * nb, 1.f, scr, lane); done = true; break; } r -= I_WUQ;
                if (r < I_WUKV) { const int kb = r / 32, nb = r % 32; cvt_pair<false>(w_ukv + (size_t)l * KVLR * 2048, 2048, WUKV + (size_t)l * 2048 * KVLR, KVLR, 128 * kb, 64 * nb, 64 * nb, 1.f, scr, lane); done = true; break; } r -= I_WUKV;
                if (r < I_WOUT) { const int kb = r / 32, nb = r % 32; cvt_pair<false>(w_out + (size_t)l * DM * DM, DM, WOUT + (size_t)l * DM * DM, DM, 128 * kb, 64 * nb, 64 * nb, 1.f, scr, lane); done = true; break; } r -= I_WOUT;
            }
            if (done) continue;
            if (r < 2 * I_DGU) { const int up = r / I_DGU, rr = r % I_DGU, kb = rr / 88, nb = rr % 88, n0 = 64 * nb;
                cvt_pair<false>(up ? dw_up : dw_gate, DFF, WGUD, DM, 128 * kb, n0, (n0 >> 7) * 256 + (n0 & 127) + up * 128, 1.f, scr, lane); continue; } r -= 2 * I_DGU;
            if (r < I_DDN) { const int kb = r / 32, nb = r % 32; cvt_pair<false>(dw_down, DM, WDND, DFF, 128 * kb, 64 * nb, 64 * nb, 1.f, scr, lane); continue; } r -= I_DDN;
            if (r < 16 * I_MGU) { const int e = r / (2 * I_MGU), r2 = r % (2 * I_MGU), up = r2 / I_MGU, rr = r2 % I_MGU, kb = rr / 112, nb = rr % 112, n0 = 64 * nb;
                cvt_pair<true, true>((up ? mw_up : mw_gate) + (size_t)e * DM * DFE, DFE, (unsigned char*)WGUM + (size_t)e * 14336 * DM, DM, 128 * kb, n0, (n0 >> 7) * 256 + (n0 & 127) + up * 128, S8_WGU, scr, lane); continue; } r -= 16 * I_MGU;
            if (r < 8 * I_MDN) { const int e = r / I_MDN, rr = r % I_MDN, kb = rr / 32, nb = rr % 32;
                cvt_pair<true, true>(mw_down + (size_t)e * DFE * DM, DM, (unsigned char*)WDNM + (size_t)e * DM * DFE, DFE, 128 * kb, 64 * nb, 64 * nb, S8_WDN, scr, lane); continue; } r -= 8 * I_MDN;
            if (r < I_ZERO) { const int l = r / 192, row = 1856 + r % 192; u32x4 z = {0u, 0u, 0u, 0u};
#pragma unroll
                for (int j = 0; j < 4; ++j) *(u32x4*)(WIN + ((size_t)l * DINP + row) * DM + (lane + 64 * j) * 8) = z;
                continue; } r -= I_ZERO;
            if (r < I_ROPE) { const int idx = r * 64 + lane, t = idx >> 5, i = idx & 31;
                const double inv = exp2(-(double)i * (13.287712379549449 / 32.0));
                const double ang = (double)pos_in[t] * inv; double sn, cs; sincos(ang, &sn, &cs);
                COS[idx] = (float)cs; SIN[idx] = (float)sn; continue; } r -= I_ROPE;
            if (r < I_TW) { const int idx = r * 64 + lane, s2 = idx >> 7, k1 = idx & 127; const int m = (s2 * k1) & 16383;
                double sn, cs; sincospi(2.0 * (double)m / 16384.0, &sn, &cs); TW[idx] = (f32x2){(float)cs, (float)(-sn)}; continue; } r -= I_TW;
            if (r < I_FM) { const int idx = r * 64 + lane, m = idx >> 7, s1 = idx & 127, k1 = m >> 1, ri = m & 1; const int ph = (k1 * s1) & 127;
                const float v = (ri ? -trig[128 + ph] : trig[ph]) * 0.08838834764831845f; FM[idx] = f2bf(v); continue; } r -= I_FM;
            if (r < I_GM) { const int idx = r * 64 + lane, m = idx >> 8, k = idx & 255, ro = m >> 7, k2 = m & 127, rin = k >> 7, s2 = k & 127; const int ph = (k2 * s2) & 127;
                float v = (ro == rin) ? trig[ph] : (ro == 0 ? trig[128 + ph] : -trig[128 + ph]);
                GM[idx] = f2bf(v * 0.08838834764831845f); continue; } r -= I_GM;
            {
                const int idx = r * 64 + lane, d = idx & 127, kk = (idx >> 7) & 255, lg = idx >> 15, ri = kk >> 7, c = kk & 127;
                const float* Wf = w_fnet + (size_t)lg * 128 * 128 + d; float a = 0.f;
                for (int m = 0; m < 128; ++m) a += trig[ri * 128 + ((m * c) & 127)] * Wf[m * 128];
                M12[idx] = f2bf(a * 0.08838834764831845f);
            }
        }
        SEAM(0);
    }
    if (IN(1)) {
        PHASE_IDS();
        for (int i = (bx * NTHR + tid); i < 2 * 12288; i += G * NTHR) { float a = ada_b[i];
#pragma unroll
            for (int k = 0; k < 64; ++k) a += MODP[(size_t)k * 2 * 12288 + i];
            MODV[i] = a; }
        SEAM(1);
    }

#pragma unroll 1
    for (int l = 0; l < 2; ++l) {
        const int pb = 2 + 16 * l;
#define modv (MODV + (size_t)l * 12288)
#define xcur ((l == 0) ? x_in : (const float*)out)
#pragma unroll 1
        for (int sub = 0; sub < 2; ++sub) {
            const int ph = pb + (sub ? 8 : 0);
            if (IN(ph)) {
                PHASE_IDS();
                const float* xs = sub ? (const float*)out : xcur;
                const float* gain = (sub ? ffn_norm : mix_norm) + (size_t)l * DM;
                const float* shv = modv + (sub ? 3 : 0) * DM; const float* scv = modv + (sub ? 4 : 1) * DM;
                const bool router = (sub == 1 && l == 1);
                LAS float* wr_l = (LAS float*)lds;
                LAS int* etab = (LAS int*)(lds + 65536); LAS int* rtab = (LAS int*)(lds + 65536 + 4096);
                if (router) { etab[tid] = 0xffff;
                    for (int i = tid; i < DM * NE / 4; i += NTHR) ((LAS f32x4*)wr_l)[i] = ((const f32x4*)router_w)[i]; }
                __syncthreads();
                f32x4 av[8], bv[8];
#pragma unroll
                for (int j = 0; j < 8; ++j) { const f32x4 g4 = ((const f32x4*)gain)[lane + 64 * j], s4 = ((const f32x4*)scv)[lane + 64 * j]; av[j] = g4 * (1.0f + s4); bv[j] = ((const f32x4*)shv)[lane + 64 * j]; }
                int my_e0 = 0, my_e1 = 0, my_tok = -1; float my_w0 = 0.f, my_w1 = 0.f; int itn = 0;
                for (int m = gw; m < SEQ; m += NGW, ++itn) {
                    f32x4 v[8]; float ss = 0.f;
#pragma unroll
                    for (int j = 0; j < 8; ++j) { v[j] = ((const f32x4*)(xs + (size_t)m * DM))[lane + 64 * j]; ss += (v[j][0] * v[j][0] + v[j][1] * v[j][1]) + (v[j][2] * v[j][2] + v[j][3] * v[j][3]); }
                    const float rstd = 1.0f / sqrtf(wave_sum(ss) * (1.0f / DM) + RMS_EPS);
#pragma unroll
                    for (int j = 0; j < 8; ++j) { v[j] = v[j] * rstd * av[j] + bv[j];
                        if (router) { int w8 = 0; w8 = __builtin_amdgcn_cvt_pk_fp8_f32(pg8::clamp448(v[j][0] * S8_H), pg8::clamp448(v[j][1] * S8_H), w8, false); w8 = __builtin_amdgcn_cvt_pk_fp8_f32(pg8::clamp448(v[j][2] * S8_H), pg8::clamp448(v[j][3] * S8_H), w8, true);
                            *(unsigned*)((unsigned char*)HB + (size_t)m * DM + 4 * lane + 256 * j) = (unsigned)w8; }
                        else *(u32x2*)(HB + (size_t)m * DM + 4 * lane + 256 * j) = pack4(v[j]); }
                    if (router) {
                        float lg[8] = {0.f, 0.f, 0.f, 0.f, 0.f, 0.f, 0.f, 0.f};
#pragma unroll
                        for (int j = 0; j < 8; ++j)
#pragma unroll
                            for (int q = 0; q < 4; ++q) { const int k = 4 * lane + 256 * j + q; const f32x4 w0 = *(const LAS f32x4*)(wr_l + k * 8), w1 = *(const LAS f32x4*)(wr_l + k * 8 + 4); const float hv = v[j][q];
                                lg[0] += hv * w0[0]; lg[1] += hv * w0[1]; lg[2] += hv * w0[2]; lg[3] += hv * w0[3]; lg[4] += hv * w1[0]; lg[5] += hv * w1[1]; lg[6] += hv * w1[2]; lg[7] += hv * w1[3]; }
#pragma unroll
                        for (int e = 0; e < 8; ++e) lg[e] = wave_sum(lg[e]);
                        int e0 = 0; float l0 = lg[0];
#pragma unroll
                        for (int e = 1; e < 8; ++e) if (lg[e] > l0) { l0 = lg[e]; e0 = e; }
                        int e1 = -1; float l1 = -3.0e38f;
#pragma unroll
                        for (int e = 0; e < 8; ++e) if (e != e0 && lg[e] > l1) { l1 = lg[e]; e1 = e; }
                        const float w1 = 1.0f / (1.0f + __expf(l0 - l1)), w0 = 1.0f - w1;
                        if (lane == 0) etab[itn * NWAVES + wave] = e0 | (e1 << 8);
                        if (lane == itn) { my_e0 = e0; my_e1 = e1; my_w0 = w0; my_w1 = w1; my_tok = m; }
                    }
                }
                if (router) {
                    __syncthreads();
                    const int nent = ((SEQ + NGW - 1) / NGW) * NWAVES;
                    if (tid < nent) {
                        const int me = etab[tid], a0 = me & 255, a1 = me >> 8; int c0 = 0, c1 = 0;
                        for (int q = 0; q < tid; ++q) { const int o = etab[q], b0 = o & 255, b1 = o >> 8; c0 += (b0 == a0) + (b1 == a0); c1 += (b0 == a1) + (b1 == a1); }
                        rtab[2 * tid] = c0; rtab[2 * tid + 1] = c1; }
                    if (tid >= 512 - 8) { const int e = tid - (512 - 8); int c = 0;
                        for (int q = 0; q < nent; ++q) { const int o = etab[q]; c += ((o & 255) == e) + ((o >> 8) == e); }
                        BLKCNT[bx * 8 + e] = c; }
                    __syncthreads();
                    if (my_tok >= 0) { int* ti = TOKINFO + (size_t)my_tok * 8; ti[0] = my_e0; ti[1] = my_e1; ti[2] = __float_as_int(my_w0); ti[3] = __float_as_int(my_w1);
                        ti[4] = rtab[2 * (lane * NWAVES + wave)]; ti[5] = rtab[2 * (lane * NWAVES + wave) + 1]; ti[6] = bx; }
                }
                __syncthreads();
                SEAM(ph);
            }
            if (sub == 0) {
            if (IN(pb + 1)) {
                PHASE_IDS();
                pg8::Gemm g{HB, WIN + (size_t)l * DINP * DM, DM, DM, DM, 0, nullptr}; pg8::TileOrder S; S.init(SEQ / 256, DINP / 256, G, bx);
                pg8::EpiBf16 E{ZB, DINP, 1.0f};
                pg8::gemm_phase<pg8::EpiBf16, pg8::TileOrder, false>(tid, lds, g, S, E);
                SEAM(pb + 1);
            }
            if (IN(pb + 2)) {
                PHASE_IDS();
                f32x4 gq0 = ((const f32x4*)(cq_norm + (size_t)l * QLR))[2 * lane], gq1 = ((const f32x4*)(cq_norm + (size_t)l * QLR))[2 * lane + 1];
                f32x4 gk = ((const f32x4*)(ckv_norm + (size_t)l * KVLR))[lane];
                for (int m = gw; m < SEQ; m += NGW) {
                    bf16_t* zr = ZB + (size_t)m * DINP;
                    const bf16x8 q8 = *(const bf16x8*)(zr + ZQ + 8 * lane); const s16x4 k4 = *(const s16x4*)(zr + ZKV + 4 * lane);
                    float qf[8], kf[4], sq = 0.f, sk = 0.f;
#pragma unroll
                    for (int j = 0; j < 8; ++j) { qf[j] = bf2f((unsigned short)q8[j]); sq += qf[j] * qf[j]; }
#pragma unroll
                    for (int j = 0; j < 4; ++j) { kf[j] = bf2f((unsigned short)k4[j]); sk += kf[j] * kf[j]; }
                    const float rq = 1.0f / sqrtf(wave_sum(sq) * (1.0f / QLR) + RMS_EPS), rk = 1.0f / sqrtf(wave_sum(sk) * (1.0f / KVLR) + RMS_EPS);
                    u32x4 wq; wq.x = cvt_pk_bf16(qf[0] * rq * gq0[0], qf[1] * rq * gq0[1]); wq.y = cvt_pk_bf16(qf[2] * rq * gq0[2], qf[3] * rq * gq0[3]);
                    wq.z = cvt_pk_bf16(qf[4] * rq * gq1[0], qf[5] * rq * gq1[1]); wq.w = cvt_pk_bf16(qf[6] * rq * gq1[2], qf[7] * rq * gq1[3]);
                    u32x2 wk; wk.x = cvt_pk_bf16(kf[0] * rk * gk[0], kf[1] * rk * gk[1]); wk.y = cvt_pk_bf16(kf[2] * rk * gk[2], kf[3] * rk * gk[3]);
                    *(u32x4*)(zr + ZQ + 8 * lane) = wq; *(u32x2*)(zr + ZKV + 4 * lane) = wk;
                }
                {   PHASE_IDS();
                    const int r32 = lane & 31, hi = lane >> 5;
                    LAS unsigned char* ost = lds + sg::OST_OFF + wave * sg::OST_WAVE;
                    bf16x8 Af[8];
#pragma unroll
                    for (int s = 0; s < 8; ++s) Af[s] = *(const bf16x8*)(FM + (size_t)(32 * wave + r32) * 128 + 16 * s + 8 * hi);
                    for (int it = bx; it < 1024; it += G) {
                        const int s2 = it >> 3, cc = it & 7;
                        __syncthreads();
                        sg::stage_b<128>(ZB + (size_t)s2 * DINP + ZU + cc * 128, (size_t)128 * DINP, (char*)lds_raw, tid);
                        __syncthreads();
                        f32x16 o[4] = {};
                        sg::mm<128>(o, Af, (char*)lds_raw, lane);
#pragma unroll
                        for (int p = 0; p < 8; ++p) { const int k1 = 16 * wave + (p & 1) + 4 * (p >> 1) + 2 * hi; const f32x2 tw = TW[s2 * 128 + k1];
#pragma unroll
                            for (int d0 = 0; d0 < 4; ++d0) { const float re = o[d0][2 * p], im = o[d0][2 * p + 1];
                                o[d0][2 * p] = re * tw[0] - im * tw[1]; o[d0][2 * p + 1] = re * tw[1] + im * tw[0]; } }
                        sg::store_tile(o, ost, lane, sg::RowF1{A1, wave, s2, cc});
                    }
                    __syncthreads();
                }
                SEAM(pb + 2);
            }
            if (IN(pb + 3)) {
                PHASE_IDS();
                { pg8::Gemm g{ZB + ZQ, WUQ + (size_t)l * 1536 * QLR, DINP, QLR, QLR, 0, nullptr}; pg8::TileOrder S; S.init(SEQ / 256, 1536 / 256, G, bx);
                  pg8::EpiBf16 E{QB, 1536, 1.0f}; pg8::gemm_phase<pg8::EpiBf16, pg8::TileOrder, false>(tid, lds, g, S, E); }
                { pg8::Gemm g{ZB + ZKV, WUKV + (size_t)l * 2048 * KVLR, DINP, KVLR, KVLR, 0, nullptr}; pg8::TileOrder S; S.init(SEQ / 256, 2048 / 256, G, bx);
                  pg8::EpiBf16 E{KVB, 2048, 1.0f}; pg8::gemm_phase<pg8::EpiBf16, pg8::TileOrder, false>(tid, lds, g, S, E); }
                {   PHASE_IDS();
                    const int r32 = lane & 31, hi = lane >> 5;
                    LAS unsigned char* ost = lds + sg::OST_OFF + wave * sg::OST_WAVE;
                    bf16x8 Af[16];
#pragma unroll
                    for (int s = 0; s < 16; ++s) Af[s] = *(const bf16x8*)(GM + (size_t)(32 * wave + r32) * 256 + 16 * s + 8 * hi);
                    for (int it = bx; it < 1024; it += G) {
                        const int k1 = it >> 3, gidx = it & 7;
                        __syncthreads();
                        sg::stage_b<256>(A1 + (size_t)k1 * 256 * 1024 + gidx * 128, 1024, (char*)lds_raw, tid);
                        __syncthreads();
                        f32x16 o[4] = {};
                        sg::mm<256>(o, Af, (char*)lds_raw, lane);
                        sg::store_tile(o, ost, lane, sg::RowF2{YC, wave, k1, gidx});
                    }
                    __syncthreads();
                }
                SEAM(pb + 3);
            }
            if (IN(pb + 4)) {
                PHASE_IDS();
                {
                    const int hd = lane >> 3, j8 = lane & 7;
                    const float* qg = q_norm + (size_t)l * QKD; const float* kg = k_norm + (size_t)l * QKD;
                    f32x4 qgn[4], kgn[4], qgr[2], kgr[2];
#pragma unroll
                    for (int j = 0; j < 4; ++j) { qgn[j] = *(const f32x4*)(qg + 16 * j8 + 4 * j); kgn[j] = *(const f32x4*)(kg + 16 * j8 + 4 * j); }
                    qgr[0] = *(const f32x4*)(qg + NOPE + 4 * j8); qgr[1] = *(const f32x4*)(qg + NOPE + 32 + 4 * j8);
                    kgr[0] = *(const f32x4*)(kg + NOPE + 4 * j8); kgr[1] = *(const f32x4*)(kg + NOPE + 32 + 4 * j8);
                    for (int m = gw; m < SEQ; m += NGW) {
                        const f32x4 cs = *(const f32x4*)(COS + (size_t)m * 32 + 4 * j8), sn = *(const f32x4*)(SIN + (size_t)m * 32 + 4 * j8);
                        {
                            bf16_t* qp = QB + (size_t)m * 1536 + hd * QKD;
                            const bf16x8 n0 = *(const bf16x8*)(qp + 16 * j8), n1 = *(const bf16x8*)(qp + 16 * j8 + 8);
                            const s16x4 ra = *(const s16x4*)(qp + NOPE + 4 * j8), rb = *(const s16x4*)(qp + NOPE + 32 + 4 * j8);
                            float f[16], x1[4], x2[4], ss = 0.f;
#pragma unroll
                            for (int j = 0; j < 8; ++j) { f[j] = bf2f((unsigned short)n0[j]); f[8 + j] = bf2f((unsigned short)n1[j]); }
#pragma unroll
                            for (int j = 0; j < 16; ++j) ss += f[j] * f[j];
#pragma unroll
                            for (int j = 0; j < 4; ++j) { x1[j] = bf2f((unsigned short)ra[j]); x2[j] = bf2f((unsigned short)rb[j]); ss += x1[j] * x1[j] + x2[j] * x2[j]; }
                            ss += swz_xor<1>(ss); ss += swz_xor<2>(ss); ss += swz_xor<4>(ss);
                            const float rs = 1.0f / sqrtf(ss * (1.0f / QKD) + RMS_EPS);
                            u32x4 w0, w1;
                            w0.x = cvt_pk_bf16(f[0] * rs * qgn[0][0], f[1] * rs * qgn[0][1]); w0.y = cvt_pk_bf16(f[2] * rs * qgn[0][2], f[3] * rs * qgn[0][3]);
                            w0.z = cvt_pk_bf16(f[4] * rs * qgn[1][0], f[5] * rs * qgn[1][1]); w0.w = cvt_pk_bf16(f[6] * rs * qgn[1][2], f[7] * rs * qgn[1][3]);
                            w1.x = cvt_pk_bf16(f[8] * rs * qgn[2][0], f[9] * rs * qgn[2][1]); w1.y = cvt_pk_bf16(f[10] * rs * qgn[2][2], f[11] * rs * qgn[2][3]);
                            w1.z = cvt_pk_bf16(f[12] * rs * qgn[3][0], f[13] * rs * qgn[3][1]); w1.w = cvt_pk_bf16(f[14] * rs * qgn[3][2], f[15] * rs * qgn[3][3]);
                            float o1[4], o2[4];
#pragma unroll
                            for (int j = 0; j < 4; ++j) { const float a = x1[j] * rs * qgr[0][j], b = x2[j] * rs * qgr[1][j]; o1[j] = a * cs[j] - b * sn[j]; o2[j] = b * cs[j] + a * sn[j]; }
                            u32x2 wa, wb; wa.x = cvt_pk_bf16(o1[0], o1[1]); wa.y = cvt_pk_bf16(o1[2], o1[3]); wb.x = cvt_pk_bf16(o2[0], o2[1]); wb.y = cvt_pk_bf16(o2[2], o2[3]);
                            *(u32x4*)(qp + 16 * j8) = w0; *(u32x4*)(qp + 16 * j8 + 8) = w1; *(u32x2*)(qp + NOPE + 4 * j8) = wa; *(u32x2*)(qp + NOPE + 32 + 4 * j8) = wb;
                        }
                        {
                            const bf16_t* kp = KVB + (size_t)m * 2048 + hd * 256; const bf16_t* krp = ZB + (size_t)m * DINP + ZKR;
                            bf16_t* ko = KB + (size_t)m * 1536 + hd * QKD;
                            const bf16x8 n0 = *(const bf16x8*)(kp + 16 * j8), n1 = *(const bf16x8*)(kp + 16 * j8 + 8);
                            const s16x4 ra = *(const s16x4*)(krp + 4 * j8), rb = *(const s16x4*)(krp + 32 + 4 * j8);
                            float f[16], x1[4], x2[4], ss = 0.f;
#pragma unroll
                            for (int j = 0; j < 8; ++j) { f[j] = bf2f((unsigned short)n0[j]); f[8 + j] = bf2f((unsigned short)n1[j]); }
#pragma unroll
                            for (int j = 0; j < 16; ++j) ss += f[j] * f[j];
#pragma unroll
                            for (int j = 0; j < 4; ++j) { x1[j] = bf2f((unsigned short)ra[j]); x2[j] = bf2f((unsigned short)rb[j]); ss += x1[j] * x1[j] + x2[j] * x2[j]; }
                            ss += swz_xor<1>(ss); ss += swz_xor<2>(ss); ss += swz_xor<4>(ss);
                            const float rs = 1.0f / sqrtf(ss * (1.0f / QKD) + RMS_EPS);
                            u32x4 w0, w1;
                            w0.x = cvt_pk_bf16(f[0] * rs * kgn[0][0], f[1] * rs * kgn[0][1]); w0.y = cvt_pk_bf16(f[2] * rs * kgn[0][2], f[3] * rs * kgn[0][3]);
                            w0.z = cvt_pk_bf16(f[4] * rs * kgn[1][0], f[5] * rs * kgn[1][1]); w0.w = cvt_pk_bf16(f[6] * rs * kgn[1][2], f[7] * rs * kgn[1][3]);
                            w1.x = cvt_pk_bf16(f[8] * rs * kgn[2][0], f[9] * rs * kgn[2][1]); w1.y = cvt_pk_bf16(f[10] * rs * kgn[2][2], f[11] * rs * kgn[2][3]);
                            w1.z = cvt_pk_bf16(f[12] * rs * kgn[3][0], f[13] * rs * kgn[3][1]); w1.w = cvt_pk_bf16(f[14] * rs * kgn[3][2], f[15] * rs * kgn[3][3]);
                            float o1[4], o2[4];
#pragma unroll
                            for (int j = 0; j < 4; ++j) { const float a = x1[j] * rs * kgr[0][j], b = x2[j] * rs * kgr[1][j]; o1[j] = a * cs[j] - b * sn[j]; o2[j] = b * cs[j] + a * sn[j]; }
                            u32x2 wa, wb; wa.x = cvt_pk_bf16(o1[0], o1[1]); wa.y = cvt_pk_bf16(o1[2], o1[3]); wb.x = cvt_pk_bf16(o2[0], o2[1]); wb.y = cvt_pk_bf16(o2[2], o2[3]);
                            *(u32x4*)(ko + 16 * j8) = w0; *(u32x4*)(ko + 16 * j8 + 8) = w1; *(u32x2*)(ko + NOPE + 4 * j8) = wa; *(u32x2*)(ko + NOPE + 32 + 4 * j8) = wb;
                        }
                    }
                }
                {   PHASE_IDS();
                    const int r32 = lane & 31, hi = lane >> 5;
                    LAS unsigned char* ost = lds + sg::OST_OFF + wave * sg::OST_WAVE;
                    for (int it = bx; it < 512; it += G) {
                        const int tt = it >> 3, gidx = it & 7;
                        bf16x8 Af[16];
                        const bf16_t* ar = YC + (size_t)(256 * tt + 32 * wave + r32) * 2048 + gidx * 256 + 8 * hi;
#pragma unroll
                        for (int s = 0; s < 16; ++s) Af[s] = *(const bf16x8*)(ar + 16 * s);
                        __syncthreads();
                        sg::stage_b<256>(M12 + (size_t)(l * 8 + gidx) * 256 * 128, 128, (char*)lds_raw, tid);
                        __syncthreads();
                        f32x16 o[4] = {};
                        sg::mm<256>(o, Af, (char*)lds_raw, lane);
                        sg::store_tile(o, ost, lane, sg::RowF3{HB, wave, tt, gidx});
                    }
                    __syncthreads();
                }
                SEAM(pb + 4);
            }
            if (IN(pb + 5)) {
                PHASE_IDS();
                float gq = 0.f, gk = 0.f;
#pragma unroll
                for (int j = 0; j < 3; ++j) { gq = fmaxf(gq, fabsf(q_norm[(size_t)l * QKD + lane + 64 * j])); gk = fmaxf(gk, fabsf(k_norm[(size_t)l * QKD + lane + 64 * j])); }
                gq = fmaxf(gq, swz_xor<1>(gq)); gq = fmaxf(gq, swz_xor<2>(gq)); gq = fmaxf(gq, swz_xor<4>(gq)); gq = fmaxf(gq, swz_xor<8>(gq)); gq = fmaxf(gq, swz_xor<16>(gq));
                gk = fmaxf(gk, swz_xor<1>(gk)); gk = fmaxf(gk, swz_xor<2>(gk)); gk = fmaxf(gk, swz_xor<4>(gk)); gk = fmaxf(gk, swz_xor<8>(gk)); gk = fmaxf(gk, swz_xor<16>(gk));
                { auto rq = __builtin_amdgcn_permlane32_swap(__float_as_uint(gq), __float_as_uint(gq), false, false); gq = fmaxf(__uint_as_float(rq[0]), __uint_as_float(rq[1]));
                  auto rk = __builtin_amdgcn_permlane32_swap(__float_as_uint(gk), __float_as_uint(gk), false, false); gk = fmaxf(__uint_as_float(rk[0]), __uint_as_float(rk[1])); }
                const int negMC = __builtin_amdgcn_readfirstlane(__builtin_bit_cast(int, -(13.856406460551018f * gq * gk) * 1.4426950408889634f));
                for (int u = bx; u < NH * (SEQ / 256); u += G) {
                    const int h = u & 7, qb = u >> 3;
                    att::attn_unit2(QB + (size_t)(qb * 256) * 1536 + h * QKD, KB + h * QKD, KVB + h * 256 + NOPE, HB + (size_t)(qb * 256) * DM + h * VHD, SEQ, lds, tid, negMC);
                }
                SEAM(pb + 5);
            }
            if (IN(pb + 6)) {
                PHASE_IDS();
                const float* og = out_norm + (size_t)l * DM;
                f32x4 ga[4], gf[4];
#pragma unroll
                for (int j = 0; j < 4; ++j) { ga[j] = *(const f32x4*)(og + 16 * lane + 4 * j); gf[j] = *(const f32x4*)(og + 1024 + 16 * lane + 4 * j); }
                for (int m = gw; m < SEQ; m += NGW) {
                    bf16_t* rp = HB + (size_t)m * DM;
#pragma unroll
                    for (int half = 0; half < 2; ++half) {
                        bf16_t* p = rp + half * 1024 + 16 * lane;
                        const bf16x8 a0 = *(const bf16x8*)p, a1 = *(const bf16x8*)(p + 8);
                        float f[16], ss = 0.f;
#pragma unroll
                        for (int j = 0; j < 8; ++j) { f[j] = bf2f((unsigned short)a0[j]); f[8 + j] = bf2f((unsigned short)a1[j]); }
#pragma unroll
                        for (int j = 0; j < 16; ++j) ss += f[j] * f[j];
                        const float rs = 1.0f / sqrtf(wave_sum(ss) * (1.0f / 1024) + RMS_EPS);
                        u32x4 w0, w1;
#define GG(j) (half ? gf[(j) >> 2][(j) & 3] : ga[(j) >> 2][(j) & 3])
                        w0.x = cvt_pk_bf16(f[0] * rs * GG(0), f[1] * rs * GG(1)); w0.y = cvt_pk_bf16(f[2] * rs * GG(2), f[3] * rs * GG(3));
                        w0.z = cvt_pk_bf16(f[4] * rs * GG(4), f[5] * rs * GG(5)); w0.w = cvt_pk_bf16(f[6] * rs * GG(6), f[7] * rs * GG(7));
                        w1.x = cvt_pk_bf16(f[8] * rs * GG(8), f[9] * rs * GG(9)); w1.y = cvt_pk_bf16(f[10] * rs * GG(10), f[11] * rs * GG(11));
                        w1.z = cvt_pk_bf16(f[12] * rs * GG(12), f[13] * rs * GG(13)); w1.w = cvt_pk_bf16(f[14] * rs * GG(14), f[15] * rs * GG(15));
#undef GG
                        *(u32x4*)p = w0; *(u32x4*)(p + 8) = w1;
                    }
                }
                SEAM(pb + 6);
            }
            if (IN(pb + 7)) {
                PHASE_IDS();
                pg8::Gemm g{HB, WOUT + (size_t)l * DM * DM, DM, DM, DM, 0, nullptr}; pg8::TileOrder S; S.init(SEQ / 256, DM / 256, G, bx);
                pg8::EpiRes E{xcur, out, modv + 2 * DM, DM};
                pg8::gemm_phase<pg8::EpiRes, pg8::TileOrder, false>(tid, lds, g, S, E);
                SEAM(pb + 7);
            }
            }
        }
        if (l == 0) {
            if (IN(pb + 9)) {
                PHASE_IDS();
                pg8::Gemm g{HB, WGUD, DM, DM, DM, 0, nullptr}; pg8::TileOrder S; S.init(SEQ / 256, 2 * DFF / 256, G, bx);
                pg8::EpiSwiGLU E{HID, DFF};
                pg8::gemm_phase<pg8::EpiSwiGLU, pg8::TileOrder, false>(tid, lds, g, S, E);
                SEAM(pb + 9);
            }
            if (IN(pb + 10)) {
                PHASE_IDS();
                pg8::Gemm g{HID, WDND, DFF, DFF, DFF, 0, nullptr}; pg8::TileOrder S; S.init(SEQ / 256, DM / 256, G, bx);
                pg8::EpiRes E{out, out, modv + 5 * DM, DM};
                pg8::gemm_phase<pg8::EpiRes, pg8::TileOrder, false>(tid, lds, g, S, E);
                SEAM(pb + 10);
            }
        } else {
#define LOAD_TS() int ts[9]; ts[0] = 0; _Pragma("unroll") for (int e = 0; e < 8; ++e) { const int c = __builtin_amdgcn_readfirstlane((int)__hip_atomic_load(ctl + CW_ECNT + 64 * e, RLX_AGENT)); ts[e + 1] = ts[e] + ((c + 255) >> 8); }
            if (IN(pb + 9)) {
                PHASE_IDS();
                LAS int* pref = (LAS int*)lds; LAS int* tot = pref + G * 8;
                for (int i = tid; i < G * 8; i += NTHR) pref[i] = BLKCNT[i];
                __syncthreads();
                if (tid < 8) { int run = 0; for (int b = 0; b < G; ++b) { const int c = pref[b * 8 + tid]; pref[b * 8 + tid] = run; run += c; } tot[tid] = run;
                    if (bx == 0) __hip_atomic_store(ctl + CW_ECNT + 64 * tid, (unsigned)run, RLX_AGENT); }
                __syncthreads();
                int ts[9]; ts[0] = 0;
#pragma unroll
                for (int e = 0; e < 8; ++e) ts[e + 1] = ts[e] + ((tot[e] + 255) >> 8);
                for (int t = bx * NTHR + tid; t < SEQ; t += G * NTHR) {
                    const int* ti = TOKINFO + (size_t)t * 8; const int e0 = ti[0], e1 = ti[1], b = ti[6];
                    int p0 = ti[4] + pref[b * 8 + e0], p1 = ti[5] + pref[b * 8 + e1];
#pragma unroll
                    for (int e = 0; e < 8; ++e) { if (e0 == e) p0 += 256 * ts[e]; if (e1 == e) p1 += 256 * ts[e]; }
                    ROWTOK[p0] = t; ROWTOK[p1] = t; TOKPOS[2 * t] = p0; TOKPOS[2 * t + 1] = p1;
                }
                __syncthreads();
                SEAM(pb + 9);
            }
            if (IN(pb + 10)) {
                PHASE_IDS(); LOAD_TS();
                pg8::Gemm g{HB, WGUM, DM, DM, DM, (size_t)14336 * DM, ROWTOK}; pg8::TileOrder S; S.init(ts[8], 2 * DFE / 256, G, bx); S.moe = true;
#pragma unroll
                for (int e = 0; e < 9; ++e) S.ts[e] = ts[e];
                pg8::EpiSwiGLU8 E{(unsigned char*)HID, DFE, 1.0f / (S8_H * S8_WGU), S8_HID};
                pg8::gemm_phase<pg8::EpiSwiGLU8, pg8::TileOrder, true, true, true>(tid, lds, g, S, E);
                SEAM(pb + 10);
            }
            if (IN(pb + 11)) {
                PHASE_IDS(); LOAD_TS();
                const int nmain = ts[8] < 128 ? ts[8] : 128;
                pg8::EpiBf16 E{YB, DM, 1.0f / (S8_HID * S8_WDN), YPART - (size_t)32768 * DM, (size_t)2048 * DM};
                { pg8::Gemm g{HID, WDNM, DFE, DFE, DFE, (size_t)DM * DFE, nullptr}; pg8::TileOrder S; S.init(nmain, DM / 256, G, bx); S.moe = true;
#pragma unroll
                  for (int e = 0; e < 9; ++e) S.ts[e] = ts[e];
                  pg8::gemm_phase<pg8::EpiBf16, pg8::TileOrder, false, true, true>(tid, lds, g, S, E); }
                if (ts[8] > 128) { asm volatile("" : "+v"(tid));
                  pg8::Gemm g{HID, WDNM, DFE, DFE, DFE / 4, (size_t)DM * DFE, nullptr, DFE / 128}; pg8::TailOrder S; S.nsub = (ts[8] - 128) * 32; S.G = G; S.c = bx; S.pm0 = 128;
#pragma unroll
                  for (int e = 0; e < 9; ++e) S.ts[e] = ts[e];
                  pg8::gemm_phase<pg8::EpiBf16, pg8::TailOrder, false, true, true>(tid, lds, g, S, E); }
                SEAM(pb + 11);
            }
            if (IN(pb + 12)) {
                PHASE_IDS();
                const float* g2 = modv + 5 * DM;
                f32x4 gv[8];
#pragma unroll
                for (int j = 0; j < 8; ++j) gv[j] = ((const f32x4*)g2)[lane + 64 * j];
                for (int m = gw; m < SEQ; m += NGW) {
                    const int* ti = TOKINFO + (size_t)m * 8; const float w0 = __int_as_float(ti[2]), w1 = __int_as_float(ti[3]);
                    const int p0 = TOKPOS[2 * m], p1 = TOKPOS[2 * m + 1];
                    const bf16_t* y0 = YB + (size_t)p0 * DM; const bf16_t* y1 = YB + (size_t)p1 * DM; float* op = out + (size_t)m * DM;
                    const bool t0 = p0 >= 32768, t1 = p1 >= 32768;
#pragma unroll
                    for (int j = 0; j < 8; ++j) { const s16x4 a = *(const s16x4*)(y0 + 4 * lane + 256 * j), b = *(const s16x4*)(y1 + 4 * lane + 256 * j);
                        f32x4 ya, yb;
#pragma unroll
                        for (int q = 0; q < 4; ++q) { ya[q] = bf2f((unsigned short)a[q]); yb[q] = bf2f((unsigned short)b[q]); }
                        if (t0) {
#pragma unroll
                            for (int kq = 0; kq < 3; ++kq) { const s16x4 e = *(const s16x4*)(YPART + ((size_t)kq * 2048 + (p0 - 32768)) * DM + 4 * lane + 256 * j);
#pragma unroll
                                for (int q = 0; q < 4; ++q) ya[q] += bf2f((unsigned short)e[q]); } }
                        if (t1) {
#pragma unroll
                            for (int kq = 0; kq < 3; ++kq) { const s16x4 e = *(const s16x4*)(YPART + ((size_t)kq * 2048 + (p1 - 32768)) * DM + 4 * lane + 256 * j);
#pragma unroll
                                for (int q = 0; q < 4; ++q) yb[q] += bf2f((unsigned short)e[q]); } }
                        f32x4 xv = ((f32x4*)op)[lane + 64 * j];
#pragma unroll
                        for (int q = 0; q < 4; ++q) xv[q] += gv[j][q] * (w0 * ya[q] + w1 * yb[q]);
                        ((f32x4*)op)[lane + 64 * j] = xv; }
                }
            }
        }
    }
#undef IN
#undef SEAM
#undef LOAD_TS
#undef modv
#undef xcur
#undef out
#undef ctl
}

extern "C" void kernel_launch(void* const* d_in, const int* in_sizes, int n_in, void* d_out, int out_size, void* d_ws, size_t ws_size, hipStream_t stream) {
    static int grid = 0;
    if (grid == 0) {
        if (n_in != 24 || out_size != SEQ * DM || ws_size < WS_END) { fprintf(stderr, "kernel_launch: unexpected shapes n_in %d out %d ws %zu (need %zu)\n", n_in, out_size, ws_size, (size_t)WS_END); grid = -1; return; }
        int dev = 0, cus = 0, per_cu = 0;
        if (hipGetDevice(&dev) != hipSuccess || hipDeviceGetAttribute(&cus, hipDeviceAttributeMultiprocessorCount, dev) != hipSuccess) { grid = -1; return; }
        if (hipFuncSetAttribute((const void*)mk_fwd, hipFuncAttributeMaxDynamicSharedMemorySize, LDS_BYTES) != hipSuccess) { fprintf(stderr, "kernel_launch: hipFuncSetAttribute failed\n"); grid = -1; return; }
        if (hipOccupancyMaxActiveBlocksPerMultiprocessor(&per_cu, (const void*)mk_fwd, NTHR, LDS_BYTES) != hipSuccess || per_cu < 1) fprintf(stderr, "kernel_launch: occupancy query says %d\n", per_cu);
        (void)hipGetLastError();
        grid = cus;
    }
    if (grid < 0) return;
    (void)hipMemsetAsync((char*)d_ws + WS_CTL, 0, CTL_BYTES, stream);
    Args a{};
    for (int i = 0; i < 24; ++i) a.in[i] = d_in[i];
    a.out = (float*)d_out; a.ws = (unsigned char*)d_ws;
#if MK_MULTI
    static const int phases[] = {0, 1, 2, 3, 4, 5, 6, 7, 8, 9, 10, 11, 12, 18, 19, 20, 21, 22, 23, 24, 25, 26, 27, 28, 29, 30};
    for (int p : phases) { a.ph_lo = p; a.ph_hi = p + 1; hipLaunchKernelGGL(mk_fwd, dim3(grid), dim3(NTHR), LDS_BYTES, stream, a); }
#else
    a.ph_lo = 0; a.ph_hi = 31;
    hipLaunchKernelGGL(mk_fwd, dim3(grid), dim3(NTHR), LDS_BYTES, stream, a);
#endif
    const hipError_t le = hipPeekAtLastError();
    if (le != hipSuccess) fprintf(stderr, "kernel_launch: launch failed: %s\n", hipGetErrorName(le));
}
```

```cpp
#include <hip/hip_runtime.h>
#include <cstdio>
#include <cstdint>

#ifndef MK_MULTI
#define MK_MULTI 0
#endif

#define GAS __attribute__((address_space(1)))
#define LAS __attribute__((address_space(3)))
typedef unsigned short bf16_t;
typedef short bf16x8 __attribute__((ext_vector_type(8)));
typedef short s16x4 __attribute__((ext_vector_type(4)));
typedef float f32x4 __attribute__((ext_vector_type(4)));
typedef float f32x2 __attribute__((ext_vector_type(2)));
typedef float f32x16 __attribute__((ext_vector_type(16)));
typedef unsigned u32x4 __attribute__((ext_vector_type(4)));
typedef unsigned u32x2 __attribute__((ext_vector_type(2)));

constexpr int SEQ = 16384, DM = 2048, DIN = 1856, DINP = 2048;
constexpr int QLR = 512, KVLR = 256, ROPE = 64, NOPE = 128, VHD = 128, QKD = 192, NH = 8;
constexpr int ZQ = 0, ZKV = 512, ZKR = 768, ZU = 832;
constexpr int FNW = 1024, FG = 8;
constexpr int DFF = 5632, NE = 8, DFE = 7168;
constexpr int MAXT = 136;
constexpr float RMS_EPS = 1e-6f;
constexpr float S8_H = 8.f, S8_WGU = 64.f, S8_HID = 8.f, S8_WDN = 128.f;
constexpr int NWAVES = 8, NTHR = 512;

constexpr size_t MiB = 1u << 20;
constexpr size_t WS_CTL = 0, CTL_BYTES = 1 * MiB;
constexpr int CW_BAR = 4096;
constexpr int CW_ECNT = 8192;
constexpr int CW_F3CTR = 12288;
constexpr size_t CTL_ROWTOK = 256 * 1024;
constexpr size_t WS_MODP = 1 * MiB;
constexpr size_t WS_MODV = WS_MODP + 16 * 2 * 12288 * 4;
constexpr size_t WS_COS = 3 * MiB, WS_SIN = 5 * MiB;
constexpr size_t WS_TW = 7 * MiB;
constexpr size_t WS_FM = WS_TW + 131072;
constexpr size_t WS_GM = WS_FM + 65536;
constexpr size_t WS_M12 = 8 * MiB;
constexpr size_t WS_TOKINFO = 9 * MiB;
constexpr size_t WS_TOKPOS = WS_TOKINFO + (size_t)SEQ * 32;
constexpr size_t WS_WIN = 10 * MiB;
constexpr size_t WS_WUQ = WS_WIN + 2 * 8 * MiB;
constexpr size_t WS_WUKV = WS_WUQ + 2 * 1536 * 512 * 2;
constexpr size_t WS_WOUT = WS_WUKV + 2 * 2048 * 256 * 2;
constexpr size_t WS_WGUD = WS_WOUT + 2 * 8 * MiB;
constexpr size_t WS_WDND = WS_WGUD + (size_t)11264 * 2048 * 2;
constexpr size_t WS_WGUM = WS_WDND + (size_t)2048 * 5632 * 2;
constexpr size_t WS_WDNM = WS_WGUM + (size_t)8 * 14336 * 2048 * 2;
constexpr size_t WS_H = WS_WDNM + (size_t)8 * 2048 * 7168 * 2;
constexpr size_t WS_Y = WS_H + (size_t)SEQ * 2048 * 2;
constexpr size_t WS_ARENA = WS_Y + (size_t)MAXT * 256 * 2048 * 2;
constexpr size_t WS_Z = WS_ARENA;
constexpr size_t WS_QB = WS_Z + (size_t)SEQ * 2048 * 2;
constexpr size_t WS_KVB = WS_QB + (size_t)SEQ * 1536 * 2;
constexpr size_t WS_KB = WS_KVB + (size_t)SEQ * 2048 * 2;
constexpr size_t WS_A1 = WS_KB + (size_t)SEQ * 1536 * 2;
constexpr size_t WS_YC = WS_A1 + (size_t)SEQ * 2048 * 2;
constexpr size_t WS_HID = WS_ARENA;
constexpr size_t WS_END = WS_ARENA + (size_t)MAXT * 256 * 7168 * 2;
static_assert(WS_YC + (size_t)SEQ * 2048 * 2 <= WS_END, "arena");
static_assert(WS_END <= (size_t)1900 * MiB, "workspace budget");

constexpr int RING_BYTES = 133120;
constexpr int LDS_COND = RING_BYTES;
constexpr int LDS_TRIG = LDS_COND + 8192;
constexpr int LDS_MISC = LDS_TRIG + 1024;
constexpr int LDS_BYTES = 147456;
static_assert(LDS_MISC + 256 <= LDS_BYTES, "LDS map");

#define LDS_WAIT() asm volatile("s_waitcnt lgkmcnt(0)" ::: "memory")
#define VM_WAIT() asm volatile("s_waitcnt vmcnt(0)" ::: "memory")
#define RLX_AGENT __ATOMIC_RELAXED, __HIP_MEMORY_SCOPE_AGENT

__device__ __forceinline__ unsigned cvt_pk_bf16(float lo, float hi) { unsigned r; asm volatile("v_cvt_pk_bf16_f32 %0, %1, %2" : "=v"(r) : "v"(lo), "v"(hi)); return r; }
__device__ __forceinline__ float bf2f(unsigned short b) { return __uint_as_float(((unsigned)b) << 16); }
__device__ __forceinline__ bf16_t f2bf(float f) { return (bf16_t)(cvt_pk_bf16(f, 0.f) & 0xffffu); }
template <int XM> __device__ __forceinline__ float swz_xor(float v) { return __int_as_float(__builtin_amdgcn_ds_swizzle(__float_as_int(v), (XM << 10) | 0x1f)); }
__device__ __forceinline__ float wave_sum(float v) {
    v += swz_xor<1>(v); v += swz_xor<2>(v); v += swz_xor<4>(v); v += swz_xor<8>(v); v += swz_xor<16>(v);
    auto rr = __builtin_amdgcn_permlane32_swap(__float_as_uint(v), __float_as_uint(v), false, false);
    return __uint_as_float(rr[0]) + __uint_as_float(rr[1]);
}

#define XB_TMO      128
#define XB_XCNT(j)  (256  + 64 * (j))
#define XB_XSUB(j)  (1280 + 64 * (j))
#define XB_XGEN(j)  (2304 + 64 * (j))
#define XB_TOP      3328
#define XB_TOPGEN   3392
#define XCD_BAR_WORDS 3456
#define XB_SPIN_CAP (1u << 18)
__device__ __forceinline__ unsigned xb_ld(unsigned* p)              { return __hip_atomic_load(p, __ATOMIC_RELAXED, __HIP_MEMORY_SCOPE_AGENT); }
__device__ __forceinline__ unsigned xb_add(unsigned* p, unsigned v) { return __hip_atomic_fetch_add(p, v, __ATOMIC_RELAXED, __HIP_MEMORY_SCOPE_AGENT); }
__device__ __forceinline__ unsigned xb_xcc_id() { return (unsigned)__builtin_amdgcn_s_getreg((3 << 11) | 20) & 0xFu; }
#define XB_SPIN(cond, bar) do { unsigned _sp = 0; while (cond) { __builtin_amdgcn_s_sleep(1); \
    if ((++_sp & 255u) == 0u) { if (xb_ld(&(bar)[XB_TMO])) break; if (_sp > XB_SPIN_CAP) { atomicAdd(&(bar)[XB_TMO], 1u); break; } } } } while (0)
struct XcdBarrier { unsigned* bar; unsigned x; volatile LAS unsigned* st; };
__device__ __forceinline__ XcdBarrier xcd_barrier_post(unsigned* bar, volatile LAS unsigned* st) {
    XcdBarrier b; b.bar = bar; b.x = xb_xcc_id(); b.st = st;
    if (threadIdx.x == 0) (void)xb_add(&bar[XB_XCNT(b.x)], 1u);
    return b;
}
__device__ __forceinline__ void xcd_barrier_complete(unsigned* bar, unsigned x, unsigned& nloc, unsigned& nx) {
    const unsigned G = gridDim.x * gridDim.y * gridDim.z;
    unsigned sum, cnt, mine, sp = 0u;
    for (;;) {
        sum = 0u; cnt = 0u; mine = 0u;
#pragma unroll
        for (unsigned j = 0; j < 16; ++j) { const unsigned c = xb_ld(&bar[XB_XCNT(j)]); sum += c; cnt += (c > 0u) ? 1u : 0u; mine = (j == x) ? c : mine; }
        if (sum == G) break;
        __builtin_amdgcn_s_sleep(1);
        if ((++sp & 255u) == 0u) { if (xb_ld(&bar[XB_TMO])) break; if (sp > XB_SPIN_CAP) { atomicAdd(&bar[XB_TMO], 1u); break; } }
    }
    nloc = mine > 0u ? mine : 1u; nx = cnt > 0u ? cnt : 1u;
}
__device__ __forceinline__ void xcd_barrier(const XcdBarrier& b) {
    asm volatile("s_waitcnt vmcnt(0)" ::: "memory");
    __syncthreads();
    if (threadIdx.x == 0) {
        unsigned* bar = b.bar;
        __builtin_amdgcn_s_waitcnt(0);
        unsigned nloc = b.st[0], nx = b.st[1];
        if (nloc == 0u) { xcd_barrier_complete(bar, b.x, nloc, nx); b.st[0] = nloc; b.st[1] = nx; }
        const unsigned old = xb_add(&bar[XB_XSUB(b.x)], 1u);
        const unsigned gen = old / nloc;
        if (old + 1u == (gen + 1u) * nloc) {
            __builtin_amdgcn_fence(__ATOMIC_RELEASE, "agent");
            asm volatile("s_waitcnt vmcnt(0)" ::: "memory");
            const unsigned og = xb_add(&bar[XB_TOP], 1u);
            const unsigned tg = og / nx;
            if (og + 1u == (tg + 1u) * nx) xb_add(&bar[XB_TOPGEN], 1u);
            else XB_SPIN(xb_ld(&bar[XB_TOPGEN]) == tg, bar);
            __builtin_amdgcn_fence(__ATOMIC_ACQUIRE, "agent");
            xb_add(&bar[XB_XGEN(b.x)], 1u);
            asm volatile("s_waitcnt vmcnt(0)" ::: "memory");
        } else {
            XB_SPIN(xb_ld(&bar[XB_XGEN(b.x)]) == gen, bar);
            __builtin_amdgcn_fence(__ATOMIC_ACQUIRE, "agent");
            asm volatile("s_waitcnt vmcnt(0)" ::: "memory");
        }
    }
    __syncthreads();
}

namespace pg8 {
constexpr int BM = 256, BK = 64, HALF = 128, HTB = HALF * BK * 2, STAGE_BYTES = 8 * HTB, NXCD = 8, WGM = 8;
__host__ __device__ __forceinline__ int lds_byte(int r, int c) { const int st = (r >> 4) * 2 + (c >> 5), rr = r & 15, cc = c & 31, ob = rr * 64 + cc * 2; return st * 1024 + (ob ^ (((ob >> 9) & 1) << 5)); }
__host__ __device__ __forceinline__ void stage_rc(int b, int& R, int& C) { const int st = b / 1024, sb = b % 1024, swz = sb ^ (((sb >> 9) & 1) << 5); R = (st >> 1) * 16 + swz / 64; C = (st & 1) * 32 + (swz % 64) / 2; }
__host__ __device__ __forceinline__ int perm32(int rho) { const int n = rho >> 4, i = rho & 15; return 8 * (i >> 2) + 4 * n + (i & 3); }

struct Unit { int pm, pn, e, kq; };
struct Gemm { const void* A; const void* Bt; int lda, ldb, K; size_t estrideB; const int* rowmap; int ktB = 0; };

struct TileOrder {
    int nM, nN, nwg, G, c; int ts[9]; bool moe;
    __device__ __forceinline__ void init(int nM_, int nN_, int G_, int c_) { nM = nM_; nN = nN_; nwg = nM * nN; G = G_; c = c_; moe = false; }
    __device__ __forceinline__ bool next(int i, Unit& u) const {
        const long L = (long)i * G + c; if (L >= nwg) return false;
        int wgid = (int)L; { const int q = nwg / NXCD, r = nwg % NXCD, xcd = wgid % NXCD, off = wgid / NXCD; wgid = (xcd < r ? xcd * (q + 1) : r * (q + 1) + (xcd - r) * q) + off; }
        const int nig = WGM * nN, gid = wgid / nig, fm = gid * WGM, gsz = (nM - fm) < WGM ? (nM - fm) : WGM;
        u.pm = fm + ((wgid % nig) % gsz); u.pn = (wgid % nig) / gsz; u.e = 0; u.kq = 0;
        if (moe) {
#pragma unroll
            for (int j = 1; j < 8; ++j) if (u.pm >= ts[j]) u.e = j;
        }
        return true;
    }
};

struct TailOrder {
    int nsub, G, c, pm0; int ts[9];
    __device__ __forceinline__ bool next(int i, Unit& u) const {
        const int L = i * G + c; if (L >= nsub) return false;
        u.kq = L & 3; u.pn = (L >> 2) & 7; u.pm = pm0 + (L >> 5); u.e = 0;
#pragma unroll
        for (int j = 1; j < 8; ++j) if (u.pm >= ts[j]) u.e = j;
        return true;
    }
};
struct EpiBf16 {
    static constexpr bool PERM = true;
    bf16_t* O; int ldc; float scale; bf16_t* O2 = nullptr; size_t kqstride = 0;
    __device__ __forceinline__ void operator()(const f32x4 (&acc)[2][2][4][2], const Unit& u, int wr, int wc, int fr, int fq) const {
        const int row0 = u.pm * BM + wr * 64 + fr, col0 = u.pn * BM + wc * 32 + 8 * fq;
        bf16_t* const Ob = u.kq ? O2 + (size_t)(u.kq - 1) * kqstride : O;
#pragma unroll
        for (int ai = 0; ai < 2; ++ai)
#pragma unroll
            for (int m = 0; m < 4; ++m) { bf16_t* rowp = Ob + (size_t)(row0 + ai * HALF + m * 16) * ldc + col0;
#pragma unroll
                for (int bj = 0; bj < 2; ++bj) { const f32x4 v0 = acc[ai][bj][m][0] * scale, v1 = acc[ai][bj][m][1] * scale;
                    u32x4 w; w.x = cvt_pk_bf16(v0[0], v0[1]); w.y = cvt_pk_bf16(v0[2], v0[3]); w.z = cvt_pk_bf16(v1[0], v1[1]); w.w = cvt_pk_bf16(v1[2], v1[3]);
                    *(u32x4*)(rowp + bj * HALF) = w; } }
    }
};
__device__ __forceinline__ float silu_f(float x) { return x * __builtin_amdgcn_rcpf(1.0f + __builtin_amdgcn_exp2f(-1.4426950408889634f * x)); }
struct EpiSwiGLU {
    static constexpr bool PERM = true;
    bf16_t* O; int ldc;
    __device__ __forceinline__ void operator()(const f32x4 (&acc)[2][2][4][2], const Unit& u, int wr, int wc, int fr, int fq) const {
        const int row0 = u.pm * BM + wr * 64 + fr, col0 = u.pn * HALF + wc * 32 + 8 * fq;
#pragma unroll
        for (int ai = 0; ai < 2; ++ai)
#pragma unroll
            for (int m = 0; m < 4; ++m) { bf16_t* rowp = O + (size_t)(row0 + ai * HALF + m * 16) * ldc + col0;
                f32x4 v0, v1;
#pragma unroll
                for (int j = 0; j < 4; ++j) { v0[j] = silu_f(acc[ai][0][m][0][j]) * acc[ai][1][m][0][j]; v1[j] = silu_f(acc[ai][0][m][1][j]) * acc[ai][1][m][1][j]; }
                u32x4 w; w.x = cvt_pk_bf16(v0[0], v0[1]); w.y = cvt_pk_bf16(v0[2], v0[3]); w.z = cvt_pk_bf16(v1[0], v1[1]); w.w = cvt_pk_bf16(v1[2], v1[3]);
                *(u32x4*)rowp = w; }
    }
};
__device__ __forceinline__ float clamp448(float x) { return __builtin_amdgcn_fmed3f(x, -448.f, 448.f); }
struct EpiSwiGLU8 {
    static constexpr bool PERM = true;
    unsigned char* O; int ldc; float iscale, oscale;
    __device__ __forceinline__ void operator()(const f32x4 (&acc)[2][2][4][2], const Unit& u, int wr, int wc, int fr, int fq) const {
        const int row0 = u.pm * BM + wr * 64 + fr, col0 = u.pn * HALF + wc * 32 + 8 * fq;
#pragma unroll
        for (int ai = 0; ai < 2; ++ai)
#pragma unroll
            for (int m = 0; m < 4; ++m) { unsigned char* rowp = O + (size_t)(row0 + ai * HALF + m * 16) * ldc + col0;
                f32x4 v0, v1;
#pragma unroll
                for (int j = 0; j < 4; ++j) { v0[j] = clamp448(silu_f(acc[ai][0][m][0][j] * iscale) * (acc[ai][1][m][0][j] * (iscale * oscale)));
                                              v1[j] = clamp448(silu_f(acc[ai][0][m][1][j] * iscale) * (acc[ai][1][m][1][j] * (iscale * oscale))); }
                int w0 = 0, w1 = 0;
                w0 = __builtin_amdgcn_cvt_pk_fp8_f32(v0[0], v0[1], w0, false); w0 = __builtin_amdgcn_cvt_pk_fp8_f32(v0[2], v0[3], w0, true);
                w1 = __builtin_amdgcn_cvt_pk_fp8_f32(v1[0], v1[1], w1, false); w1 = __builtin_amdgcn_cvt_pk_fp8_f32(v1[2], v1[3], w1, true);
                u32x2 w; w.x = (unsigned)w0; w.y = (unsigned)w1; *(u32x2*)rowp = w; }
    }
};
struct EpiRes {
    static constexpr bool PERM = false;
    const float* X; float* O; const float* gate; int ldc;
    __device__ __forceinline__ void operator()(const f32x4 (&acc)[2][2][4][2], const Unit& u, int wr, int wc, int fr, int fq) const {
        const int row0 = u.pm * BM + wr * 64 + fr, col0 = u.pn * BM + wc * 32 + 4 * fq;
        f32x4 gv[2][2];
#pragma unroll
        for (int bj = 0; bj < 2; ++bj)
#pragma unroll
            for (int n = 0; n < 2; ++n) gv[bj][n] = *(const f32x4*)(gate + col0 + bj * HALF + n * 16);
#pragma unroll
        for (int ai = 0; ai < 2; ++ai)
#pragma unroll
            for (int m = 0; m < 4; ++m) { const size_t off = (size_t)(row0 + ai * HALF + m * 16) * ldc + col0;
#pragma unroll
                for (int bj = 0; bj < 2; ++bj)
#pragma unroll
                    for (int n = 0; n < 2; ++n) { const f32x4 xv = *(const f32x4*)(X + off + bj * HALF + n * 16);
                        *(f32x4*)(O + off + bj * HALF + n * 16) = xv + gv[bj][n] * acc[ai][bj][m][n]; }
                asm volatile("" ::: "memory"); }
    }
};

typedef int v8i __attribute__((ext_vector_type(8)));
typedef unsigned u32x8 __attribute__((ext_vector_type(8)));
template <class Epi, class Sched, bool GATHER, bool FP8 = false, bool TILEDB = false>
__device__ __forceinline__ void gemm_phase(const int tid, LAS unsigned char* lds, const Gemm g, const Sched& S, const Epi& E) {
    const int wid = __builtin_amdgcn_readfirstlane(tid >> 6), lane = tid & 63, wr = wid >> 2, wc = wid & 3, fr = lane & 15, fq = lane >> 4;
    constexpr int ESZ = FP8 ? 1 : 2;
    const int nt = g.K * ESZ / (BK * 2);
    unsigned voffA[2], voffB[2];
#pragma unroll
    for (int i = 0; i < 2; ++i) { int R, C; stage_rc(tid * 16 + i * 8192, R, C); const int Rb = Epi::PERM ? ((R & ~31) + perm32(R & 31)) : R;
        voffA[i] = (unsigned)(R * g.lda * ESZ + C * 2); voffB[i] = TILEDB ? (unsigned)(Rb * 128 + C * 2) : (unsigned)(Rb * g.ldb * ESZ + C * 2); }
    const size_t kstep = (size_t)(BK * 2);
    const size_t hstepA = (size_t)HALF * g.lda * ESZ, tstepA = 2 * hstepA;
    const size_t kstepB = TILEDB ? (size_t)32768 : kstep;
    const size_t hstepB = TILEDB ? (size_t)16384 : (size_t)HALF * g.ldb * ESZ, tstepB = TILEDB ? (size_t)(g.ktB ? g.ktB : nt) * 32768 : 2 * hstepB;
    const size_t kqA = (size_t)nt * kstep, kqB = (size_t)nt * kstepB;
    const unsigned ldsw = (unsigned)wid * 1024u;
    const int aoff = lds_byte(wr * 64 + fr, fq * 8), boff = lds_byte(wc * 32 + fr, fq * 8);
#define PG8_SA(b, h) (((b) * 2 + (h)) * HTB)
#define PG8_SB(b, h) ((4 + (b) * 2 + (h)) * HTB)
#define PG8_STAGE(bufoff, gbase, voff) do { _Pragma("unroll") for (int _i = 0; _i < 2; ++_i) \
        __builtin_amdgcn_global_load_lds((const unsigned*)((const char*)(gbase) + (voff)[_i]), (LAS unsigned*)(lds + (bufoff) + ldsw + _i * 8192), 16, 0, 0); } while (0)
#define PG8_STAGE_A(bufoff, UB, h, kb, V0, V1) do { if constexpr (GATHER) { if (h) PG8_STAGE(bufoff, gA + (kb), V1); else PG8_STAGE(bufoff, gA + (kb), V0); } \
        else PG8_STAGE(bufoff, (UB) + (h) * hstepA + (kb), voffA); } while (0)
#define PG8_LD8(P) __builtin_shufflevector(*(const LAS u32x4*)(P), *(const LAS u32x4*)((P) + 1024), 0, 1, 2, 3, 4, 5, 6, 7)
#define PG8_LDA(dst, b, h) do { if constexpr (FP8) { _Pragma("unroll") for (int m = 0; m < 4; ++m) dst##8[m] = PG8_LD8(lds + PG8_SA(b, h) + aoff + m * 2048); } \
        else { _Pragma("unroll") for (int m = 0; m < 4; ++m) _Pragma("unroll") for (int k = 0; k < 2; ++k) dst[m][k] = *(const LAS bf16x8*)(lds + PG8_SA(b, h) + aoff + m * 2048 + k * 1024); } } while (0)
#define PG8_LDB(dst, b, h) do { if constexpr (FP8) { _Pragma("unroll") for (int n = 0; n < 2; ++n) dst##8[n] = PG8_LD8(lds + PG8_SB(b, h) + boff + n * 2048); } \
        else { _Pragma("unroll") for (int n = 0; n < 2; ++n) _Pragma("unroll") for (int k = 0; k < 2; ++k) dst[n][k] = *(const LAS bf16x8*)(lds + PG8_SB(b, h) + boff + n * 2048 + k * 1024); } } while (0)
#define PG8_MMA(ai, bj, At, Bt) do { __builtin_amdgcn_s_setprio(1); _Pragma("unroll") for (int m = 0; m < 4; ++m) _Pragma("unroll") for (int n = 0; n < 2; ++n) { \
        if constexpr (FP8) { asm("v_mfma_scale_f32_16x16x128_f8f6f4 %0, %1, %2, %0, %3, %3 op_sel_hi:[0,0,0]" : "+v"(acc[ai][bj][m][n]) : "v"(Bt##8[n]), "v"(At##8[m]), "v"(sc8)); } \
        else { _Pragma("unroll") for (int k = 0; k < 2; ++k) acc[ai][bj][m][n] = __builtin_amdgcn_mfma_f32_16x16x32_bf16(Bt[n][k], At[m][k], acc[ai][bj][m][n], 0, 0, 0); } } \
        __builtin_amdgcn_s_setprio(0); } while (0)
#define PG8_WAIT_V(n) asm volatile("s_waitcnt vmcnt(" #n ")" ::: "memory")
#define PG8_WAIT_L(n) asm volatile("s_waitcnt lgkmcnt(" #n ")" ::: "memory")
#define PG8_BAR __builtin_amdgcn_s_barrier()
#define PG8_SCHED __builtin_amdgcn_sched_barrier(0)
#define PG8_AOFFS(U, V0, V1) do { _Pragma("unroll") for (int _i = 0; _i < 2; ++_i) { int R_, C_; stage_rc(tid * 16 + _i * 8192, R_, C_); \
        const int r0 = g.rowmap[(U).pm * BM + R_], r1 = g.rowmap[(U).pm * BM + HALF + R_]; \
        V0[_i] = (unsigned)(r0 * g.lda * ESZ + C_ * 2); V1[_i] = (unsigned)(r1 * g.lda * ESZ + C_ * 2); } } while (0)
    Unit cur, nxt; int ui = 0;
    if (!S.next(0, cur)) return;
    f32x4 acc[2][2][4][2];
#pragma unroll
    for (int a = 0; a < 2; ++a)
#pragma unroll
        for (int b = 0; b < 2; ++b)
#pragma unroll
            for (int m = 0; m < 4; ++m)
#pragma unroll
                for (int n = 0; n < 2; ++n) acc[a][b][m][n] = (f32x4){0.f, 0.f, 0.f, 0.f};
    const unsigned sc8 = 0x7f7f7f7fu; (void)sc8;
    bf16x8 At[4][2], B0[2][2], B1[2][2]; u32x8 At8[4], B08[2], B18[2]; (void)At; (void)B0; (void)B1; (void)At8; (void)B08; (void)B18;
    unsigned vc0[2] = {0u, 0u}, vc1[2] = {0u, 0u}, vn0[2] = {0u, 0u}, vn1[2] = {0u, 0u};
    if constexpr (GATHER) PG8_AOFFS(cur, vc0, vc1);
    const char* gA = (const char*)g.A;
    const char* cA = gA + (size_t)cur.pm * tstepA + (size_t)cur.kq * kqA;
    const char* cB = (const char*)g.Bt + (size_t)cur.e * g.estrideB * ESZ + (size_t)cur.pn * tstepB + (size_t)cur.kq * kqB;
    PG8_STAGE(PG8_SB(0, 0), cB, voffB); PG8_STAGE(PG8_SB(0, 1), cB + hstepB, voffB); PG8_STAGE_A(PG8_SA(0, 0), cA, 0, 0, vc0, vc1); PG8_STAGE_A(PG8_SA(0, 1), cA, 1, 0, vc0, vc1);
    if (wr == 1) PG8_BAR;
    PG8_WAIT_V(2); PG8_BAR;
    PG8_STAGE(PG8_SB(1, 0), cB + kstepB, voffB); PG8_STAGE_A(PG8_SA(1, 0), cA, 0, kstep, vc0, vc1); PG8_STAGE(PG8_SB(1, 1), cB + hstepB + kstepB, voffB);
    PG8_WAIT_V(6); PG8_BAR;
    for (;;) {
        const bool has_next = S.next(ui + 1, nxt);
        const char* nA = cA; const char* nB = cB;
        if (has_next) { nA = gA + (size_t)nxt.pm * tstepA + (size_t)nxt.kq * kqA; nB = (const char*)g.Bt + (size_t)nxt.e * g.estrideB * ESZ + (size_t)nxt.pn * tstepB + (size_t)nxt.kq * kqB; }
        if constexpr (GATHER) { if (has_next) PG8_AOFFS(nxt, vn0, vn1); else {
#pragma unroll
            for (int _i = 0; _i < 2; ++_i) { vn0[_i] = vc0[_i]; vn1[_i] = vc1[_i]; } } }
        for (int t = 0; t < nt; t += 2) {
            const bool last = (t == nt - 2);
            const size_t k1 = (size_t)(t + 1) * kstep, k2 = last ? 0 : (size_t)(t + 2) * kstep, k3 = k2 + kstep;
            const char* u2 = last ? nA : cA; const char* b2 = (last ? nB : cB) + (last ? 0 : (size_t)(t + 2) * kstepB); const char* b3 = b2 + kstepB;
            unsigned va0[2] = {0u, 0u}, va1[2] = {0u, 0u};
            if constexpr (GATHER) {
#pragma unroll
                for (int _i = 0; _i < 2; ++_i) { va0[_i] = last ? vn0[_i] : vc0[_i]; va1[_i] = last ? vn1[_i] : vc1[_i]; } }
            PG8_LDB(B0, 0, 0); PG8_LDB(B1, 0, 1); PG8_SCHED; PG8_LDA(At, 0, 0); PG8_STAGE_A(PG8_SA(1, 1), cA, 1, k1, vc0, vc1);
            PG8_WAIT_V(8); PG8_WAIT_L(0); PG8_BAR; PG8_MMA(0, 0, At, B0); PG8_MMA(0, 1, At, B1); PG8_BAR; PG8_SCHED;
            PG8_LDA(At, 0, 1); PG8_STAGE(PG8_SB(0, 0), b2, voffB); PG8_STAGE(PG8_SB(0, 1), b2 + hstepB, voffB); PG8_STAGE_A(PG8_SA(0, 0), u2, 0, k2, va0, va1);
            PG8_WAIT_V(8); PG8_WAIT_L(0); PG8_BAR; PG8_MMA(1, 0, At, B0); PG8_MMA(1, 1, At, B1); PG8_BAR; PG8_SCHED;
            PG8_LDB(B0, 1, 0); PG8_LDB(B1, 1, 1); PG8_SCHED; PG8_LDA(At, 1, 0); PG8_STAGE_A(PG8_SA(0, 1), u2, 1, k2, va0, va1);
            PG8_WAIT_V(8); PG8_WAIT_L(0); PG8_BAR; PG8_MMA(0, 0, At, B0); PG8_MMA(0, 1, At, B1); PG8_BAR; PG8_SCHED;
            PG8_LDA(At, 1, 1); PG8_STAGE(PG8_SB(1, 0), b3, voffB); PG8_STAGE(PG8_SB(1, 1), b3 + hstepB, voffB); PG8_STAGE_A(PG8_SA(1, 0), u2, 0, k3, va0, va1);
            PG8_WAIT_V(8); PG8_WAIT_L(0); PG8_BAR; PG8_MMA(1, 0, At, B0); PG8_MMA(1, 1, At, B1); PG8_BAR; PG8_SCHED;
        }
        if constexpr (FP8) asm volatile("s_nop 15\n\ts_nop 15" ::: "memory");
        if (wr == 0) PG8_BAR;
        { int fr_ = fr, fq_ = fq; asm volatile("" : "+v"(fr_), "+v"(fq_)); E(acc, cur, wr, wc, fr_, fq_); }
        if (!has_next) break;
#pragma unroll
        for (int a = 0; a < 2; ++a)
#pragma unroll
            for (int b = 0; b < 2; ++b)
#pragma unroll
                for (int m = 0; m < 4; ++m)
#pragma unroll
                    for (int n = 0; n < 2; ++n) acc[a][b][m][n] = (f32x4){0.f, 0.f, 0.f, 0.f};
        cur = nxt; cA = nA; cB = nB; ++ui;
        if constexpr (GATHER) {
#pragma unroll
            for (int _i = 0; _i < 2; ++_i) { vc0[_i] = vn0[_i]; vc1[_i] = vn1[_i]; } }
        if (wr == 1) PG8_BAR;
    }
    PG8_WAIT_V(0);
    PG8_BAR;
#undef PG8_SA
#undef PG8_SB
#undef PG8_STAGE
#undef PG8_STAGE_A
#undef PG8_LDA
#undef PG8_LD8
#undef PG8_LDB
#undef PG8_MMA
#undef PG8_WAIT_V
#undef PG8_WAIT_L
#undef PG8_BAR
#undef PG8_SCHED
#undef PG8_AOFFS
}
}

namespace att {
constexpr int NW = 8, QBLK = 32, KVBLK = 64, DQ = QKD, DV = VHD;
constexpr float SCALE = 0.07216878364870322f;
constexpr float THR = 8.f;
constexpr int LDQ = 1536, LDK = 1536, LDV = 2048, LDO = 2048;
constexpr int SHM_V = KVBLK * DV * 2, SHM_K = KVBLK * DQ * 2, SHM_ATTN = 2 * SHM_V + 2 * SHM_K + NW * 64 * 4;
#define KSWZ(row, colB) ((row) * 384 + ((colB) ^ ((((row) >> 1) & 7) << 4)))
#define SBAR() __builtin_amdgcn_sched_barrier(0)
__device__ __forceinline__ int crow(int r, int hi) { return (r & 3) + 8 * (r >> 2) + 4 * hi; }
__device__ __forceinline__ void partialSM(f32x16& p0, f32x16& p1, float& m_reg, float& mn, float& alpha) {
  constexpr float C = SCALE * 1.4426950408889634f;
  float pmax = p0[0];
#pragma unroll
  for (int r = 1; r < 16; ++r) pmax = fmaxf(pmax, p0[r]);
#pragma unroll
  for (int r = 0; r < 16; ++r) pmax = fmaxf(pmax, p1[r]);
  { auto rr = __builtin_amdgcn_permlane32_swap(__float_as_uint(pmax), __float_as_uint(pmax), false, false);
    pmax = fmaxf(__uint_as_float(rr[0]), __uint_as_float(rr[1])); }
  if (__builtin_expect(__all(pmax - m_reg <= THR / SCALE), 1)) { mn = m_reg; alpha = 1.f; }
  else { mn = fmaxf(m_reg, pmax); alpha = __builtin_amdgcn_exp2f((m_reg - mn) * C); m_reg = mn; }
  float mnC = -mn * C;
#pragma unroll
  for (int r = 0; r < 16; ++r) p0[r] = fmaf(p0[r], C, mnC);
#pragma unroll
  for (int r = 0; r < 16; ++r) p1[r] = fmaf(p1[r], C, mnC);
#pragma unroll
  for (int r = 0; r < 16; ++r) p0[r] = __builtin_amdgcn_exp2f(p0[r]);
}
__device__ __forceinline__ void finishSM(f32x16& p0, f32x16& p1, float alpha, float& l_reg, bf16x8& pa0, bf16x8& pa1, bf16x8& pa2, bf16x8& pa3) {
#pragma unroll
  for (int r = 0; r < 16; ++r) p1[r] = __builtin_amdgcn_exp2f(p1[r]);
  float ps = 0;
#pragma unroll
  for (int r = 0; r < 16; ++r) ps += p0[r];
#pragma unroll
  for (int r = 0; r < 16; ++r) ps += p1[r];
  { auto rr = __builtin_amdgcn_permlane32_swap(__float_as_uint(ps), __float_as_uint(ps), false, false);
    ps = __uint_as_float(rr[0]) + __uint_as_float(rr[1]); }
  l_reg = l_reg * alpha + ps;
#define PK4(P, BASE, OUT) do { unsigned a0 = cvt_pk_bf16(P[BASE + 0], P[BASE + 1]), a1 = cvt_pk_bf16(P[BASE + 2], P[BASE + 3]);   \
    unsigned b0 = cvt_pk_bf16(P[BASE + 4], P[BASE + 5]), b1 = cvt_pk_bf16(P[BASE + 6], P[BASE + 7]);                              \
    auto r0 = __builtin_amdgcn_permlane32_swap(a0, b0, false, false); auto r1 = __builtin_amdgcn_permlane32_swap(a1, b1, false, false); \
    u32x4 w = {r0[0], r1[0], r0[1], r1[1]}; OUT = *reinterpret_cast<bf16x8*>(&w); } while (0)
  PK4(p0, 0, pa0); PK4(p0, 8, pa1); PK4(p1, 0, pa2); PK4(p1, 8, pa3);
#undef PK4
}
__device__ __forceinline__ void qkt(f32x16& p0, f32x16& p1, const char* Ks, const bf16x8* qr, int r32, int hi) {
  p0 = f32x16{}; p1 = f32x16{};
#pragma unroll
  for (int d0 = 0; d0 < DQ / 16; ++d0) { int cb = (d0 * 16 + hi * 8) * 2;
    bf16x8 b0 = *reinterpret_cast<const bf16x8*>(Ks + KSWZ(r32, cb));
    bf16x8 b1 = *reinterpret_cast<const bf16x8*>(Ks + KSWZ(32 + r32, cb));
    p0 = __builtin_amdgcn_mfma_f32_32x32x16_bf16(b0, qr[d0], p0, 0, 0, 0);
    p1 = __builtin_amdgcn_mfma_f32_32x32x16_bf16(b1, qr[d0], p1, 0, 0, 0);
    if ((d0 & 3) == 3) SBAR(); }
}
__device__ __forceinline__ int v_st(int k, int c) { const int kk = (k & ~0xC) | ((k & 4) << 1) | ((k & 8) >> 1); return ((kk >> 3) * 4 + (c >> 5)) * 512 + ((kk & 7) * 32 + (c & 31)) * 2; }
__device__ __forceinline__ int v_rd_base(int lane) { return ((lane & 3) << 3) | (((lane >> 2) & 3) << 6) | (((lane >> 4) & 1) << 5) | (((lane >> 5) & 1) << 8); }
constexpr int v_rd_off(int d0, int ks, int half) { return d0 * 512 + ks * 4096 + half * 2048; }
template <int OFF> __device__ __forceinline__ s16x4 tr_read(int vb) {
  s16x4 r; asm volatile("ds_read_b64_tr_b16 %0, %1 offset:%2" : "=&v"(r) : "v"(vb), "i"(OFF) : "memory"); return r;
}
template <int D0> __device__ __forceinline__ void pv_one(f32x16& od, int vb, bf16x8 pa0, bf16x8 pa1, bf16x8 pa2, bf16x8 pa3) {
  const s16x4 l0 = tr_read<v_rd_off(D0, 0, 0)>(vb), h0 = tr_read<v_rd_off(D0, 0, 1)>(vb), l1 = tr_read<v_rd_off(D0, 1, 0)>(vb), h1 = tr_read<v_rd_off(D0, 1, 1)>(vb);
  const s16x4 l2 = tr_read<v_rd_off(D0, 2, 0)>(vb), h2 = tr_read<v_rd_off(D0, 2, 1)>(vb), l3 = tr_read<v_rd_off(D0, 3, 0)>(vb), h3 = tr_read<v_rd_off(D0, 3, 1)>(vb);
  asm volatile("s_waitcnt lgkmcnt(0)" ::: "memory"); SBAR();
#define PK(L, H) (bf16x8){L[0], L[1], L[2], L[3], H[0], H[1], H[2], H[3]}
  od = __builtin_amdgcn_mfma_f32_32x32x16_bf16(pa0, PK(l0, h0), od, 0, 0, 0);
  od = __builtin_amdgcn_mfma_f32_32x32x16_bf16(pa1, PK(l1, h1), od, 0, 0, 0);
  od = __builtin_amdgcn_mfma_f32_32x32x16_bf16(pa2, PK(l2, h2), od, 0, 0, 0);
  od = __builtin_amdgcn_mfma_f32_32x32x16_bf16(pa3, PK(l3, h3), od, 0, 0, 0);
#undef PK
}
#define PV_RD(D0, L, H) do { L[0] = tr_read<v_rd_off(D0, 0, 0)>(vb); H[0] = tr_read<v_rd_off(D0, 0, 1)>(vb); L[1] = tr_read<v_rd_off(D0, 1, 0)>(vb); H[1] = tr_read<v_rd_off(D0, 1, 1)>(vb); \
    L[2] = tr_read<v_rd_off(D0, 2, 0)>(vb); H[2] = tr_read<v_rd_off(D0, 2, 1)>(vb); L[3] = tr_read<v_rd_off(D0, 3, 0)>(vb); H[3] = tr_read<v_rd_off(D0, 3, 1)>(vb); } while (0)
#define PV_MM(OD, L, H) do { OD = __builtin_amdgcn_mfma_f32_32x32x16_bf16(pa0, PKX(L[0], H[0]), OD, 0, 0, 0); OD = __builtin_amdgcn_mfma_f32_32x32x16_bf16(pa1, PKX(L[1], H[1]), OD, 0, 0, 0); \
    OD = __builtin_amdgcn_mfma_f32_32x32x16_bf16(pa2, PKX(L[2], H[2]), OD, 0, 0, 0); OD = __builtin_amdgcn_mfma_f32_32x32x16_bf16(pa3, PKX(L[3], H[3]), OD, 0, 0, 0); } while (0)
#define PKX(L, H) (bf16x8){L[0], L[1], L[2], L[3], H[0], H[1], H[2], H[3]}
__device__ __forceinline__ void pv_d0_pipe(f32x16* o, int vb, bf16x8 pa0, bf16x8 pa1, bf16x8 pa2, bf16x8 pa3) {
  s16x4 la[4], ha[4], lb[4], hb[4];
  PV_RD(0, la, ha);
#define PV_PIN(OD) asm volatile("" : "+v"(OD))
  PV_RD(1, lb, hb); asm volatile("s_waitcnt lgkmcnt(8)" ::: "memory"); SBAR(); PV_MM(o[0], la, ha); PV_PIN(o[0]);
  PV_RD(2, la, ha); asm volatile("s_waitcnt lgkmcnt(8)" ::: "memory"); SBAR(); PV_MM(o[1], lb, hb); PV_PIN(o[1]);
  PV_RD(3, lb, hb); asm volatile("s_waitcnt lgkmcnt(8)" ::: "memory"); SBAR(); PV_MM(o[2], la, ha); PV_PIN(o[2]);
  asm volatile("s_waitcnt lgkmcnt(0)" ::: "memory"); SBAR(); PV_MM(o[3], lb, hb); PV_PIN(o[3]);
#undef PV_PIN
}
__device__ __forceinline__ void pv_fsm(f32x16* o, int vb, bf16x8 pa0, bf16x8 pa1, bf16x8 pa2, bf16x8 pa3, f32x16& p0, f32x16& p1, int negMCbits, s16x4* la, s16x4* ha) {
  constexpr float C = SCALE * 1.4426950408889634f;
  int nb_ = __builtin_amdgcn_readfirstlane(negMCbits); asm volatile("" : "+s"(nb_)); const float negMC = __builtin_bit_cast(float, nb_);
  s16x4 lb[4], hb[4];
#define FSQ(q) do { _Pragma("unroll") for (int r_ = (q); r_ < 16; r_ += 4) { float x_ = p1[r_]; asm("" : "+v"(x_)); p0[r_] = fmaf(p0[r_], C, negMC); p1[r_] = fmaf(x_, C, negMC); p0[r_] = __builtin_amdgcn_exp2f(p0[r_]); } } while (0)
#define PV_PIN(OD, q) asm volatile("" :: "v"(OD), "v"(p0[q]), "v"(p0[q + 4]), "v"(p0[q + 8]), "v"(p0[q + 12]), "v"(p1[q]), "v"(p1[q + 4]), "v"(p1[q + 8]), "v"(p1[q + 12]))
  PV_RD(1, lb, hb); asm volatile("s_waitcnt lgkmcnt(8)" : "+v"(la[0]), "+v"(ha[0]), "+v"(la[1]), "+v"(ha[1]), "+v"(la[2]), "+v"(ha[2]), "+v"(la[3]), "+v"(ha[3]) :: "memory"); SBAR(); PV_MM(o[0], la, ha); FSQ(0); PV_PIN(o[0], 0);
  PV_RD(2, la, ha); asm volatile("s_waitcnt lgkmcnt(8)" ::: "memory"); SBAR(); PV_MM(o[1], lb, hb); FSQ(1); PV_PIN(o[1], 1);
  PV_RD(3, lb, hb); asm volatile("s_waitcnt lgkmcnt(8)" ::: "memory"); SBAR(); PV_MM(o[2], la, ha); FSQ(2); PV_PIN(o[2], 2);
  asm volatile("s_waitcnt lgkmcnt(0)" ::: "memory"); SBAR(); PV_MM(o[3], lb, hb); FSQ(3); PV_PIN(o[3], 3);
#undef FSQ
#undef PV_PIN
}
#undef PV_RD
#undef PV_MM
#undef PKX
__device__ __forceinline__ void pv_d0(f32x16* o, int vb, bf16x8 pa0, bf16x8 pa1, bf16x8 pa2, bf16x8 pa3) {
  pv_one<0>(o[0], vb, pa0, pa1, pa2, pa3); pv_one<1>(o[1], vb, pa0, pa1, pa2, pa3); pv_one<2>(o[2], vb, pa0, pa1, pa2, pa3); pv_one<3>(o[3], vb, pa0, pa1, pa2, pa3);
}


constexpr int K_OFF = 0, V_OFF = 3 * SHM_K, WS_OFF = V_OFF + 3 * SHM_V, SHM_ATTN2 = WS_OFF + NW * 64 * 4;
constexpr int KOFS_OFF = SHM_ATTN2;
__device__ __forceinline__ void qkt_l(f32x16& p0, f32x16& p1, LAS const char* Ks, const bf16x8* qr, int r32, int hi) {
  p0 = f32x16{}; p1 = f32x16{};
  __builtin_amdgcn_s_setprio(1);
  const int swz = ((r32 >> 1) & 7) << 4, rowb = r32 * 384;
  LAS const char* ar[4];
#pragma unroll
  for (int r = 0; r < 4; ++r) ar[r] = Ks + rowb + ((32 * r + 16 * hi) ^ swz);
#pragma unroll
  for (int q = 0; q < DQ / 64; ++q)
#pragma unroll
    for (int r = 0; r < 4; ++r) { const int d0 = 4 * q + r;
      bf16x8 b0 = *reinterpret_cast<LAS const bf16x8*>(ar[r] + 128 * q);
      bf16x8 b1 = *reinterpret_cast<LAS const bf16x8*>(ar[r] + 128 * q + 32 * 384);
      p0 = __builtin_amdgcn_mfma_f32_32x32x16_bf16(b0, qr[d0], p0, 0, 0, 0);
      p1 = __builtin_amdgcn_mfma_f32_32x32x16_bf16(b1, qr[d0], p1, 0, 0, 0);
      if (r == 3 && d0 != DQ / 16 - 1) SBAR(); }
  __builtin_amdgcn_s_setprio(0);
}
__device__ __forceinline__ void qkt_l2(f32x16& p0, f32x16& p1, LAS const char* Ks, const bf16x8* qr, int r32, int hi) {
  p0 = f32x16{}; p1 = f32x16{};
  const int swz = ((r32 >> 1) & 7) << 4, rowb = r32 * 384;
  LAS const char* ar[4];
#pragma unroll
  for (int r = 0; r < 4; ++r) ar[r] = Ks + rowb + ((32 * r + 16 * hi) ^ swz);
#pragma unroll
  for (int q = 0; q < DQ / 64; ++q)
#pragma unroll
    for (int r = 0; r < 4; ++r) { const int d0 = 4 * q + r;
      bf16x8 b0 = *reinterpret_cast<LAS const bf16x8*>(ar[r] + 128 * q);
      bf16x8 b1 = *reinterpret_cast<LAS const bf16x8*>(ar[r] + 128 * q + 32 * 384);
      p0 = __builtin_amdgcn_mfma_f32_32x32x16_bf16(b0, qr[d0], p0, 0, 0, 0);
      p1 = __builtin_amdgcn_mfma_f32_32x32x16_bf16(b1, qr[d0], p1, 0, 0, 0);
    }
}
__device__ __forceinline__ float psm_max(const f32x16& p) { float m = p[0];
#pragma unroll
  for (int r = 1; r < 16; ++r) m = fmaxf(m, p[r]);
  return m; }
__device__ __forceinline__ void psm_decide(float pmax, float& m_reg, float& mnC, float& alpha) {
  constexpr float C = SCALE * 1.4426950408889634f;
  { auto rr = __builtin_amdgcn_permlane32_swap(__float_as_uint(pmax), __float_as_uint(pmax), false, false);
    pmax = fmaxf(__uint_as_float(rr[0]), __uint_as_float(rr[1])); }
  float mn;
  if (__builtin_expect(__all(pmax - m_reg <= THR / SCALE), 1)) { mn = m_reg; alpha = 1.f; }
  else { mn = fmaxf(m_reg, pmax); alpha = __builtin_amdgcn_exp2f((m_reg - mn) * C); m_reg = mn; }
  mnC = -mn * C;
}
__device__ __forceinline__ void psm_scale(f32x16& p, float mnC) { constexpr float C = SCALE * 1.4426950408889634f;
#pragma unroll
  for (int r = 0; r < 16; ++r) p[r] = fmaf(p[r], C, mnC); }
__device__ __forceinline__ void psm_exp(f32x16& p) {
#pragma unroll
  for (int r = 0; r < 16; ++r) p[r] = __builtin_amdgcn_exp2f(p[r]); }

__device__ __forceinline__ void fsm_first(f32x16& p0, f32x16& p1, int negMCbits) {
  constexpr float C = SCALE * 1.4426950408889634f;
  int nb_ = __builtin_amdgcn_readfirstlane(negMCbits); asm volatile("" : "+s"(nb_)); const float negMC = __builtin_bit_cast(float, nb_);
#pragma unroll
  for (int r = 0; r < 16; ++r) p0[r] = fmaf(p0[r], C, negMC);
#pragma unroll
  for (int r = 0; r < 16; ++r) p1[r] = fmaf(p1[r], C, negMC);
#pragma unroll
  for (int r = 0; r < 16; ++r) p0[r] = __builtin_amdgcn_exp2f(p0[r]);
}
__device__ __forceinline__ void fsm_finish(f32x16& p0, f32x16& p1, float& l_reg, bf16x8& pa0, bf16x8& pa1, bf16x8& pa2, bf16x8& pa3) {
#pragma unroll
  for (int r = 0; r < 16; ++r) p1[r] = __builtin_amdgcn_exp2f(p1[r]);
  float ps = 0;
#pragma unroll
  for (int r = 0; r < 16; ++r) ps += p0[r];
#pragma unroll
  for (int r = 0; r < 16; ++r) ps += p1[r];
  { auto rr = __builtin_amdgcn_permlane32_swap(__float_as_uint(ps), __float_as_uint(ps), false, false);
    ps = __uint_as_float(rr[0]) + __uint_as_float(rr[1]); }
  l_reg += ps;
#define PK4(P, BASE, OUT) do { unsigned a0 = cvt_pk_bf16(P[BASE + 0], P[BASE + 1]), a1 = cvt_pk_bf16(P[BASE + 2], P[BASE + 3]);   \
    unsigned b0 = cvt_pk_bf16(P[BASE + 4], P[BASE + 5]), b1 = cvt_pk_bf16(P[BASE + 6], P[BASE + 7]);                              \
    auto r0 = __builtin_amdgcn_permlane32_swap(a0, b0, false, false); auto r1 = __builtin_amdgcn_permlane32_swap(a1, b1, false, false); \
    u32x4 w = {r0[0], r1[0], r0[1], r1[1]}; OUT = *reinterpret_cast<bf16x8*>(&w); } while (0)
  PK4(p0, 0, pa0); PK4(p0, 8, pa1); PK4(p1, 0, pa2); PK4(p1, 8, pa3);
#undef PK4
}
struct DmaT { const char* gK; const char* gV; LAS unsigned char* lK; LAS unsigned char* lV; int kofs; unsigned v0, v1; };
__device__ __forceinline__ void qk_fsm(f32x16& p0, f32x16& p1, int ksb, const bf16x8* qr, int r32, int hi, f32x16& f0, f32x16& f1, float& l_reg, bf16x8& pa0, bf16x8& pa1, bf16x8& pa2, bf16x8& pa3, const DmaT d, s16x4* la, s16x4* ha, int vb) {
  const int swz = ((r32 >> 1) & 7) << 4, rowb = r32 * 384;
  int ar[4];
#pragma unroll
  for (int r = 0; r < 4; ++r) ar[r] = ksb + rowb + ((32 * r + 16 * hi) ^ swz);
  bf16x8 ka[4], kb[4];
#define KRD(dst, d0, h) asm volatile("ds_read_b128 %0, %1 offset:%2" : "=v"(dst) : "v"(ar[(d0) & 3]), "i"(128 * ((d0) >> 2) + 12288 * (h)))
#define KRD4(B, s) do { KRD(B[0], 2 * (s), 0); KRD(B[1], 2 * (s), 1); KRD(B[2], 2 * (s) + 1, 0); KRD(B[3], 2 * (s) + 1, 1); } while (0)
#define KWAIT(N, B) asm volatile("s_waitcnt lgkmcnt(" #N ")" : "+v"(B[0]), "+v"(B[1]), "+v"(B[2]), "+v"(B[3]))
#define KMM(B, s) do { p0 = __builtin_amdgcn_mfma_f32_32x32x16_bf16(B[0], qr[2 * (s)], p0, 0, 0, 0); p1 = __builtin_amdgcn_mfma_f32_32x32x16_bf16(B[1], qr[2 * (s)], p1, 0, 0, 0); \
    p0 = __builtin_amdgcn_mfma_f32_32x32x16_bf16(B[2], qr[2 * (s) + 1], p0, 0, 0, 0); p1 = __builtin_amdgcn_mfma_f32_32x32x16_bf16(B[3], qr[2 * (s) + 1], p1, 0, 0, 0); } while (0)
#define PK4(P, BASE, OUT) do { unsigned a0 = cvt_pk_bf16(P[BASE + 0], P[BASE + 1]), a1 = cvt_pk_bf16(P[BASE + 2], P[BASE + 3]);   \
    unsigned b0 = cvt_pk_bf16(P[BASE + 4], P[BASE + 5]), b1 = cvt_pk_bf16(P[BASE + 6], P[BASE + 7]);                              \
    auto r0 = __builtin_amdgcn_permlane32_swap(a0, b0, false, false); auto r1 = __builtin_amdgcn_permlane32_swap(a1, b1, false, false); \
    u32x4 w = {r0[0], r1[0], r0[1], r1[1]}; OUT = *reinterpret_cast<bf16x8*>(&w); } while (0)
  p0 = f32x16{}; p1 = f32x16{};
  u32x4 ko; asm volatile("ds_read_b128 %0, %1" : "=v"(ko) : "v"(d.kofs));
#define DMA_PK(i_) __builtin_amdgcn_global_load_lds((const unsigned*)(d.gK + ko[i_]), (LAS unsigned*)(d.lK + 8192 * (i_)), 16, 0, 0)
#define DMA_PV(i_, vo_) __builtin_amdgcn_global_load_lds((const unsigned*)(d.gV + (vo_)), (LAS unsigned*)(d.lV + 8192 * (i_)), 16, 0, 0)
  KRD4(ka, 0); KRD4(kb, 1);
#pragma unroll
  for (int r = 0; r < 16; ++r) f1[r] = __builtin_amdgcn_exp2f(f1[r]);
  asm volatile("" :: "v"(f1[0]), "v"(f1[1]), "v"(f1[2]), "v"(f1[3]), "v"(f1[4]), "v"(f1[5]), "v"(f1[6]), "v"(f1[7]), "v"(f1[8]), "v"(f1[9]), "v"(f1[10]), "v"(f1[11]), "v"(f1[12]), "v"(f1[13]), "v"(f1[14]), "v"(f1[15]));
  KWAIT(4, ka); asm volatile("" : "+v"(ko)); KMM(ka, 0);
  DMA_PK(0);
  asm volatile("" :: "v"(p0), "v"(p1));
  KRD4(ka, 2); KWAIT(4, kb); KMM(kb, 1);
  DMA_PK(1);
  float ps = 0;
#pragma unroll
  for (int r = 0; r < 8; ++r) ps += f0[r];
  asm volatile("" :: "v"(p0), "v"(p1), "v"(ps));
  KRD4(kb, 3); KWAIT(4, ka); KMM(ka, 2);
  DMA_PK(2);
#pragma unroll
  for (int r = 8; r < 16; ++r) ps += f0[r];
  asm volatile("" :: "v"(p0), "v"(p1), "v"(ps));
  KRD4(ka, 4); KWAIT(4, kb); KMM(kb, 3);
  DMA_PV(0, d.v0);
#pragma unroll
  for (int r = 0; r < 16; ++r) ps += f1[r];
  { auto rr = __builtin_amdgcn_permlane32_swap(__float_as_uint(ps), __float_as_uint(ps), false, false);
    ps = __uint_as_float(rr[0]) + __uint_as_float(rr[1]); }
  l_reg += ps;
  asm volatile("" :: "v"(p0), "v"(p1), "v"(l_reg));
  KRD4(kb, 5); KWAIT(4, ka); KMM(ka, 4);
  DMA_PV(1, d.v1);
  PK4(f0, 0, pa0); PK4(f0, 8, pa1);
  asm volatile("" :: "v"(p0), "v"(p1), "v"(pa0), "v"(pa1));
  KWAIT(0, kb);
  la[0] = tr_read<v_rd_off(0, 0, 0)>(vb); ha[0] = tr_read<v_rd_off(0, 0, 1)>(vb); la[1] = tr_read<v_rd_off(0, 1, 0)>(vb); ha[1] = tr_read<v_rd_off(0, 1, 1)>(vb);
  la[2] = tr_read<v_rd_off(0, 2, 0)>(vb); ha[2] = tr_read<v_rd_off(0, 2, 1)>(vb); la[3] = tr_read<v_rd_off(0, 3, 0)>(vb); ha[3] = tr_read<v_rd_off(0, 3, 1)>(vb);
  KMM(kb, 5);
  PK4(f1, 0, pa2); PK4(f1, 8, pa3);
  asm volatile("" :: "v"(p0), "v"(p1), "v"(pa2), "v"(pa3));
#undef KRD
#undef KRD4
#undef KWAIT
#undef KMM
#undef PK4
#undef DMA_PK
#undef DMA_PV
}
__device__ __forceinline__ void attn_unit2(const bf16_t* __restrict__ Qb, const bf16_t* __restrict__ Kh, const bf16_t* __restrict__ Vh, bf16_t* __restrict__ Ob, int seq, LAS unsigned char* lds, const int tid, const int negMC) {
  const int wid = __builtin_amdgcn_readfirstlane(tid >> 6), lane = tid & 63, r32 = lane & 31, hi = lane >> 5;
  LAS float* ws = (LAS float*)(lds + WS_OFF) + wid * 64; LAS float* li_l = ws; LAS float* al_l = ws + 32;
  float l_reg = 0; f32x16 o[4] = {}; bf16x8 qr[DQ / 16];
  const bf16_t* Qw = Qb + (long)(wid * QBLK + r32) * LDQ + hi * 8;
#pragma unroll
  for (int d0 = 0; d0 < DQ / 16; ++d0) qr[d0] = *reinterpret_cast<const bf16x8*>(Qw + d0 * 16);
#define KOFF(i_, ln_) ({ const int b_ = 1024 * (wid + 8 * (i_)) + 16 * (ln_), row_ = b_ / 384, x_ = b_ % 384; (unsigned)(row_ * LDK * 2 + (x_ ^ (((row_ >> 1) & 7) << 4))); })
  unsigned voff[2];
#pragma unroll
  for (int i = 0; i < 2; ++i) { const int b = 1024 * (wid + 8 * i) + 16 * lane, st = b >> 9, off = b & 511, kk = (st >> 2) * 8 + (off >> 6), c = (st & 3) * 32 + ((off & 63) >> 1);
    const int k = (kk & ~0xC) | ((kk & 4) << 1) | ((kk & 8) >> 1); voff[i] = (unsigned)(k * LDV * 2 + c * 2); }
  const int NT = seq / KVBLK;
  const int kofs = (int)(uintptr_t)(lds + KOFS_OFF) + tid * 16;
  { u32x4 kv_ = {KOFF(0, lane), KOFF(1, lane), KOFF(2, lane), 0u}; asm volatile("ds_write_b128 %0, %1" :: "v"(kofs), "v"(kv_) : "memory"); }
#define DMAT(tk, ks, tv, vs) att::DmaT{(const char*)Kh + (size_t)((tk) < NT ? (tk) : NT - 1) * (KVBLK * LDK * 2), (const char*)Vh + (size_t)((tv) < NT ? (tv) : NT - 1) * (KVBLK * LDV * 2), \
    lds + K_OFF + (ks) * SHM_K + wid * 1024, lds + V_OFF + (vs) * SHM_V + wid * 1024, kofs, voff[0], voff[1]}
#define DMA_K(t, slot) do { const int t_ = (t) < NT ? (t) : NT - 1; const char* g_ = (const char*)Kh + (size_t)t_ * (KVBLK * LDK * 2); int ln_ = lane; asm volatile("" : "+v"(ln_)); _Pragma("unroll") for (int i_ = 0; i_ < 3; ++i_) \
    __builtin_amdgcn_global_load_lds((const unsigned*)(g_ + KOFF(i_, ln_)), (LAS unsigned*)(lds + K_OFF + (slot) * SHM_K + (wid + 8 * i_) * 1024), 16, 0, 0); } while (0)
#define DMA_V(t, slot) do { const int t_ = (t) < NT ? (t) : NT - 1; const char* g_ = (const char*)Vh + (size_t)t_ * (KVBLK * LDV * 2); _Pragma("unroll") for (int i_ = 0; i_ < 2; ++i_) \
    __builtin_amdgcn_global_load_lds((const unsigned*)(g_ + voff[i_]), (LAS unsigned*)(lds + V_OFF + (slot) * SHM_V + (wid + 8 * i_) * 1024), 16, 0, 0); } while (0)
#define QK_PACE() do { _Pragma("unroll") for (int g_ = 0; g_ < 12; ++g_) { __builtin_amdgcn_sched_group_barrier(0x100, 2, 0); __builtin_amdgcn_sched_group_barrier(0x008, 2, 0); __builtin_amdgcn_sched_group_barrier(0x002, 8, 0); } } while (0)
#define WAITBAR() do { asm volatile("s_waitcnt vmcnt(5) lgkmcnt(0)" ::: "memory"); __builtin_amdgcn_s_barrier(); asm volatile("" ::: "memory"); } while (0)
  const int vbase = (int)(uintptr_t)(lds + V_OFF) + v_rd_base(lane);
  f32x16 pA0, pA1, pB0, pB1; bf16x8 pa0, pa1, pa2, pa3;
  s16x4 la[4], ha[4];
  DMA_K(0, 0); DMA_K(1, 1); DMA_V(0, 0);
  WAITBAR();
  DMA_K(2, 2); DMA_V(1, 1);
  qkt_l(pA0, pA1, (LAS const char*)(lds + K_OFF), qr, r32, hi); fsm_first(pA0, pA1, negMC);
  WAITBAR();
  int a = 1;
  for (int t = 1; t + 1 < NT; t += 2) {
    { const int kd = (a + 2) % 3, vd = (a + 1) % 3;
      SBAR(); __builtin_amdgcn_s_setprio(1); qk_fsm(pB0, pB1, (int)(uintptr_t)(lds + K_OFF) + a * SHM_K, qr, r32, hi, pA0, pA1, l_reg, pa0, pa1, pa2, pa3, DMAT(t + 2, kd, t + 1, vd), la, ha, vbase + kd * SHM_V); __builtin_amdgcn_s_setprio(0); SBAR();
      pv_fsm(o, vbase + kd * SHM_V, pa0, pa1, pa2, pa3, pB0, pB1, negMC, la, ha);
      WAITBAR(); a = (a + 1) % 3; }
    { const int kd = (a + 2) % 3, vd = (a + 1) % 3;
      SBAR(); __builtin_amdgcn_s_setprio(1); qk_fsm(pA0, pA1, (int)(uintptr_t)(lds + K_OFF) + a * SHM_K, qr, r32, hi, pB0, pB1, l_reg, pa0, pa1, pa2, pa3, DMAT(t + 3, kd, t + 2, vd), la, ha, vbase + kd * SHM_V); __builtin_amdgcn_s_setprio(0); SBAR();
      pv_fsm(o, vbase + kd * SHM_V, pa0, pa1, pa2, pa3, pA0, pA1, negMC, la, ha);
      WAITBAR(); a = (a + 1) % 3; }
  }
  { const int kd = (a + 2) % 3, vd = (a + 1) % 3;
    SBAR(); __builtin_amdgcn_s_setprio(1); qk_fsm(pB0, pB1, (int)(uintptr_t)(lds + K_OFF) + a * SHM_K, qr, r32, hi, pA0, pA1, l_reg, pa0, pa1, pa2, pa3, DMAT(NT - 1, kd, NT - 1, vd), la, ha, vbase + kd * SHM_V); __builtin_amdgcn_s_setprio(0); SBAR();
    pv_fsm(o, vbase + kd * SHM_V, pa0, pa1, pa2, pa3, pB0, pB1, negMC, la, ha);
      WAITBAR(); a = (a + 1) % 3; }
  { const int kd = (a + 2) % 3;
    fsm_finish(pB0, pB1, l_reg, pa0, pa1, pa2, pa3); SBAR();
    pv_d0_pipe(o, vbase + kd * SHM_V, pa0, pa1, pa2, pa3); }
  int lne; asm volatile("v_mbcnt_lo_u32_b32 %0, -1, 0\n\tv_mbcnt_hi_u32_b32 %0, -1, %0" : "=v"(lne));
  const int r32e = lne & 31, hie = lne >> 5;
  if (hie == 0) li_l[r32e] = l_reg; asm volatile("s_waitcnt lgkmcnt(0)" ::: "memory");
  float rli[16];
#pragma unroll
  for (int r = 0; r < 16; ++r) rli[r] = __builtin_amdgcn_rcpf(li_l[crow(r, hie)]);
  bf16_t* Ow = Ob + (long)(wid * QBLK) * LDO;
#pragma unroll
  for (int r = 0; r < 16; ++r) { int orow = crow(r, hie);
#pragma unroll
    for (int d0 = 0; d0 < 4; ++d0) Ow[(long)orow * LDO + d0 * 32 + r32e] = f2bf(o[d0][r] * rli[r]); }
  asm volatile("s_waitcnt vmcnt(0) lgkmcnt(0)" ::: "memory"); __builtin_amdgcn_s_barrier(); asm volatile("" ::: "memory");
#undef DMA_K
#undef KOFF
#undef DMAT
#undef DMA_V
#undef WAITBAR
}
}

namespace sg {
using att::v_st; using att::v_rd_base; using att::pv_d0; using att::crow;
template <int KK> __device__ __forceinline__ void load_b(bf16x8* v, const bf16_t* Bsrc, size_t ldb, const int tid) {
    const int n = (tid & 15) * 8;
#pragma unroll
    for (int i = 0; i < KK / 32; ++i) { const int k = (tid >> 4) + 32 * i; v[i] = *(const bf16x8*)(Bsrc + (size_t)k * ldb + n); }
}
template <int KK> __device__ __forceinline__ void write_b(const bf16x8* v, char* lds, const int tid) {
    const int n = (tid & 15) * 8;
#pragma unroll
    for (int i = 0; i < KK / 32; ++i) { const int k = (tid >> 4) + 32 * i; *(bf16x8*)(lds + (k >> 6) * 16384 + v_st(k & 63, n)) = v[i]; }
}
template <int KK> __device__ __forceinline__ void stage_b(const bf16_t* Bsrc, size_t ldb, char* lds, const int tid) { bf16x8 v[KK / 32]; load_b<KK>(v, Bsrc, ldb, tid); write_b<KK>(v, lds, tid); }
constexpr int OST_PITCH = 272, OST_WAVE = 32 * OST_PITCH, OST_OFF = 65536;
template <class RowPtr>
__device__ __forceinline__ void store_tile(const f32x16* o, LAS unsigned char* ost, int lane, const RowPtr& rowptr) {
    const int r32 = lane & 31, hi = lane >> 5; const bool odd = lane & 1;
#pragma unroll
    for (int pr = 0; pr < 8; ++pr)
#pragma unroll
        for (int d0 = 0; d0 < 4; ++d0) { const float a = o[d0][2 * pr], b = o[d0][2 * pr + 1];
            const float x = odd ? a : b;
            const float y = __int_as_float(__builtin_amdgcn_mov_dpp(__float_as_int(x), 0xB1, 0xf, 0xf, true));
            const unsigned w = odd ? cvt_pk_bf16(y, b) : cvt_pk_bf16(a, y);
            const int row = crow(odd ? 2 * pr + 1 : 2 * pr, hi);
            *(LAS unsigned*)(ost + row * OST_PITCH + (32 * d0 + (r32 & ~1)) * 2) = w; }
    asm volatile("s_waitcnt lgkmcnt(0)" ::: "memory");
#pragma unroll
    for (int j = 0; j < 8; ++j) { const int i = (lane >> 4) + 4 * j; const u32x4 v = *(const LAS u32x4*)(ost + i * OST_PITCH + (lane & 15) * 16);
        *(u32x4*)(rowptr(i) + (lane & 15) * 8) = v; }
    asm volatile("s_waitcnt lgkmcnt(0)" ::: "memory");
}
struct RowF1 { bf16_t* a1; int wave, s2, cc; __device__ __forceinline__ bf16_t* operator()(int i) const { return a1 + ((size_t)(32 * wave + i) * 128 + s2) * 1024 + cc * 128; } };
struct RowF2 { bf16_t* yc; int wave, k1, g; __device__ __forceinline__ bf16_t* operator()(int i) const { const int m = 32 * wave + i; return yc + (size_t)(k1 + 128 * (m & 127)) * 2048 + g * 256 + (m >> 7) * 128; } };
struct RowF3 { bf16_t* hb; int wave, tt, g; __device__ __forceinline__ bf16_t* operator()(int i) const { return hb + (size_t)(256 * tt + 32 * wave + i) * 2048 + 1024 + g * 128; } };
template <int KK> __device__ __forceinline__ void mm(f32x16* o, const bf16x8* A, char* lds, int lane) {
    const int vb0 = (int)(uintptr_t)lds + v_rd_base(lane);
#pragma unroll
    for (int t = 0; t < KK / 64; ++t) pv_d0(o, vb0 + t * 16384, A[4 * t], A[4 * t + 1], A[4 * t + 2], A[4 * t + 3]);
}
}

struct Args { const void* in[24]; float* out; unsigned char* ws; int ph_lo, ph_hi; };

__device__ __forceinline__ u32x2 pack4(f32x4 v) { u32x2 w; w.x = cvt_pk_bf16(v[0], v[1]); w.y = cvt_pk_bf16(v[2], v[3]); return w; }

template <bool FP8, bool TILED = false>
__device__ __forceinline__ void cvt_pair(const float* W, int N, void* WT, int ldd, int k0, int n0, int drow0, float scale, LAS float* scr, int lane) {
    const int lr = lane >> 4, lc = (lane & 15) * 4;
    f32x4 v[2][16];
#pragma unroll
    for (int t = 0; t < 2; ++t)
#pragma unroll
        for (int i = 0; i < 16; ++i) v[t][i] = *(const f32x4*)(W + (size_t)(k0 + 64 * t + 4 * i + lr) * N + n0 + lc);
    const int c = lane & 7;
#pragma unroll
    for (int t = 0; t < 2; ++t) {
#pragma unroll
        for (int i = 0; i < 16; ++i) { LAS float* s = scr + (4 * i + lr) * 65 + lc; s[0] = v[t][i][0]; s[1] = v[t][i][1]; s[2] = v[t][i][2]; s[3] = v[t][i][3]; }
        LDS_WAIT(); asm volatile("" ::: "memory");
#pragma unroll
        for (int j = 0; j < 8; ++j) { const int n = (lane >> 3) + 8 * j; const LAS float* s = scr + (8 * c) * 65 + n;
            if constexpr (!FP8) { u32x4 o; o.x = cvt_pk_bf16(s[0 * 65], s[1 * 65]); o.y = cvt_pk_bf16(s[2 * 65], s[3 * 65]); o.z = cvt_pk_bf16(s[4 * 65], s[5 * 65]); o.w = cvt_pk_bf16(s[6 * 65], s[7 * 65]);
                *(u32x4*)((bf16_t*)WT + (size_t)(drow0 + n) * ldd + k0 + 64 * t + 8 * c) = o; }
            else { int w0 = 0, w1 = 0;
                w0 = __builtin_amdgcn_cvt_pk_fp8_f32(pg8::clamp448(s[0 * 65] * scale), pg8::clamp448(s[1 * 65] * scale), w0, false); w0 = __builtin_amdgcn_cvt_pk_fp8_f32(pg8::clamp448(s[2 * 65] * scale), pg8::clamp448(s[3 * 65] * scale), w0, true);
                w1 = __builtin_amdgcn_cvt_pk_fp8_f32(pg8::clamp448(s[4 * 65] * scale), pg8::clamp448(s[5 * 65] * scale), w1, false); w1 = __builtin_amdgcn_cvt_pk_fp8_f32(pg8::clamp448(s[6 * 65] * scale), pg8::clamp448(s[7 * 65] * scale), w1, true);
                u32x2 o; o.x = (unsigned)w0; o.y = (unsigned)w1;
                if constexpr (TILED) { const int dr = drow0 + n;
                    *(u32x2*)((unsigned char*)WT + ((size_t)(dr >> 8) * (ldd >> 7) + (k0 >> 7)) * 32768 + (dr & 255) * 128 + 64 * t + 8 * c) = o; }
                else *(u32x2*)((unsigned char*)WT + (size_t)(drow0 + n) * ldd + k0 + 64 * t + 8 * c) = o; } }
        LDS_WAIT(); asm volatile("" ::: "memory");
    }
}

typedef __attribute__((address_space(4))) const char* karg_cptr;
__device__ __forceinline__ void* karg_ptr(int k) {
    karg_cptr p = (karg_cptr)__builtin_amdgcn_kernarg_segment_ptr();
    asm volatile("" : "+s"(p));
    typedef void* voidp_t; typedef __attribute__((address_space(4))) const voidp_t* karg_vpp;
    return *(karg_vpp)(p + 8 * k);
}
__global__ void __launch_bounds__(NTHR, 2) mk_fwd(Args args) {
    extern __shared__ __attribute__((aligned(16))) unsigned char lds_raw[];
    LAS unsigned char* lds = (LAS unsigned char*)lds_raw;
    volatile LAS unsigned* MISC = (volatile LAS unsigned*)(lds + LDS_MISC);
    const int wave0 = __builtin_amdgcn_readfirstlane((int)threadIdx.x >> 6);
    const int G = gridDim.x, bx0 = blockIdx.x, NGW = G * NWAVES;
#define PHASE_IDS() int lane_; asm volatile("v_mbcnt_lo_u32_b32 %0, -1, 0\n\tv_mbcnt_hi_u32_b32 %0, -1, %0" : "=v"(lane_)); int wave_ = wave0; asm volatile("" : "+s"(wave_)); \
    int bx = bx0; asm volatile("" : "+s"(bx)); int tid = wave_ * 64 + lane_; \
    const int lane = lane_, wave = wave_; \
    const int vcu = (G % 8 == 0) ? (bx % 8) * (G / 8) + bx / 8 : bx; const int gw = vcu * NWAVES + wave; (void)lane; (void)gw
    for (int u = threadIdx.x; u < 64; u += NTHR) MISC[u] = 0u;
    __syncthreads();
    unsigned* const barw = (unsigned*)((unsigned char*)karg_ptr(25) + WS_CTL) + CW_BAR;
    XcdBarrier bar; bar.bar = barw; bar.x = 0; bar.st = nullptr;
#if !MK_MULTI
    bar = xcd_barrier_post(barw, MISC + 8);
#endif
    const int lo = args.ph_lo, hi = args.ph_hi;
#ifndef PH_MASK
#define PH_MASK 0xffffffffu
#endif
#define IN(k) (lo <= (k) && (k) < hi && ((PH_MASK >> ((k) > 15 ? (k) - 16 : (k))) & 1u))
#if MK_MULTI
#define SEAM(k) do { } while (0)
#else
#ifndef TIME_MASK
#define TIME_MASK 0ull
#endif
#ifndef TIME_BAR
#define TIME_BAR 0
#endif
#ifndef TIME_SCALE
#define TIME_SCALE 0.001f
#endif
#if 0
#endif
#define IS_T0() ({ int l0_; asm volatile("v_mbcnt_lo_u32_b32 %0, -1, 0\n\tv_mbcnt_hi_u32_b32 %0, -1, %0" : "=v"(l0_)); (wave0 == 0) && (l0_ == 0); })
    if (TIME_MASK != 0ull && IS_T0()) { MISC[40] = 0u; MISC[41] = (unsigned)__builtin_amdgcn_s_memrealtime(); }
#define TPROBE(k) do { if (TIME_MASK != 0ull && IS_T0()) { const unsigned now_ = (unsigned)__builtin_amdgcn_s_memrealtime(); if ((TIME_MASK >> (k)) & 1ull) MISC[40] += now_ - MISC[41]; MISC[41] = now_; } } while (0)
#define SEAM(k) do { if (TIME_BAR && TIME_MASK != 0ull) { asm volatile("s_waitcnt vmcnt(0)" ::: "memory"); if (IS_T0()) MISC[41] = (unsigned)__builtin_amdgcn_s_memrealtime(); } if ((k) + 1 < hi) xcd_barrier(bar); TPROBE(k); } while (0)
#endif
#define KARG(k) (karg_ptr(k))
#define x_in ((const float*)KARG(0))
#define c_in ((const float*)KARG(1))
#define pos_in ((const int*)KARG(2))
#define ada_w ((const float*)KARG(3))
#define ada_b ((const float*)KARG(4))
#define mix_norm ((const float*)KARG(5))
#define w_in ((const float*)KARG(6))
#define cq_norm ((const float*)KARG(7))
#define ckv_norm ((const float*)KARG(8))
#define w_uq ((const float*)KARG(9))
#define w_ukv ((const float*)KARG(10))
#define q_norm ((const float*)KARG(11))
#define k_norm ((const float*)KARG(12))
#define w_fnet ((const float*)KARG(13))
#define out_norm ((const float*)KARG(14))
#define w_out ((const float*)KARG(15))
#define ffn_norm ((const float*)KARG(16))
#define dw_gate ((const float*)KARG(17))
#define dw_up ((const float*)KARG(18))
#define dw_down ((const float*)KARG(19))
#define router_w ((const float*)KARG(20))
#define mw_gate ((const float*)KARG(21))
#define mw_up ((const float*)KARG(22))
#define mw_down ((const float*)KARG(23))
#define out ((float*)KARG(24))
#define WSB ((unsigned char*)KARG(25))
#define ctl ((unsigned*)(WSB + WS_CTL))
#define MODP ((float*)(WSB + WS_ARENA))
#define MODV ((float*)(WSB + WS_MODV))
#define COS ((float*)(WSB + WS_COS))
#define SIN ((float*)(WSB + WS_SIN))
#define TW ((f32x2*)(WSB + WS_TW))
#define FM ((bf16_t*)(WSB + WS_FM))
#define GM ((bf16_t*)(WSB + WS_GM))
#define M12 ((bf16_t*)(WSB + WS_M12))
#define TOKINFO ((int*)(WSB + WS_TOKINFO))
#define TOKPOS ((int*)(WSB + WS_TOKPOS))
#define BLKCNT ((int*)(WSB + WS_TOKPOS + (size_t)SEQ * 8))
#define ROWTOK ((int*)(WSB + CTL_ROWTOK))
#define WIN ((bf16_t*)(WSB + WS_WIN))
#define WUQ ((bf16_t*)(WSB + WS_WUQ))
#define WUKV ((bf16_t*)(WSB + WS_WUKV))
#define WOUT ((bf16_t*)(WSB + WS_WOUT))
#define WGUD ((bf16_t*)(WSB + WS_WGUD))
#define WDND ((bf16_t*)(WSB + WS_WDND))
#define WGUM ((bf16_t*)(WSB + WS_WGUM))
#define WDNM ((bf16_t*)(WSB + WS_WDNM))
#define HB ((bf16_t*)(WSB + WS_H))
#define YB ((bf16_t*)(WSB + WS_Y))
#define ZB ((bf16_t*)(WSB + WS_Z))
#define QB ((bf16_t*)(WSB + WS_QB))
#define KVB ((bf16_t*)(WSB + WS_KVB))
#define KB ((bf16_t*)(WSB + WS_KB))
#define A1 ((bf16_t*)(WSB + WS_A1))
#define YC ((bf16_t*)(WSB + WS_YC))
#define HID ((bf16_t*)(WSB + WS_HID))
#define YPART ((bf16_t*)(WSB + WS_ARENA + 256 * MiB))

    if (IN(0)) {
        PHASE_IDS();
        LAS float* cond = (LAS float*)(lds + LDS_COND); LAS float* trig = (LAS float*)(lds + LDS_TRIG);
        for (int i = tid; i < DM; i += NTHR) { const float c = c_in[i]; cond[i] = c / (1.0f + __expf(-c)); }
        if (tid < 128) { trig[tid] = (float)cospi(2.0 * tid / 128.0); trig[128 + tid] = (float)sinpi(2.0 * tid / 128.0); }
        __syncthreads();
        LAS float* scr = (LAS float*)(lds + wave * 16640);
        constexpr int I_GEMV = 2 * 48 * 64;
        constexpr int I_WIN = 16 * 29, I_WUQ = 4 * 24, I_WUKV = 2 * 32, I_WOUT = 16 * 32;
        constexpr int I_DGU = 16 * 88, I_DDN = 44 * 32, I_MGU = 16 * 112, I_MDN = 56 * 32;
        constexpr int I_ZERO = 2 * 192;
        constexpr int I_ROPE = SEQ * 32 / 64;
        constexpr int I_TW = 16384 / 64, I_FM = 32768 / 64, I_GM = 65536 / 64, I_M12 = 2 * 8 * 256 * 128 / 64;
        constexpr int NITEMS = I_GEMV + 2 * (I_WIN + I_WUQ + I_WUKV + I_WOUT) + 2 * I_DGU + I_DDN + 16 * I_MGU + 8 * I_MDN + I_ZERO + I_ROPE + I_TW + I_FM + I_GM + I_M12;
        for (int it = gw; it < NITEMS; it += NGW) {
            int r = it;
            if (r < I_GEMV) {
                const int kc = r & 63, cb = r >> 6, l = cb / 48, n0 = (cb % 48) * 256 + 4 * lane;
                const float* W = ada_w + ((size_t)l * DM + kc * 32) * 12288 + n0;
                f32x4 a = {0.f, 0.f, 0.f, 0.f};
                f32x4 v[32];
#pragma unroll
                for (int k = 0; k < 32; ++k) v[k] = *(const f32x4*)(W + (size_t)k * 12288);
#pragma unroll
                for (int k = 0; k < 32; ++k) a += v[k] * cond[kc * 32 + k];
                *(f32x4*)(MODP + ((size_t)kc * 2 + l) * 12288 + n0) = a;
                continue;
            } r -= I_GEMV;
            bool done = false;
#pragma unroll 1
            for (int l = 0; l < 2 && !done; ++l) {
                if (r < I_WIN) { const int kb = r / 29, nb = r % 29; cvt_pair<false>(w_in + (size_t)l * DM * DIN, DIN, WIN + (size_t)l * DINP * DM, DM, 128 * kb, 64 * nb, 64 * nb, 1.f, scr, lane); done = true; break; } r -= I_WIN;
                if (r < I_WUQ) { const int kb = r / 24, nb = r % 24; cvt_pair<false>(w_uq + (size_t)l * QLR * 1536, 1536, WUQ + (size_t)l * 1536 * QLR, QLR, 128 * kb, 64 * nb, 64 * nb, 1.f, scr, lane); done = true; break; } r -= I_WUQ;
                if (r < I_WUKV) { const int kb = r / 32, nb = r % 32; cvt_pair<false>(w_ukv + (size_t)l * KVLR * 2048, 2048, WUKV + (size_t)l * 2048 * KVLR, KVLR, 128 * kb, 64 * nb, 64 * nb, 1.f, scr, lane); done = true; break; } r -= I_WUKV;
                if (r < I_WOUT) { const int kb = r / 32, nb = r % 32; cvt_pair<false>(w_out + (size_t)l * DM * DM, DM, WOUT + (size_t)l * DM * DM, DM, 128 * kb, 64 * nb, 64 * nb, 1.f, scr, lane); done = true; break; } r -= I_WOUT;
            }
            if (done) continue;
            if (r < 2 * I_DGU) { const int up = r / I_DGU, rr = r % I_DGU, kb = rr / 88, nb = rr % 88, n0 = 64 * nb;
                cvt_pair<false>(up ? dw_up : dw_gate, DFF, WGUD, DM, 128 * kb, n0, (n0 >> 7) * 256 + (n0 & 127) + up * 128, 1.f, scr, lane); continue; } r -= 2 * I_DGU;
            if (r < I_DDN) { const int kb = r / 32, nb = r % 32; cvt_pair<false>(dw_down, DM, WDND, DFF, 128 * kb, 64 * nb, 64 * nb, 1.f, scr, lane); continue; } r -= I_DDN;
            if (r < 16 * I_MGU) { const int e = r / (2 * I_MGU), r2 = r % (2 * I_MGU), up = r2 / I_MGU, rr = r2 % I_MGU, kb = rr / 112, nb = rr % 112, n0 = 64 * nb;
                cvt_pair<true, true>((up ? mw_up : mw_gate) + (size_t)e * DM * DFE, DFE, (unsigned char*)WGUM + (size_t)e * 14336 * DM, DM, 128 * kb, n0, (n0 >> 7) * 256 + (n0 & 127) + up * 128, S8_WGU, scr, lane); continue; } r -= 16 * I_MGU;
            if (r < 8 * I_MDN) { const int e = r / I_MDN, rr = r % I_MDN, kb = rr / 32, nb = rr % 32;
                cvt_pair<true, true>(mw_down + (size_t)e * DFE * DM, DM, (unsigned char*)WDNM + (size_t)e * DM * DFE, DFE, 128 * kb, 64 * nb, 64 * nb, S8_WDN, scr, lane); continue; } r -= 8 * I_MDN;
            if (r < I_ZERO) { const int l = r / 192, row = 1856 + r % 192; u32x4 z = {0u, 0u, 0u, 0u};
#pragma unroll
                for (int j = 0; j < 4; ++j) *(u32x4*)(WIN + ((size_t)l * DINP + row) * DM + (lane + 64 * j) * 8) = z;
                continue; } r -= I_ZERO;
            if (r < I_ROPE) { const int idx = r * 64 + lane, t = idx >> 5, i = idx & 31;
                const double inv = exp2(-(double)i * (13.287712379549449 / 32.0));
                const double ang = (double)pos_in[t] * inv; double sn, cs; sincos(ang, &sn, &cs);
                COS[idx] = (float)cs; SIN[idx] = (float)sn; continue; } r -= I_ROPE;
            if (r < I_TW) { const int idx = r * 64 + lane, s2 = idx >> 7, k1 = idx & 127; const int m = (s2 * k1) & 16383;
                double sn, cs; sincospi(2.0 * (double)m / 16384.0, &sn, &cs); TW[idx] = (f32x2){(float)cs, (float)(-sn)}; continue; } r -= I_TW;
            if (r < I_FM) { const int idx = r * 64 + lane, m = idx >> 7, s1 = idx & 127, k1 = m >> 1, ri = m & 1; const int ph = (k1 * s1) & 127;
                const float v = (ri ? -trig[128 + ph] : trig[ph]) * 0.08838834764831845f; FM[idx] = f2bf(v); continue; } r -= I_FM;
            if (r < I_GM) { const int idx = r * 64 + lane, m = idx >> 8, k = idx & 255, ro = m >> 7, k2 = m & 127, rin = k >> 7, s2 = k & 127; const int ph = (k2 * s2) & 127;
                float v = (ro == rin) ? trig[ph] : (ro == 0 ? trig[128 + ph] : -trig[128 + ph]);
                GM[idx] = f2bf(v * 0.08838834764831845f); continue; } r -= I_GM;
            {
                const int idx = r * 64 + lane, d = idx & 127, kk = (idx >> 7) & 255, lg = idx >> 15, ri = kk >> 7, c = kk & 127;
                const float* Wf = w_fnet + (size_t)lg * 128 * 128 + d; float a = 0.f;
                for (int m = 0; m < 128; ++m) a += trig[ri * 128 + ((m * c) & 127)] * Wf[m * 128];
                M12[idx] = f2bf(a * 0.08838834764831845f);
            }
        }
        SEAM(0);
    }
    if (IN(1)) {
        PHASE_IDS();
        for (int i = (bx * NTHR + tid); i < 2 * 12288; i += G * NTHR) { float a = ada_b[i];
#pragma unroll
            for (int k = 0; k < 64; ++k) a += MODP[(size_t)k * 2 * 12288 + i];
            MODV[i] = a; }
        SEAM(1);
    }

#pragma unroll 1
    for (int l = 0; l < 2; ++l) {
        const int pb = 2 + 16 * l;
#define modv (MODV + (size_t)l * 12288)
#define xcur ((l == 0) ? x_in : (const float*)out)
#pragma unroll 1
        for (int sub = 0; sub < 2; ++sub) {
            const int ph = pb + (sub ? 8 : 0);
            if (IN(ph)) {
                PHASE_IDS();
                const float* xs = sub ? (const float*)out : xcur;
                const float* gain = (sub ? ffn_norm : mix_norm) + (size_t)l * DM;
                const float* shv = modv + (sub ? 3 : 0) * DM; const float* scv = modv + (sub ? 4 : 1) * DM;
                const bool router = (sub == 1 && l == 1);
                LAS float* wr_l = (LAS float*)lds;
                LAS int* etab = (LAS int*)(lds + 65536); LAS int* rtab = (LAS int*)(lds + 65536 + 4096);
                if (router) { etab[tid] = 0xffff;
                    for (int i = tid; i < DM * NE / 4; i += NTHR) ((LAS f32x4*)wr_l)[i] = ((const f32x4*)router_w)[i]; }
                __syncthreads();
                f32x4 av[8], bv[8];
#pragma unroll
                for (int j = 0; j < 8; ++j) { const f32x4 g4 = ((const f32x4*)gain)[lane + 64 * j], s4 = ((const f32x4*)scv)[lane + 64 * j]; av[j] = g4 * (1.0f + s4); bv[j] = ((const f32x4*)shv)[lane + 64 * j]; }
                int my_e0 = 0, my_e1 = 0, my_tok = -1; float my_w0 = 0.f, my_w1 = 0.f; int itn = 0;
                f32x4 vnx[8];
#pragma unroll
                for (int j = 0; j < 8; ++j) vnx[j] = ((const f32x4*)(xs + (size_t)(gw < SEQ ? gw : 0) * DM))[lane + 64 * j];
                for (int m = gw; m < SEQ; m += NGW, ++itn) {
                    f32x4 v[8]; float ss = 0.f;
#pragma unroll
                    for (int j = 0; j < 8; ++j) v[j] = vnx[j];
                    { const int mn = m + NGW < SEQ ? m + NGW : m;
#pragma unroll
                      for (int j = 0; j < 8; ++j) vnx[j] = ((const f32x4*)(xs + (size_t)mn * DM))[lane + 64 * j]; }
#pragma unroll
                    for (int j = 0; j < 8; ++j) ss += (v[j][0] * v[j][0] + v[j][1] * v[j][1]) + (v[j][2] * v[j][2] + v[j][3] * v[j][3]);
                    const float rstd = 1.0f / sqrtf(wave_sum(ss) * (1.0f / DM) + RMS_EPS);
#pragma unroll
                    for (int j = 0; j < 8; ++j) { v[j] = v[j] * rstd * av[j] + bv[j];
                        if (router) { int w8 = 0; w8 = __builtin_amdgcn_cvt_pk_fp8_f32(pg8::clamp448(v[j][0] * S8_H), pg8::clamp448(v[j][1] * S8_H), w8, false); w8 = __builtin_amdgcn_cvt_pk_fp8_f32(pg8::clamp448(v[j][2] * S8_H), pg8::clamp448(v[j][3] * S8_H), w8, true);
                            *(unsigned*)((unsigned char*)HB + (size_t)m * DM + 4 * lane + 256 * j) = (unsigned)w8; }
                        else *(u32x2*)(HB + (size_t)m * DM + 4 * lane + 256 * j) = pack4(v[j]); }
                    if (router) {
                        float lg[8] = {0.f, 0.f, 0.f, 0.f, 0.f, 0.f, 0.f, 0.f};
#pragma unroll
                        for (int j = 0; j < 8; ++j)
#pragma unroll
                            for (int q = 0; q < 4; ++q) { const int k = 4 * lane + 256 * j + q; const f32x4 w0 = *(const LAS f32x4*)(wr_l + k * 8), w1 = *(const LAS f32x4*)(wr_l + k * 8 + 4); const float hv = v[j][q];
                                lg[0] += hv * w0[0]; lg[1] += hv * w0[1]; lg[2] += hv * w0[2]; lg[3] += hv * w0[3]; lg[4] += hv * w1[0]; lg[5] += hv * w1[1]; lg[6] += hv * w1[2]; lg[7] += hv * w1[3]; }
#pragma unroll
                        for (int e = 0; e < 8; ++e) lg[e] = wave_sum(lg[e]);
                        int e0 = 0; float l0 = lg[0];
#pragma unroll
                        for (int e = 1; e < 8; ++e) if (lg[e] > l0) { l0 = lg[e]; e0 = e; }
                        int e1 = -1; float l1 = -3.0e38f;
#pragma unroll
                        for (int e = 0; e < 8; ++e) if (e != e0 && lg[e] > l1) { l1 = lg[e]; e1 = e; }
                        const float w1 = 1.0f / (1.0f + __expf(l0 - l1)), w0 = 1.0f - w1;
                        if (lane == 0) etab[itn * NWAVES + wave] = e0 | (e1 << 8);
                        if (lane == itn) { my_e0 = e0; my_e1 = e1; my_w0 = w0; my_w1 = w1; my_tok = m; }
                    }
                }
                if (router) {
                    __syncthreads();
                    const int nent = ((SEQ + NGW - 1) / NGW) * NWAVES;
                    if (tid < nent) {
                        const int me = etab[tid], a0 = me & 255, a1 = me >> 8; int c0 = 0, c1 = 0;
                        for (int q = 0; q < tid; ++q) { const int o = etab[q], b0 = o & 255, b1 = o >> 8; c0 += (b0 == a0) + (b1 == a0); c1 += (b0 == a1) + (b1 == a1); }
                        rtab[2 * tid] = c0; rtab[2 * tid + 1] = c1; }
                    if (tid >= 512 - 8) { const int e = tid - (512 - 8); int c = 0;
                        for (int q = 0; q < nent; ++q) { const int o = etab[q]; c += ((o & 255) == e) + ((o >> 8) == e); }
                        BLKCNT[bx * 8 + e] = c; }
                    __syncthreads();
                    if (my_tok >= 0) { int* ti = TOKINFO + (size_t)my_tok * 8; ti[0] = my_e0; ti[1] = my_e1; ti[2] = __float_as_int(my_w0); ti[3] = __float_as_int(my_w1);
                        ti[4] = rtab[2 * (lane * NWAVES + wave)]; ti[5] = rtab[2 * (lane * NWAVES + wave) + 1]; ti[6] = bx; }
                }
                __syncthreads();
                SEAM(ph);
            }
            if (sub == 0) {
            if (IN(pb + 1)) {
                PHASE_IDS();
                pg8::Gemm g{HB, WIN + (size_t)l * DINP * DM, DM, DM, DM, 0, nullptr}; pg8::TileOrder S; S.init(SEQ / 256, DINP / 256, G, bx);
                pg8::EpiBf16 E{ZB, DINP, 1.0f};
                pg8::gemm_phase<pg8::EpiBf16, pg8::TileOrder, false>(tid, lds, g, S, E);
                SEAM(pb + 1);
            }
            if (IN(pb + 2)) {
                PHASE_IDS();
                f32x4 gq0 = ((const f32x4*)(cq_norm + (size_t)l * QLR))[2 * lane], gq1 = ((const f32x4*)(cq_norm + (size_t)l * QLR))[2 * lane + 1];
                f32x4 gk = ((const f32x4*)(ckv_norm + (size_t)l * KVLR))[lane];
                for (int m = gw; m < SEQ; m += NGW) {
                    bf16_t* zr = ZB + (size_t)m * DINP;
                    const bf16x8 q8 = *(const bf16x8*)(zr + ZQ + 8 * lane); const s16x4 k4 = *(const s16x4*)(zr + ZKV + 4 * lane);
                    float qf[8], kf[4], sq = 0.f, sk = 0.f;
#pragma unroll
                    for (int j = 0; j < 8; ++j) { qf[j] = bf2f((unsigned short)q8[j]); sq += qf[j] * qf[j]; }
#pragma unroll
                    for (int j = 0; j < 4; ++j) { kf[j] = bf2f((unsigned short)k4[j]); sk += kf[j] * kf[j]; }
                    const float rq = 1.0f / sqrtf(wave_sum(sq) * (1.0f / QLR) + RMS_EPS), rk = 1.0f / sqrtf(wave_sum(sk) * (1.0f / KVLR) + RMS_EPS);
                    u32x4 wq; wq.x = cvt_pk_bf16(qf[0] * rq * gq0[0], qf[1] * rq * gq0[1]); wq.y = cvt_pk_bf16(qf[2] * rq * gq0[2], qf[3] * rq * gq0[3]);
                    wq.z = cvt_pk_bf16(qf[4] * rq * gq1[0], qf[5] * rq * gq1[1]); wq.w = cvt_pk_bf16(qf[6] * rq * gq1[2], qf[7] * rq * gq1[3]);
                    u32x2 wk; wk.x = cvt_pk_bf16(kf[0] * rk * gk[0], kf[1] * rk * gk[1]); wk.y = cvt_pk_bf16(kf[2] * rk * gk[2], kf[3] * rk * gk[3]);
                    *(u32x4*)(zr + ZQ + 8 * lane) = wq; *(u32x2*)(zr + ZKV + 4 * lane) = wk;
                }
                {   PHASE_IDS();
                    const int r32 = lane & 31, hi = lane >> 5;
                    LAS unsigned char* ost = lds + sg::OST_OFF + wave * sg::OST_WAVE;
                    bf16x8 Af[8];
#pragma unroll
                    for (int s = 0; s < 8; ++s) Af[s] = *(const bf16x8*)(FM + (size_t)(32 * wave + r32) * 128 + 16 * s + 8 * hi);
                    for (int it = bx; it < 1024; it += G) {
                        const int s2 = it >> 3, cc = it & 7;
                        __syncthreads();
                        sg::stage_b<128>(ZB + (size_t)s2 * DINP + ZU + cc * 128, (size_t)128 * DINP, (char*)lds_raw, tid);
                        __syncthreads();
                        f32x16 o[4] = {};
                        sg::mm<128>(o, Af, (char*)lds_raw, lane);
#pragma unroll
                        for (int p = 0; p < 8; ++p) { const int k1 = 16 * wave + (p & 1) + 4 * (p >> 1) + 2 * hi; const f32x2 tw = TW[s2 * 128 + k1];
#pragma unroll
                            for (int d0 = 0; d0 < 4; ++d0) { const float re = o[d0][2 * p], im = o[d0][2 * p + 1];
                                o[d0][2 * p] = re * tw[0] - im * tw[1]; o[d0][2 * p + 1] = re * tw[1] + im * tw[0]; } }
                        sg::store_tile(o, ost, lane, sg::RowF1{A1, wave, s2, cc});
                    }
                    __syncthreads();
                }
                SEAM(pb + 2);
            }
            if (IN(pb + 3)) {
                PHASE_IDS();
                { pg8::Gemm g{ZB + ZQ, WUQ + (size_t)l * 1536 * QLR, DINP, QLR, QLR, 0, nullptr}; pg8::TileOrder S; S.init(SEQ / 256, 1536 / 256, G, bx);
                  pg8::EpiBf16 E{QB, 1536, 1.0f}; pg8::gemm_phase<pg8::EpiBf16, pg8::TileOrder, false>(tid, lds, g, S, E); }
                { pg8::Gemm g{ZB + ZKV, WUKV + (size_t)l * 2048 * KVLR, DINP, KVLR, KVLR, 0, nullptr}; pg8::TileOrder S; S.init(SEQ / 256, 2048 / 256, G, bx);
                  pg8::EpiBf16 E{KVB, 2048, 1.0f}; pg8::gemm_phase<pg8::EpiBf16, pg8::TileOrder, false>(tid, lds, g, S, E); }
                {   PHASE_IDS();
                    const int r32 = lane & 31, hi = lane >> 5;
                    LAS unsigned char* ost = lds + sg::OST_OFF + wave * sg::OST_WAVE;
                    bf16x8 Af[16];
#pragma unroll
                    for (int s = 0; s < 16; ++s) Af[s] = *(const bf16x8*)(GM + (size_t)(32 * wave + r32) * 256 + 16 * s + 8 * hi);
                    for (;;) {
                        __syncthreads();
                        if (tid == 0) MISC[32] = atomicAdd(ctl + CW_F3CTR + 128 + 64 * l, 1u);
                        __syncthreads();
                        const int it = (int)MISC[32]; if (it >= 1024) break;
                        const int k1 = it >> 3, gidx = it & 7;
                        sg::stage_b<256>(A1 + (size_t)k1 * 256 * 1024 + gidx * 128, 1024, (char*)lds_raw, tid);
                        __syncthreads();
                        f32x16 o[4] = {};
                        sg::mm<256>(o, Af, (char*)lds_raw, lane);
                        sg::store_tile(o, ost, lane, sg::RowF2{YC, wave, k1, gidx});
                    }
                    __syncthreads();
                }
                SEAM(pb + 3);
            }
            if (IN(pb + 4)) {
                PHASE_IDS();
                {
                    const int hd = lane >> 3, j8 = lane & 7;
                    const float* qg = q_norm + (size_t)l * QKD; const float* kg = k_norm + (size_t)l * QKD;
                    f32x4 qgn[4], kgn[4], qgr[2], kgr[2];
#pragma unroll
                    for (int j = 0; j < 4; ++j) { qgn[j] = *(const f32x4*)(qg + 16 * j8 + 4 * j); kgn[j] = *(const f32x4*)(kg + 16 * j8 + 4 * j); }
                    qgr[0] = *(const f32x4*)(qg + NOPE + 4 * j8); qgr[1] = *(const f32x4*)(qg + NOPE + 32 + 4 * j8);
                    kgr[0] = *(const f32x4*)(kg + NOPE + 4 * j8); kgr[1] = *(const f32x4*)(kg + NOPE + 32 + 4 * j8);
                    for (int m = gw; m < SEQ; m += NGW) {
                        const f32x4 cs = *(const f32x4*)(COS + (size_t)m * 32 + 4 * j8), sn = *(const f32x4*)(SIN + (size_t)m * 32 + 4 * j8);
                        const bf16_t* kp = KVB + (size_t)m * 2048 + hd * 256; const bf16_t* krp = ZB + (size_t)m * DINP + ZKR;
                        const bf16x8 kn0 = *(const bf16x8*)(kp + 16 * j8), kn1 = *(const bf16x8*)(kp + 16 * j8 + 8);
                        const s16x4 kra = *(const s16x4*)(krp + 4 * j8), krb = *(const s16x4*)(krp + 32 + 4 * j8);
                        {
                            bf16_t* qp = QB + (size_t)m * 1536 + hd * QKD;
                            const bf16x8 n0 = *(const bf16x8*)(qp + 16 * j8), n1 = *(const bf16x8*)(qp + 16 * j8 + 8);
                            const s16x4 ra = *(const s16x4*)(qp + NOPE + 4 * j8), rb = *(const s16x4*)(qp + NOPE + 32 + 4 * j8);
                            float f[16], x1[4], x2[4], ss = 0.f;
#pragma unroll
                            for (int j = 0; j < 8; ++j) { f[j] = bf2f((unsigned short)n0[j]); f[8 + j] = bf2f((unsigned short)n1[j]); }
#pragma unroll
                            for (int j = 0; j < 16; ++j) ss += f[j] * f[j];
#pragma unroll
                            for (int j = 0; j < 4; ++j) { x1[j] = bf2f((unsigned short)ra[j]); x2[j] = bf2f((unsigned short)rb[j]); ss += x1[j] * x1[j] + x2[j] * x2[j]; }
                            ss += swz_xor<1>(ss); ss += swz_xor<2>(ss); ss += swz_xor<4>(ss);
                            const float rs = 1.0f / sqrtf(ss * (1.0f / QKD) + RMS_EPS);
                            u32x4 w0, w1;
                            w0.x = cvt_pk_bf16(f[0] * rs * qgn[0][0], f[1] * rs * qgn[0][1]); w0.y = cvt_pk_bf16(f[2] * rs * qgn[0][2], f[3] * rs * qgn[0][3]);
                            w0.z = cvt_pk_bf16(f[4] * rs * qgn[1][0], f[5] * rs * qgn[1][1]); w0.w = cvt_pk_bf16(f[6] * rs * qgn[1][2], f[7] * rs * qgn[1][3]);
                            w1.x = cvt_pk_bf16(f[8] * rs * qgn[2][0], f[9] * rs * qgn[2][1]); w1.y = cvt_pk_bf16(f[10] * rs * qgn[2][2], f[11] * rs * qgn[2][3]);
                            w1.z = cvt_pk_bf16(f[12] * rs * qgn[3][0], f[13] * rs * qgn[3][1]); w1.w = cvt_pk_bf16(f[14] * rs * qgn[3][2], f[15] * rs * qgn[3][3]);
                            float o1[4], o2[4];
#pragma unroll
                            for (int j = 0; j < 4; ++j) { const float a = x1[j] * rs * qgr[0][j], b = x2[j] * rs * qgr[1][j]; o1[j] = a * cs[j] - b * sn[j]; o2[j] = b * cs[j] + a * sn[j]; }
                            u32x2 wa, wb; wa.x = cvt_pk_bf16(o1[0], o1[1]); wa.y = cvt_pk_bf16(o1[2], o1[3]); wb.x = cvt_pk_bf16(o2[0], o2[1]); wb.y = cvt_pk_bf16(o2[2], o2[3]);
                            *(u32x4*)(qp + 16 * j8) = w0; *(u32x4*)(qp + 16 * j8 + 8) = w1; *(u32x2*)(qp + NOPE + 4 * j8) = wa; *(u32x2*)(qp + NOPE + 32 + 4 * j8) = wb;
                        }
                        {
                            bf16_t* ko = KB + (size_t)m * 1536 + hd * QKD;
                            const bf16x8 n0 = kn0, n1 = kn1; const s16x4 ra = kra, rb = krb;
                            float f[16], x1[4], x2[4], ss = 0.f;
#pragma unroll
                            for (int j = 0; j < 8; ++j) { f[j] = bf2f((unsigned short)n0[j]); f[8 + j] = bf2f((unsigned short)n1[j]); }
#pragma unroll
                            for (int j = 0; j < 16; ++j) ss += f[j] * f[j];
#pragma unroll
                            for (int j = 0; j < 4; ++j) { x1[j] = bf2f((unsigned short)ra[j]); x2[j] = bf2f((unsigned short)rb[j]); ss += x1[j] * x1[j] + x2[j] * x2[j]; }
                            ss += swz_xor<1>(ss); ss += swz_xor<2>(ss); ss += swz_xor<4>(ss);
                            const float rs = 1.0f / sqrtf(ss * (1.0f / QKD) + RMS_EPS);
                            u32x4 w0, w1;
                            w0.x = cvt_pk_bf16(f[0] * rs * kgn[0][0], f[1] * rs * kgn[0][1]); w0.y = cvt_pk_bf16(f[2] * rs * kgn[0][2], f[3] * rs * kgn[0][3]);
                            w0.z = cvt_pk_bf16(f[4] * rs * kgn[1][0], f[5] * rs * kgn[1][1]); w0.w = cvt_pk_bf16(f[6] * rs * kgn[1][2], f[7] * rs * kgn[1][3]);
                            w1.x = cvt_pk_bf16(f[8] * rs * kgn[2][0], f[9] * rs * kgn[2][1]); w1.y = cvt_pk_bf16(f[10] * rs * kgn[2][2], f[11] * rs * kgn[2][3]);
                            w1.z = cvt_pk_bf16(f[12] * rs * kgn[3][0], f[13] * rs * kgn[3][1]); w1.w = cvt_pk_bf16(f[14] * rs * kgn[3][2], f[15] * rs * kgn[3][3]);
                            float o1[4], o2[4];
#pragma unroll
                            for (int j = 0; j < 4; ++j) { const float a = x1[j] * rs * kgr[0][j], b = x2[j] * rs * kgr[1][j]; o1[j] = a * cs[j] - b * sn[j]; o2[j] = b * cs[j] + a * sn[j]; }
                            u32x2 wa, wb; wa.x = cvt_pk_bf16(o1[0], o1[1]); wa.y = cvt_pk_bf16(o1[2], o1[3]); wb.x = cvt_pk_bf16(o2[0], o2[1]); wb.y = cvt_pk_bf16(o2[2], o2[3]);
                            *(u32x4*)(ko + 16 * j8) = w0; *(u32x4*)(ko + 16 * j8 + 8) = w1; *(u32x2*)(ko + NOPE + 4 * j8) = wa; *(u32x2*)(ko + NOPE + 32 + 4 * j8) = wb;
                        }
                    }
                }
                SEAM(pb + 4);
            }
            if (IN(pb + 5)) {
                PHASE_IDS();
                float gq = 0.f, gk = 0.f;
#pragma unroll
                for (int j = 0; j < 3; ++j) { gq = fmaxf(gq, fabsf(q_norm[(size_t)l * QKD + lane + 64 * j])); gk = fmaxf(gk, fabsf(k_norm[(size_t)l * QKD + lane + 64 * j])); }
                gq = fmaxf(gq, swz_xor<1>(gq)); gq = fmaxf(gq, swz_xor<2>(gq)); gq = fmaxf(gq, swz_xor<4>(gq)); gq = fmaxf(gq, swz_xor<8>(gq)); gq = fmaxf(gq, swz_xor<16>(gq));
                gk = fmaxf(gk, swz_xor<1>(gk)); gk = fmaxf(gk, swz_xor<2>(gk)); gk = fmaxf(gk, swz_xor<4>(gk)); gk = fmaxf(gk, swz_xor<8>(gk)); gk = fmaxf(gk, swz_xor<16>(gk));
                { auto rq = __builtin_amdgcn_permlane32_swap(__float_as_uint(gq), __float_as_uint(gq), false, false); gq = fmaxf(__uint_as_float(rq[0]), __uint_as_float(rq[1]));
                  auto rk = __builtin_amdgcn_permlane32_swap(__float_as_uint(gk), __float_as_uint(gk), false, false); gk = fmaxf(__uint_as_float(rk[0]), __uint_as_float(rk[1])); }
                const int negMC = __builtin_amdgcn_readfirstlane(__builtin_bit_cast(int, -fminf(13.856406460551018f * gq * gk, 60.f) * 1.4426950408889634f));
                for (int u = bx; u < NH * (SEQ / 256); u += G) {
                    const int h = u & 7, qb = u >> 3;
                    int ln_u; asm volatile("v_mbcnt_lo_u32_b32 %0, -1, 0\n\tv_mbcnt_hi_u32_b32 %0, -1, %0" : "=v"(ln_u));
                    const int tid_u = wave * 64 + ln_u;
                    att::attn_unit2(QB + (size_t)(qb * 256) * 1536 + h * QKD, KB + h * QKD, KVB + h * 256 + NOPE, HB + (size_t)(qb * 256) * DM + h * VHD, SEQ, lds, tid_u, negMC);
                }
                {   PHASE_IDS();
                    const int r32 = lane & 31, hi = lane >> 5;
                    LAS unsigned char* ost = lds + sg::OST_OFF + wave * sg::OST_WAVE;
                    for (;;) {
                        __syncthreads();
                        if (tid == 0) MISC[32] = atomicAdd(ctl + CW_F3CTR + 64 * l, 1u);
                        __syncthreads();
                        const int it = (int)MISC[32]; if (it >= 512) break;
                        const int tt = it >> 3, gidx = it & 7;
                        bf16x8 Af[16];
                        const bf16_t* ar = YC + (size_t)(256 * tt + 32 * wave + r32) * 2048 + gidx * 256 + 8 * hi;
#pragma unroll
                        for (int s = 0; s < 16; ++s) Af[s] = *(const bf16x8*)(ar + 16 * s);
                        __syncthreads();
                        sg::stage_b<256>(M12 + (size_t)(l * 8 + gidx) * 256 * 128, 128, (char*)lds_raw, tid);
                        __syncthreads();
                        f32x16 o[4] = {};
                        sg::mm<256>(o, Af, (char*)lds_raw, lane);
                        sg::store_tile(o, ost, lane, sg::RowF3{HB, wave, tt, gidx});
                    }
                    __syncthreads();
                }
                SEAM(pb + 5);
            }
            if (IN(pb + 6)) {
                PHASE_IDS();
                const float* og = out_norm + (size_t)l * DM;
                f32x4 ga[4], gf[4];
#pragma unroll
                for (int j = 0; j < 4; ++j) { ga[j] = *(const f32x4*)(og + 16 * lane + 4 * j); gf[j] = *(const f32x4*)(og + 1024 + 16 * lane + 4 * j); }
                bf16x8 nx[4];
                { const bf16_t* p0 = HB + (size_t)(gw < SEQ ? gw : 0) * DM + 16 * lane; nx[0] = *(const bf16x8*)p0; nx[1] = *(const bf16x8*)(p0 + 8); nx[2] = *(const bf16x8*)(p0 + 1024); nx[3] = *(const bf16x8*)(p0 + 1032); }
                for (int m = gw; m < SEQ; m += NGW) {
                    bf16_t* rp = HB + (size_t)m * DM;
                    bf16x8 cu[4];
#pragma unroll
                    for (int j = 0; j < 4; ++j) cu[j] = nx[j];
                    { const bf16_t* p0 = HB + (size_t)(m + NGW < SEQ ? m + NGW : m) * DM + 16 * lane; nx[0] = *(const bf16x8*)p0; nx[1] = *(const bf16x8*)(p0 + 8); nx[2] = *(const bf16x8*)(p0 + 1024); nx[3] = *(const bf16x8*)(p0 + 1032); }
#pragma unroll
                    for (int half = 0; half < 2; ++half) {
                        bf16_t* p = rp + half * 1024 + 16 * lane;
                        const bf16x8 a0 = cu[2 * half], a1 = cu[2 * half + 1];
                        float f[16], ss = 0.f;
#pragma unroll
                        for (int j = 0; j < 8; ++j) { f[j] = bf2f((unsigned short)a0[j]); f[8 + j] = bf2f((unsigned short)a1[j]); }
#pragma unroll
                        for (int j = 0; j < 16; ++j) ss += f[j] * f[j];
                        const float rs = 1.0f / sqrtf(wave_sum(ss) * (1.0f / 1024) + RMS_EPS);
                        u32x4 w0, w1;
#define GG(j) (half ? gf[(j) >> 2][(j) & 3] : ga[(j) >> 2][(j) & 3])
                        w0.x = cvt_pk_bf16(f[0] * rs * GG(0), f[1] * rs * GG(1)); w0.y = cvt_pk_bf16(f[2] * rs * GG(2), f[3] * rs * GG(3));
                        w0.z = cvt_pk_bf16(f[4] * rs * GG(4), f[5] * rs * GG(5)); w0.w = cvt_pk_bf16(f[6] * rs * GG(6), f[7] * rs * GG(7));
                        w1.x = cvt_pk_bf16(f[8] * rs * GG(8), f[9] * rs * GG(9)); w1.y = cvt_pk_bf16(f[10] * rs * GG(10), f[11] * rs * GG(11));
                        w1.z = cvt_pk_bf16(f[12] * rs * GG(12), f[13] * rs * GG(13)); w1.w = cvt_pk_bf16(f[14] * rs * GG(14), f[15] * rs * GG(15));
#undef GG
                        *(u32x4*)p = w0; *(u32x4*)(p + 8) = w1;
                    }
                }
                SEAM(pb + 6);
            }
            if (IN(pb + 7)) {
                PHASE_IDS();
                pg8::Gemm g{HB, WOUT + (size_t)l * DM * DM, DM, DM, DM, 0, nullptr}; pg8::TileOrder S; S.init(SEQ / 256, DM / 256, G, bx);
                pg8::EpiRes E{xcur, out, modv + 2 * DM, DM};
                pg8::gemm_phase<pg8::EpiRes, pg8::TileOrder, false>(tid, lds, g, S, E);
                SEAM(pb + 7);
            }
            }
        }
        if (l == 0) {
            if (IN(pb + 9)) {
                PHASE_IDS();
                pg8::Gemm g{HB, WGUD, DM, DM, DM, 0, nullptr}; pg8::TileOrder S; S.init(SEQ / 256, 2 * DFF / 256, G, bx);
                pg8::EpiSwiGLU E{HID, DFF};
                pg8::gemm_phase<pg8::EpiSwiGLU, pg8::TileOrder, false>(tid, lds, g, S, E);
                SEAM(pb + 9);
            }
            if (IN(pb + 10)) {
                PHASE_IDS();
                pg8::Gemm g{HID, WDND, DFF, DFF, DFF, 0, nullptr}; pg8::TileOrder S; S.init(SEQ / 256, DM / 256, G, bx);
                pg8::EpiRes E{out, out, modv + 5 * DM, DM};
                pg8::gemm_phase<pg8::EpiRes, pg8::TileOrder, false>(tid, lds, g, S, E);
                SEAM(pb + 10);
            }
        } else {
#define LOAD_TS() int ts[9]; ts[0] = 0; _Pragma("unroll") for (int e = 0; e < 8; ++e) { const int c = __builtin_amdgcn_readfirstlane((int)__hip_atomic_load(ctl + CW_ECNT + 64 * e, RLX_AGENT)); ts[e + 1] = ts[e] + ((c + 255) >> 8); }
            if (IN(pb + 9)) {
                PHASE_IDS();
                LAS int* pref = (LAS int*)lds; LAS int* tot = pref + G * 8;
                for (int i = tid; i < G * 8; i += NTHR) pref[i] = BLKCNT[i];
                __syncthreads();
                if (tid < 8) { int run = 0; for (int b = 0; b < G; ++b) { const int c = pref[b * 8 + tid]; pref[b * 8 + tid] = run; run += c; } tot[tid] = run;
                    if (bx == 0) __hip_atomic_store(ctl + CW_ECNT + 64 * tid, (unsigned)run, RLX_AGENT); }
                __syncthreads();
                int ts[9]; ts[0] = 0;
#pragma unroll
                for (int e = 0; e < 8; ++e) ts[e + 1] = ts[e] + ((tot[e] + 255) >> 8);
                for (int t = bx * NTHR + tid; t < SEQ; t += G * NTHR) {
                    const int* ti = TOKINFO + (size_t)t * 8; const int e0 = ti[0], e1 = ti[1], b = ti[6];
                    int p0 = ti[4] + pref[b * 8 + e0], p1 = ti[5] + pref[b * 8 + e1];
#pragma unroll
                    for (int e = 0; e < 8; ++e) { if (e0 == e) p0 += 256 * ts[e]; if (e1 == e) p1 += 256 * ts[e]; }
                    ROWTOK[p0] = t; ROWTOK[p1] = t; TOKPOS[2 * t] = p0; TOKPOS[2 * t + 1] = p1;
                }
                __syncthreads();
                SEAM(pb + 9);
            }
            if (IN(pb + 10)) {
                PHASE_IDS(); LOAD_TS();
                pg8::Gemm g{HB, WGUM, DM, DM, DM, (size_t)14336 * DM, ROWTOK}; pg8::TileOrder S; S.init(ts[8], 2 * DFE / 256, G, bx); S.moe = true;
#pragma unroll
                for (int e = 0; e < 9; ++e) S.ts[e] = ts[e];
                pg8::EpiSwiGLU8 E{(unsigned char*)HID, DFE, 1.0f / (S8_H * S8_WGU), S8_HID};
                pg8::gemm_phase<pg8::EpiSwiGLU8, pg8::TileOrder, true, true, true>(tid, lds, g, S, E);
                SEAM(pb + 10);
            }
            if (IN(pb + 11)) {
                PHASE_IDS(); LOAD_TS();
                const int nmain = ts[8] < 128 ? ts[8] : 128;
                pg8::EpiBf16 E{YB, DM, 1.0f / (S8_HID * S8_WDN), YPART - (size_t)32768 * DM, (size_t)2048 * DM};
                { pg8::Gemm g{HID, WDNM, DFE, DFE, DFE, (size_t)DM * DFE, nullptr}; pg8::TileOrder S; S.init(nmain, DM / 256, G, bx); S.moe = true;
#pragma unroll
                  for (int e = 0; e < 9; ++e) S.ts[e] = ts[e];
                  pg8::gemm_phase<pg8::EpiBf16, pg8::TileOrder, false, true, true>(tid, lds, g, S, E); }
                if (ts[8] > 128) { asm volatile("" : "+v"(tid));
                  pg8::Gemm g{HID, WDNM, DFE, DFE, DFE / 4, (size_t)DM * DFE, nullptr, DFE / 128}; pg8::TailOrder S; S.nsub = (ts[8] - 128) * 32; S.G = G; S.c = bx; S.pm0 = 128;
#pragma unroll
                  for (int e = 0; e < 9; ++e) S.ts[e] = ts[e];
                  pg8::gemm_phase<pg8::EpiBf16, pg8::TailOrder, false, true, true>(tid, lds, g, S, E); }
                SEAM(pb + 11);
            }
            if (IN(pb + 12)) {
                PHASE_IDS();
                const float* g2 = modv + 5 * DM;
                f32x4 gv[8];
#pragma unroll
                for (int j = 0; j < 8; ++j) gv[j] = ((const f32x4*)g2)[lane + 64 * j];
                int pn0 = 0, pn1 = 0; float wn0 = 0.f, wn1 = 0.f;
                { const int m0 = gw < SEQ ? gw : 0; const int* ti = TOKINFO + (size_t)m0 * 8; wn0 = __int_as_float(ti[2]); wn1 = __int_as_float(ti[3]); pn0 = TOKPOS[2 * m0]; pn1 = TOKPOS[2 * m0 + 1]; }
                for (int m = gw; m < SEQ; m += NGW) {
                    const float w0 = wn0, w1 = wn1; const int p0 = pn0, p1 = pn1;
                    { const int mn = m + NGW < SEQ ? m + NGW : m; const int* ti = TOKINFO + (size_t)mn * 8; wn0 = __int_as_float(ti[2]); wn1 = __int_as_float(ti[3]); pn0 = TOKPOS[2 * mn]; pn1 = TOKPOS[2 * mn + 1]; }
                    const bf16_t* y0 = YB + (size_t)p0 * DM; const bf16_t* y1 = YB + (size_t)p1 * DM; float* op = out + (size_t)m * DM;
                    s16x4 ya4[8], yb4[8]; f32x4 xv[8];
#pragma unroll
                    for (int j = 0; j < 8; ++j) { ya4[j] = *(const s16x4*)(y0 + 4 * lane + 256 * j); yb4[j] = *(const s16x4*)(y1 + 4 * lane + 256 * j); xv[j] = ((const f32x4*)op)[lane + 64 * j]; }
                    f32x4 ya[8], yb[8];
#pragma unroll
                    for (int j = 0; j < 8; ++j)
#pragma unroll
                        for (int q = 0; q < 4; ++q) { ya[j][q] = bf2f((unsigned short)ya4[j][q]); yb[j][q] = bf2f((unsigned short)yb4[j][q]); }
                    if (p0 >= 32768) {
#pragma unroll
                        for (int kq = 0; kq < 3; ++kq)
#pragma unroll
                            for (int j = 0; j < 8; ++j) { const s16x4 e = *(const s16x4*)(YPART + ((size_t)kq * 2048 + (p0 - 32768)) * DM + 4 * lane + 256 * j);
#pragma unroll
                                for (int q = 0; q < 4; ++q) ya[j][q] += bf2f((unsigned short)e[q]); } }
                    if (p1 >= 32768) {
#pragma unroll
                        for (int kq = 0; kq < 3; ++kq)
#pragma unroll
                            for (int j = 0; j < 8; ++j) { const s16x4 e = *(const s16x4*)(YPART + ((size_t)kq * 2048 + (p1 - 32768)) * DM + 4 * lane + 256 * j);
#pragma unroll
                                for (int q = 0; q < 4; ++q) yb[j][q] += bf2f((unsigned short)e[q]); } }
#pragma unroll
                    for (int j = 0; j < 8; ++j) {
#pragma unroll
                        for (int q = 0; q < 4; ++q) xv[j][q] += gv[j][q] * (w0 * ya[j][q] + w1 * yb[j][q]);
                        ((f32x4*)op)[lane + 64 * j] = xv[j]; }
                }
            }
        }
    }
    TPROBE(30);
    if (TIME_MASK != 0ull && bx0 == 0 && IS_T0()) out[0] = (float)MISC[40] * TIME_SCALE;
#undef IN
#undef SEAM
#undef LOAD_TS
#undef modv
#undef xcur
#undef out
#undef ctl
}

extern "C" void kernel_launch(void* const* d_in, const int* in_sizes, int n_in, void* d_out, int out_size, void* d_ws, size_t ws_size, hipStream_t stream) {
    static int grid = 0;
    if (grid == 0) {
        if (n_in != 24 || out_size != SEQ * DM || ws_size < WS_END) { fprintf(stderr, "kernel_launch: unexpected shapes n_in %d out %d ws %zu (need %zu)\n", n_in, out_size, ws_size, (size_t)WS_END); grid = -1; return; }
        int dev = 0, cus = 0, per_cu = 0;
        if (hipGetDevice(&dev) != hipSuccess || hipDeviceGetAttribute(&cus, hipDeviceAttributeMultiprocessorCount, dev) != hipSuccess) { grid = -1; return; }
        if (hipFuncSetAttribute((const void*)mk_fwd, hipFuncAttributeMaxDynamicSharedMemorySize, LDS_BYTES) != hipSuccess) { fprintf(stderr, "kernel_launch: hipFuncSetAttribute failed\n"); grid = -1; return; }
        if (hipOccupancyMaxActiveBlocksPerMultiprocessor(&per_cu, (const void*)mk_fwd, NTHR, LDS_BYTES) != hipSuccess || per_cu < 1) fprintf(stderr, "kernel_launch: occupancy query says %d\n", per_cu);
        (void)hipGetLastError();
        grid = cus;
    }
    if (grid < 0) return;
    (void)hipMemsetAsync((char*)d_ws + WS_CTL, 0, CTL_BYTES, stream);
    Args a{};
    for (int i = 0; i < 24; ++i) a.in[i] = d_in[i];
    a.out = (float*)d_out; a.ws = (unsigned char*)d_ws;
#if MK_MULTI
    static const int phases[] = {0, 1, 2, 3, 4, 5, 6, 7, 8, 9, 10, 11, 12, 18, 19, 20, 21, 22, 23, 24, 25, 26, 27, 28, 29, 30};
    for (int p : phases) { a.ph_lo = p; a.ph_hi = p + 1; hipLaunchKernelGGL(mk_fwd, dim3(grid), dim3(NTHR), LDS_BYTES, stream, a); }
#else
    a.ph_lo = 0; a.ph_hi = 31;
    hipLaunchKernelGGL(mk_fwd, dim3(grid), dim3(NTHR), LDS_BYTES, stream, a);
#endif
    const hipError_t le = hipPeekAtLastError();
    if (le != hipSuccess) fprintf(stderr, "kernel_launch: launch failed: %s\n", hipGetErrorName(le));
}
```

```cpp
#include <hip/hip_runtime.h>
#include <cstdio>
#include <cstdint>

#ifndef MK_MULTI
#define MK_MULTI 0
#endif

#define GAS __attribute__((address_space(1)))
#define LAS __attribute__((address_space(3)))
typedef unsigned short bf16_t;
typedef short bf16x8 __attribute__((ext_vector_type(8)));
typedef short s16x4 __attribute__((ext_vector_type(4)));
typedef float f32x4 __attribute__((ext_vector_type(4)));
typedef float f32x2 __attribute__((ext_vector_type(2)));
typedef float f32x16 __attribute__((ext_vector_type(16)));
typedef unsigned u32x4 __attribute__((ext_vector_type(4)));
typedef unsigned u32x2 __attribute__((ext_vector_type(2)));

constexpr int SEQ = 16384, DM = 2048, DIN = 1856, DINP = 2048;
constexpr int QLR = 512, KVLR = 256, ROPE = 64, NOPE = 128, VHD = 128, QKD = 192, NH = 8;
constexpr int ZQ = 0, ZKV = 512, ZKR = 768, ZU = 832;
constexpr int FNW = 1024, FG = 8;
constexpr int DFF = 5632, NE = 8, DFE = 7168;
constexpr int MAXT = 136;
constexpr float RMS_EPS = 1e-6f;
constexpr float S8_H = 8.f, S8_WGU = 64.f, S8_HID = 8.f, S8_WDN = 128.f;
constexpr int NWAVES = 8, NTHR = 512;

constexpr size_t MiB = 1u << 20;
constexpr size_t WS_CTL = 0, CTL_BYTES = 1 * MiB;
constexpr int CW_BAR = 4096;
constexpr int CW_ECNT = 8192;
constexpr int CW_F3CTR = 12288;
constexpr size_t CTL_ROWTOK = 256 * 1024;
constexpr size_t WS_MODP = 1 * MiB;
constexpr size_t WS_MODV = WS_MODP + 16 * 2 * 12288 * 4;
constexpr size_t WS_COS = 3 * MiB, WS_SIN = 5 * MiB;
constexpr size_t WS_TW = 7 * MiB;
constexpr size_t WS_FM = WS_TW + 131072;
constexpr size_t WS_GM = WS_FM + 65536;
constexpr size_t WS_M12 = 8 * MiB;
constexpr size_t WS_TOKINFO = 9 * MiB;
constexpr size_t WS_TOKPOS = WS_TOKINFO + (size_t)SEQ * 32;
constexpr size_t WS_WIN = 10 * MiB;
constexpr size_t WS_WUQ = WS_WIN + 2 * 8 * MiB;
constexpr size_t WS_WUKV = WS_WUQ + 2 * 1536 * 512 * 2;
constexpr size_t WS_WOUT = WS_WUKV + 2 * 2048 * 256 * 2;
constexpr size_t WS_WGUD = WS_WOUT + 2 * 8 * MiB;
constexpr size_t WS_WDND = WS_WGUD + (size_t)11264 * 2048 * 2;
constexpr size_t WS_WGUM = WS_WDND + (size_t)2048 * 5632 * 2;
constexpr size_t WS_WDNM = WS_WGUM + (size_t)8 * 14336 * 2048 * 2;
constexpr size_t WS_H = WS_WDNM + (size_t)8 * 2048 * 7168 * 2;
constexpr size_t WS_Y = WS_H + (size_t)SEQ * 2048 * 2;
constexpr size_t WS_ARENA = WS_Y + (size_t)MAXT * 256 * 2048 * 2;
constexpr size_t WS_Z = WS_ARENA;
constexpr size_t WS_QB = WS_Z + (size_t)SEQ * 2048 * 2;
constexpr size_t WS_KVB = WS_QB + (size_t)SEQ * 1536 * 2;
constexpr size_t WS_KB = WS_KVB + (size_t)SEQ * 2048 * 2;
constexpr size_t WS_A1 = WS_KB + (size_t)SEQ * 1536 * 2;
constexpr size_t WS_YC = WS_A1 + (size_t)SEQ * 2048 * 2;
constexpr size_t WS_HID = WS_ARENA;
constexpr size_t WS_END = WS_ARENA + (size_t)MAXT * 256 * 7168 * 2;
static_assert(WS_YC + (size_t)SEQ * 2048 * 2 <= WS_END, "arena");
static_assert(WS_END <= (size_t)1900 * MiB, "workspace budget");

constexpr int RING_BYTES = 133120;
constexpr int LDS_COND = RING_BYTES;
constexpr int LDS_TRIG = LDS_COND + 8192;
constexpr int LDS_MISC = LDS_TRIG + 1024;
constexpr int LDS_BYTES = 147456;
static_assert(LDS_MISC + 256 <= LDS_BYTES, "LDS map");

#define LDS_WAIT() asm volatile("s_waitcnt lgkmcnt(0)" ::: "memory")
#define VM_WAIT() asm volatile("s_waitcnt vmcnt(0)" ::: "memory")
#define RLX_AGENT __ATOMIC_RELAXED, __HIP_MEMORY_SCOPE_AGENT

__device__ __forceinline__ unsigned cvt_pk_bf16(float lo, float hi) { unsigned r; asm volatile("v_cvt_pk_bf16_f32 %0, %1, %2" : "=v"(r) : "v"(lo), "v"(hi)); return r; }
__device__ __forceinline__ float bf2f(unsigned short b) { return __uint_as_float(((unsigned)b) << 16); }
__device__ __forceinline__ bf16_t f2bf(float f) { return (bf16_t)(cvt_pk_bf16(f, 0.f) & 0xffffu); }
template <int XM> __device__ __forceinline__ float swz_xor(float v) { return __int_as_float(__builtin_amdgcn_ds_swizzle(__float_as_int(v), (XM << 10) | 0x1f)); }
__device__ __forceinline__ float wave_sum(float v) {
    v += swz_xor<1>(v); v += swz_xor<2>(v); v += swz_xor<4>(v); v += swz_xor<8>(v); v += swz_xor<16>(v);
    auto rr = __builtin_amdgcn_permlane32_swap(__float_as_uint(v), __float_as_uint(v), false, false);
    return __uint_as_float(rr[0]) + __uint_as_float(rr[1]);
}

#define XB_TMO      128
#define XB_XCNT(j)  (256  + 64 * (j))
#define XB_XSUB(j)  (1280 + 64 * (j))
#define XB_XGEN(j)  (2304 + 64 * (j))
#define XB_TOP      3328
#define XB_TOPGEN   3392
#define XCD_BAR_WORDS 3456
#define XB_SPIN_CAP (1u << 18)
__device__ __forceinline__ unsigned xb_ld(unsigned* p)              { return __hip_atomic_load(p, __ATOMIC_RELAXED, __HIP_MEMORY_SCOPE_AGENT); }
__device__ __forceinline__ unsigned xb_add(unsigned* p, unsigned v) { return __hip_atomic_fetch_add(p, v, __ATOMIC_RELAXED, __HIP_MEMORY_SCOPE_AGENT); }
__device__ __forceinline__ unsigned xb_xcc_id() { return (unsigned)__builtin_amdgcn_s_getreg((3 << 11) | 20) & 0xFu; }
#define XB_SPIN(cond, bar) do { unsigned _sp = 0; while (cond) { __builtin_amdgcn_s_sleep(1); \
    if ((++_sp & 255u) == 0u) { if (xb_ld(&(bar)[XB_TMO])) break; if (_sp > XB_SPIN_CAP) { atomicAdd(&(bar)[XB_TMO], 1u); break; } } } } while (0)
struct XcdBarrier { unsigned* bar; unsigned x; volatile LAS unsigned* st; };
__device__ __forceinline__ XcdBarrier xcd_barrier_post(unsigned* bar, volatile LAS unsigned* st) {
    XcdBarrier b; b.bar = bar; b.x = xb_xcc_id(); b.st = st;
    if (threadIdx.x == 0) (void)xb_add(&bar[XB_XCNT(b.x)], 1u);
    return b;
}
__device__ __forceinline__ void xcd_barrier_complete(unsigned* bar, unsigned x, unsigned& nloc, unsigned& nx) {
    const unsigned G = gridDim.x * gridDim.y * gridDim.z;
    unsigned sum, cnt, mine, sp = 0u;
    for (;;) {
        sum = 0u; cnt = 0u; mine = 0u;
#pragma unroll
        for (unsigned j = 0; j < 16; ++j) { const unsigned c = xb_ld(&bar[XB_XCNT(j)]); sum += c; cnt += (c > 0u) ? 1u : 0u; mine = (j == x) ? c : mine; }
        if (sum == G) break;
        __builtin_amdgcn_s_sleep(1);
        if ((++sp & 255u) == 0u) { if (xb_ld(&bar[XB_TMO])) break; if (sp > XB_SPIN_CAP) { atomicAdd(&bar[XB_TMO], 1u); break; } }
    }
    nloc = mine > 0u ? mine : 1u; nx = cnt > 0u ? cnt : 1u;
}
__device__ __forceinline__ void xcd_barrier(const XcdBarrier& b) {
    asm volatile("s_waitcnt vmcnt(0)" ::: "memory");
    __syncthreads();
    if (threadIdx.x == 0) {
        unsigned* bar = b.bar;
        __builtin_amdgcn_s_waitcnt(0);
        unsigned nloc = b.st[0], nx = b.st[1];
        if (nloc == 0u) { xcd_barrier_complete(bar, b.x, nloc, nx); b.st[0] = nloc; b.st[1] = nx; }
        const unsigned old = xb_add(&bar[XB_XSUB(b.x)], 1u);
        const unsigned gen = old / nloc;
        if (old + 1u == (gen + 1u) * nloc) {
            __builtin_amdgcn_fence(__ATOMIC_RELEASE, "agent");
            asm volatile("s_waitcnt vmcnt(0)" ::: "memory");
            const unsigned og = xb_add(&bar[XB_TOP], 1u);
            const unsigned tg = og / nx;
            if (og + 1u == (tg + 1u) * nx) xb_add(&bar[XB_TOPGEN], 1u);
            else XB_SPIN(xb_ld(&bar[XB_TOPGEN]) == tg, bar);
            __builtin_amdgcn_fence(__ATOMIC_ACQUIRE, "agent");
            xb_add(&bar[XB_XGEN(b.x)], 1u);
            asm volatile("s_waitcnt vmcnt(0)" ::: "memory");
        } else {
            XB_SPIN(xb_ld(&bar[XB_XGEN(b.x)]) == gen, bar);
            __builtin_amdgcn_fence(__ATOMIC_ACQUIRE, "agent");
            asm volatile("s_waitcnt vmcnt(0)" ::: "memory");
        }
    }
    __syncthreads();
}

namespace pg8 {
constexpr int BM = 256, BK = 64, HALF = 128, HTB = HALF * BK * 2, STAGE_BYTES = 8 * HTB, NXCD = 8, WGM = 8;
__host__ __device__ __forceinline__ int lds_byte(int r, int c) { const int st = (r >> 4) * 2 + (c >> 5), rr = r & 15, cc = c & 31, ob = rr * 64 + cc * 2; return st * 1024 + (ob ^ (((ob >> 9) & 1) << 5)); }
__host__ __device__ __forceinline__ void stage_rc(int b, int& R, int& C) { const int st = b / 1024, sb = b % 1024, swz = sb ^ (((sb >> 9) & 1) << 5); R = (st >> 1) * 16 + swz / 64; C = (st & 1) * 32 + (swz % 64) / 2; }
__host__ __device__ __forceinline__ int perm32(int rho) { const int n = rho >> 4, i = rho & 15; return 8 * (i >> 2) + 4 * n + (i & 3); }

struct Unit { int pm, pn, e, kq; };
struct Gemm { const void* A; const void* Bt; int lda, ldb, K; size_t estrideB; const int* rowmap; int ktB = 0; };

struct TileOrder {
    int nM, nN, nwg, G, c; int ts[9]; bool moe;
    __device__ __forceinline__ void init(int nM_, int nN_, int G_, int c_) { nM = nM_; nN = nN_; nwg = nM * nN; G = G_; c = c_; moe = false; }
    __device__ __forceinline__ bool next(int i, Unit& u) const {
        const long L = (long)i * G + c; if (L >= nwg) return false;
        int wgid = (int)L; { const int q = nwg / NXCD, r = nwg % NXCD, xcd = wgid % NXCD, off = wgid / NXCD; wgid = (xcd < r ? xcd * (q + 1) : r * (q + 1) + (xcd - r) * q) + off; }
        const int nig = WGM * nN, gid = wgid / nig, fm = gid * WGM, gsz = (nM - fm) < WGM ? (nM - fm) : WGM;
        u.pm = fm + ((wgid % nig) % gsz); u.pn = (wgid % nig) / gsz; u.e = 0; u.kq = 0;
        if (moe) {
#pragma unroll
            for (int j = 1; j < 8; ++j) if (u.pm >= ts[j]) u.e = j;
        }
        return true;
    }
};

struct TailOrder {
    int nsub, G, c, pm0; int ts[9];
    __device__ __forceinline__ bool next(int i, Unit& u) const {
        const int L = i * G + c; if (L >= nsub) return false;
        u.kq = L & 3; u.pn = (L >> 2) & 7; u.pm = pm0 + (L >> 5); u.e = 0;
#pragma unroll
        for (int j = 1; j < 8; ++j) if (u.pm >= ts[j]) u.e = j;
        return true;
    }
};
struct EpiBf16 {
    static constexpr bool PERM = true;
    bf16_t* O; int ldc; float scale; bf16_t* O2 = nullptr; size_t kqstride = 0;
    __device__ __forceinline__ void operator()(const f32x4 (&acc)[2][2][4][2], const Unit& u, int wr, int wc, int fr, int fq) const {
        const int row0 = u.pm * BM + wr * 64 + fr, col0 = u.pn * BM + wc * 32 + 8 * fq;
        bf16_t* const Ob = u.kq ? O2 + (size_t)(u.kq - 1) * kqstride : O;
#pragma unroll
        for (int ai = 0; ai < 2; ++ai)
#pragma unroll
            for (int m = 0; m < 4; ++m) { bf16_t* rowp = Ob + (size_t)(row0 + ai * HALF + m * 16) * ldc + col0;
#pragma unroll
                for (int bj = 0; bj < 2; ++bj) { const f32x4 v0 = acc[ai][bj][m][0] * scale, v1 = acc[ai][bj][m][1] * scale;
                    u32x4 w; w.x = cvt_pk_bf16(v0[0], v0[1]); w.y = cvt_pk_bf16(v0[2], v0[3]); w.z = cvt_pk_bf16(v1[0], v1[1]); w.w = cvt_pk_bf16(v1[2], v1[3]);
                    *(u32x4*)(rowp + bj * HALF) = w; } }
    }
};
__device__ __forceinline__ float silu_f(float x) { return x * __builtin_amdgcn_rcpf(1.0f + __builtin_amdgcn_exp2f(-1.4426950408889634f * x)); }
struct EpiSwiGLU {
    static constexpr bool PERM = true;
    bf16_t* O; int ldc;
    __device__ __forceinline__ void operator()(const f32x4 (&acc)[2][2][4][2], const Unit& u, int wr, int wc, int fr, int fq) const {
        const int row0 = u.pm * BM + wr * 64 + fr, col0 = u.pn * HALF + wc * 32 + 8 * fq;
#pragma unroll
        for (int ai = 0; ai < 2; ++ai)
#pragma unroll
            for (int m = 0; m < 4; ++m) { bf16_t* rowp = O + (size_t)(row0 + ai * HALF + m * 16) * ldc + col0;
                f32x4 v0, v1;
#pragma unroll
                for (int j = 0; j < 4; ++j) { v0[j] = silu_f(acc[ai][0][m][0][j]) * acc[ai][1][m][0][j]; v1[j] = silu_f(acc[ai][0][m][1][j]) * acc[ai][1][m][1][j]; }
                u32x4 w; w.x = cvt_pk_bf16(v0[0], v0[1]); w.y = cvt_pk_bf16(v0[2], v0[3]); w.z = cvt_pk_bf16(v1[0], v1[1]); w.w = cvt_pk_bf16(v1[2], v1[3]);
                *(u32x4*)rowp = w; }
    }
};
__device__ __forceinline__ float clamp448(float x) { return __builtin_amdgcn_fmed3f(x, -448.f, 448.f); }
struct EpiSwiGLU8 {
    static constexpr bool PERM = true;
    unsigned char* O; int ldc; float iscale, oscale;
    __device__ __forceinline__ void operator()(const f32x4 (&acc)[2][2][4][2], const Unit& u, int wr, int wc, int fr, int fq) const {
        const int row0 = u.pm * BM + wr * 64 + fr, col0 = u.pn * HALF + wc * 32 + 8 * fq;
#pragma unroll
        for (int ai = 0; ai < 2; ++ai)
#pragma unroll
            for (int m = 0; m < 4; ++m) { unsigned char* rowp = O + (size_t)(row0 + ai * HALF + m * 16) * ldc + col0;
                f32x4 v0, v1;
#pragma unroll
                for (int j = 0; j < 4; ++j) { v0[j] = clamp448(silu_f(acc[ai][0][m][0][j] * iscale) * (acc[ai][1][m][0][j] * (iscale * oscale)));
                                              v1[j] = clamp448(silu_f(acc[ai][0][m][1][j] * iscale) * (acc[ai][1][m][1][j] * (iscale * oscale))); }
                int w0 = 0, w1 = 0;
                w0 = __builtin_amdgcn_cvt_pk_fp8_f32(v0[0], v0[1], w0, false); w0 = __builtin_amdgcn_cvt_pk_fp8_f32(v0[2], v0[3], w0, true);
                w1 = __builtin_amdgcn_cvt_pk_fp8_f32(v1[0], v1[1], w1, false); w1 = __builtin_amdgcn_cvt_pk_fp8_f32(v1[2], v1[3], w1, true);
                u32x2 w; w.x = (unsigned)w0; w.y = (unsigned)w1; *(u32x2*)rowp = w; }
    }
};
struct EpiRes {
    static constexpr bool PERM = false;
    const float* X; float* O; const float* gate; int ldc;
    __device__ __forceinline__ void operator()(const f32x4 (&acc)[2][2][4][2], const Unit& u, int wr, int wc, int fr, int fq) const {
        const int row0 = u.pm * BM + wr * 64 + fr, col0 = u.pn * BM + wc * 32 + 4 * fq;
        f32x4 gv[2][2];
#pragma unroll
        for (int bj = 0; bj < 2; ++bj)
#pragma unroll
            for (int n = 0; n < 2; ++n) gv[bj][n] = *(const f32x4*)(gate + col0 + bj * HALF + n * 16);
#pragma unroll
        for (int ai = 0; ai < 2; ++ai)
#pragma unroll
            for (int m = 0; m < 4; ++m) { const size_t off = (size_t)(row0 + ai * HALF + m * 16) * ldc + col0;
#pragma unroll
                for (int bj = 0; bj < 2; ++bj)
#pragma unroll
                    for (int n = 0; n < 2; ++n) { const f32x4 xv = *(const f32x4*)(X + off + bj * HALF + n * 16);
                        *(f32x4*)(O + off + bj * HALF + n * 16) = xv + gv[bj][n] * acc[ai][bj][m][n]; }
                asm volatile("" ::: "memory"); }
    }
};

typedef int v8i __attribute__((ext_vector_type(8)));
typedef unsigned u32x8 __attribute__((ext_vector_type(8)));
template <class Epi, class Sched, bool GATHER, bool FP8 = false, bool TILEDB = false>
__device__ __forceinline__ void gemm_phase(const int tid, LAS unsigned char* lds, const Gemm g, const Sched& S, const Epi& E) {
    const int wid = __builtin_amdgcn_readfirstlane(tid >> 6), lane = tid & 63, wr = wid >> 2, wc = wid & 3, fr = lane & 15, fq = lane >> 4;
    constexpr int ESZ = FP8 ? 1 : 2;
    const int nt = g.K * ESZ / (BK * 2);
    unsigned voffA[2], voffB[2];
#pragma unroll
    for (int i = 0; i < 2; ++i) { int R, C; stage_rc(tid * 16 + i * 8192, R, C); const int Rb = Epi::PERM ? ((R & ~31) + perm32(R & 31)) : R;
        voffA[i] = (unsigned)(R * g.lda * ESZ + C * 2); voffB[i] = TILEDB ? (unsigned)(Rb * 128 + C * 2) : (unsigned)(Rb * g.ldb * ESZ + C * 2); }
    const size_t kstep = (size_t)(BK * 2);
    const size_t hstepA = (size_t)HALF * g.lda * ESZ, tstepA = 2 * hstepA;
    const size_t kstepB = TILEDB ? (size_t)32768 : kstep;
    const size_t hstepB = TILEDB ? (size_t)16384 : (size_t)HALF * g.ldb * ESZ, tstepB = TILEDB ? (size_t)(g.ktB ? g.ktB : nt) * 32768 : 2 * hstepB;
    const size_t kqA = (size_t)nt * kstep, kqB = (size_t)nt * kstepB;
    const unsigned ldsw = (unsigned)wid * 1024u;
    const int aoff = lds_byte(wr * 64 + fr, fq * 8), boff = lds_byte(wc * 32 + fr, fq * 8);
#define PG8_SA(b, h) (((b) * 2 + (h)) * HTB)
#define PG8_SB(b, h) ((4 + (b) * 2 + (h)) * HTB)
#define PG8_STAGE(bufoff, gbase, voff) do { _Pragma("unroll") for (int _i = 0; _i < 2; ++_i) \
        __builtin_amdgcn_global_load_lds((const unsigned*)((const char*)(gbase) + (voff)[_i]), (LAS unsigned*)(lds + (bufoff) + ldsw + _i * 8192), 16, 0, 0); } while (0)
#define PG8_STAGE_A(bufoff, UB, h, kb, V0, V1) do { if constexpr (GATHER) { if (h) PG8_STAGE(bufoff, gA + (kb), V1); else PG8_STAGE(bufoff, gA + (kb), V0); } \
        else PG8_STAGE(bufoff, (UB) + (h) * hstepA + (kb), voffA); } while (0)
#define PG8_LD8(P) __builtin_shufflevector(*(const LAS u32x4*)(P), *(const LAS u32x4*)((P) + 1024), 0, 1, 2, 3, 4, 5, 6, 7)
#define PG8_LDA(dst, b, h) do { if constexpr (FP8) { _Pragma("unroll") for (int m = 0; m < 4; ++m) dst##8[m] = PG8_LD8(lds + PG8_SA(b, h) + aoff + m * 2048); } \
        else { _Pragma("unroll") for (int m = 0; m < 4; ++m) _Pragma("unroll") for (int k = 0; k < 2; ++k) dst[m][k] = *(const LAS bf16x8*)(lds + PG8_SA(b, h) + aoff + m * 2048 + k * 1024); } } while (0)
#define PG8_LDB(dst, b, h) do { if constexpr (FP8) { _Pragma("unroll") for (int n = 0; n < 2; ++n) dst##8[n] = PG8_LD8(lds + PG8_SB(b, h) + boff + n * 2048); } \
        else { _Pragma("unroll") for (int n = 0; n < 2; ++n) _Pragma("unroll") for (int k = 0; k < 2; ++k) dst[n][k] = *(const LAS bf16x8*)(lds + PG8_SB(b, h) + boff + n * 2048 + k * 1024); } } while (0)
#define PG8_MMA(ai, bj, At, Bt) do { __builtin_amdgcn_s_setprio(1); _Pragma("unroll") for (int m = 0; m < 4; ++m) _Pragma("unroll") for (int n = 0; n < 2; ++n) { \
        if constexpr (FP8) { asm("v_mfma_scale_f32_16x16x128_f8f6f4 %0, %1, %2, %0, %3, %3 op_sel_hi:[0,0,0]" : "+v"(acc[ai][bj][m][n]) : "v"(Bt##8[n]), "v"(At##8[m]), "v"(sc8)); } \
        else { _Pragma("unroll") for (int k = 0; k < 2; ++k) acc[ai][bj][m][n] = __builtin_amdgcn_mfma_f32_16x16x32_bf16(Bt[n][k], At[m][k], acc[ai][bj][m][n], 0, 0, 0); } } \
        __builtin_amdgcn_s_setprio(0); } while (0)
#define PG8_WAIT_V(n) asm volatile("s_waitcnt vmcnt(" #n ")" ::: "memory")
#define PG8_WAIT_L(n) asm volatile("s_waitcnt lgkmcnt(" #n ")" ::: "memory")
#define PG8_BAR __builtin_amdgcn_s_barrier()
#define PG8_SCHED __builtin_amdgcn_sched_barrier(0)
#define PG8_AOFFS(U, V0, V1) do { _Pragma("unroll") for (int _i = 0; _i < 2; ++_i) { int R_, C_; stage_rc(tid * 16 + _i * 8192, R_, C_); \
        const int r0 = g.rowmap[(U).pm * BM + R_], r1 = g.rowmap[(U).pm * BM + HALF + R_]; \
        V0[_i] = (unsigned)(r0 * g.lda * ESZ + C_ * 2); V1[_i] = (unsigned)(r1 * g.lda * ESZ + C_ * 2); } } while (0)
    Unit cur, nxt; int ui = 0;
    if (!S.next(0, cur)) return;
    f32x4 acc[2][2][4][2];
#pragma unroll
    for (int a = 0; a < 2; ++a)
#pragma unroll
        for (int b = 0; b < 2; ++b)
#pragma unroll
            for (int m = 0; m < 4; ++m)
#pragma unroll
                for (int n = 0; n < 2; ++n) acc[a][b][m][n] = (f32x4){0.f, 0.f, 0.f, 0.f};
    const unsigned sc8 = 0x7f7f7f7fu; (void)sc8;
    bf16x8 At[4][2], B0[2][2], B1[2][2]; u32x8 At8[4], B08[2], B18[2]; (void)At; (void)B0; (void)B1; (void)At8; (void)B08; (void)B18;
    unsigned vc0[2] = {0u, 0u}, vc1[2] = {0u, 0u}, vn0[2] = {0u, 0u}, vn1[2] = {0u, 0u};
    if constexpr (GATHER) PG8_AOFFS(cur, vc0, vc1);
    const char* gA = (const char*)g.A;
    const char* cA = gA + (size_t)cur.pm * tstepA + (size_t)cur.kq * kqA;
    const char* cB = (const char*)g.Bt + (size_t)cur.e * g.estrideB * ESZ + (size_t)cur.pn * tstepB + (size_t)cur.kq * kqB;
    PG8_STAGE(PG8_SB(0, 0), cB, voffB); PG8_STAGE(PG8_SB(0, 1), cB + hstepB, voffB); PG8_STAGE_A(PG8_SA(0, 0), cA, 0, 0, vc0, vc1); PG8_STAGE_A(PG8_SA(0, 1), cA, 1, 0, vc0, vc1);
    if (wr == 1) PG8_BAR;
    PG8_WAIT_V(2); PG8_BAR;
    PG8_STAGE(PG8_SB(1, 0), cB + kstepB, voffB); PG8_STAGE_A(PG8_SA(1, 0), cA, 0, kstep, vc0, vc1); PG8_STAGE(PG8_SB(1, 1), cB + hstepB + kstepB, voffB);
    PG8_WAIT_V(6); PG8_BAR;
    for (;;) {
        const bool has_next = S.next(ui + 1, nxt);
        const char* nA = cA; const char* nB = cB;
        if (has_next) { nA = gA + (size_t)nxt.pm * tstepA + (size_t)nxt.kq * kqA; nB = (const char*)g.Bt + (size_t)nxt.e * g.estrideB * ESZ + (size_t)nxt.pn * tstepB + (size_t)nxt.kq * kqB; }
        if constexpr (GATHER) { if (has_next) PG8_AOFFS(nxt, vn0, vn1); else {
#pragma unroll
            for (int _i = 0; _i < 2; ++_i) { vn0[_i] = vc0[_i]; vn1[_i] = vc1[_i]; } } }
        for (int t = 0; t < nt; t += 2) {
            const bool last = (t == nt - 2);
            const size_t k1 = (size_t)(t + 1) * kstep, k2 = last ? 0 : (size_t)(t + 2) * kstep, k3 = k2 + kstep;
            const char* u2 = last ? nA : cA; const char* b2 = (last ? nB : cB) + (last ? 0 : (size_t)(t + 2) * kstepB); const char* b3 = b2 + kstepB;
            unsigned va0[2] = {0u, 0u}, va1[2] = {0u, 0u};
            if constexpr (GATHER) {
#pragma unroll
                for (int _i = 0; _i < 2; ++_i) { va0[_i] = last ? vn0[_i] : vc0[_i]; va1[_i] = last ? vn1[_i] : vc1[_i]; } }
            PG8_LDB(B0, 0, 0); PG8_LDB(B1, 0, 1); PG8_SCHED; PG8_LDA(At, 0, 0); PG8_STAGE_A(PG8_SA(1, 1), cA, 1, k1, vc0, vc1);
            PG8_WAIT_V(8); PG8_WAIT_L(0); PG8_BAR; PG8_MMA(0, 0, At, B0); PG8_MMA(0, 1, At, B1); PG8_BAR; PG8_SCHED;
            PG8_LDA(At, 0, 1); PG8_STAGE(PG8_SB(0, 0), b2, voffB); PG8_STAGE(PG8_SB(0, 1), b2 + hstepB, voffB); PG8_STAGE_A(PG8_SA(0, 0), u2, 0, k2, va0, va1);
            PG8_WAIT_V(8); PG8_WAIT_L(0); PG8_BAR; PG8_MMA(1, 0, At, B0); PG8_MMA(1, 1, At, B1); PG8_BAR; PG8_SCHED;
            PG8_LDB(B0, 1, 0); PG8_LDB(B1, 1, 1); PG8_SCHED; PG8_LDA(At, 1, 0); PG8_STAGE_A(PG8_SA(0, 1), u2, 1, k2, va0, va1);
            PG8_WAIT_V(8); PG8_WAIT_L(0); PG8_BAR; PG8_MMA(0, 0, At, B0); PG8_MMA(0, 1, At, B1); PG8_BAR; PG8_SCHED;
            PG8_LDA(At, 1, 1); PG8_STAGE(PG8_SB(1, 0), b3, voffB); PG8_STAGE(PG8_SB(1, 1), b3 + hstepB, voffB); PG8_STAGE_A(PG8_SA(1, 0), u2, 0, k3, va0, va1);
            PG8_WAIT_V(8); PG8_WAIT_L(0); PG8_BAR; PG8_MMA(1, 0, At, B0); PG8_MMA(1, 1, At, B1); PG8_BAR; PG8_SCHED;
        }
        if constexpr (FP8) asm volatile("s_nop 15\n\ts_nop 15" ::: "memory");
        if (wr == 0) PG8_BAR;
        { int fr_ = fr, fq_ = fq; asm volatile("" : "+v"(fr_), "+v"(fq_)); E(acc, cur, wr, wc, fr_, fq_); }
        if (!has_next) break;
#pragma unroll
        for (int a = 0; a < 2; ++a)
#pragma unroll
            for (int b = 0; b < 2; ++b)
#pragma unroll
                for (int m = 0; m < 4; ++m)
#pragma unroll
                    for (int n = 0; n < 2; ++n) acc[a][b][m][n] = (f32x4){0.f, 0.f, 0.f, 0.f};
        cur = nxt; cA = nA; cB = nB; ++ui;
        if constexpr (GATHER) {
#pragma unroll
            for (int _i = 0; _i < 2; ++_i) { vc0[_i] = vn0[_i]; vc1[_i] = vn1[_i]; } }
        if (wr == 1) PG8_BAR;
    }
    PG8_WAIT_V(0);
    PG8_BAR;
#undef PG8_SA
#undef PG8_SB
#undef PG8_STAGE
#undef PG8_STAGE_A
#undef PG8_LDA
#undef PG8_LD8
#undef PG8_LDB
#undef PG8_MMA
#undef PG8_WAIT_V
#undef PG8_WAIT_L
#undef PG8_BAR
#undef PG8_SCHED
#undef PG8_AOFFS
}
}

namespace att {
constexpr int NW = 8, QBLK = 32, KVBLK = 64, DQ = QKD, DV = VHD;
constexpr float SCALE = 0.07216878364870322f;
constexpr float THR = 8.f;
constexpr int LDQ = 1536, LDK = 1536, LDV = 2048, LDO = 2048;
constexpr int SHM_V = KVBLK * DV * 2, SHM_K = KVBLK * DQ * 2, SHM_ATTN = 2 * SHM_V + 2 * SHM_K + NW * 64 * 4;
#define KSWZ(row, colB) ((row) * 384 + ((colB) ^ ((((row) >> 1) & 7) << 4)))
#define SBAR() __builtin_amdgcn_sched_barrier(0)
__device__ __forceinline__ int crow(int r, int hi) { return (r & 3) + 8 * (r >> 2) + 4 * hi; }
__device__ __forceinline__ void partialSM(f32x16& p0, f32x16& p1, float& m_reg, float& mn, float& alpha) {
  constexpr float C = SCALE * 1.4426950408889634f;
  float pmax = p0[0];
#pragma unroll
  for (int r = 1; r < 16; ++r) pmax = fmaxf(pmax, p0[r]);
#pragma unroll
  for (int r = 0; r < 16; ++r) pmax = fmaxf(pmax, p1[r]);
  { auto rr = __builtin_amdgcn_permlane32_swap(__float_as_uint(pmax), __float_as_uint(pmax), false, false);
    pmax = fmaxf(__uint_as_float(rr[0]), __uint_as_float(rr[1])); }
  if (__builtin_expect(__all(pmax - m_reg <= THR / SCALE), 1)) { mn = m_reg; alpha = 1.f; }
  else { mn = fmaxf(m_reg, pmax); alpha = __builtin_amdgcn_exp2f((m_reg - mn) * C); m_reg = mn; }
  float mnC = -mn * C;
#pragma unroll
  for (int r = 0; r < 16; ++r) p0[r] = fmaf(p0[r], C, mnC);
#pragma unroll
  for (int r = 0; r < 16; ++r) p1[r] = fmaf(p1[r], C, mnC);
#pragma unroll
  for (int r = 0; r < 16; ++r) p0[r] = __builtin_amdgcn_exp2f(p0[r]);
}
__device__ __forceinline__ void finishSM(f32x16& p0, f32x16& p1, float alpha, float& l_reg, bf16x8& pa0, bf16x8& pa1, bf16x8& pa2, bf16x8& pa3) {
#pragma unroll
  for (int r = 0; r < 16; ++r) p1[r] = __builtin_amdgcn_exp2f(p1[r]);
  float ps = 0;
#pragma unroll
  for (int r = 0; r < 16; ++r) ps += p0[r];
#pragma unroll
  for (int r = 0; r < 16; ++r) ps += p1[r];
  { auto rr = __builtin_amdgcn_permlane32_swap(__float_as_uint(ps), __float_as_uint(ps), false, false);
    ps = __uint_as_float(rr[0]) + __uint_as_float(rr[1]); }
  l_reg = l_reg * alpha + ps;
#define PK4(P, BASE, OUT) do { unsigned a0 = cvt_pk_bf16(P[BASE + 0], P[BASE + 1]), a1 = cvt_pk_bf16(P[BASE + 2], P[BASE + 3]);   \
    unsigned b0 = cvt_pk_bf16(P[BASE + 4], P[BASE + 5]), b1 = cvt_pk_bf16(P[BASE + 6], P[BASE + 7]);                              \
    auto r0 = __builtin_amdgcn_permlane32_swap(a0, b0, false, false); auto r1 = __builtin_amdgcn_permlane32_swap(a1, b1, false, false); \
    u32x4 w = {r0[0], r1[0], r0[1], r1[1]}; OUT = *reinterpret_cast<bf16x8*>(&w); } while (0)
  PK4(p0, 0, pa0); PK4(p0, 8, pa1); PK4(p1, 0, pa2); PK4(p1, 8, pa3);
#undef PK4
}
__device__ __forceinline__ void qkt(f32x16& p0, f32x16& p1, const char* Ks, const bf16x8* qr, int r32, int hi) {
  p0 = f32x16{}; p1 = f32x16{};
#pragma unroll
  for (int d0 = 0; d0 < DQ / 16; ++d0) { int cb = (d0 * 16 + hi * 8) * 2;
    bf16x8 b0 = *reinterpret_cast<const bf16x8*>(Ks + KSWZ(r32, cb));
    bf16x8 b1 = *reinterpret_cast<const bf16x8*>(Ks + KSWZ(32 + r32, cb));
    p0 = __builtin_amdgcn_mfma_f32_32x32x16_bf16(b0, qr[d0], p0, 0, 0, 0);
    p1 = __builtin_amdgcn_mfma_f32_32x32x16_bf16(b1, qr[d0], p1, 0, 0, 0);
    if ((d0 & 3) == 3) SBAR(); }
}
__device__ __forceinline__ int v_st(int k, int c) { const int kk = (k & ~0xC) | ((k & 4) << 1) | ((k & 8) >> 1); return ((kk >> 3) * 4 + (c >> 5)) * 512 + ((kk & 7) * 32 + (c & 31)) * 2; }
__device__ __forceinline__ int v_rd_base(int lane) { return ((lane & 3) << 3) | (((lane >> 2) & 3) << 6) | (((lane >> 4) & 1) << 5) | (((lane >> 5) & 1) << 8); }
constexpr int v_rd_off(int d0, int ks, int half) { return d0 * 512 + ks * 4096 + half * 2048; }
template <int OFF> __device__ __forceinline__ s16x4 tr_read(int vb) {
  s16x4 r; asm volatile("ds_read_b64_tr_b16 %0, %1 offset:%2" : "=&v"(r) : "v"(vb), "i"(OFF) : "memory"); return r;
}
template <int D0> __device__ __forceinline__ void pv_one(f32x16& od, int vb, bf16x8 pa0, bf16x8 pa1, bf16x8 pa2, bf16x8 pa3) {
  const s16x4 l0 = tr_read<v_rd_off(D0, 0, 0)>(vb), h0 = tr_read<v_rd_off(D0, 0, 1)>(vb), l1 = tr_read<v_rd_off(D0, 1, 0)>(vb), h1 = tr_read<v_rd_off(D0, 1, 1)>(vb);
  const s16x4 l2 = tr_read<v_rd_off(D0, 2, 0)>(vb), h2 = tr_read<v_rd_off(D0, 2, 1)>(vb), l3 = tr_read<v_rd_off(D0, 3, 0)>(vb), h3 = tr_read<v_rd_off(D0, 3, 1)>(vb);
  asm volatile("s_waitcnt lgkmcnt(0)" ::: "memory"); SBAR();
#define PK(L, H) (bf16x8){L[0], L[1], L[2], L[3], H[0], H[1], H[2], H[3]}
  od = __builtin_amdgcn_mfma_f32_32x32x16_bf16(pa0, PK(l0, h0), od, 0, 0, 0);
  od = __builtin_amdgcn_mfma_f32_32x32x16_bf16(pa1, PK(l1, h1), od, 0, 0, 0);
  od = __builtin_amdgcn_mfma_f32_32x32x16_bf16(pa2, PK(l2, h2), od, 0, 0, 0);
  od = __builtin_amdgcn_mfma_f32_32x32x16_bf16(pa3, PK(l3, h3), od, 0, 0, 0);
#undef PK
}
#define PV_RD(D0, L, H) do { L[0] = tr_read<v_rd_off(D0, 0, 0)>(vb); H[0] = tr_read<v_rd_off(D0, 0, 1)>(vb); L[1] = tr_read<v_rd_off(D0, 1, 0)>(vb); H[1] = tr_read<v_rd_off(D0, 1, 1)>(vb); \
    L[2] = tr_read<v_rd_off(D0, 2, 0)>(vb); H[2] = tr_read<v_rd_off(D0, 2, 1)>(vb); L[3] = tr_read<v_rd_off(D0, 3, 0)>(vb); H[3] = tr_read<v_rd_off(D0, 3, 1)>(vb); } while (0)
#define PV_MM(OD, L, H) do { OD = __builtin_amdgcn_mfma_f32_32x32x16_bf16(pa0, PKX(L[0], H[0]), OD, 0, 0, 0); OD = __builtin_amdgcn_mfma_f32_32x32x16_bf16(pa1, PKX(L[1], H[1]), OD, 0, 0, 0); \
    OD = __builtin_amdgcn_mfma_f32_32x32x16_bf16(pa2, PKX(L[2], H[2]), OD, 0, 0, 0); OD = __builtin_amdgcn_mfma_f32_32x32x16_bf16(pa3, PKX(L[3], H[3]), OD, 0, 0, 0); } while (0)
#define PKX(L, H) (bf16x8){L[0], L[1], L[2], L[3], H[0], H[1], H[2], H[3]}
__device__ __forceinline__ void pv_d0_pipe(f32x16* o, int vb, bf16x8 pa0, bf16x8 pa1, bf16x8 pa2, bf16x8 pa3) {
  s16x4 la[4], ha[4], lb[4], hb[4];
  PV_RD(0, la, ha);
#define PV_PIN(OD) asm volatile("" : "+v"(OD))
  PV_RD(1, lb, hb); asm volatile("s_waitcnt lgkmcnt(8)" ::: "memory"); SBAR(); PV_MM(o[0], la, ha); PV_PIN(o[0]);
  PV_RD(2, la, ha); asm volatile("s_waitcnt lgkmcnt(8)" ::: "memory"); SBAR(); PV_MM(o[1], lb, hb); PV_PIN(o[1]);
  PV_RD(3, lb, hb); asm volatile("s_waitcnt lgkmcnt(8)" ::: "memory"); SBAR(); PV_MM(o[2], la, ha); PV_PIN(o[2]);
  asm volatile("s_waitcnt lgkmcnt(0)" ::: "memory"); SBAR(); PV_MM(o[3], lb, hb); PV_PIN(o[3]);
#undef PV_PIN
}
__device__ __forceinline__ void pv_fsm(f32x16* o, int vb, bf16x8 pa0, bf16x8 pa1, bf16x8 pa2, bf16x8 pa3, f32x16& p0, f32x16& p1, int negMCbits, s16x4* la, s16x4* ha, s16x4* lb, s16x4* hb) {
  constexpr float C = SCALE * 1.4426950408889634f;
  int nb_ = __builtin_amdgcn_readfirstlane(negMCbits); asm volatile("" : "+s"(nb_)); const float negMC = __builtin_bit_cast(float, nb_);
#define FSQ(q) do { _Pragma("unroll") for (int r_ = (q); r_ < 16; r_ += 4) { float x_ = p1[r_]; asm("" : "+v"(x_)); p0[r_] = fmaf(p0[r_], C, negMC); p1[r_] = fmaf(x_, C, negMC); p0[r_] = __builtin_amdgcn_exp2f(p0[r_]); } } while (0)
#define PV_PIN(OD, q) asm volatile("" :: "v"(OD), "v"(p0[q]), "v"(p0[q + 4]), "v"(p0[q + 8]), "v"(p0[q + 12]), "v"(p1[q]), "v"(p1[q + 4]), "v"(p1[q + 8]), "v"(p1[q + 12]))
#define PV_WAIT(N, L, H) asm volatile("s_waitcnt lgkmcnt(" #N ")" : "+v"(L[0]), "+v"(H[0]), "+v"(L[1]), "+v"(H[1]), "+v"(L[2]), "+v"(H[2]), "+v"(L[3]), "+v"(H[3]) :: "memory")
  PV_RD(1, lb, hb); PV_WAIT(8, la, ha); SBAR(); PV_MM(o[0], la, ha); FSQ(0); PV_PIN(o[0], 0);
  PV_RD(2, la, ha); PV_WAIT(8, lb, hb); SBAR(); PV_MM(o[1], lb, hb); FSQ(1); PV_PIN(o[1], 1);
  PV_RD(3, lb, hb); PV_WAIT(8, la, ha); SBAR(); PV_MM(o[2], la, ha); FSQ(2); FSQ(3); PV_PIN(o[2], 2); PV_PIN(o[2], 3);
  PV_WAIT(0, lb, hb);
#undef FSQ
#undef PV_PIN
#undef PV_WAIT
}
#undef PV_RD
#undef PV_MM
#undef PKX
__device__ __forceinline__ void pv_d0(f32x16* o, int vb, bf16x8 pa0, bf16x8 pa1, bf16x8 pa2, bf16x8 pa3) {
  pv_one<0>(o[0], vb, pa0, pa1, pa2, pa3); pv_one<1>(o[1], vb, pa0, pa1, pa2, pa3); pv_one<2>(o[2], vb, pa0, pa1, pa2, pa3); pv_one<3>(o[3], vb, pa0, pa1, pa2, pa3);
}


constexpr int K_OFF = 0, V_OFF = 3 * SHM_K, WS_OFF = V_OFF + 3 * SHM_V, SHM_ATTN2 = WS_OFF + NW * 64 * 4;
constexpr int KOFS_OFF = SHM_ATTN2;
__device__ __forceinline__ void qkt_l(f32x16& p0, f32x16& p1, LAS const char* Ks, const bf16x8* qr, int r32, int hi) {
  p0 = f32x16{}; p1 = f32x16{};
  __builtin_amdgcn_s_setprio(1);
  const int swz = ((r32 >> 1) & 7) << 4, rowb = r32 * 384;
  LAS const char* ar[4];
#pragma unroll
  for (int r = 0; r < 4; ++r) ar[r] = Ks + rowb + ((32 * r + 16 * hi) ^ swz);
#pragma unroll
  for (int q = 0; q < DQ / 64; ++q)
#pragma unroll
    for (int r = 0; r < 4; ++r) { const int d0 = 4 * q + r;
      bf16x8 b0 = *reinterpret_cast<LAS const bf16x8*>(ar[r] + 128 * q);
      bf16x8 b1 = *reinterpret_cast<LAS const bf16x8*>(ar[r] + 128 * q + 32 * 384);
      p0 = __builtin_amdgcn_mfma_f32_32x32x16_bf16(b0, qr[d0], p0, 0, 0, 0);
      p1 = __builtin_amdgcn_mfma_f32_32x32x16_bf16(b1, qr[d0], p1, 0, 0, 0);
      if (r == 3 && d0 != DQ / 16 - 1) SBAR(); }
  __builtin_amdgcn_s_setprio(0);
}
__device__ __forceinline__ void qkt_l2(f32x16& p0, f32x16& p1, LAS const char* Ks, const bf16x8* qr, int r32, int hi) {
  p0 = f32x16{}; p1 = f32x16{};
  const int swz = ((r32 >> 1) & 7) << 4, rowb = r32 * 384;
  LAS const char* ar[4];
#pragma unroll
  for (int r = 0; r < 4; ++r) ar[r] = Ks + rowb + ((32 * r + 16 * hi) ^ swz);
#pragma unroll
  for (int q = 0; q < DQ / 64; ++q)
#pragma unroll
    for (int r = 0; r < 4; ++r) { const int d0 = 4 * q + r;
      bf16x8 b0 = *reinterpret_cast<LAS const bf16x8*>(ar[r] + 128 * q);
      bf16x8 b1 = *reinterpret_cast<LAS const bf16x8*>(ar[r] + 128 * q + 32 * 384);
      p0 = __builtin_amdgcn_mfma_f32_32x32x16_bf16(b0, qr[d0], p0, 0, 0, 0);
      p1 = __builtin_amdgcn_mfma_f32_32x32x16_bf16(b1, qr[d0], p1, 0, 0, 0);
    }
}
__device__ __forceinline__ float psm_max(const f32x16& p) { float m = p[0];
#pragma unroll
  for (int r = 1; r < 16; ++r) m = fmaxf(m, p[r]);
  return m; }
__device__ __forceinline__ void psm_decide(float pmax, float& m_reg, float& mnC, float& alpha) {
  constexpr float C = SCALE * 1.4426950408889634f;
  { auto rr = __builtin_amdgcn_permlane32_swap(__float_as_uint(pmax), __float_as_uint(pmax), false, false);
    pmax = fmaxf(__uint_as_float(rr[0]), __uint_as_float(rr[1])); }
  float mn;
  if (__builtin_expect(__all(pmax - m_reg <= THR / SCALE), 1)) { mn = m_reg; alpha = 1.f; }
  else { mn = fmaxf(m_reg, pmax); alpha = __builtin_amdgcn_exp2f((m_reg - mn) * C); m_reg = mn; }
  mnC = -mn * C;
}
__device__ __forceinline__ void psm_scale(f32x16& p, float mnC) { constexpr float C = SCALE * 1.4426950408889634f;
#pragma unroll
  for (int r = 0; r < 16; ++r) p[r] = fmaf(p[r], C, mnC); }
__device__ __forceinline__ void psm_exp(f32x16& p) {
#pragma unroll
  for (int r = 0; r < 16; ++r) p[r] = __builtin_amdgcn_exp2f(p[r]); }

__device__ __forceinline__ void fsm_first(f32x16& p0, f32x16& p1, int negMCbits) {
  constexpr float C = SCALE * 1.4426950408889634f;
  int nb_ = __builtin_amdgcn_readfirstlane(negMCbits); asm volatile("" : "+s"(nb_)); const float negMC = __builtin_bit_cast(float, nb_);
#pragma unroll
  for (int r = 0; r < 16; ++r) p0[r] = fmaf(p0[r], C, negMC);
#pragma unroll
  for (int r = 0; r < 16; ++r) p1[r] = fmaf(p1[r], C, negMC);
#pragma unroll
  for (int r = 0; r < 16; ++r) p0[r] = __builtin_amdgcn_exp2f(p0[r]);
}
__device__ __forceinline__ void fsm_finish(f32x16& p0, f32x16& p1, float& l_reg, bf16x8& pa0, bf16x8& pa1, bf16x8& pa2, bf16x8& pa3) {
#pragma unroll
  for (int r = 0; r < 16; ++r) p1[r] = __builtin_amdgcn_exp2f(p1[r]);
  float ps = 0;
#pragma unroll
  for (int r = 0; r < 16; ++r) ps += p0[r];
#pragma unroll
  for (int r = 0; r < 16; ++r) ps += p1[r];
  { auto rr = __builtin_amdgcn_permlane32_swap(__float_as_uint(ps), __float_as_uint(ps), false, false);
    ps = __uint_as_float(rr[0]) + __uint_as_float(rr[1]); }
  l_reg += ps;
#define PK4(P, BASE, OUT) do { unsigned a0 = cvt_pk_bf16(P[BASE + 0], P[BASE + 1]), a1 = cvt_pk_bf16(P[BASE + 2], P[BASE + 3]);   \
    unsigned b0 = cvt_pk_bf16(P[BASE + 4], P[BASE + 5]), b1 = cvt_pk_bf16(P[BASE + 6], P[BASE + 7]);                              \
    auto r0 = __builtin_amdgcn_permlane32_swap(a0, b0, false, false); auto r1 = __builtin_amdgcn_permlane32_swap(a1, b1, false, false); \
    u32x4 w = {r0[0], r1[0], r0[1], r1[1]}; OUT = *reinterpret_cast<bf16x8*>(&w); } while (0)
  PK4(p0, 0, pa0); PK4(p0, 8, pa1); PK4(p1, 0, pa2); PK4(p1, 8, pa3);
#undef PK4
}
struct DmaT { const char* gK; const char* gV; LAS unsigned char* lK; LAS unsigned char* lV; int kofs; unsigned v0, v1; };
__device__ __forceinline__ void qk_fsm(f32x16& p0, f32x16& p1, int ksb, const bf16x8* qr, int r32, int hi, f32x16& f0, f32x16& f1, float& l_reg, bf16x8& pa0, bf16x8& pa1, bf16x8& pa2, bf16x8& pa3, const DmaT d, s16x4* la, s16x4* ha, int vb, f32x16& o3, const s16x4* lb, const s16x4* hb) {
  const int swz = ((r32 >> 1) & 7) << 4, rowb = r32 * 384;
  int ar[4];
#pragma unroll
  for (int r = 0; r < 4; ++r) ar[r] = ksb + rowb + ((32 * r + 16 * hi) ^ swz);
  bf16x8 ka[4], kb[4];
#define KRD(dst, d0, h) asm volatile("ds_read_b128 %0, %1 offset:%2" : "=v"(dst) : "v"(ar[(d0) & 3]), "i"(128 * ((d0) >> 2) + 12288 * (h)))
#define KRD4(B, s) do { KRD(B[0], 2 * (s), 0); KRD(B[1], 2 * (s), 1); KRD(B[2], 2 * (s) + 1, 0); KRD(B[3], 2 * (s) + 1, 1); } while (0)
#define KWAIT(N, B) asm volatile("s_waitcnt lgkmcnt(" #N ")" : "+v"(B[0]), "+v"(B[1]), "+v"(B[2]), "+v"(B[3]))
#define KMM(B, s) do { p0 = __builtin_amdgcn_mfma_f32_32x32x16_bf16(B[0], qr[2 * (s)], p0, 0, 0, 0); p1 = __builtin_amdgcn_mfma_f32_32x32x16_bf16(B[1], qr[2 * (s)], p1, 0, 0, 0); \
    p0 = __builtin_amdgcn_mfma_f32_32x32x16_bf16(B[2], qr[2 * (s) + 1], p0, 0, 0, 0); p1 = __builtin_amdgcn_mfma_f32_32x32x16_bf16(B[3], qr[2 * (s) + 1], p1, 0, 0, 0); } while (0)
#define PK4(P, BASE, OUT) do { unsigned a0 = cvt_pk_bf16(P[BASE + 0], P[BASE + 1]), a1 = cvt_pk_bf16(P[BASE + 2], P[BASE + 3]);   \
    unsigned b0 = cvt_pk_bf16(P[BASE + 4], P[BASE + 5]), b1 = cvt_pk_bf16(P[BASE + 6], P[BASE + 7]);                              \
    auto r0 = __builtin_amdgcn_permlane32_swap(a0, b0, false, false); auto r1 = __builtin_amdgcn_permlane32_swap(a1, b1, false, false); \
    u32x4 w = {r0[0], r1[0], r0[1], r1[1]}; OUT = *reinterpret_cast<bf16x8*>(&w); } while (0)
  p0 = f32x16{}; p1 = f32x16{};
  u32x4 ko; asm volatile("ds_read_b128 %0, %1" : "=v"(ko) : "v"(d.kofs));
#define DMA_PK(i_) __builtin_amdgcn_global_load_lds((const unsigned*)(d.gK + ko[i_]), (LAS unsigned*)(d.lK + 8192 * (i_)), 16, 0, 0)
#define DMA_PV(i_, vo_) __builtin_amdgcn_global_load_lds((const unsigned*)(d.gV + (vo_)), (LAS unsigned*)(d.lV + 8192 * (i_)), 16, 0, 0)
  KRD4(ka, 0); KRD4(kb, 1);
#define PKX(L, H) (bf16x8){L[0], L[1], L[2], L[3], H[0], H[1], H[2], H[3]}
  o3 = __builtin_amdgcn_mfma_f32_32x32x16_bf16(pa0, PKX(lb[0], hb[0]), o3, 0, 0, 0); o3 = __builtin_amdgcn_mfma_f32_32x32x16_bf16(pa1, PKX(lb[1], hb[1]), o3, 0, 0, 0);
  o3 = __builtin_amdgcn_mfma_f32_32x32x16_bf16(pa2, PKX(lb[2], hb[2]), o3, 0, 0, 0); o3 = __builtin_amdgcn_mfma_f32_32x32x16_bf16(pa3, PKX(lb[3], hb[3]), o3, 0, 0, 0);
#undef PKX
#pragma unroll
  for (int r = 0; r < 16; ++r) f1[r] = __builtin_amdgcn_exp2f(f1[r]);
  asm volatile("" :: "v"(o3), "v"(f1[0]), "v"(f1[1]), "v"(f1[2]), "v"(f1[3]), "v"(f1[4]), "v"(f1[5]), "v"(f1[6]), "v"(f1[7]), "v"(f1[8]), "v"(f1[9]), "v"(f1[10]), "v"(f1[11]), "v"(f1[12]), "v"(f1[13]), "v"(f1[14]), "v"(f1[15]));
  KWAIT(4, ka); asm volatile("" : "+v"(ko)); KMM(ka, 0);
  DMA_PK(0);
  asm volatile("" :: "v"(p0), "v"(p1));
  KRD4(ka, 2); KWAIT(4, kb); KMM(kb, 1);
  DMA_PK(1);
  float ps = 0;
#pragma unroll
  for (int r = 0; r < 8; ++r) ps += f0[r];
  asm volatile("" :: "v"(p0), "v"(p1), "v"(ps));
  KRD4(kb, 3); KWAIT(4, ka); KMM(ka, 2);
  DMA_PK(2);
#pragma unroll
  for (int r = 8; r < 16; ++r) ps += f0[r];
  asm volatile("" :: "v"(p0), "v"(p1), "v"(ps));
  KRD4(ka, 4); KWAIT(4, kb); KMM(kb, 3);
  DMA_PV(0, d.v0);
#pragma unroll
  for (int r = 0; r < 16; ++r) ps += f1[r];
  { auto rr = __builtin_amdgcn_permlane32_swap(__float_as_uint(ps), __float_as_uint(ps), false, false);
    ps = __uint_as_float(rr[0]) + __uint_as_float(rr[1]); }
  l_reg += ps;
  asm volatile("" :: "v"(p0), "v"(p1), "v"(l_reg));
  KRD4(kb, 5); KWAIT(4, ka); KMM(ka, 4);
  DMA_PV(1, d.v1);
  PK4(f0, 0, pa0); PK4(f0, 8, pa1);
  asm volatile("" :: "v"(p0), "v"(p1), "v"(pa0), "v"(pa1));
  KWAIT(0, kb);
  la[0] = tr_read<v_rd_off(0, 0, 0)>(vb); ha[0] = tr_read<v_rd_off(0, 0, 1)>(vb); la[1] = tr_read<v_rd_off(0, 1, 0)>(vb); ha[1] = tr_read<v_rd_off(0, 1, 1)>(vb);
  la[2] = tr_read<v_rd_off(0, 2, 0)>(vb); ha[2] = tr_read<v_rd_off(0, 2, 1)>(vb); la[3] = tr_read<v_rd_off(0, 3, 0)>(vb); ha[3] = tr_read<v_rd_off(0, 3, 1)>(vb);
  KMM(kb, 5);
  PK4(f1, 0, pa2); PK4(f1, 8, pa3);
  asm volatile("" :: "v"(p0), "v"(p1), "v"(pa2), "v"(pa3));
#undef KRD
#undef KRD4
#undef KWAIT
#undef KMM
#undef PK4
#undef DMA_PK
#undef DMA_PV
}
__device__ __forceinline__ void attn_unit2(const bf16_t* __restrict__ Qb, const bf16_t* __restrict__ Kh, const bf16_t* __restrict__ Vh, bf16_t* __restrict__ Ob, int seq, LAS unsigned char* lds, const int tid, const int negMC) {
  const int wid = __builtin_amdgcn_readfirstlane(tid >> 6), lane = tid & 63, r32 = lane & 31, hi = lane >> 5;
  LAS float* ws = (LAS float*)(lds + WS_OFF) + wid * 64; LAS float* li_l = ws; LAS float* al_l = ws + 32;
  float l_reg = 0; f32x16 o[4] = {}; bf16x8 qr[DQ / 16];
  const bf16_t* Qw = Qb + (long)(wid * QBLK + r32) * LDQ + hi * 8;
#pragma unroll
  for (int d0 = 0; d0 < DQ / 16; ++d0) qr[d0] = *reinterpret_cast<const bf16x8*>(Qw + d0 * 16);
#define KOFF(i_, ln_) ({ const int b_ = 1024 * (wid + 8 * (i_)) + 16 * (ln_), row_ = b_ / 384, x_ = b_ % 384; (unsigned)(row_ * LDK * 2 + (x_ ^ (((row_ >> 1) & 7) << 4))); })
  unsigned voff[2];
#pragma unroll
  for (int i = 0; i < 2; ++i) { const int b = 1024 * (wid + 8 * i) + 16 * lane, st = b >> 9, off = b & 511, kk = (st >> 2) * 8 + (off >> 6), c = (st & 3) * 32 + ((off & 63) >> 1);
    const int k = (kk & ~0xC) | ((kk & 4) << 1) | ((kk & 8) >> 1); voff[i] = (unsigned)(k * LDV * 2 + c * 2); }
  const int NT = seq / KVBLK;
  const int kofs = (int)(uintptr_t)(lds + KOFS_OFF) + tid * 16;
  { u32x4 kv_ = {KOFF(0, lane), KOFF(1, lane), KOFF(2, lane), 0u}; asm volatile("ds_write_b128 %0, %1" :: "v"(kofs), "v"(kv_) : "memory"); }
#define DMAT(tk, ks, tv, vs) att::DmaT{(const char*)Kh + (size_t)((tk) < NT ? (tk) : NT - 1) * (KVBLK * LDK * 2), (const char*)Vh + (size_t)((tv) < NT ? (tv) : NT - 1) * (KVBLK * LDV * 2), \
    lds + K_OFF + (ks) * SHM_K + wid * 1024, lds + V_OFF + (vs) * SHM_V + wid * 1024, kofs, voff[0], voff[1]}
#define DMA_K(t, slot) do { const int t_ = (t) < NT ? (t) : NT - 1; const char* g_ = (const char*)Kh + (size_t)t_ * (KVBLK * LDK * 2); int ln_ = lane; asm volatile("" : "+v"(ln_)); _Pragma("unroll") for (int i_ = 0; i_ < 3; ++i_) \
    __builtin_amdgcn_global_load_lds((const unsigned*)(g_ + KOFF(i_, ln_)), (LAS unsigned*)(lds + K_OFF + (slot) * SHM_K + (wid + 8 * i_) * 1024), 16, 0, 0); } while (0)
#define DMA_V(t, slot) do { const int t_ = (t) < NT ? (t) : NT - 1; const char* g_ = (const char*)Vh + (size_t)t_ * (KVBLK * LDV * 2); _Pragma("unroll") for (int i_ = 0; i_ < 2; ++i_) \
    __builtin_amdgcn_global_load_lds((const unsigned*)(g_ + voff[i_]), (LAS unsigned*)(lds + V_OFF + (slot) * SHM_V + (wid + 8 * i_) * 1024), 16, 0, 0); } while (0)
#define QK_PACE() do { _Pragma("unroll") for (int g_ = 0; g_ < 12; ++g_) { __builtin_amdgcn_sched_group_barrier(0x100, 2, 0); __builtin_amdgcn_sched_group_barrier(0x008, 2, 0); __builtin_amdgcn_sched_group_barrier(0x002, 8, 0); } } while (0)
#define WAITBAR() do { asm volatile("s_waitcnt vmcnt(5) lgkmcnt(0)" ::: "memory"); __builtin_amdgcn_s_barrier(); asm volatile("" ::: "memory"); } while (0)
  const int vbase = (int)(uintptr_t)(lds + V_OFF) + v_rd_base(lane);
  f32x16 pA0, pA1, pB0, pB1; bf16x8 pa0 = {}, pa1 = {}, pa2 = {}, pa3 = {};
  s16x4 la[4], ha[4], lb[4] = {}, hb[4] = {};
  DMA_K(0, 0); DMA_K(1, 1); DMA_V(0, 0);
  WAITBAR();
  DMA_K(2, 2); DMA_V(1, 1);
  qkt_l(pA0, pA1, (LAS const char*)(lds + K_OFF), qr, r32, hi); fsm_first(pA0, pA1, negMC);
  WAITBAR();
  int a = 1;
  for (int t = 1; t + 1 < NT; t += 2) {
    { const int kd = (a + 2) % 3, vd = (a + 1) % 3;
      SBAR(); __builtin_amdgcn_s_setprio(1); qk_fsm(pB0, pB1, (int)(uintptr_t)(lds + K_OFF) + a * SHM_K, qr, r32, hi, pA0, pA1, l_reg, pa0, pa1, pa2, pa3, DMAT(t + 2, kd, t + 1, vd), la, ha, vbase + kd * SHM_V, o[3], lb, hb); __builtin_amdgcn_s_setprio(0); SBAR();
      pv_fsm(o, vbase + kd * SHM_V, pa0, pa1, pa2, pa3, pB0, pB1, negMC, la, ha, lb, hb);
      WAITBAR(); a = (a + 1) % 3; }
    { const int kd = (a + 2) % 3, vd = (a + 1) % 3;
      SBAR(); __builtin_amdgcn_s_setprio(1); qk_fsm(pA0, pA1, (int)(uintptr_t)(lds + K_OFF) + a * SHM_K, qr, r32, hi, pB0, pB1, l_reg, pa0, pa1, pa2, pa3, DMAT(t + 3, kd, t + 2, vd), la, ha, vbase + kd * SHM_V, o[3], lb, hb); __builtin_amdgcn_s_setprio(0); SBAR();
      pv_fsm(o, vbase + kd * SHM_V, pa0, pa1, pa2, pa3, pA0, pA1, negMC, la, ha, lb, hb);
      WAITBAR(); a = (a + 1) % 3; }
  }
  { const int kd = (a + 2) % 3, vd = (a + 1) % 3;
    SBAR(); __builtin_amdgcn_s_setprio(1); qk_fsm(pB0, pB1, (int)(uintptr_t)(lds + K_OFF) + a * SHM_K, qr, r32, hi, pA0, pA1, l_reg, pa0, pa1, pa2, pa3, DMAT(NT - 1, kd, NT - 1, vd), la, ha, vbase + kd * SHM_V, o[3], lb, hb); __builtin_amdgcn_s_setprio(0); SBAR();
    pv_fsm(o, vbase + kd * SHM_V, pa0, pa1, pa2, pa3, pB0, pB1, negMC, la, ha, lb, hb);
      WAITBAR(); a = (a + 1) % 3; }
  { const int kd = (a + 2) % 3;
#define PKX(L, H) (bf16x8){L[0], L[1], L[2], L[3], H[0], H[1], H[2], H[3]}
    o[3] = __builtin_amdgcn_mfma_f32_32x32x16_bf16(pa0, PKX(lb[0], hb[0]), o[3], 0, 0, 0); o[3] = __builtin_amdgcn_mfma_f32_32x32x16_bf16(pa1, PKX(lb[1], hb[1]), o[3], 0, 0, 0);
    o[3] = __builtin_amdgcn_mfma_f32_32x32x16_bf16(pa2, PKX(lb[2], hb[2]), o[3], 0, 0, 0); o[3] = __builtin_amdgcn_mfma_f32_32x32x16_bf16(pa3, PKX(lb[3], hb[3]), o[3], 0, 0, 0);
#undef PKX
    asm volatile("" : "+v"(o[3]));
    fsm_finish(pB0, pB1, l_reg, pa0, pa1, pa2, pa3); SBAR();
    pv_d0_pipe(o, vbase + kd * SHM_V, pa0, pa1, pa2, pa3); }
  int lne; asm volatile("v_mbcnt_lo_u32_b32 %0, -1, 0\n\tv_mbcnt_hi_u32_b32 %0, -1, %0" : "=v"(lne));
  const int r32e = lne & 31, hie = lne >> 5;
  if (hie == 0) li_l[r32e] = l_reg; asm volatile("s_waitcnt lgkmcnt(0)" ::: "memory");
  float rli[16];
#pragma unroll
  for (int r = 0; r < 16; ++r) rli[r] = __builtin_amdgcn_rcpf(li_l[crow(r, hie)]);
  bf16_t* Ow = Ob + (long)(wid * QBLK) * LDO;
#pragma unroll
  for (int r = 0; r < 16; ++r) { int orow = crow(r, hie);
#pragma unroll
    for (int d0 = 0; d0 < 4; ++d0) Ow[(long)orow * LDO + d0 * 32 + r32e] = f2bf(o[d0][r] * rli[r]); }
  asm volatile("s_waitcnt vmcnt(0) lgkmcnt(0)" ::: "memory"); __builtin_amdgcn_s_barrier(); asm volatile("" ::: "memory");
#undef DMA_K
#undef KOFF
#undef DMAT
#undef DMA_V
#undef WAITBAR
}
}

namespace sg {
using att::v_st; using att::v_rd_base; using att::pv_d0; using att::crow;
template <int KK> __device__ __forceinline__ void load_b(bf16x8* v, const bf16_t* Bsrc, size_t ldb, const int tid) {
    const int n = (tid & 15) * 8;
#pragma unroll
    for (int i = 0; i < KK / 32; ++i) { const int k = (tid >> 4) + 32 * i; v[i] = *(const bf16x8*)(Bsrc + (size_t)k * ldb + n); }
}
template <int KK> __device__ __forceinline__ void write_b(const bf16x8* v, char* lds, const int tid) {
    const int n = (tid & 15) * 8;
#pragma unroll
    for (int i = 0; i < KK / 32; ++i) { const int k = (tid >> 4) + 32 * i; *(bf16x8*)(lds + (k >> 6) * 16384 + v_st(k & 63, n)) = v[i]; }
}
template <int KK> __device__ __forceinline__ void stage_b(const bf16_t* Bsrc, size_t ldb, char* lds, const int tid) { bf16x8 v[KK / 32]; load_b<KK>(v, Bsrc, ldb, tid); write_b<KK>(v, lds, tid); }
constexpr int OST_PITCH = 272, OST_WAVE = 32 * OST_PITCH, OST_OFF = 65536;
template <class RowPtr>
__device__ __forceinline__ void store_tile(const f32x16* o, LAS unsigned char* ost, int lane, const RowPtr& rowptr) {
    const int r32 = lane & 31, hi = lane >> 5; const bool odd = lane & 1;
#pragma unroll
    for (int pr = 0; pr < 8; ++pr)
#pragma unroll
        for (int d0 = 0; d0 < 4; ++d0) { const float a = o[d0][2 * pr], b = o[d0][2 * pr + 1];
            const float x = odd ? a : b;
            const float y = __int_as_float(__builtin_amdgcn_mov_dpp(__float_as_int(x), 0xB1, 0xf, 0xf, true));
            const unsigned w = odd ? cvt_pk_bf16(y, b) : cvt_pk_bf16(a, y);
            const int row = crow(odd ? 2 * pr + 1 : 2 * pr, hi);
            *(LAS unsigned*)(ost + row * OST_PITCH + (32 * d0 + (r32 & ~1)) * 2) = w; }
    asm volatile("s_waitcnt lgkmcnt(0)" ::: "memory");
#pragma unroll
    for (int j = 0; j < 8; ++j) { const int i = (lane >> 4) + 4 * j; const u32x4 v = *(const LAS u32x4*)(ost + i * OST_PITCH + (lane & 15) * 16);
        *(u32x4*)(rowptr(i) + (lane & 15) * 8) = v; }
    asm volatile("s_waitcnt lgkmcnt(0)" ::: "memory");
}
struct RowF1 { bf16_t* a1; int wave, s2, cc; __device__ __forceinline__ bf16_t* operator()(int i) const { return a1 + ((size_t)(32 * wave + i) * 128 + s2) * 1024 + cc * 128; } };
struct RowF2 { bf16_t* yc; int wave, k1, g; __device__ __forceinline__ bf16_t* operator()(int i) const { const int m = 32 * wave + i; return yc + (size_t)(k1 + 128 * (m & 127)) * 2048 + g * 256 + (m >> 7) * 128; } };
struct RowF3 { bf16_t* hb; int wave, tt, g; __device__ __forceinline__ bf16_t* operator()(int i) const { return hb + (size_t)(256 * tt + 32 * wave + i) * 2048 + 1024 + g * 128; } };
template <int KK> __device__ __forceinline__ void mm(f32x16* o, const bf16x8* A, char* lds, int lane) {
    const int vb0 = (int)(uintptr_t)lds + v_rd_base(lane);
#pragma unroll
    for (int t = 0; t < KK / 64; ++t) pv_d0(o, vb0 + t * 16384, A[4 * t], A[4 * t + 1], A[4 * t + 2], A[4 * t + 3]);
}
}

struct Args { const void* in[24]; float* out; unsigned char* ws; int ph_lo, ph_hi; };

__device__ __forceinline__ u32x2 pack4(f32x4 v) { u32x2 w; w.x = cvt_pk_bf16(v[0], v[1]); w.y = cvt_pk_bf16(v[2], v[3]); return w; }

template <bool FP8, bool TILED = false>
__device__ __forceinline__ void cvt_pair(const float* W, int N, void* WT, int ldd, int k0, int n0, int drow0, float scale, LAS float* scr, int lane) {
    const int lr = lane >> 4, lc = (lane & 15) * 4;
    f32x4 v[2][16];
#pragma unroll
    for (int t = 0; t < 2; ++t)
#pragma unroll
        for (int i = 0; i < 16; ++i) v[t][i] = *(const f32x4*)(W + (size_t)(k0 + 64 * t + 4 * i + lr) * N + n0 + lc);
    const int c = lane & 7;
#pragma unroll
    for (int t = 0; t < 2; ++t) {
#pragma unroll
        for (int i = 0; i < 16; ++i) { LAS float* s = scr + (4 * i + lr) * 65 + lc; s[0] = v[t][i][0]; s[1] = v[t][i][1]; s[2] = v[t][i][2]; s[3] = v[t][i][3]; }
        LDS_WAIT(); asm volatile("" ::: "memory");
#pragma unroll
        for (int j = 0; j < 8; ++j) { const int n = (lane >> 3) + 8 * j; const LAS float* s = scr + (8 * c) * 65 + n;
            if constexpr (!FP8) { u32x4 o; o.x = cvt_pk_bf16(s[0 * 65], s[1 * 65]); o.y = cvt_pk_bf16(s[2 * 65], s[3 * 65]); o.z = cvt_pk_bf16(s[4 * 65], s[5 * 65]); o.w = cvt_pk_bf16(s[6 * 65], s[7 * 65]);
                *(u32x4*)((bf16_t*)WT + (size_t)(drow0 + n) * ldd + k0 + 64 * t + 8 * c) = o; }
            else { int w0 = 0, w1 = 0;
                w0 = __builtin_amdgcn_cvt_pk_fp8_f32(pg8::clamp448(s[0 * 65] * scale), pg8::clamp448(s[1 * 65] * scale), w0, false); w0 = __builtin_amdgcn_cvt_pk_fp8_f32(pg8::clamp448(s[2 * 65] * scale), pg8::clamp448(s[3 * 65] * scale), w0, true);
                w1 = __builtin_amdgcn_cvt_pk_fp8_f32(pg8::clamp448(s[4 * 65] * scale), pg8::clamp448(s[5 * 65] * scale), w1, false); w1 = __builtin_amdgcn_cvt_pk_fp8_f32(pg8::clamp448(s[6 * 65] * scale), pg8::clamp448(s[7 * 65] * scale), w1, true);
                u32x2 o; o.x = (unsigned)w0; o.y = (unsigned)w1;
                if constexpr (TILED) { const int dr = drow0 + n;
                    *(u32x2*)((unsigned char*)WT + ((size_t)(dr >> 8) * (ldd >> 7) + (k0 >> 7)) * 32768 + (dr & 255) * 128 + 64 * t + 8 * c) = o; }
                else *(u32x2*)((unsigned char*)WT + (size_t)(drow0 + n) * ldd + k0 + 64 * t + 8 * c) = o; } }
        LDS_WAIT(); asm volatile("" ::: "memory");
    }
}

typedef __attribute__((address_space(4))) const char* karg_cptr;
__device__ __forceinline__ void* karg_ptr(int k) {
    karg_cptr p = (karg_cptr)__builtin_amdgcn_kernarg_segment_ptr();
    asm volatile("" : "+s"(p));
    typedef void* voidp_t; typedef __attribute__((address_space(4))) const voidp_t* karg_vpp;
    return *(karg_vpp)(p + 8 * k);
}
__global__ void __launch_bounds__(NTHR, 2) mk_fwd(Args args) {
    extern __shared__ __attribute__((aligned(16))) unsigned char lds_raw[];
    LAS unsigned char* lds = (LAS unsigned char*)lds_raw;
    volatile LAS unsigned* MISC = (volatile LAS unsigned*)(lds + LDS_MISC);
    const int wave0 = __builtin_amdgcn_readfirstlane((int)threadIdx.x >> 6);
    const int G = gridDim.x, bx0 = blockIdx.x, NGW = G * NWAVES;
#define PHASE_IDS() int lane_; asm volatile("v_mbcnt_lo_u32_b32 %0, -1, 0\n\tv_mbcnt_hi_u32_b32 %0, -1, %0" : "=v"(lane_)); int wave_ = wave0; asm volatile("" : "+s"(wave_)); \
    int bx = bx0; asm volatile("" : "+s"(bx)); int tid = wave_ * 64 + lane_; \
    const int lane = lane_, wave = wave_; \
    const int vcu = (G % 8 == 0) ? (bx % 8) * (G / 8) + bx / 8 : bx; const int gw = vcu * NWAVES + wave; (void)lane; (void)gw
    for (int u = threadIdx.x; u < 64; u += NTHR) MISC[u] = 0u;
    __syncthreads();
    unsigned* const barw = (unsigned*)((unsigned char*)karg_ptr(25) + WS_CTL) + CW_BAR;
    XcdBarrier bar; bar.bar = barw; bar.x = 0; bar.st = nullptr;
#if !MK_MULTI
    bar = xcd_barrier_post(barw, MISC + 8);
#endif
    const int lo = args.ph_lo, hi = args.ph_hi;
#ifndef PH_MASK
#define PH_MASK 0xffffffffu
#endif
#define IN(k) (lo <= (k) && (k) < hi && ((PH_MASK >> ((k) > 15 ? (k) - 16 : (k))) & 1u))
#if MK_MULTI
#define SEAM(k) do { } while (0)
#else
#ifndef TIME_MASK
#define TIME_MASK 0ull
#endif
#ifndef TIME_BAR
#define TIME_BAR 0
#endif
#ifndef TIME_SCALE
#define TIME_SCALE 0.001f
#endif
#if 0
#endif
#define IS_T0() ({ int l0_; asm volatile("v_mbcnt_lo_u32_b32 %0, -1, 0\n\tv_mbcnt_hi_u32_b32 %0, -1, %0" : "=v"(l0_)); (wave0 == 0) && (l0_ == 0); })
    if (TIME_MASK != 0ull && IS_T0()) { MISC[40] = 0u; MISC[41] = (unsigned)__builtin_amdgcn_s_memrealtime(); }
#define TPROBE(k) do { if (TIME_MASK != 0ull && IS_T0()) { const unsigned now_ = (unsigned)__builtin_amdgcn_s_memrealtime(); if ((TIME_MASK >> (k)) & 1ull) MISC[40] += now_ - MISC[41]; MISC[41] = now_; } } while (0)
#define SEAM(k) do { if (TIME_BAR && TIME_MASK != 0ull) { asm volatile("s_waitcnt vmcnt(0)" ::: "memory"); if (IS_T0()) MISC[41] = (unsigned)__builtin_amdgcn_s_memrealtime(); } if ((k) + 1 < hi) xcd_barrier(bar); TPROBE(k); } while (0)
#endif
#define KARG(k) (karg_ptr(k))
#define x_in ((const float*)KARG(0))
#define c_in ((const float*)KARG(1))
#define pos_in ((const int*)KARG(2))
#define ada_w ((const float*)KARG(3))
#define ada_b ((const float*)KARG(4))
#define mix_norm ((const float*)KARG(5))
#define w_in ((const float*)KARG(6))
#define cq_norm ((const float*)KARG(7))
#define ckv_norm ((const float*)KARG(8))
#define w_uq ((const float*)KARG(9))
#define w_ukv ((const float*)KARG(10))
#define q_norm ((const float*)KARG(11))
#define k_norm ((const float*)KARG(12))
#define w_fnet ((const float*)KARG(13))
#define out_norm ((const float*)KARG(14))
#define w_out ((const float*)KARG(15))
#define ffn_norm ((const float*)KARG(16))
#define dw_gate ((const float*)KARG(17))
#define dw_up ((const float*)KARG(18))
#define dw_down ((const float*)KARG(19))
#define router_w ((const float*)KARG(20))
#define mw_gate ((const float*)KARG(21))
#define mw_up ((const float*)KARG(22))
#define mw_down ((const float*)KARG(23))
#define out ((float*)KARG(24))
#define WSB ((unsigned char*)KARG(25))
#define ctl ((unsigned*)(WSB + WS_CTL))
#define MODP ((float*)(WSB + WS_ARENA))
#define MODV ((float*)(WSB + WS_MODV))
#define COS ((float*)(WSB + WS_COS))
#define SIN ((float*)(WSB + WS_SIN))
#define TW ((f32x2*)(WSB + WS_TW))
#define FM ((bf16_t*)(WSB + WS_FM))
#define GM ((bf16_t*)(WSB + WS_GM))
#define M12 ((bf16_t*)(WSB + WS_M12))
#define TOKINFO ((int*)(WSB + WS_TOKINFO))
#define TOKPOS ((int*)(WSB + WS_TOKPOS))
#define BLKCNT ((int*)(WSB + WS_TOKPOS + (size_t)SEQ * 8))
#define ROWTOK ((int*)(WSB + CTL_ROWTOK))
#define WIN ((bf16_t*)(WSB + WS_WIN))
#define WUQ ((bf16_t*)(WSB + WS_WUQ))
#define WUKV ((bf16_t*)(WSB + WS_WUKV))
#define WOUT ((bf16_t*)(WSB + WS_WOUT))
#define WGUD ((bf16_t*)(WSB + WS_WGUD))
#define WDND ((bf16_t*)(WSB + WS_WDND))
#define WGUM ((bf16_t*)(WSB + WS_WGUM))
#define WDNM ((bf16_t*)(WSB + WS_WDNM))
#define HB ((bf16_t*)(WSB + WS_H))
#define YB ((bf16_t*)(WSB + WS_Y))
#define ZB ((bf16_t*)(WSB + WS_Z))
#define QB ((bf16_t*)(WSB + WS_QB))
#define KVB ((bf16_t*)(WSB + WS_KVB))
#define KB ((bf16_t*)(WSB + WS_KB))
#define A1 ((bf16_t*)(WSB + WS_A1))
#define YC ((bf16_t*)(WSB + WS_YC))
#define HID ((bf16_t*)(WSB + WS_HID))
#define YPART ((bf16_t*)(WSB + WS_ARENA + 256 * MiB))

    if (IN(0)) {
        PHASE_IDS();
        LAS float* cond = (LAS float*)(lds + LDS_COND); LAS float* trig = (LAS float*)(lds + LDS_TRIG);
        for (int i = tid; i < DM; i += NTHR) { const float c = c_in[i]; cond[i] = c / (1.0f + __expf(-c)); }
        if (tid < 128) { trig[tid] = (float)cospi(2.0 * tid / 128.0); trig[128 + tid] = (float)sinpi(2.0 * tid / 128.0); }
        __syncthreads();
        LAS float* scr = (LAS float*)(lds + wave * 16640);
        constexpr int I_GEMV = 2 * 48 * 64;
        constexpr int I_WIN = 16 * 29, I_WUQ = 4 * 24, I_WUKV = 2 * 32, I_WOUT = 16 * 32;
        constexpr int I_DGU = 16 * 88, I_DDN = 44 * 32, I_MGU = 16 * 112, I_MDN = 56 * 32;
        constexpr int I_ZERO = 2 * 192;
        constexpr int I_ROPE = SEQ * 32 / 64;
        constexpr int I_TW = 16384 / 64, I_FM = 32768 / 64, I_GM = 65536 / 64, I_M12 = 2 * 8 * 256 * 128 / 64;
        constexpr int NITEMS = I_GEMV + 2 * (I_WIN + I_WUQ + I_WUKV + I_WOUT) + 2 * I_DGU + I_DDN + 16 * I_MGU + 8 * I_MDN + I_ZERO + I_ROPE + I_TW + I_FM + I_GM + I_M12;
        for (int it = gw; it < NITEMS; it += NGW) {
            int r = it;
            if (r < I_GEMV) {
                const int kc = r & 63, cb = r >> 6, l = cb / 48, n0 = (cb % 48) * 256 + 4 * lane;
                const float* W = ada_w + ((size_t)l * DM + kc * 32) * 12288 + n0;
                f32x4 a = {0.f, 0.f, 0.f, 0.f};
                f32x4 v[32];
#pragma unroll
                for (int k = 0; k < 32; ++k) v[k] = *(const f32x4*)(W + (size_t)k * 12288);
#pragma unroll
                for (int k = 0; k < 32; ++k) a += v[k] * cond[kc * 32 + k];
                *(f32x4*)(MODP + ((size_t)kc * 2 + l) * 12288 + n0) = a;
                continue;
            } r -= I_GEMV;
            bool done = false;
#pragma unroll 1
            for (int l = 0; l < 2 && !done; ++l) {
                if (r < I_WIN) { const int kb = r / 29, nb = r % 29; cvt_pair<false>(w_in + (size_t)l * DM * DIN, DIN, WIN + (size_t)l * DINP * DM, DM, 128 * kb, 64 * nb, 64 * nb, 1.f, scr, lane); done = true; break; } r -= I_WIN;
                if (r < I_WUQ) { const int kb = r / 24, nb = r % 24; cvt_pair<false>(w_uq + (size_t)l * QLR * 1536, 1536, WUQ + (size_t)l * 1536 * QLR, QLR, 128 * kb, 64 * nb, 64 * nb, 1.f, scr, lane); done = true; break; } r -= I_WUQ;
                if (r < I_WUKV) { const int kb = r / 32, nb = r % 32; cvt_pair<false>(w_ukv + (size_t)l * KVLR * 2048, 2048, WUKV + (size_t)l * 2048 * KVLR, KVLR, 128 * kb, 64 * nb, 64 * nb, 1.f, scr, lane); done = true; break; } r -= I_WUKV;
                if (r < I_WOUT) { const int kb = r / 32, nb = r % 32; cvt_pair<false>(w_out + (size_t)l * DM * DM, DM, WOUT + (size_t)l * DM * DM, DM, 128 * kb, 64 * nb, 64 * nb, 1.f, scr, lane); done = true; break; } r -= I_WOUT;
            }
            if (done) continue;
            if (r < 2 * I_DGU) { const int up = r / I_DGU, rr = r % I_DGU, kb = rr / 88, nb = rr % 88, n0 = 64 * nb;
                cvt_pair<false>(up ? dw_up : dw_gate, DFF, WGUD, DM, 128 * kb, n0, (n0 >> 7) * 256 + (n0 & 127) + up * 128, 1.f, scr, lane); continue; } r -= 2 * I_DGU;
            if (r < I_DDN) { const int kb = r / 32, nb = r % 32; cvt_pair<false>(dw_down, DM, WDND, DFF, 128 * kb, 64 * nb, 64 * nb, 1.f, scr, lane); continue; } r -= I_DDN;
            if (r < 16 * I_MGU) { const int e = r / (2 * I_MGU), r2 = r % (2 * I_MGU), up = r2 / I_MGU, rr = r2 % I_MGU, kb = rr / 112, nb = rr % 112, n0 = 64 * nb;
                cvt_pair<true, true>((up ? mw_up : mw_gate) + (size_t)e * DM * DFE, DFE, (unsigned char*)WGUM + (size_t)e * 14336 * DM, DM, 128 * kb, n0, (n0 >> 7) * 256 + (n0 & 127) + up * 128, S8_WGU, scr, lane); continue; } r -= 16 * I_MGU;
            if (r < 8 * I_MDN) { const int e = r / I_MDN, rr = r % I_MDN, kb = rr / 32, nb = rr % 32;
                cvt_pair<true, true>(mw_down + (size_t)e * DFE * DM, DM, (unsigned char*)WDNM + (size_t)e * DM * DFE, DFE, 128 * kb, 64 * nb, 64 * nb, S8_WDN, scr, lane); continue; } r -= 8 * I_MDN;
            if (r < I_ZERO) { const int l = r / 192, row = 1856 + r % 192; u32x4 z = {0u, 0u, 0u, 0u};
#pragma unroll
                for (int j = 0; j < 4; ++j) *(u32x4*)(WIN + ((size_t)l * DINP + row) * DM + (lane + 64 * j) * 8) = z;
                continue; } r -= I_ZERO;
            if (r < I_ROPE) { const int idx = r * 64 + lane, t = idx >> 5, i = idx & 31;
                const double inv = exp2(-(double)i * (13.287712379549449 / 32.0));
                const double ang = (double)pos_in[t] * inv; double sn, cs; sincos(ang, &sn, &cs);
                COS[idx] = (float)cs; SIN[idx] = (float)sn; continue; } r -= I_ROPE;
            if (r < I_TW) { const int idx = r * 64 + lane, s2 = idx >> 7, k1 = idx & 127; const int m = (s2 * k1) & 16383;
                double sn, cs; sincospi(2.0 * (double)m / 16384.0, &sn, &cs); TW[idx] = (f32x2){(float)cs, (float)(-sn)}; continue; } r -= I_TW;
            if (r < I_FM) { const int idx = r * 64 + lane, m = idx >> 7, s1 = idx & 127, k1 = m >> 1, ri = m & 1; const int ph = (k1 * s1) & 127;
                const float v = (ri ? -trig[128 + ph] : trig[ph]) * 0.08838834764831845f; FM[idx] = f2bf(v); continue; } r -= I_FM;
            if (r < I_GM) { const int idx = r * 64 + lane, m = idx >> 8, k = idx & 255, ro = m >> 7, k2 = m & 127, rin = k >> 7, s2 = k & 127; const int ph = (k2 * s2) & 127;
                float v = (ro == rin) ? trig[ph] : (ro == 0 ? trig[128 + ph] : -trig[128 + ph]);
                GM[idx] = f2bf(v * 0.08838834764831845f); continue; } r -= I_GM;
            {
                const int idx = r * 64 + lane, d = idx & 127, kk = (idx >> 7) & 255, lg = idx >> 15, ri = kk >> 7, c = kk & 127;
                const float* Wf = w_fnet + (size_t)lg * 128 * 128 + d; float a = 0.f;
                for (int m = 0; m < 128; ++m) a += trig[ri * 128 + ((m * c) & 127)] * Wf[m * 128];
                M12[idx] = f2bf(a * 0.08838834764831845f);
            }
        }
        SEAM(0);
    }
    if (IN(1)) {
        PHASE_IDS();
        for (int i = (bx * NTHR + tid); i < 2 * 12288; i += G * NTHR) { float a = ada_b[i];
#pragma unroll
            for (int k = 0; k < 64; ++k) a += MODP[(size_t)k * 2 * 12288 + i];
            MODV[i] = a; }
        SEAM(1);
    }

#pragma unroll 1
    for (int l = 0; l < 2; ++l) {
        const int pb = 2 + 16 * l;
#define modv (MODV + (size_t)l * 12288)
#define xcur ((l == 0) ? x_in : (const float*)out)
#pragma unroll 1
        for (int sub = 0; sub < 2; ++sub) {
            const int ph = pb + (sub ? 8 : 0);
            if (IN(ph)) {
                PHASE_IDS();
                const float* xs = sub ? (const float*)out : xcur;
                const float* gain = (sub ? ffn_norm : mix_norm) + (size_t)l * DM;
                const float* shv = modv + (sub ? 3 : 0) * DM; const float* scv = modv + (sub ? 4 : 1) * DM;
                const bool router = (sub == 1 && l == 1);
                LAS float* wr_l = (LAS float*)lds;
                LAS int* etab = (LAS int*)(lds + 65536); LAS int* rtab = (LAS int*)(lds + 65536 + 4096);
                if (router) { etab[tid] = 0xffff;
                    for (int i = tid; i < DM * NE / 4; i += NTHR) ((LAS f32x4*)wr_l)[i] = ((const f32x4*)router_w)[i]; }
                __syncthreads();
                f32x4 av[8], bv[8];
#pragma unroll
                for (int j = 0; j < 8; ++j) { const f32x4 g4 = ((const f32x4*)gain)[lane + 64 * j], s4 = ((const f32x4*)scv)[lane + 64 * j]; av[j] = g4 * (1.0f + s4); bv[j] = ((const f32x4*)shv)[lane + 64 * j]; }
                int my_e0 = 0, my_e1 = 0, my_tok = -1; float my_w0 = 0.f, my_w1 = 0.f; int itn = 0;
                f32x4 vnx[8];
#pragma unroll
                for (int j = 0; j < 8; ++j) vnx[j] = ((const f32x4*)(xs + (size_t)(gw < SEQ ? gw : 0) * DM))[lane + 64 * j];
                for (int m = gw; m < SEQ; m += NGW, ++itn) {
                    f32x4 v[8]; float ss = 0.f;
#pragma unroll
                    for (int j = 0; j < 8; ++j) v[j] = vnx[j];
                    { const int mn = m + NGW < SEQ ? m + NGW : m;
#pragma unroll
                      for (int j = 0; j < 8; ++j) vnx[j] = ((const f32x4*)(xs + (size_t)mn * DM))[lane + 64 * j]; }
#pragma unroll
                    for (int j = 0; j < 8; ++j) ss += (v[j][0] * v[j][0] + v[j][1] * v[j][1]) + (v[j][2] * v[j][2] + v[j][3] * v[j][3]);
                    const float rstd = 1.0f / sqrtf(wave_sum(ss) * (1.0f / DM) + RMS_EPS);
#pragma unroll
                    for (int j = 0; j < 8; ++j) { v[j] = v[j] * rstd * av[j] + bv[j];
                        if (router) { int w8 = 0; w8 = __builtin_amdgcn_cvt_pk_fp8_f32(pg8::clamp448(v[j][0] * S8_H), pg8::clamp448(v[j][1] * S8_H), w8, false); w8 = __builtin_amdgcn_cvt_pk_fp8_f32(pg8::clamp448(v[j][2] * S8_H), pg8::clamp448(v[j][3] * S8_H), w8, true);
                            *(unsigned*)((unsigned char*)HB + (size_t)m * DM + 4 * lane + 256 * j) = (unsigned)w8; }
                        else *(u32x2*)(HB + (size_t)m * DM + 4 * lane + 256 * j) = pack4(v[j]); }
                    if (router) {
                        float lg[8] = {0.f, 0.f, 0.f, 0.f, 0.f, 0.f, 0.f, 0.f};
#pragma unroll
                        for (int j = 0; j < 8; ++j)
#pragma unroll
                            for (int q = 0; q < 4; ++q) { const int k = 4 * lane + 256 * j + q; const f32x4 w0 = *(const LAS f32x4*)(wr_l + k * 8), w1 = *(const LAS f32x4*)(wr_l + k * 8 + 4); const float hv = v[j][q];
                                lg[0] += hv * w0[0]; lg[1] += hv * w0[1]; lg[2] += hv * w0[2]; lg[3] += hv * w0[3]; lg[4] += hv * w1[0]; lg[5] += hv * w1[1]; lg[6] += hv * w1[2]; lg[7] += hv * w1[3]; }
#pragma unroll
                        for (int e = 0; e < 8; ++e) lg[e] = wave_sum(lg[e]);
                        int e0 = 0; float l0 = lg[0];
#pragma unroll
                        for (int e = 1; e < 8; ++e) if (lg[e] > l0) { l0 = lg[e]; e0 = e; }
                        int e1 = -1; float l1 = -3.0e38f;
#pragma unroll
                        for (int e = 0; e < 8; ++e) if (e != e0 && lg[e] > l1) { l1 = lg[e]; e1 = e; }
                        const float w1 = 1.0f / (1.0f + __expf(l0 - l1)), w0 = 1.0f - w1;
                        if (lane == 0) etab[itn * NWAVES + wave] = e0 | (e1 << 8);
                        if (lane == itn) { my_e0 = e0; my_e1 = e1; my_w0 = w0; my_w1 = w1; my_tok = m; }
                    }
                }
                if (router) {
                    __syncthreads();
                    const int nent = ((SEQ + NGW - 1) / NGW) * NWAVES;
                    if (tid < nent) {
                        const int me = etab[tid], a0 = me & 255, a1 = me >> 8; int c0 = 0, c1 = 0;
                        for (int q = 0; q < tid; ++q) { const int o = etab[q], b0 = o & 255, b1 = o >> 8; c0 += (b0 == a0) + (b1 == a0); c1 += (b0 == a1) + (b1 == a1); }
                        rtab[2 * tid] = c0; rtab[2 * tid + 1] = c1; }
                    if (tid >= 512 - 8) { const int e = tid - (512 - 8); int c = 0;
                        for (int q = 0; q < nent; ++q) { const int o = etab[q]; c += ((o & 255) == e) + ((o >> 8) == e); }
                        BLKCNT[bx * 8 + e] = c; }
                    __syncthreads();
                    if (my_tok >= 0) { int* ti = TOKINFO + (size_t)my_tok * 8; ti[0] = my_e0; ti[1] = my_e1; ti[2] = __float_as_int(my_w0); ti[3] = __float_as_int(my_w1);
                        ti[4] = rtab[2 * (lane * NWAVES + wave)]; ti[5] = rtab[2 * (lane * NWAVES + wave) + 1]; ti[6] = bx; }
                }
                __syncthreads();
                SEAM(ph);
            }
            if (sub == 0) {
            if (IN(pb + 1)) {
                PHASE_IDS();
                pg8::Gemm g{HB, WIN + (size_t)l * DINP * DM, DM, DM, DM, 0, nullptr}; pg8::TileOrder S; S.init(SEQ / 256, DINP / 256, G, bx);
                pg8::EpiBf16 E{ZB, DINP, 1.0f};
                pg8::gemm_phase<pg8::EpiBf16, pg8::TileOrder, false>(tid, lds, g, S, E);
                SEAM(pb + 1);
            }
            if (IN(pb + 2)) {
                PHASE_IDS();
                f32x4 gq0 = ((const f32x4*)(cq_norm + (size_t)l * QLR))[2 * lane], gq1 = ((const f32x4*)(cq_norm + (size_t)l * QLR))[2 * lane + 1];
                f32x4 gk = ((const f32x4*)(ckv_norm + (size_t)l * KVLR))[lane];
                for (int m = gw; m < SEQ; m += NGW) {
                    bf16_t* zr = ZB + (size_t)m * DINP;
                    const bf16x8 q8 = *(const bf16x8*)(zr + ZQ + 8 * lane); const s16x4 k4 = *(const s16x4*)(zr + ZKV + 4 * lane);
                    float qf[8], kf[4], sq = 0.f, sk = 0.f;
#pragma unroll
                    for (int j = 0; j < 8; ++j) { qf[j] = bf2f((unsigned short)q8[j]); sq += qf[j] * qf[j]; }
#pragma unroll
                    for (int j = 0; j < 4; ++j) { kf[j] = bf2f((unsigned short)k4[j]); sk += kf[j] * kf[j]; }
                    const float rq = 1.0f / sqrtf(wave_sum(sq) * (1.0f / QLR) + RMS_EPS), rk = 1.0f / sqrtf(wave_sum(sk) * (1.0f / KVLR) + RMS_EPS);
                    u32x4 wq; wq.x = cvt_pk_bf16(qf[0] * rq * gq0[0], qf[1] * rq * gq0[1]); wq.y = cvt_pk_bf16(qf[2] * rq * gq0[2], qf[3] * rq * gq0[3]);
                    wq.z = cvt_pk_bf16(qf[4] * rq * gq1[0], qf[5] * rq * gq1[1]); wq.w = cvt_pk_bf16(qf[6] * rq * gq1[2], qf[7] * rq * gq1[3]);
                    u32x2 wk; wk.x = cvt_pk_bf16(kf[0] * rk * gk[0], kf[1] * rk * gk[1]); wk.y = cvt_pk_bf16(kf[2] * rk * gk[2], kf[3] * rk * gk[3]);
                    *(u32x4*)(zr + ZQ + 8 * lane) = wq; *(u32x2*)(zr + ZKV + 4 * lane) = wk;
                }
                {   PHASE_IDS();
                    const int r32 = lane & 31, hi = lane >> 5;
                    LAS unsigned char* ost = lds + sg::OST_OFF + wave * sg::OST_WAVE;
                    bf16x8 Af[8];
#pragma unroll
                    for (int s = 0; s < 8; ++s) Af[s] = *(const bf16x8*)(FM + (size_t)(32 * wave + r32) * 128 + 16 * s + 8 * hi);
                    for (int it = bx; it < 1024; it += G) {
                        const int s2 = it >> 3, cc = it & 7;
                        __syncthreads();
                        sg::stage_b<128>(ZB + (size_t)s2 * DINP + ZU + cc * 128, (size_t)128 * DINP, (char*)lds_raw, tid);
                        __syncthreads();
                        f32x16 o[4] = {};
                        sg::mm<128>(o, Af, (char*)lds_raw, lane);
#pragma unroll
                        for (int p = 0; p < 8; ++p) { const int k1 = 16 * wave + (p & 1) + 4 * (p >> 1) + 2 * hi; const f32x2 tw = TW[s2 * 128 + k1];
#pragma unroll
                            for (int d0 = 0; d0 < 4; ++d0) { const float re = o[d0][2 * p], im = o[d0][2 * p + 1];
                                o[d0][2 * p] = re * tw[0] - im * tw[1]; o[d0][2 * p + 1] = re * tw[1] + im * tw[0]; } }
                        sg::store_tile(o, ost, lane, sg::RowF1{A1, wave, s2, cc});
                    }
                    __syncthreads();
                }
                SEAM(pb + 2);
            }
            if (IN(pb + 3)) {
                PHASE_IDS();
                { pg8::Gemm g{ZB + ZQ, WUQ + (size_t)l * 1536 * QLR, DINP, QLR, QLR, 0, nullptr}; pg8::TileOrder S; S.init(SEQ / 256, 1536 / 256, G, bx);
                  pg8::EpiBf16 E{QB, 1536, 1.0f}; pg8::gemm_phase<pg8::EpiBf16, pg8::TileOrder, false>(tid, lds, g, S, E); }
                { pg8::Gemm g{ZB + ZKV, WUKV + (size_t)l * 2048 * KVLR, DINP, KVLR, KVLR, 0, nullptr}; pg8::TileOrder S; S.init(SEQ / 256, 2048 / 256, G, bx);
                  pg8::EpiBf16 E{KVB, 2048, 1.0f}; pg8::gemm_phase<pg8::EpiBf16, pg8::TileOrder, false>(tid, lds, g, S, E); }
                {   PHASE_IDS();
                    const int r32 = lane & 31, hi = lane >> 5;
                    LAS unsigned char* ost = lds + sg::OST_OFF + wave * sg::OST_WAVE;
                    bf16x8 Af[16];
#pragma unroll
                    for (int s = 0; s < 16; ++s) Af[s] = *(const bf16x8*)(GM + (size_t)(32 * wave + r32) * 256 + 16 * s + 8 * hi);
                    for (;;) {
                        __syncthreads();
                        if (tid == 0) MISC[32] = atomicAdd(ctl + CW_F3CTR + 128 + 64 * l, 1u);
                        __syncthreads();
                        const int it = (int)MISC[32]; if (it >= 1024) break;
                        const int k1 = it >> 3, gidx = it & 7;
                        sg::stage_b<256>(A1 + (size_t)k1 * 256 * 1024 + gidx * 128, 1024, (char*)lds_raw, tid);
                        __syncthreads();
                        f32x16 o[4] = {};
                        sg::mm<256>(o, Af, (char*)lds_raw, lane);
                        sg::store_tile(o, ost, lane, sg::RowF2{YC, wave, k1, gidx});
                    }
                    __syncthreads();
                }
                SEAM(pb + 3);
            }
            if (IN(pb + 4)) {
                PHASE_IDS();
                {
                    const int hd = lane >> 3, j8 = lane & 7;
                    const float* qg = q_norm + (size_t)l * QKD; const float* kg = k_norm + (size_t)l * QKD;
                    f32x4 qgn[4], kgn[4], qgr[2], kgr[2];
#pragma unroll
                    for (int j = 0; j < 4; ++j) { qgn[j] = *(const f32x4*)(qg + 16 * j8 + 4 * j); kgn[j] = *(const f32x4*)(kg + 16 * j8 + 4 * j); }
                    qgr[0] = *(const f32x4*)(qg + NOPE + 4 * j8); qgr[1] = *(const f32x4*)(qg + NOPE + 32 + 4 * j8);
                    kgr[0] = *(const f32x4*)(kg + NOPE + 4 * j8); kgr[1] = *(const f32x4*)(kg + NOPE + 32 + 4 * j8);
                    for (int m = gw; m < SEQ; m += NGW) {
                        const f32x4 cs = *(const f32x4*)(COS + (size_t)m * 32 + 4 * j8), sn = *(const f32x4*)(SIN + (size_t)m * 32 + 4 * j8);
                        const bf16_t* kp = KVB + (size_t)m * 2048 + hd * 256; const bf16_t* krp = ZB + (size_t)m * DINP + ZKR;
                        const bf16x8 kn0 = *(const bf16x8*)(kp + 16 * j8), kn1 = *(const bf16x8*)(kp + 16 * j8 + 8);
                        const s16x4 kra = *(const s16x4*)(krp + 4 * j8), krb = *(const s16x4*)(krp + 32 + 4 * j8);
                        {
                            bf16_t* qp = QB + (size_t)m * 1536 + hd * QKD;
                            const bf16x8 n0 = *(const bf16x8*)(qp + 16 * j8), n1 = *(const bf16x8*)(qp + 16 * j8 + 8);
                            const s16x4 ra = *(const s16x4*)(qp + NOPE + 4 * j8), rb = *(const s16x4*)(qp + NOPE + 32 + 4 * j8);
                            float f[16], x1[4], x2[4], ss = 0.f;
#pragma unroll
                            for (int j = 0; j < 8; ++j) { f[j] = bf2f((unsigned short)n0[j]); f[8 + j] = bf2f((unsigned short)n1[j]); }
#pragma unroll
                            for (int j = 0; j < 16; ++j) ss += f[j] * f[j];
#pragma unroll
                            for (int j = 0; j < 4; ++j) { x1[j] = bf2f((unsigned short)ra[j]); x2[j] = bf2f((unsigned short)rb[j]); ss += x1[j] * x1[j] + x2[j] * x2[j]; }
                            ss += swz_xor<1>(ss); ss += swz_xor<2>(ss); ss += swz_xor<4>(ss);
                            const float rs = 1.0f / sqrtf(ss * (1.0f / QKD) + RMS_EPS);
                            u32x4 w0, w1;
                            w0.x = cvt_pk_bf16(f[0] * rs * qgn[0][0], f[1] * rs * qgn[0][1]); w0.y = cvt_pk_bf16(f[2] * rs * qgn[0][2], f[3] * rs * qgn[0][3]);
                            w0.z = cvt_pk_bf16(f[4] * rs * qgn[1][0], f[5] * rs * qgn[1][1]); w0.w = cvt_pk_bf16(f[6] * rs * qgn[1][2], f[7] * rs * qgn[1][3]);
                            w1.x = cvt_pk_bf16(f[8] * rs * qgn[2][0], f[9] * rs * qgn[2][1]); w1.y = cvt_pk_bf16(f[10] * rs * qgn[2][2], f[11] * rs * qgn[2][3]);
                            w1.z = cvt_pk_bf16(f[12] * rs * qgn[3][0], f[13] * rs * qgn[3][1]); w1.w = cvt_pk_bf16(f[14] * rs * qgn[3][2], f[15] * rs * qgn[3][3]);
                            float o1[4], o2[4];
#pragma unroll
                            for (int j = 0; j < 4; ++j) { const float a = x1[j] * rs * qgr[0][j], b = x2[j] * rs * qgr[1][j]; o1[j] = a * cs[j] - b * sn[j]; o2[j] = b * cs[j] + a * sn[j]; }
                            u32x2 wa, wb; wa.x = cvt_pk_bf16(o1[0], o1[1]); wa.y = cvt_pk_bf16(o1[2], o1[3]); wb.x = cvt_pk_bf16(o2[0], o2[1]); wb.y = cvt_pk_bf16(o2[2], o2[3]);
                            *(u32x4*)(qp + 16 * j8) = w0; *(u32x4*)(qp + 16 * j8 + 8) = w1; *(u32x2*)(qp + NOPE + 4 * j8) = wa; *(u32x2*)(qp + NOPE + 32 + 4 * j8) = wb;
                        }
                        {
                            bf16_t* ko = KB + (size_t)m * 1536 + hd * QKD;
                            const bf16x8 n0 = kn0, n1 = kn1; const s16x4 ra = kra, rb = krb;
                            float f[16], x1[4], x2[4], ss = 0.f;
#pragma unroll
                            for (int j = 0; j < 8; ++j) { f[j] = bf2f((unsigned short)n0[j]); f[8 + j] = bf2f((unsigned short)n1[j]); }
#pragma unroll
                            for (int j = 0; j < 16; ++j) ss += f[j] * f[j];
#pragma unroll
                            for (int j = 0; j < 4; ++j) { x1[j] = bf2f((unsigned short)ra[j]); x2[j] = bf2f((unsigned short)rb[j]); ss += x1[j] * x1[j] + x2[j] * x2[j]; }
                            ss += swz_xor<1>(ss); ss += swz_xor<2>(ss); ss += swz_xor<4>(ss);
                            const float rs = 1.0f / sqrtf(ss * (1.0f / QKD) + RMS_EPS);
                            u32x4 w0, w1;
                            w0.x = cvt_pk_bf16(f[0] * rs * kgn[0][0], f[1] * rs * kgn[0][1]); w0.y = cvt_pk_bf16(f[2] * rs * kgn[0][2], f[3] * rs * kgn[0][3]);
                            w0.z = cvt_pk_bf16(f[4] * rs * kgn[1][0], f[5] * rs * kgn[1][1]); w0.w = cvt_pk_bf16(f[6] * rs * kgn[1][2], f[7] * rs * kgn[1][3]);
                            w1.x = cvt_pk_bf16(f[8] * rs * kgn[2][0], f[9] * rs * kgn[2][1]); w1.y = cvt_pk_bf16(f[10] * rs * kgn[2][2], f[11] * rs * kgn[2][3]);
                            w1.z = cvt_pk_bf16(f[12] * rs * kgn[3][0], f[13] * rs * kgn[3][1]); w1.w = cvt_pk_bf16(f[14] * rs * kgn[3][2], f[15] * rs * kgn[3][3]);
                            float o1[4], o2[4];
#pragma unroll
                            for (int j = 0; j < 4; ++j) { const float a = x1[j] * rs * kgr[0][j], b = x2[j] * rs * kgr[1][j]; o1[j] = a * cs[j] - b * sn[j]; o2[j] = b * cs[j] + a * sn[j]; }
                            u32x2 wa, wb; wa.x = cvt_pk_bf16(o1[0], o1[1]); wa.y = cvt_pk_bf16(o1[2], o1[3]); wb.x = cvt_pk_bf16(o2[0], o2[1]); wb.y = cvt_pk_bf16(o2[2], o2[3]);
                            *(u32x4*)(ko + 16 * j8) = w0; *(u32x4*)(ko + 16 * j8 + 8) = w1; *(u32x2*)(ko + NOPE + 4 * j8) = wa; *(u32x2*)(ko + NOPE + 32 + 4 * j8) = wb;
                        }
                    }
                }
                SEAM(pb + 4);
            }
            if (IN(pb + 5)) {
                PHASE_IDS();
                float gq = 0.f, gk = 0.f;
#pragma unroll
                for (int j = 0; j < 3; ++j) { gq = fmaxf(gq, fabsf(q_norm[(size_t)l * QKD + lane + 64 * j])); gk = fmaxf(gk, fabsf(k_norm[(size_t)l * QKD + lane + 64 * j])); }
                gq = fmaxf(gq, swz_xor<1>(gq)); gq = fmaxf(gq, swz_xor<2>(gq)); gq = fmaxf(gq, swz_xor<4>(gq)); gq = fmaxf(gq, swz_xor<8>(gq)); gq = fmaxf(gq, swz_xor<16>(gq));
                gk = fmaxf(gk, swz_xor<1>(gk)); gk = fmaxf(gk, swz_xor<2>(gk)); gk = fmaxf(gk, swz_xor<4>(gk)); gk = fmaxf(gk, swz_xor<8>(gk)); gk = fmaxf(gk, swz_xor<16>(gk));
                { auto rq = __builtin_amdgcn_permlane32_swap(__float_as_uint(gq), __float_as_uint(gq), false, false); gq = fmaxf(__uint_as_float(rq[0]), __uint_as_float(rq[1]));
                  auto rk = __builtin_amdgcn_permlane32_swap(__float_as_uint(gk), __float_as_uint(gk), false, false); gk = fmaxf(__uint_as_float(rk[0]), __uint_as_float(rk[1])); }
                const int negMC = __builtin_amdgcn_readfirstlane(__builtin_bit_cast(int, -fminf(13.856406460551018f * gq * gk, 60.f) * 1.4426950408889634f));
                for (int u = bx; u < NH * (SEQ / 256); u += G) {
                    const int h = u & 7, qb = u >> 3;
                    int ln_u; asm volatile("v_mbcnt_lo_u32_b32 %0, -1, 0\n\tv_mbcnt_hi_u32_b32 %0, -1, %0" : "=v"(ln_u));
                    const int tid_u = wave * 64 + ln_u;
                    att::attn_unit2(QB + (size_t)(qb * 256) * 1536 + h * QKD, KB + h * QKD, KVB + h * 256 + NOPE, HB + (size_t)(qb * 256) * DM + h * VHD, SEQ, lds, tid_u, negMC);
                }
                {   PHASE_IDS();
                    const int r32 = lane & 31, hi = lane >> 5;
                    LAS unsigned char* ost = lds + sg::OST_OFF + wave * sg::OST_WAVE;
                    for (;;) {
                        __syncthreads();
                        if (tid == 0) MISC[32] = atomicAdd(ctl + CW_F3CTR + 64 * l, 1u);
                        __syncthreads();
                        const int it = (int)MISC[32]; if (it >= 512) break;
                        const int tt = it >> 3, gidx = it & 7;
                        bf16x8 Af[16];
                        const bf16_t* ar = YC + (size_t)(256 * tt + 32 * wave + r32) * 2048 + gidx * 256 + 8 * hi;
#pragma unroll
                        for (int s = 0; s < 16; ++s) Af[s] = *(const bf16x8*)(ar + 16 * s);
                        __syncthreads();
                        sg::stage_b<256>(M12 + (size_t)(l * 8 + gidx) * 256 * 128, 128, (char*)lds_raw, tid);
                        __syncthreads();
                        f32x16 o[4] = {};
                        sg::mm<256>(o, Af, (char*)lds_raw, lane);
                        sg::store_tile(o, ost, lane, sg::RowF3{HB, wave, tt, gidx});
                    }
                    __syncthreads();
                }
                SEAM(pb + 5);
            }
            if (IN(pb + 6)) {
                PHASE_IDS();
                const float* og = out_norm + (size_t)l * DM;
                f32x4 ga[4], gf[4];
#pragma unroll
                for (int j = 0; j < 4; ++j) { ga[j] = *(const f32x4*)(og + 16 * lane + 4 * j); gf[j] = *(const f32x4*)(og + 1024 + 16 * lane + 4 * j); }
                bf16x8 nx[4];
                { const bf16_t* p0 = HB + (size_t)(gw < SEQ ? gw : 0) * DM + 16 * lane; nx[0] = *(const bf16x8*)p0; nx[1] = *(const bf16x8*)(p0 + 8); nx[2] = *(const bf16x8*)(p0 + 1024); nx[3] = *(const bf16x8*)(p0 + 1032); }
                for (int m = gw; m < SEQ; m += NGW) {
                    bf16_t* rp = HB + (size_t)m * DM;
                    bf16x8 cu[4];
#pragma unroll
                    for (int j = 0; j < 4; ++j) cu[j] = nx[j];
                    { const bf16_t* p0 = HB + (size_t)(m + NGW < SEQ ? m + NGW : m) * DM + 16 * lane; nx[0] = *(const bf16x8*)p0; nx[1] = *(const bf16x8*)(p0 + 8); nx[2] = *(const bf16x8*)(p0 + 1024); nx[3] = *(const bf16x8*)(p0 + 1032); }
#pragma unroll
                    for (int half = 0; half < 2; ++half) {
                        bf16_t* p = rp + half * 1024 + 16 * lane;
                        const bf16x8 a0 = cu[2 * half], a1 = cu[2 * half + 1];
                        float f[16], ss = 0.f;
#pragma unroll
                        for (int j = 0; j < 8; ++j) { f[j] = bf2f((unsigned short)a0[j]); f[8 + j] = bf2f((unsigned short)a1[j]); }
#pragma unroll
                        for (int j = 0; j < 16; ++j) ss += f[j] * f[j];
                        const float rs = 1.0f / sqrtf(wave_sum(ss) * (1.0f / 1024) + RMS_EPS);
                        u32x4 w0, w1;
#define GG(j) (half ? gf[(j) >> 2][(j) & 3] : ga[(j) >> 2][(j) & 3])
                        w0.x = cvt_pk_bf16(f[0] * rs * GG(0), f[1] * rs * GG(1)); w0.y = cvt_pk_bf16(f[2] * rs * GG(2), f[3] * rs * GG(3));
                        w0.z = cvt_pk_bf16(f[4] * rs * GG(4), f[5] * rs * GG(5)); w0.w = cvt_pk_bf16(f[6] * rs * GG(6), f[7] * rs * GG(7));
                        w1.x = cvt_pk_bf16(f[8] * rs * GG(8), f[9] * rs * GG(9)); w1.y = cvt_pk_bf16(f[10] * rs * GG(10), f[11] * rs * GG(11));
                        w1.z = cvt_pk_bf16(f[12] * rs * GG(12), f[13] * rs * GG(13)); w1.w = cvt_pk_bf16(f[14] * rs * GG(14), f[15] * rs * GG(15));
#undef GG
                        *(u32x4*)p = w0; *(u32x4*)(p + 8) = w1;
                    }
                }
                SEAM(pb + 6);
            }
            if (IN(pb + 7)) {
                PHASE_IDS();
                pg8::Gemm g{HB, WOUT + (size_t)l * DM * DM, DM, DM, DM, 0, nullptr}; pg8::TileOrder S; S.init(SEQ / 256, DM / 256, G, bx);
                pg8::EpiRes E{xcur, out, modv + 2 * DM, DM};
                pg8::gemm_phase<pg8::EpiRes, pg8::TileOrder, false>(tid, lds, g, S, E);
                SEAM(pb + 7);
            }
            }
        }
        if (l == 0) {
            if (IN(pb + 9)) {
                PHASE_IDS();
                pg8::Gemm g{HB, WGUD, DM, DM, DM, 0, nullptr}; pg8::TileOrder S; S.init(SEQ / 256, 2 * DFF / 256, G, bx);
                pg8::EpiSwiGLU E{HID, DFF};
                pg8::gemm_phase<pg8::EpiSwiGLU, pg8::TileOrder, false>(tid, lds, g, S, E);
                SEAM(pb + 9);
            }
            if (IN(pb + 10)) {
                PHASE_IDS();
                pg8::Gemm g{HID, WDND, DFF, DFF, DFF, 0, nullptr}; pg8::TileOrder S; S.init(SEQ / 256, DM / 256, G, bx);
                pg8::EpiRes E{out, out, modv + 5 * DM, DM};
                pg8::gemm_phase<pg8::EpiRes, pg8::TileOrder, false>(tid, lds, g, S, E);
                SEAM(pb + 10);
            }
        } else {
#define LOAD_TS() int ts[9]; ts[0] = 0; _Pragma("unroll") for (int e = 0; e < 8; ++e) { const int c = __builtin_amdgcn_readfirstlane((int)__hip_atomic_load(ctl + CW_ECNT + 64 * e, RLX_AGENT)); ts[e + 1] = ts[e] + ((c + 255) >> 8); }
            if (IN(pb + 9)) {
                PHASE_IDS();
                LAS int* pref = (LAS int*)lds; LAS int* tot = pref + G * 8;
                for (int i = tid; i < G * 8; i += NTHR) pref[i] = BLKCNT[i];
                __syncthreads();
                if (tid < 8) { int run = 0; for (int b = 0; b < G; ++b) { const int c = pref[b * 8 + tid]; pref[b * 8 + tid] = run; run += c; } tot[tid] = run;
                    if (bx == 0) __hip_atomic_store(ctl + CW_ECNT + 64 * tid, (unsigned)run, RLX_AGENT); }
                __syncthreads();
                int ts[9]; ts[0] = 0;
#pragma unroll
                for (int e = 0; e < 8; ++e) ts[e + 1] = ts[e] + ((tot[e] + 255) >> 8);
                for (int t = bx * NTHR + tid; t < SEQ; t += G * NTHR) {
                    const int* ti = TOKINFO + (size_t)t * 8; const int e0 = ti[0], e1 = ti[1], b = ti[6];
                    int p0 = ti[4] + pref[b * 8 + e0], p1 = ti[5] + pref[b * 8 + e1];
#pragma unroll
                    for (int e = 0; e < 8; ++e) { if (e0 == e) p0 += 256 * ts[e]; if (e1 == e) p1 += 256 * ts[e]; }
                    ROWTOK[p0] = t; ROWTOK[p1] = t; TOKPOS[2 * t] = p0; TOKPOS[2 * t + 1] = p1;
                }
                __syncthreads();
                SEAM(pb + 9);
            }
            if (IN(pb + 10)) {
                PHASE_IDS(); LOAD_TS();
                pg8::Gemm g{HB, WGUM, DM, DM, DM, (size_t)14336 * DM, ROWTOK}; pg8::TileOrder S; S.init(ts[8], 2 * DFE / 256, G, bx); S.moe = true;
#pragma unroll
                for (int e = 0; e < 9; ++e) S.ts[e] = ts[e];
                pg8::EpiSwiGLU8 E{(unsigned char*)HID, DFE, 1.0f / (S8_H * S8_WGU), S8_HID};
                pg8::gemm_phase<pg8::EpiSwiGLU8, pg8::TileOrder, true, true, true>(tid, lds, g, S, E);
                SEAM(pb + 10);
            }
            if (IN(pb + 11)) {
                PHASE_IDS(); LOAD_TS();
                const int nmain = ts[8] < 128 ? ts[8] : 128;
                pg8::EpiBf16 E{YB, DM, 1.0f / (S8_HID * S8_WDN), YPART - (size_t)32768 * DM, (size_t)2048 * DM};
                { pg8::Gemm g{HID, WDNM, DFE, DFE, DFE, (size_t)DM * DFE, nullptr}; pg8::TileOrder S; S.init(nmain, DM / 256, G, bx); S.moe = true;
#pragma unroll
                  for (int e = 0; e < 9; ++e) S.ts[e] = ts[e];
                  pg8::gemm_phase<pg8::EpiBf16, pg8::TileOrder, false, true, true>(tid, lds, g, S, E); }
                if (ts[8] > 128) { asm volatile("" : "+v"(tid));
                  pg8::Gemm g{HID, WDNM, DFE, DFE, DFE / 4, (size_t)DM * DFE, nullptr, DFE / 128}; pg8::TailOrder S; S.nsub = (ts[8] - 128) * 32; S.G = G; S.c = bx; S.pm0 = 128;
#pragma unroll
                  for (int e = 0; e < 9; ++e) S.ts[e] = ts[e];
                  pg8::gemm_phase<pg8::EpiBf16, pg8::TailOrder, false, true, true>(tid, lds, g, S, E); }
                SEAM(pb + 11);
            }
            if (IN(pb + 12)) {
                PHASE_IDS();
                const float* g2 = modv + 5 * DM;
                f32x4 gv[8];
#pragma unroll
                for (int j = 0; j < 8; ++j) gv[j] = ((const f32x4*)g2)[lane + 64 * j];
                int pn0 = 0, pn1 = 0; float wn0 = 0.f, wn1 = 0.f;
                { const int m0 = gw < SEQ ? gw : 0; const int* ti = TOKINFO + (size_t)m0 * 8; wn0 = __int_as_float(ti[2]); wn1 = __int_as_float(ti[3]); pn0 = TOKPOS[2 * m0]; pn1 = TOKPOS[2 * m0 + 1]; }
                for (int m = gw; m < SEQ; m += NGW) {
                    const float w0 = wn0, w1 = wn1; const int p0 = pn0, p1 = pn1;
                    { const int mn = m + NGW < SEQ ? m + NGW : m; const int* ti = TOKINFO + (size_t)mn * 8; wn0 = __int_as_float(ti[2]); wn1 = __int_as_float(ti[3]); pn0 = TOKPOS[2 * mn]; pn1 = TOKPOS[2 * mn + 1]; }
                    const bf16_t* y0 = YB + (size_t)p0 * DM; const bf16_t* y1 = YB + (size_t)p1 * DM; float* op = out + (size_t)m * DM;
                    s16x4 ya4[8], yb4[8]; f32x4 xv[8];
#pragma unroll
                    for (int j = 0; j < 8; ++j) { ya4[j] = *(const s16x4*)(y0 + 4 * lane + 256 * j); yb4[j] = *(const s16x4*)(y1 + 4 * lane + 256 * j); xv[j] = ((const f32x4*)op)[lane + 64 * j]; }
                    f32x4 ya[8], yb[8];
#pragma unroll
                    for (int j = 0; j < 8; ++j)
#pragma unroll
                        for (int q = 0; q < 4; ++q) { ya[j][q] = bf2f((unsigned short)ya4[j][q]); yb[j][q] = bf2f((unsigned short)yb4[j][q]); }
                    if (p0 >= 32768) {
#pragma unroll
                        for (int kq = 0; kq < 3; ++kq)
#pragma unroll
                            for (int j = 0; j < 8; ++j) { const s16x4 e = *(const s16x4*)(YPART + ((size_t)kq * 2048 + (p0 - 32768)) * DM + 4 * lane + 256 * j);
#pragma unroll
                                for (int q = 0; q < 4; ++q) ya[j][q] += bf2f((unsigned short)e[q]); } }
                    if (p1 >= 32768) {
#pragma unroll
                        for (int kq = 0; kq < 3; ++kq)
#pragma unroll
                            for (int j = 0; j < 8; ++j) { const s16x4 e = *(const s16x4*)(YPART + ((size_t)kq * 2048 + (p1 - 32768)) * DM + 4 * lane + 256 * j);
#pragma unroll
                                for (int q = 0; q < 4; ++q) yb[j][q] += bf2f((unsigned short)e[q]); } }
#pragma unroll
                    for (int j = 0; j < 8; ++j) {
#pragma unroll
                        for (int q = 0; q < 4; ++q) xv[j][q] += gv[j][q] * (w0 * ya[j][q] + w1 * yb[j][q]);
                        ((f32x4*)op)[lane + 64 * j] = xv[j]; }
                }
            }
        }
    }
    TPROBE(30);
    if (TIME_MASK != 0ull && bx0 == 0 && IS_T0()) out[0] = (float)MISC[40] * TIME_SCALE;
#undef IN
#undef SEAM
#undef LOAD_TS
#undef modv
#undef xcur
#undef out
#undef ctl
}

extern "C" void kernel_launch(void* const* d_in, const int* in_sizes, int n_in, void* d_out, int out_size, void* d_ws, size_t ws_size, hipStream_t stream) {
    static int grid = 0;
    if (grid == 0) {
        if (n_in != 24 || out_size != SEQ * DM || ws_size < WS_END) { fprintf(stderr, "kernel_launch: unexpected shapes n_in %d out %d ws %zu (need %zu)\n", n_in, out_size, ws_size, (size_t)WS_END); grid = -1; return; }
        int dev = 0, cus = 0, per_cu = 0;
        if (hipGetDevice(&dev) != hipSuccess || hipDeviceGetAttribute(&cus, hipDeviceAttributeMultiprocessorCount, dev) != hipSuccess) { grid = -1; return; }
        if (hipFuncSetAttribute((const void*)mk_fwd, hipFuncAttributeMaxDynamicSharedMemorySize, LDS_BYTES) != hipSuccess) { fprintf(stderr, "kernel_launch: hipFuncSetAttribute failed\n"); grid = -1; return; }
        if (hipOccupancyMaxActiveBlocksPerMultiprocessor(&per_cu, (const void*)mk_fwd, NTHR, LDS_BYTES) != hipSuccess || per_cu < 1) fprintf(stderr, "kernel_launch: occupancy query says %d\n", per_cu);
        (void)hipGetLastError();
        grid = cus;
    }
    if (grid < 0) return;
    (void)hipMemsetAsync((char*)d_ws + WS_CTL, 0, CTL_BYTES, stream);
    Args a{};
    for (int i = 0; i < 24; ++i) a.in[i] = d_in[i];
    a.out = (float*)d_out; a.ws = (unsigned char*)d_ws;
#if MK_MULTI
    static const int phases[] = {0, 1, 2, 3, 4, 5, 6, 7, 8, 9, 10, 11, 12, 18, 19, 20, 21, 22, 23, 24, 25, 26, 27, 28, 29, 30};
    for (int p : phases) { a.ph_lo = p; a.ph_hi = p + 1; hipLaunchKernelGGL(mk_fwd, dim3(grid), dim3(NTHR), LDS_BYTES, stream, a); }
#else
    a.ph_lo = 0; a.ph_hi = 31;
    hipLaunchKernelGGL(mk_fwd, dim3(grid), dim3(NTHR), LDS_BYTES, stream, a);
#endif
    const hipError_t le = hipPeekAtLastError();
    if (le != hipSuccess) fprintf(stderr, "kernel_launch: launch failed: %s\n", hipGetErrorName(le));
}
```

```cpp
#include <hip/hip_runtime.h>
#include <cstdio>
#include <cstdint>

#ifndef MK_MULTI
#define MK_MULTI 0
#endif

#define GAS __attribute__((address_space(1)))
#define LAS __attribute__((address_space(3)))
typedef unsigned short bf16_t;
typedef short bf16x8 __attribute__((ext_vector_type(8)));
typedef short s16x4 __attribute__((ext_vector_type(4)));
typedef float f32x4 __attribute__((ext_vector_type(4)));
typedef float f32x2 __attribute__((ext_vector_type(2)));
typedef float f32x16 __attribute__((ext_vector_type(16)));
typedef unsigned u32x4 __attribute__((ext_vector_type(4)));
typedef unsigned u32x2 __attribute__((ext_vector_type(2)));

constexpr int SEQ = 16384, DM = 2048, DIN = 1856, DINP = 2048;
constexpr int QLR = 512, KVLR = 256, ROPE = 64, NOPE = 128, VHD = 128, QKD = 192, NH = 8;
constexpr int ZQ = 0, ZKV = 512, ZKR = 768, ZU = 832;
constexpr int FNW = 1024, FG = 8;
constexpr int DFF = 5632, NE = 8, DFE = 7168;
constexpr int MAXT = 136;
constexpr float RMS_EPS = 1e-6f;
constexpr float S8_H = 8.f, S8_WGU = 64.f, S8_HID = 8.f, S8_WDN = 128.f;
constexpr int NWAVES = 8, NTHR = 512;

constexpr size_t MiB = 1u << 20;
constexpr size_t WS_CTL = 0, CTL_BYTES = 1 * MiB;
constexpr int CW_BAR = 4096;
constexpr int CW_ECNT = 8192;
constexpr int CW_F3CTR = 12288;
constexpr size_t CTL_ROWTOK = 256 * 1024;
constexpr size_t WS_MODP = 1 * MiB;
constexpr size_t WS_MODV = WS_MODP + 16 * 2 * 12288 * 4;
constexpr size_t WS_COS = 3 * MiB, WS_SIN = 5 * MiB;
constexpr size_t WS_TW = 7 * MiB;
constexpr size_t WS_FM = WS_TW + 131072;
constexpr size_t WS_GM = WS_FM + 65536;
constexpr size_t WS_M12 = 8 * MiB;
constexpr size_t WS_TOKINFO = 9 * MiB;
constexpr size_t WS_TOKPOS = WS_TOKINFO + (size_t)SEQ * 32;
constexpr size_t WS_WIN = 10 * MiB;
constexpr size_t WS_WUQ = WS_WIN + 2 * 8 * MiB;
constexpr size_t WS_WUKV = WS_WUQ + 2 * 1536 * 512 * 2;
constexpr size_t WS_WOUT = WS_WUKV + 2 * 2048 * 256 * 2;
constexpr size_t WS_WGUD = WS_WOUT + 2 * 8 * MiB;
constexpr size_t WS_WDND = WS_WGUD + (size_t)11264 * 2048 * 2;
constexpr size_t WS_WGUM = WS_WDND + (size_t)2048 * 5632 * 2;
constexpr size_t WS_WDNM = WS_WGUM + (size_t)8 * 14336 * 2048 * 2;
constexpr size_t WS_H = WS_WDNM + (size_t)8 * 2048 * 7168 * 2;
constexpr size_t WS_Y = WS_H + (size_t)SEQ * 2048 * 2;
constexpr size_t WS_ARENA = WS_Y + (size_t)MAXT * 256 * 2048 * 2;
constexpr size_t WS_Z = WS_ARENA;
constexpr size_t WS_QB = WS_Z + (size_t)SEQ * 2048 * 2;
constexpr size_t WS_KVB = WS_QB + (size_t)SEQ * 1536 * 2;
constexpr size_t WS_KB = WS_KVB + (size_t)SEQ * 2048 * 2;
constexpr size_t WS_A1 = WS_KB + (size_t)SEQ * 1536 * 2;
constexpr size_t WS_YC = WS_A1 + (size_t)SEQ * 2048 * 2;
constexpr size_t WS_HID = WS_ARENA;
constexpr size_t WS_END = WS_ARENA + (size_t)MAXT * 256 * 7168 * 2;
static_assert(WS_YC + (size_t)SEQ * 2048 * 2 <= WS_END, "arena");
static_assert(WS_END <= (size_t)1900 * MiB, "workspace budget");

constexpr int RING_BYTES = 133120;
constexpr int LDS_COND = RING_BYTES;
constexpr int LDS_TRIG = LDS_COND + 8192;
constexpr int LDS_MISC = LDS_TRIG + 1024;
constexpr int LDS_BYTES = 147456;
static_assert(LDS_MISC + 256 <= LDS_BYTES, "LDS map");

#define LDS_WAIT() asm volatile("s_waitcnt lgkmcnt(0)" ::: "memory")
#define VM_WAIT() asm volatile("s_waitcnt vmcnt(0)" ::: "memory")
#define RLX_AGENT __ATOMIC_RELAXED, __HIP_MEMORY_SCOPE_AGENT

__device__ __forceinline__ unsigned cvt_pk_bf16(float lo, float hi) { unsigned r; asm volatile("v_cvt_pk_bf16_f32 %0, %1, %2" : "=v"(r) : "v"(lo), "v"(hi)); return r; }
__device__ __forceinline__ float bf2f(unsigned short b) { return __uint_as_float(((unsigned)b) << 16); }
__device__ __forceinline__ bf16_t f2bf(float f) { return (bf16_t)(cvt_pk_bf16(f, 0.f) & 0xffffu); }
template <int XM> __device__ __forceinline__ float swz_xor(float v) { return __int_as_float(__builtin_amdgcn_ds_swizzle(__float_as_int(v), (XM << 10) | 0x1f)); }
__device__ __forceinline__ float wave_sum(float v) {
    v += swz_xor<1>(v); v += swz_xor<2>(v); v += swz_xor<4>(v); v += swz_xor<8>(v); v += swz_xor<16>(v);
    auto rr = __builtin_amdgcn_permlane32_swap(__float_as_uint(v), __float_as_uint(v), false, false);
    return __uint_as_float(rr[0]) + __uint_as_float(rr[1]);
}

#define XB_TMO      128
#define XB_XCNT(j)  (256  + 64 * (j))
#define XB_XSUB(j)  (1280 + 64 * (j))
#define XB_XGEN(j)  (2304 + 64 * (j))
#define XB_TOP      3328
#define XB_TOPGEN   3392
#define XCD_BAR_WORDS 3456
#define XB_SPIN_CAP (1u << 18)
__device__ __forceinline__ unsigned xb_ld(unsigned* p)              { return __hip_atomic_load(p, __ATOMIC_RELAXED, __HIP_MEMORY_SCOPE_AGENT); }
__device__ __forceinline__ unsigned xb_add(unsigned* p, unsigned v) { return __hip_atomic_fetch_add(p, v, __ATOMIC_RELAXED, __HIP_MEMORY_SCOPE_AGENT); }
__device__ __forceinline__ unsigned xb_xcc_id() { return (unsigned)__builtin_amdgcn_s_getreg((3 << 11) | 20) & 0xFu; }
#define XB_SPIN(cond, bar) do { unsigned _sp = 0; while (cond) { __builtin_amdgcn_s_sleep(1); \
    if ((++_sp & 255u) == 0u) { if (xb_ld(&(bar)[XB_TMO])) break; if (_sp > XB_SPIN_CAP) { atomicAdd(&(bar)[XB_TMO], 1u); break; } } } } while (0)
struct XcdBarrier { unsigned* bar; unsigned x; volatile LAS unsigned* st; };
__device__ __forceinline__ XcdBarrier xcd_barrier_post(unsigned* bar, volatile LAS unsigned* st) {
    XcdBarrier b; b.bar = bar; b.x = xb_xcc_id(); b.st = st;
    if (threadIdx.x == 0) (void)xb_add(&bar[XB_XCNT(b.x)], 1u);
    return b;
}
__device__ __forceinline__ void xcd_barrier_complete(unsigned* bar, unsigned x, unsigned& nloc, unsigned& nx) {
    const unsigned G = gridDim.x * gridDim.y * gridDim.z;
    unsigned sum, cnt, mine, sp = 0u;
    for (;;) {
        sum = 0u; cnt = 0u; mine = 0u;
#pragma unroll
        for (unsigned j = 0; j < 16; ++j) { const unsigned c = xb_ld(&bar[XB_XCNT(j)]); sum += c; cnt += (c > 0u) ? 1u : 0u; mine = (j == x) ? c : mine; }
        if (sum == G) break;
        __builtin_amdgcn_s_sleep(1);
        if ((++sp & 255u) == 0u) { if (xb_ld(&bar[XB_TMO])) break; if (sp > XB_SPIN_CAP) { atomicAdd(&bar[XB_TMO], 1u); break; } }
    }
    nloc = mine > 0u ? mine : 1u; nx = cnt > 0u ? cnt : 1u;
}
__device__ __forceinline__ void xcd_barrier(const XcdBarrier& b) {
    asm volatile("s_waitcnt vmcnt(0)" ::: "memory");
    __syncthreads();
    if (threadIdx.x == 0) {
        unsigned* bar = b.bar;
        __builtin_amdgcn_s_waitcnt(0);
        unsigned nloc = b.st[0], nx = b.st[1];
        if (nloc == 0u) { xcd_barrier_complete(bar, b.x, nloc, nx); b.st[0] = nloc; b.st[1] = nx; }
        const unsigned old = xb_add(&bar[XB_XSUB(b.x)], 1u);
        const unsigned gen = old / nloc;
        if (old + 1u == (gen + 1u) * nloc) {
            __builtin_amdgcn_fence(__ATOMIC_RELEASE, "agent");
            asm volatile("s_waitcnt vmcnt(0)" ::: "memory");
            const unsigned og = xb_add(&bar[XB_TOP], 1u);
            const unsigned tg = og / nx;
            if (og + 1u == (tg + 1u) * nx) xb_add(&bar[XB_TOPGEN], 1u);
            else XB_SPIN(xb_ld(&bar[XB_TOPGEN]) == tg, bar);
            __builtin_amdgcn_fence(__ATOMIC_ACQUIRE, "agent");
            xb_add(&bar[XB_XGEN(b.x)], 1u);
            asm volatile("s_waitcnt vmcnt(0)" ::: "memory");
        } else {
            XB_SPIN(xb_ld(&bar[XB_XGEN(b.x)]) == gen, bar);
            __builtin_amdgcn_fence(__ATOMIC_ACQUIRE, "agent");
            asm volatile("s_waitcnt vmcnt(0)" ::: "memory");
        }
    }
    __syncthreads();
}

namespace pg8 {
constexpr int BM = 256, BK = 64, HALF = 128, HTB = HALF * BK * 2, STAGE_BYTES = 8 * HTB, NXCD = 8, WGM = 8;
__host__ __device__ __forceinline__ int lds_byte(int r, int c) { const int st = (r >> 4) * 2 + (c >> 5), rr = r & 15, cc = c & 31, ob = rr * 64 + cc * 2; return st * 1024 + (ob ^ (((ob >> 9) & 1) << 5)); }
__host__ __device__ __forceinline__ void stage_rc(int b, int& R, int& C) { const int st = b / 1024, sb = b % 1024, swz = sb ^ (((sb >> 9) & 1) << 5); R = (st >> 1) * 16 + swz / 64; C = (st & 1) * 32 + (swz % 64) / 2; }
__host__ __device__ __forceinline__ int perm32(int rho) { const int n = rho >> 4, i = rho & 15; return 8 * (i >> 2) + 4 * n + (i & 3); }

struct Unit { int pm, pn, e, kq; };
struct Gemm { const void* A; const void* Bt; int lda, ldb, K; size_t estrideB; const int* rowmap; int ktB = 0; };

struct TileOrder {
    int nM, nN, nwg, G, c; int ts[9]; bool moe;
    __device__ __forceinline__ void init(int nM_, int nN_, int G_, int c_) { nM = nM_; nN = nN_; nwg = nM * nN; G = G_; c = c_; moe = false; }
    __device__ __forceinline__ bool next(int i, Unit& u) const {
        const long L = (long)i * G + c; if (L >= nwg) return false;
        int wgid = (int)L; { const int q = nwg / NXCD, r = nwg % NXCD, xcd = wgid % NXCD, off = wgid / NXCD; wgid = (xcd < r ? xcd * (q + 1) : r * (q + 1) + (xcd - r) * q) + off; }
        const int nig = WGM * nN, gid = wgid / nig, fm = gid * WGM, gsz = (nM - fm) < WGM ? (nM - fm) : WGM;
        u.pm = fm + ((wgid % nig) % gsz); u.pn = (wgid % nig) / gsz; u.e = 0; u.kq = 0;
        if (moe) {
#pragma unroll
            for (int j = 1; j < 8; ++j) if (u.pm >= ts[j]) u.e = j;
        }
        return true;
    }
};

struct TailOrder {
    int nsub, G, c, pm0; int ts[9];
    __device__ __forceinline__ bool next(int i, Unit& u) const {
        const int L = i * G + c; if (L >= nsub) return false;
        u.kq = L & 3; u.pn = (L >> 2) & 7; u.pm = pm0 + (L >> 5); u.e = 0;
#pragma unroll
        for (int j = 1; j < 8; ++j) if (u.pm >= ts[j]) u.e = j;
        return true;
    }
};
struct EpiBf16 {
    static constexpr bool PERM = true;
    bf16_t* O; int ldc; float scale; bf16_t* O2 = nullptr; size_t kqstride = 0;
    __device__ __forceinline__ void operator()(const f32x4 (&acc)[2][2][4][2], const Unit& u, int wr, int wc, int fr, int fq) const {
        const int row0 = u.pm * BM + wr * 64 + fr, col0 = u.pn * BM + wc * 32 + 8 * fq;
        bf16_t* const Ob = u.kq ? O2 + (size_t)(u.kq - 1) * kqstride : O;
#pragma unroll
        for (int ai = 0; ai < 2; ++ai)
#pragma unroll
            for (int m = 0; m < 4; ++m) { bf16_t* rowp = Ob + (size_t)(row0 + ai * HALF + m * 16) * ldc + col0;
#pragma unroll
                for (int bj = 0; bj < 2; ++bj) { const f32x4 v0 = acc[ai][bj][m][0] * scale, v1 = acc[ai][bj][m][1] * scale;
                    u32x4 w; w.x = cvt_pk_bf16(v0[0], v0[1]); w.y = cvt_pk_bf16(v0[2], v0[3]); w.z = cvt_pk_bf16(v1[0], v1[1]); w.w = cvt_pk_bf16(v1[2], v1[3]);
                    *(u32x4*)(rowp + bj * HALF) = w; } }
    }
};
__device__ __forceinline__ float silu_f(float x) { return x * __builtin_amdgcn_rcpf(1.0f + __builtin_amdgcn_exp2f(-1.4426950408889634f * x)); }
struct EpiSwiGLU {
    static constexpr bool PERM = true;
    bf16_t* O; int ldc;
    __device__ __forceinline__ void operator()(const f32x4 (&acc)[2][2][4][2], const Unit& u, int wr, int wc, int fr, int fq) const {
        const int row0 = u.pm * BM + wr * 64 + fr, col0 = u.pn * HALF + wc * 32 + 8 * fq;
#pragma unroll
        for (int ai = 0; ai < 2; ++ai)
#pragma unroll
            for (int m = 0; m < 4; ++m) { bf16_t* rowp = O + (size_t)(row0 + ai * HALF + m * 16) * ldc + col0;
                f32x4 v0, v1;
#pragma unroll
                for (int j = 0; j < 4; ++j) { v0[j] = silu_f(acc[ai][0][m][0][j]) * acc[ai][1][m][0][j]; v1[j] = silu_f(acc[ai][0][m][1][j]) * acc[ai][1][m][1][j]; }
                u32x4 w; w.x = cvt_pk_bf16(v0[0], v0[1]); w.y = cvt_pk_bf16(v0[2], v0[3]); w.z = cvt_pk_bf16(v1[0], v1[1]); w.w = cvt_pk_bf16(v1[2], v1[3]);
                *(u32x4*)rowp = w; }
    }
};
__device__ __forceinline__ float clamp448(float x) { return __builtin_amdgcn_fmed3f(x, -448.f, 448.f); }
struct EpiSwiGLU8 {
    static constexpr bool PERM = true;
    unsigned char* O; int ldc; float iscale, oscale;
    __device__ __forceinline__ void operator()(const f32x4 (&acc)[2][2][4][2], const Unit& u, int wr, int wc, int fr, int fq) const {
        const int row0 = u.pm * BM + wr * 64 + fr, col0 = u.pn * HALF + wc * 32 + 8 * fq;
#pragma unroll
        for (int ai = 0; ai < 2; ++ai)
#pragma unroll
            for (int m = 0; m < 4; ++m) { unsigned char* rowp = O + (size_t)(row0 + ai * HALF + m * 16) * ldc + col0;
                f32x4 v0, v1;
#pragma unroll
                for (int j = 0; j < 4; ++j) { v0[j] = clamp448(silu_f(acc[ai][0][m][0][j] * iscale) * (acc[ai][1][m][0][j] * (iscale * oscale)));
                                              v1[j] = clamp448(silu_f(acc[ai][0][m][1][j] * iscale) * (acc[ai][1][m][1][j] * (iscale * oscale))); }
                int w0 = 0, w1 = 0;
                w0 = __builtin_amdgcn_cvt_pk_fp8_f32(v0[0], v0[1], w0, false); w0 = __builtin_amdgcn_cvt_pk_fp8_f32(v0[2], v0[3], w0, true);
                w1 = __builtin_amdgcn_cvt_pk_fp8_f32(v1[0], v1[1], w1, false); w1 = __builtin_amdgcn_cvt_pk_fp8_f32(v1[2], v1[3], w1, true);
                u32x2 w; w.x = (unsigned)w0; w.y = (unsigned)w1; *(u32x2*)rowp = w; }
    }
};
struct EpiRes {
    static constexpr bool PERM = false;
    const float* X; float* O; const float* gate; int ldc;
    __device__ __forceinline__ void operator()(const f32x4 (&acc)[2][2][4][2], const Unit& u, int wr, int wc, int fr, int fq) const {
        const int row0 = u.pm * BM + wr * 64 + fr, col0 = u.pn * BM + wc * 32 + 4 * fq;
        f32x4 gv[2][2];
#pragma unroll
        for (int bj = 0; bj < 2; ++bj)
#pragma unroll
            for (int n = 0; n < 2; ++n) gv[bj][n] = *(const f32x4*)(gate + col0 + bj * HALF + n * 16);
        f32x4 xv[3][2][2];
#define EPR_LD(g_) do { const size_t off_ = (size_t)(row0 + ((g_) >> 2) * HALF + ((g_) & 3) * 16) * ldc + col0; _Pragma("unroll") for (int bj = 0; bj < 2; ++bj) _Pragma("unroll") for (int n = 0; n < 2; ++n) \
            xv[(g_) % 3][bj][n] = *(const f32x4*)(X + off_ + bj * HALF + n * 16); } while (0)
        EPR_LD(0); EPR_LD(1); EPR_LD(2);
#pragma unroll
        for (int g = 0; g < 8; ++g) { const int ai = g >> 2, m = g & 3; const size_t off = (size_t)(row0 + ai * HALF + m * 16) * ldc + col0;
            asm volatile("" ::: "memory");
#pragma unroll
            for (int bj = 0; bj < 2; ++bj)
#pragma unroll
                for (int n = 0; n < 2; ++n) *(f32x4*)(O + off + bj * HALF + n * 16) = xv[g % 3][bj][n] + gv[bj][n] * acc[ai][bj][m][n];
            asm volatile("" ::: "memory");
            if (g + 3 < 8) EPR_LD(g + 3); }
#undef EPR_LD
    }
};

typedef int v8i __attribute__((ext_vector_type(8)));
typedef unsigned u32x8 __attribute__((ext_vector_type(8)));
template <class Epi, class Sched, bool GATHER, bool FP8 = false, bool TILEDB = false>
__device__ __forceinline__ void gemm_phase(const int tid, LAS unsigned char* lds, const Gemm g, const Sched& S, const Epi& E) {
    const int wid = __builtin_amdgcn_readfirstlane(tid >> 6), lane = tid & 63, wr = wid >> 2, wc = wid & 3, fr = lane & 15, fq = lane >> 4;
    constexpr int ESZ = FP8 ? 1 : 2;
    const int nt = g.K * ESZ / (BK * 2);
    unsigned voffA[2], voffB[2];
#pragma unroll
    for (int i = 0; i < 2; ++i) { int R, C; stage_rc(tid * 16 + i * 8192, R, C); const int Rb = Epi::PERM ? ((R & ~31) + perm32(R & 31)) : R;
        voffA[i] = (unsigned)(R * g.lda * ESZ + C * 2); voffB[i] = TILEDB ? (unsigned)(Rb * 128 + C * 2) : (unsigned)(Rb * g.ldb * ESZ + C * 2); }
    const size_t kstep = (size_t)(BK * 2);
    const size_t hstepA = (size_t)HALF * g.lda * ESZ, tstepA = 2 * hstepA;
    const size_t kstepB = TILEDB ? (size_t)32768 : kstep;
    const size_t hstepB = TILEDB ? (size_t)16384 : (size_t)HALF * g.ldb * ESZ, tstepB = TILEDB ? (size_t)(g.ktB ? g.ktB : nt) * 32768 : 2 * hstepB;
    const size_t kqA = (size_t)nt * kstep, kqB = (size_t)nt * kstepB;
    const unsigned ldsw = (unsigned)wid * 1024u;
    const int aoff = lds_byte(wr * 64 + fr, fq * 8), boff = lds_byte(wc * 32 + fr, fq * 8);
#define PG8_SA(b, h) (((b) * 2 + (h)) * HTB)
#define PG8_SB(b, h) ((4 + (b) * 2 + (h)) * HTB)
#define PG8_STAGE(bufoff, gbase, voff) do { _Pragma("unroll") for (int _i = 0; _i < 2; ++_i) \
        __builtin_amdgcn_global_load_lds((const unsigned*)((const char*)(gbase) + (voff)[_i]), (LAS unsigned*)(lds + (bufoff) + ldsw + _i * 8192), 16, 0, 0); } while (0)
#define PG8_STAGE_A(bufoff, UB, h, kb, V0, V1) do { if constexpr (GATHER) { if (h) PG8_STAGE(bufoff, gA + (kb), V1); else PG8_STAGE(bufoff, gA + (kb), V0); } \
        else PG8_STAGE(bufoff, (UB) + (h) * hstepA + (kb), voffA); } while (0)
#define PG8_LD8(P) __builtin_shufflevector(*(const LAS u32x4*)(P), *(const LAS u32x4*)((P) + 1024), 0, 1, 2, 3, 4, 5, 6, 7)
#define PG8_LDA(dst, b, h) do { if constexpr (FP8) { _Pragma("unroll") for (int m = 0; m < 4; ++m) dst##8[m] = PG8_LD8(lds + PG8_SA(b, h) + aoff + m * 2048); } \
        else { _Pragma("unroll") for (int m = 0; m < 4; ++m) _Pragma("unroll") for (int k = 0; k < 2; ++k) dst[m][k] = *(const LAS bf16x8*)(lds + PG8_SA(b, h) + aoff + m * 2048 + k * 1024); } } while (0)
#define PG8_LDB(dst, b, h) do { if constexpr (FP8) { _Pragma("unroll") for (int n = 0; n < 2; ++n) dst##8[n] = PG8_LD8(lds + PG8_SB(b, h) + boff + n * 2048); } \
        else { _Pragma("unroll") for (int n = 0; n < 2; ++n) _Pragma("unroll") for (int k = 0; k < 2; ++k) dst[n][k] = *(const LAS bf16x8*)(lds + PG8_SB(b, h) + boff + n * 2048 + k * 1024); } } while (0)
#define PG8_MMA(ai, bj, At, Bt) do { __builtin_amdgcn_s_setprio(1); _Pragma("unroll") for (int m = 0; m < 4; ++m) _Pragma("unroll") for (int n = 0; n < 2; ++n) { \
        if constexpr (FP8) { asm("v_mfma_scale_f32_16x16x128_f8f6f4 %0, %1, %2, %0, %3, %3 op_sel_hi:[0,0,0]" : "+v"(acc[ai][bj][m][n]) : "v"(Bt##8[n]), "v"(At##8[m]), "v"(sc8)); } \
        else { _Pragma("unroll") for (int k = 0; k < 2; ++k) acc[ai][bj][m][n] = __builtin_amdgcn_mfma_f32_16x16x32_bf16(Bt[n][k], At[m][k], acc[ai][bj][m][n], 0, 0, 0); } } \
        __builtin_amdgcn_s_setprio(0); } while (0)
#define PG8_WAIT_V(n) asm volatile("s_waitcnt vmcnt(" #n ")" ::: "memory")
#define PG8_WAIT_L(n) asm volatile("s_waitcnt lgkmcnt(" #n ")" ::: "memory")
#define PG8_BAR __builtin_amdgcn_s_barrier()
#define PG8_SCHED __builtin_amdgcn_sched_barrier(0)
#define PG8_AOFFS(U, V0, V1) do { _Pragma("unroll") for (int _i = 0; _i < 2; ++_i) { int R_, C_; stage_rc(tid * 16 + _i * 8192, R_, C_); \
        const int r0 = g.rowmap[(U).pm * BM + R_], r1 = g.rowmap[(U).pm * BM + HALF + R_]; \
        V0[_i] = (unsigned)(r0 * g.lda * ESZ + C_ * 2); V1[_i] = (unsigned)(r1 * g.lda * ESZ + C_ * 2); } } while (0)
    Unit cur, nxt; int ui = 0;
    if (!S.next(0, cur)) return;
    f32x4 acc[2][2][4][2];
#pragma unroll
    for (int a = 0; a < 2; ++a)
#pragma unroll
        for (int b = 0; b < 2; ++b)
#pragma unroll
            for (int m = 0; m < 4; ++m)
#pragma unroll
                for (int n = 0; n < 2; ++n) acc[a][b][m][n] = (f32x4){0.f, 0.f, 0.f, 0.f};
    const unsigned sc8 = 0x7f7f7f7fu; (void)sc8;
    bf16x8 At[4][2], B0[2][2], B1[2][2]; u32x8 At8[4], B08[2], B18[2]; (void)At; (void)B0; (void)B1; (void)At8; (void)B08; (void)B18;
    unsigned vc0[2] = {0u, 0u}, vc1[2] = {0u, 0u}, vn0[2] = {0u, 0u}, vn1[2] = {0u, 0u};
    if constexpr (GATHER) PG8_AOFFS(cur, vc0, vc1);
    const char* gA = (const char*)g.A;
    const char* cA = gA + (size_t)cur.pm * tstepA + (size_t)cur.kq * kqA;
    const char* cB = (const char*)g.Bt + (size_t)cur.e * g.estrideB * ESZ + (size_t)cur.pn * tstepB + (size_t)cur.kq * kqB;
    PG8_STAGE(PG8_SB(0, 0), cB, voffB); PG8_STAGE(PG8_SB(0, 1), cB + hstepB, voffB); PG8_STAGE_A(PG8_SA(0, 0), cA, 0, 0, vc0, vc1); PG8_STAGE_A(PG8_SA(0, 1), cA, 1, 0, vc0, vc1);
    if (wr == 1) PG8_BAR;
    PG8_WAIT_V(2); PG8_BAR;
    PG8_STAGE(PG8_SB(1, 0), cB + kstepB, voffB); PG8_STAGE_A(PG8_SA(1, 0), cA, 0, kstep, vc0, vc1); PG8_STAGE(PG8_SB(1, 1), cB + hstepB + kstepB, voffB);
    PG8_WAIT_V(6); PG8_BAR;
    for (;;) {
        const bool has_next = S.next(ui + 1, nxt);
        const char* nA = cA; const char* nB = cB;
        if (has_next) { nA = gA + (size_t)nxt.pm * tstepA + (size_t)nxt.kq * kqA; nB = (const char*)g.Bt + (size_t)nxt.e * g.estrideB * ESZ + (size_t)nxt.pn * tstepB + (size_t)nxt.kq * kqB; }
        if constexpr (GATHER) { if (has_next) PG8_AOFFS(nxt, vn0, vn1); else {
#pragma unroll
            for (int _i = 0; _i < 2; ++_i) { vn0[_i] = vc0[_i]; vn1[_i] = vc1[_i]; } } }
        for (int t = 0; t < nt; t += 2) {
            const bool last = (t == nt - 2);
            const size_t k1 = (size_t)(t + 1) * kstep, k2 = last ? 0 : (size_t)(t + 2) * kstep, k3 = k2 + kstep;
            const char* u2 = last ? nA : cA; const char* b2 = (last ? nB : cB) + (last ? 0 : (size_t)(t + 2) * kstepB); const char* b3 = b2 + kstepB;
            unsigned va0[2] = {0u, 0u}, va1[2] = {0u, 0u};
            if constexpr (GATHER) {
#pragma unroll
                for (int _i = 0; _i < 2; ++_i) { va0[_i] = last ? vn0[_i] : vc0[_i]; va1[_i] = last ? vn1[_i] : vc1[_i]; } }
            PG8_LDB(B0, 0, 0); PG8_LDB(B1, 0, 1); PG8_SCHED; PG8_LDA(At, 0, 0); PG8_STAGE_A(PG8_SA(1, 1), cA, 1, k1, vc0, vc1);
            PG8_WAIT_V(8); PG8_WAIT_L(0); PG8_BAR; PG8_MMA(0, 0, At, B0); PG8_MMA(0, 1, At, B1); PG8_BAR; PG8_SCHED;
            PG8_LDA(At, 0, 1); PG8_STAGE(PG8_SB(0, 0), b2, voffB); PG8_STAGE(PG8_SB(0, 1), b2 + hstepB, voffB); PG8_STAGE_A(PG8_SA(0, 0), u2, 0, k2, va0, va1);
            PG8_WAIT_V(8); PG8_WAIT_L(0); PG8_BAR; PG8_MMA(1, 0, At, B0); PG8_MMA(1, 1, At, B1); PG8_BAR; PG8_SCHED;
            PG8_LDB(B0, 1, 0); PG8_LDB(B1, 1, 1); PG8_SCHED; PG8_LDA(At, 1, 0); PG8_STAGE_A(PG8_SA(0, 1), u2, 1, k2, va0, va1);
            PG8_WAIT_V(8); PG8_WAIT_L(0); PG8_BAR; PG8_MMA(0, 0, At, B0); PG8_MMA(0, 1, At, B1); PG8_BAR; PG8_SCHED;
            PG8_LDA(At, 1, 1); PG8_STAGE(PG8_SB(1, 0), b3, voffB); PG8_STAGE(PG8_SB(1, 1), b3 + hstepB, voffB); PG8_STAGE_A(PG8_SA(1, 0), u2, 0, k3, va0, va1);
            PG8_WAIT_V(8); PG8_WAIT_L(0); PG8_BAR; PG8_MMA(1, 0, At, B0); PG8_MMA(1, 1, At, B1); PG8_BAR; PG8_SCHED;
        }
        if constexpr (FP8) asm volatile("s_nop 15\n\ts_nop 15" ::: "memory");
        if (wr == 0) PG8_BAR;
        { int fr_ = fr, fq_ = fq; asm volatile("" : "+v"(fr_), "+v"(fq_)); E(acc, cur, wr, wc, fr_, fq_); }
        if (!has_next) break;
#pragma unroll
        for (int a = 0; a < 2; ++a)
#pragma unroll
            for (int b = 0; b < 2; ++b)
#pragma unroll
                for (int m = 0; m < 4; ++m)
#pragma unroll
                    for (int n = 0; n < 2; ++n) acc[a][b][m][n] = (f32x4){0.f, 0.f, 0.f, 0.f};
        cur = nxt; cA = nA; cB = nB; ++ui;
        if constexpr (GATHER) {
#pragma unroll
            for (int _i = 0; _i < 2; ++_i) { vc0[_i] = vn0[_i]; vc1[_i] = vn1[_i]; } }
        if (wr == 1) PG8_BAR;
    }
    PG8_WAIT_V(0);
    PG8_BAR;
#undef PG8_SA
#undef PG8_SB
#undef PG8_STAGE
#undef PG8_STAGE_A
#undef PG8_LDA
#undef PG8_LD8
#undef PG8_LDB
#undef PG8_MMA
#undef PG8_WAIT_V
#undef PG8_WAIT_L
#undef PG8_BAR
#undef PG8_SCHED
#undef PG8_AOFFS
}
}

namespace att {
constexpr int NW = 8, QBLK = 32, KVBLK = 64, DQ = QKD, DV = VHD;
constexpr float SCALE = 0.07216878364870322f;
constexpr float THR = 8.f;
constexpr int LDQ = 1536, LDK = 1536, LDV = 2048, LDO = 2048;
constexpr int SHM_V = KVBLK * DV * 2, SHM_K = KVBLK * DQ * 2, SHM_ATTN = 2 * SHM_V + 2 * SHM_K + NW * 64 * 4;
#define KSWZ(row, colB) ((row) * 384 + ((colB) ^ ((((row) >> 1) & 7) << 4)))
#define SBAR() __builtin_amdgcn_sched_barrier(0)
__device__ __forceinline__ int crow(int r, int hi) { return (r & 3) + 8 * (r >> 2) + 4 * hi; }
__device__ __forceinline__ void partialSM(f32x16& p0, f32x16& p1, float& m_reg, float& mn, float& alpha) {
  constexpr float C = SCALE * 1.4426950408889634f;
  float pmax = p0[0];
#pragma unroll
  for (int r = 1; r < 16; ++r) pmax = fmaxf(pmax, p0[r]);
#pragma unroll
  for (int r = 0; r < 16; ++r) pmax = fmaxf(pmax, p1[r]);
  { auto rr = __builtin_amdgcn_permlane32_swap(__float_as_uint(pmax), __float_as_uint(pmax), false, false);
    pmax = fmaxf(__uint_as_float(rr[0]), __uint_as_float(rr[1])); }
  if (__builtin_expect(__all(pmax - m_reg <= THR / SCALE), 1)) { mn = m_reg; alpha = 1.f; }
  else { mn = fmaxf(m_reg, pmax); alpha = __builtin_amdgcn_exp2f((m_reg - mn) * C); m_reg = mn; }
  float mnC = -mn * C;
#pragma unroll
  for (int r = 0; r < 16; ++r) p0[r] = fmaf(p0[r], C, mnC);
#pragma unroll
  for (int r = 0; r < 16; ++r) p1[r] = fmaf(p1[r], C, mnC);
#pragma unroll
  for (int r = 0; r < 16; ++r) p0[r] = __builtin_amdgcn_exp2f(p0[r]);
}
__device__ __forceinline__ void finishSM(f32x16& p0, f32x16& p1, float alpha, float& l_reg, bf16x8& pa0, bf16x8& pa1, bf16x8& pa2, bf16x8& pa3) {
#pragma unroll
  for (int r = 0; r < 16; ++r) p1[r] = __builtin_amdgcn_exp2f(p1[r]);
  float ps = 0;
#pragma unroll
  for (int r = 0; r < 16; ++r) ps += p0[r];
#pragma unroll
  for (int r = 0; r < 16; ++r) ps += p1[r];
  { auto rr = __builtin_amdgcn_permlane32_swap(__float_as_uint(ps), __float_as_uint(ps), false, false);
    ps = __uint_as_float(rr[0]) + __uint_as_float(rr[1]); }
  l_reg = l_reg * alpha + ps;
#define PK4(P, BASE, OUT) do { unsigned a0 = cvt_pk_bf16(P[BASE + 0], P[BASE + 1]), a1 = cvt_pk_bf16(P[BASE + 2], P[BASE + 3]);   \
    unsigned b0 = cvt_pk_bf16(P[BASE + 4], P[BASE + 5]), b1 = cvt_pk_bf16(P[BASE + 6], P[BASE + 7]);                              \
    auto r0 = __builtin_amdgcn_permlane32_swap(a0, b0, false, false); auto r1 = __builtin_amdgcn_permlane32_swap(a1, b1, false, false); \
    u32x4 w = {r0[0], r1[0], r0[1], r1[1]}; OUT = *reinterpret_cast<bf16x8*>(&w); } while (0)
  PK4(p0, 0, pa0); PK4(p0, 8, pa1); PK4(p1, 0, pa2); PK4(p1, 8, pa3);
#undef PK4
}
__device__ __forceinline__ void qkt(f32x16& p0, f32x16& p1, const char* Ks, const bf16x8* qr, int r32, int hi) {
  p0 = f32x16{}; p1 = f32x16{};
#pragma unroll
  for (int d0 = 0; d0 < DQ / 16; ++d0) { int cb = (d0 * 16 + hi * 8) * 2;
    bf16x8 b0 = *reinterpret_cast<const bf16x8*>(Ks + KSWZ(r32, cb));
    bf16x8 b1 = *reinterpret_cast<const bf16x8*>(Ks + KSWZ(32 + r32, cb));
    p0 = __builtin_amdgcn_mfma_f32_32x32x16_bf16(b0, qr[d0], p0, 0, 0, 0);
    p1 = __builtin_amdgcn_mfma_f32_32x32x16_bf16(b1, qr[d0], p1, 0, 0, 0);
    if ((d0 & 3) == 3) SBAR(); }
}
__device__ __forceinline__ int v_st(int k, int c) { const int kk = (k & ~0xC) | ((k & 4) << 1) | ((k & 8) >> 1); return ((kk >> 3) * 4 + (c >> 5)) * 512 + ((kk & 7) * 32 + (c & 31)) * 2; }
__device__ __forceinline__ int v_rd_base(int lane) { return ((lane & 3) << 3) | (((lane >> 2) & 3) << 6) | (((lane >> 4) & 1) << 5) | (((lane >> 5) & 1) << 8); }
constexpr int v_rd_off(int d0, int ks, int half) { return d0 * 512 + ks * 4096 + half * 2048; }
template <int OFF> __device__ __forceinline__ s16x4 tr_read(int vb) {
  s16x4 r; asm volatile("ds_read_b64_tr_b16 %0, %1 offset:%2" : "=&v"(r) : "v"(vb), "i"(OFF) : "memory"); return r;
}
template <int D0> __device__ __forceinline__ void pv_one(f32x16& od, int vb, bf16x8 pa0, bf16x8 pa1, bf16x8 pa2, bf16x8 pa3) {
  const s16x4 l0 = tr_read<v_rd_off(D0, 0, 0)>(vb), h0 = tr_read<v_rd_off(D0, 0, 1)>(vb), l1 = tr_read<v_rd_off(D0, 1, 0)>(vb), h1 = tr_read<v_rd_off(D0, 1, 1)>(vb);
  const s16x4 l2 = tr_read<v_rd_off(D0, 2, 0)>(vb), h2 = tr_read<v_rd_off(D0, 2, 1)>(vb), l3 = tr_read<v_rd_off(D0, 3, 0)>(vb), h3 = tr_read<v_rd_off(D0, 3, 1)>(vb);
  asm volatile("s_waitcnt lgkmcnt(0)" ::: "memory"); SBAR();
#define PK(L, H) (bf16x8){L[0], L[1], L[2], L[3], H[0], H[1], H[2], H[3]}
  od = __builtin_amdgcn_mfma_f32_32x32x16_bf16(pa0, PK(l0, h0), od, 0, 0, 0);
  od = __builtin_amdgcn_mfma_f32_32x32x16_bf16(pa1, PK(l1, h1), od, 0, 0, 0);
  od = __builtin_amdgcn_mfma_f32_32x32x16_bf16(pa2, PK(l2, h2), od, 0, 0, 0);
  od = __builtin_amdgcn_mfma_f32_32x32x16_bf16(pa3, PK(l3, h3), od, 0, 0, 0);
#undef PK
}
#define PV_RD(D0, L, H) do { L[0] = tr_read<v_rd_off(D0, 0, 0)>(vb); H[0] = tr_read<v_rd_off(D0, 0, 1)>(vb); L[1] = tr_read<v_rd_off(D0, 1, 0)>(vb); H[1] = tr_read<v_rd_off(D0, 1, 1)>(vb); \
    L[2] = tr_read<v_rd_off(D0, 2, 0)>(vb); H[2] = tr_read<v_rd_off(D0, 2, 1)>(vb); L[3] = tr_read<v_rd_off(D0, 3, 0)>(vb); H[3] = tr_read<v_rd_off(D0, 3, 1)>(vb); } while (0)
#define PV_MM(OD, L, H) do { OD = __builtin_amdgcn_mfma_f32_32x32x16_bf16(pa0, PKX(L[0], H[0]), OD, 0, 0, 0); OD = __builtin_amdgcn_mfma_f32_32x32x16_bf16(pa1, PKX(L[1], H[1]), OD, 0, 0, 0); \
    OD = __builtin_amdgcn_mfma_f32_32x32x16_bf16(pa2, PKX(L[2], H[2]), OD, 0, 0, 0); OD = __builtin_amdgcn_mfma_f32_32x32x16_bf16(pa3, PKX(L[3], H[3]), OD, 0, 0, 0); } while (0)
#define PKX(L, H) (bf16x8){L[0], L[1], L[2], L[3], H[0], H[1], H[2], H[3]}
__device__ __forceinline__ void pv_d0_pipe(f32x16* o, int vb, bf16x8 pa0, bf16x8 pa1, bf16x8 pa2, bf16x8 pa3) {
  s16x4 la[4], ha[4], lb[4], hb[4];
  PV_RD(0, la, ha);
#define PV_PIN(OD) asm volatile("" : "+v"(OD))
  PV_RD(1, lb, hb); asm volatile("s_waitcnt lgkmcnt(8)" ::: "memory"); SBAR(); PV_MM(o[0], la, ha); PV_PIN(o[0]);
  PV_RD(2, la, ha); asm volatile("s_waitcnt lgkmcnt(8)" ::: "memory"); SBAR(); PV_MM(o[1], lb, hb); PV_PIN(o[1]);
  PV_RD(3, lb, hb); asm volatile("s_waitcnt lgkmcnt(8)" ::: "memory"); SBAR(); PV_MM(o[2], la, ha); PV_PIN(o[2]);
  asm volatile("s_waitcnt lgkmcnt(0)" ::: "memory"); SBAR(); PV_MM(o[3], lb, hb); PV_PIN(o[3]);
#undef PV_PIN
}
__device__ __forceinline__ void pv_fsm(f32x16* o, int vb, bf16x8 pa0, bf16x8 pa1, bf16x8 pa2, bf16x8 pa3, f32x16& p0, f32x16& p1, int negMCbits, s16x4* la, s16x4* ha, s16x4* lb, s16x4* hb) {
  constexpr float C = SCALE * 1.4426950408889634f;
  int nb_ = __builtin_amdgcn_readfirstlane(negMCbits); asm volatile("" : "+s"(nb_)); const float negMC = __builtin_bit_cast(float, nb_);
#define FSQ(q) do { _Pragma("unroll") for (int r_ = (q); r_ < 16; r_ += 4) { float x_ = p1[r_]; asm("" : "+v"(x_)); p0[r_] = fmaf(p0[r_], C, negMC); p1[r_] = fmaf(x_, C, negMC); p0[r_] = __builtin_amdgcn_exp2f(p0[r_]); } } while (0)
#define PV_PIN(OD, q) asm volatile("" :: "v"(OD), "v"(p0[q]), "v"(p0[q + 4]), "v"(p0[q + 8]), "v"(p0[q + 12]), "v"(p1[q]), "v"(p1[q + 4]), "v"(p1[q + 8]), "v"(p1[q + 12]))
#define PV_WAIT(N, L, H) asm volatile("s_waitcnt lgkmcnt(" #N ")" : "+v"(L[0]), "+v"(H[0]), "+v"(L[1]), "+v"(H[1]), "+v"(L[2]), "+v"(H[2]), "+v"(L[3]), "+v"(H[3]) :: "memory")
  PV_RD(1, lb, hb); PV_WAIT(8, la, ha); SBAR(); PV_MM(o[0], la, ha); FSQ(0); PV_PIN(o[0], 0);
  PV_RD(2, la, ha); PV_WAIT(8, lb, hb); SBAR(); PV_MM(o[1], lb, hb); FSQ(1); PV_PIN(o[1], 1);
  PV_RD(3, lb, hb); PV_WAIT(8, la, ha); SBAR(); PV_MM(o[2], la, ha); FSQ(2); FSQ(3); PV_PIN(o[2], 2); PV_PIN(o[2], 3);
  PV_WAIT(0, lb, hb);
#undef FSQ
#undef PV_PIN
#undef PV_WAIT
}
#undef PV_RD
#undef PV_MM
#undef PKX
__device__ __forceinline__ void pv_d0(f32x16* o, int vb, bf16x8 pa0, bf16x8 pa1, bf16x8 pa2, bf16x8 pa3) {
  pv_one<0>(o[0], vb, pa0, pa1, pa2, pa3); pv_one<1>(o[1], vb, pa0, pa1, pa2, pa3); pv_one<2>(o[2], vb, pa0, pa1, pa2, pa3); pv_one<3>(o[3], vb, pa0, pa1, pa2, pa3);
}


constexpr int K_OFF = 0, V_OFF = 3 * SHM_K, WS_OFF = V_OFF + 3 * SHM_V, SHM_ATTN2 = WS_OFF + NW * 64 * 4;
constexpr int KOFS_OFF = SHM_ATTN2;
__device__ __forceinline__ void qkt_l(f32x16& p0, f32x16& p1, LAS const char* Ks, const bf16x8* qr, int r32, int hi) {
  p0 = f32x16{}; p1 = f32x16{};
  __builtin_amdgcn_s_setprio(1);
  const int swz = ((r32 >> 1) & 7) << 4, rowb = r32 * 384;
  LAS const char* ar[4];
#pragma unroll
  for (int r = 0; r < 4; ++r) ar[r] = Ks + rowb + ((32 * r + 16 * hi) ^ swz);
#pragma unroll
  for (int q = 0; q < DQ / 64; ++q)
#pragma unroll
    for (int r = 0; r < 4; ++r) { const int d0 = 4 * q + r;
      bf16x8 b0 = *reinterpret_cast<LAS const bf16x8*>(ar[r] + 128 * q);
      bf16x8 b1 = *reinterpret_cast<LAS const bf16x8*>(ar[r] + 128 * q + 32 * 384);
      p0 = __builtin_amdgcn_mfma_f32_32x32x16_bf16(b0, qr[d0], p0, 0, 0, 0);
      p1 = __builtin_amdgcn_mfma_f32_32x32x16_bf16(b1, qr[d0], p1, 0, 0, 0);
      if (r == 3 && d0 != DQ / 16 - 1) SBAR(); }
  __builtin_amdgcn_s_setprio(0);
}
__device__ __forceinline__ void qkt_l2(f32x16& p0, f32x16& p1, LAS const char* Ks, const bf16x8* qr, int r32, int hi) {
  p0 = f32x16{}; p1 = f32x16{};
  const int swz = ((r32 >> 1) & 7) << 4, rowb = r32 * 384;
  LAS const char* ar[4];
#pragma unroll
  for (int r = 0; r < 4; ++r) ar[r] = Ks + rowb + ((32 * r + 16 * hi) ^ swz);
#pragma unroll
  for (int q = 0; q < DQ / 64; ++q)
#pragma unroll
    for (int r = 0; r < 4; ++r) { const int d0 = 4 * q + r;
      bf16x8 b0 = *reinterpret_cast<LAS const bf16x8*>(ar[r] + 128 * q);
      bf16x8 b1 = *reinterpret_cast<LAS const bf16x8*>(ar[r] + 128 * q + 32 * 384);
      p0 = __builtin_amdgcn_mfma_f32_32x32x16_bf16(b0, qr[d0], p0, 0, 0, 0);
      p1 = __builtin_amdgcn_mfma_f32_32x32x16_bf16(b1, qr[d0], p1, 0, 0, 0);
    }
}
__device__ __forceinline__ float psm_max(const f32x16& p) { float m = p[0];
#pragma unroll
  for (int r = 1; r < 16; ++r) m = fmaxf(m, p[r]);
  return m; }
__device__ __forceinline__ void psm_decide(float pmax, float& m_reg, float& mnC, float& alpha) {
  constexpr float C = SCALE * 1.4426950408889634f;
  { auto rr = __builtin_amdgcn_permlane32_swap(__float_as_uint(pmax), __float_as_uint(pmax), false, false);
    pmax = fmaxf(__uint_as_float(rr[0]), __uint_as_float(rr[1])); }
  float mn;
  if (__builtin_expect(__all(pmax - m_reg <= THR / SCALE), 1)) { mn = m_reg; alpha = 1.f; }
  else { mn = fmaxf(m_reg, pmax); alpha = __builtin_amdgcn_exp2f((m_reg - mn) * C); m_reg = mn; }
  mnC = -mn * C;
}
__device__ __forceinline__ void psm_scale(f32x16& p, float mnC) { constexpr float C = SCALE * 1.4426950408889634f;
#pragma unroll
  for (int r = 0; r < 16; ++r) p[r] = fmaf(p[r], C, mnC); }
__device__ __forceinline__ void psm_exp(f32x16& p) {
#pragma unroll
  for (int r = 0; r < 16; ++r) p[r] = __builtin_amdgcn_exp2f(p[r]); }

__device__ __forceinline__ void fsm_first(f32x16& p0, f32x16& p1, int negMCbits) {
  constexpr float C = SCALE * 1.4426950408889634f;
  int nb_ = __builtin_amdgcn_readfirstlane(negMCbits); asm volatile("" : "+s"(nb_)); const float negMC = __builtin_bit_cast(float, nb_);
#pragma unroll
  for (int r = 0; r < 16; ++r) p0[r] = fmaf(p0[r], C, negMC);
#pragma unroll
  for (int r = 0; r < 16; ++r) p1[r] = fmaf(p1[r], C, negMC);
#pragma unroll
  for (int r = 0; r < 16; ++r) p0[r] = __builtin_amdgcn_exp2f(p0[r]);
}
__device__ __forceinline__ void fsm_finish(f32x16& p0, f32x16& p1, float& l_reg, bf16x8& pa0, bf16x8& pa1, bf16x8& pa2, bf16x8& pa3) {
#pragma unroll
  for (int r = 0; r < 16; ++r) p1[r] = __builtin_amdgcn_exp2f(p1[r]);
  float ps = 0;
#pragma unroll
  for (int r = 0; r < 16; ++r) ps += p0[r];
#pragma unroll
  for (int r = 0; r < 16; ++r) ps += p1[r];
  { auto rr = __builtin_amdgcn_permlane32_swap(__float_as_uint(ps), __float_as_uint(ps), false, false);
    ps = __uint_as_float(rr[0]) + __uint_as_float(rr[1]); }
  l_reg += ps;
#define PK4(P, BASE, OUT) do { unsigned a0 = cvt_pk_bf16(P[BASE + 0], P[BASE + 1]), a1 = cvt_pk_bf16(P[BASE + 2], P[BASE + 3]);   \
    unsigned b0 = cvt_pk_bf16(P[BASE + 4], P[BASE + 5]), b1 = cvt_pk_bf16(P[BASE + 6], P[BASE + 7]);                              \
    auto r0 = __builtin_amdgcn_permlane32_swap(a0, b0, false, false); auto r1 = __builtin_amdgcn_permlane32_swap(a1, b1, false, false); \
    u32x4 w = {r0[0], r1[0], r0[1], r1[1]}; OUT = *reinterpret_cast<bf16x8*>(&w); } while (0)
  PK4(p0, 0, pa0); PK4(p0, 8, pa1); PK4(p1, 0, pa2); PK4(p1, 8, pa3);
#undef PK4
}
struct DmaT { const char* gK; const char* gV; LAS unsigned char* lK; LAS unsigned char* lV; int kofs; unsigned v0, v1; };
__device__ __forceinline__ void qk_fsm(f32x16& p0, f32x16& p1, int ksb, const bf16x8* qr, int r32, int hi, f32x16& f0, f32x16& f1, float& l_reg, bf16x8& pa0, bf16x8& pa1, bf16x8& pa2, bf16x8& pa3, const DmaT d, s16x4* la, s16x4* ha, int vb, f32x16& o3, const s16x4* lb, const s16x4* hb) {
  const int swz = ((r32 >> 1) & 7) << 4, rowb = r32 * 384;
  int ar[4];
#pragma unroll
  for (int r = 0; r < 4; ++r) ar[r] = ksb + rowb + ((32 * r + 16 * hi) ^ swz);
  bf16x8 ka[4], kb[4];
#define KRD(dst, d0, h) asm volatile("ds_read_b128 %0, %1 offset:%2" : "=v"(dst) : "v"(ar[(d0) & 3]), "i"(128 * ((d0) >> 2) + 12288 * (h)))
#define KRD4(B, s) do { KRD(B[0], 2 * (s), 0); KRD(B[1], 2 * (s), 1); KRD(B[2], 2 * (s) + 1, 0); KRD(B[3], 2 * (s) + 1, 1); } while (0)
#define KWAIT(N, B) asm volatile("s_waitcnt lgkmcnt(" #N ")" : "+v"(B[0]), "+v"(B[1]), "+v"(B[2]), "+v"(B[3]))
#define KMM(B, s) do { p0 = __builtin_amdgcn_mfma_f32_32x32x16_bf16(B[0], qr[2 * (s)], p0, 0, 0, 0); p1 = __builtin_amdgcn_mfma_f32_32x32x16_bf16(B[1], qr[2 * (s)], p1, 0, 0, 0); \
    p0 = __builtin_amdgcn_mfma_f32_32x32x16_bf16(B[2], qr[2 * (s) + 1], p0, 0, 0, 0); p1 = __builtin_amdgcn_mfma_f32_32x32x16_bf16(B[3], qr[2 * (s) + 1], p1, 0, 0, 0); } while (0)
#define PK4(P, BASE, OUT) do { unsigned a0 = cvt_pk_bf16(P[BASE + 0], P[BASE + 1]), a1 = cvt_pk_bf16(P[BASE + 2], P[BASE + 3]);   \
    unsigned b0 = cvt_pk_bf16(P[BASE + 4], P[BASE + 5]), b1 = cvt_pk_bf16(P[BASE + 6], P[BASE + 7]);                              \
    auto r0 = __builtin_amdgcn_permlane32_swap(a0, b0, false, false); auto r1 = __builtin_amdgcn_permlane32_swap(a1, b1, false, false); \
    u32x4 w = {r0[0], r1[0], r0[1], r1[1]}; OUT = *reinterpret_cast<bf16x8*>(&w); } while (0)
  p0 = f32x16{}; p1 = f32x16{};
  u32x4 ko; asm volatile("ds_read_b128 %0, %1" : "=v"(ko) : "v"(d.kofs));
#define DMA_PK(i_) __builtin_amdgcn_global_load_lds((const unsigned*)(d.gK + ko[i_]), (LAS unsigned*)(d.lK + 8192 * (i_)), 16, 0, 0)
#define DMA_PV(i_, vo_) __builtin_amdgcn_global_load_lds((const unsigned*)(d.gV + (vo_)), (LAS unsigned*)(d.lV + 8192 * (i_)), 16, 0, 0)
  KRD4(ka, 0); KRD4(kb, 1);
#define PKX(L, H) (bf16x8){L[0], L[1], L[2], L[3], H[0], H[1], H[2], H[3]}
  o3 = __builtin_amdgcn_mfma_f32_32x32x16_bf16(pa0, PKX(lb[0], hb[0]), o3, 0, 0, 0); o3 = __builtin_amdgcn_mfma_f32_32x32x16_bf16(pa1, PKX(lb[1], hb[1]), o3, 0, 0, 0);
  o3 = __builtin_amdgcn_mfma_f32_32x32x16_bf16(pa2, PKX(lb[2], hb[2]), o3, 0, 0, 0); o3 = __builtin_amdgcn_mfma_f32_32x32x16_bf16(pa3, PKX(lb[3], hb[3]), o3, 0, 0, 0);
#undef PKX
#pragma unroll
  for (int r = 0; r < 16; ++r) f1[r] = __builtin_amdgcn_exp2f(f1[r]);
  asm volatile("" :: "v"(o3), "v"(f1[0]), "v"(f1[1]), "v"(f1[2]), "v"(f1[3]), "v"(f1[4]), "v"(f1[5]), "v"(f1[6]), "v"(f1[7]), "v"(f1[8]), "v"(f1[9]), "v"(f1[10]), "v"(f1[11]), "v"(f1[12]), "v"(f1[13]), "v"(f1[14]), "v"(f1[15]));
  KWAIT(4, ka); asm volatile("" : "+v"(ko)); KMM(ka, 0);
  DMA_PK(0);
  asm volatile("" :: "v"(p0), "v"(p1));
  KRD4(ka, 2); KWAIT(4, kb); KMM(kb, 1);
  DMA_PK(1);
  float ps = 0;
#pragma unroll
  for (int r = 0; r < 8; ++r) ps += f0[r];
  asm volatile("" :: "v"(p0), "v"(p1), "v"(ps));
  KRD4(kb, 3); KWAIT(4, ka); KMM(ka, 2);
  DMA_PK(2);
#pragma unroll
  for (int r = 8; r < 16; ++r) ps += f0[r];
  asm volatile("" :: "v"(p0), "v"(p1), "v"(ps));
  KRD4(ka, 4); KWAIT(4, kb); KMM(kb, 3);
  DMA_PV(0, d.v0);
#pragma unroll
  for (int r = 0; r < 16; ++r) ps += f1[r];
  { auto rr = __builtin_amdgcn_permlane32_swap(__float_as_uint(ps), __float_as_uint(ps), false, false);
    ps = __uint_as_float(rr[0]) + __uint_as_float(rr[1]); }
  l_reg += ps;
  asm volatile("" :: "v"(p0), "v"(p1), "v"(l_reg));
  KRD4(kb, 5); KWAIT(4, ka); KMM(ka, 4);
  DMA_PV(1, d.v1);
  PK4(f0, 0, pa0); PK4(f0, 8, pa1);
  asm volatile("" :: "v"(p0), "v"(p1), "v"(pa0), "v"(pa1));
  KWAIT(0, kb);
  la[0] = tr_read<v_rd_off(0, 0, 0)>(vb); ha[0] = tr_read<v_rd_off(0, 0, 1)>(vb); la[1] = tr_read<v_rd_off(0, 1, 0)>(vb); ha[1] = tr_read<v_rd_off(0, 1, 1)>(vb);
  la[2] = tr_read<v_rd_off(0, 2, 0)>(vb); ha[2] = tr_read<v_rd_off(0, 2, 1)>(vb); la[3] = tr_read<v_rd_off(0, 3, 0)>(vb); ha[3] = tr_read<v_rd_off(0, 3, 1)>(vb);
  KMM(kb, 5);
  PK4(f1, 0, pa2); PK4(f1, 8, pa3);
  asm volatile("" :: "v"(p0), "v"(p1), "v"(pa2), "v"(pa3));
#undef KRD
#undef KRD4
#undef KWAIT
#undef KMM
#undef PK4
#undef DMA_PK
#undef DMA_PV
}
__device__ __forceinline__ void attn_unit2(const bf16_t* __restrict__ Qb, const bf16_t* __restrict__ Kh, const bf16_t* __restrict__ Vh, bf16_t* __restrict__ Ob, int seq, LAS unsigned char* lds, const int tid, const int negMC) {
  const int wid = __builtin_amdgcn_readfirstlane(tid >> 6), lane = tid & 63, r32 = lane & 31, hi = lane >> 5;
  LAS float* ws = (LAS float*)(lds + WS_OFF) + wid * 64; LAS float* li_l = ws; LAS float* al_l = ws + 32;
  float l_reg = 0; f32x16 o[4] = {}; bf16x8 qr[DQ / 16];
  const bf16_t* Qw = Qb + (long)(wid * QBLK + r32) * LDQ + hi * 8;
#pragma unroll
  for (int d0 = 0; d0 < DQ / 16; ++d0) qr[d0] = *reinterpret_cast<const bf16x8*>(Qw + d0 * 16);
#define KOFF(i_, ln_) ({ const int b_ = 1024 * (wid + 8 * (i_)) + 16 * (ln_), row_ = b_ / 384, x_ = b_ % 384; (unsigned)(row_ * LDK * 2 + (x_ ^ (((row_ >> 1) & 7) << 4))); })
  unsigned voff[2];
#pragma unroll
  for (int i = 0; i < 2; ++i) { const int b = 1024 * (wid + 8 * i) + 16 * lane, st = b >> 9, off = b & 511, kk = (st >> 2) * 8 + (off >> 6), c = (st & 3) * 32 + ((off & 63) >> 1);
    const int k = (kk & ~0xC) | ((kk & 4) << 1) | ((kk & 8) >> 1); voff[i] = (unsigned)(k * LDV * 2 + c * 2); }
  const int NT = seq / KVBLK;
  const int kofs = (int)(uintptr_t)(lds + KOFS_OFF) + tid * 16;
  { u32x4 kv_ = {KOFF(0, lane), KOFF(1, lane), KOFF(2, lane), 0u}; asm volatile("ds_write_b128 %0, %1" :: "v"(kofs), "v"(kv_) : "memory"); }
#define DMAT(tk, ks, tv, vs) att::DmaT{(const char*)Kh + (size_t)((tk) < NT ? (tk) : NT - 1) * (KVBLK * LDK * 2), (const char*)Vh + (size_t)((tv) < NT ? (tv) : NT - 1) * (KVBLK * LDV * 2), \
    lds + K_OFF + (ks) * SHM_K + wid * 1024, lds + V_OFF + (vs) * SHM_V + wid * 1024, kofs, voff[0], voff[1]}
#define DMA_K(t, slot) do { const int t_ = (t) < NT ? (t) : NT - 1; const char* g_ = (const char*)Kh + (size_t)t_ * (KVBLK * LDK * 2); int ln_ = lane; asm volatile("" : "+v"(ln_)); _Pragma("unroll") for (int i_ = 0; i_ < 3; ++i_) \
    __builtin_amdgcn_global_load_lds((const unsigned*)(g_ + KOFF(i_, ln_)), (LAS unsigned*)(lds + K_OFF + (slot) * SHM_K + (wid + 8 * i_) * 1024), 16, 0, 0); } while (0)
#define DMA_V(t, slot) do { const int t_ = (t) < NT ? (t) : NT - 1; const char* g_ = (const char*)Vh + (size_t)t_ * (KVBLK * LDV * 2); _Pragma("unroll") for (int i_ = 0; i_ < 2; ++i_) \
    __builtin_amdgcn_global_load_lds((const unsigned*)(g_ + voff[i_]), (LAS unsigned*)(lds + V_OFF + (slot) * SHM_V + (wid + 8 * i_) * 1024), 16, 0, 0); } while (0)
#define QK_PACE() do { _Pragma("unroll") for (int g_ = 0; g_ < 12; ++g_) { __builtin_amdgcn_sched_group_barrier(0x100, 2, 0); __builtin_amdgcn_sched_group_barrier(0x008, 2, 0); __builtin_amdgcn_sched_group_barrier(0x002, 8, 0); } } while (0)
#define WAITBAR() do { asm volatile("s_waitcnt vmcnt(5) lgkmcnt(0)" ::: "memory"); __builtin_amdgcn_s_barrier(); asm volatile("" ::: "memory"); } while (0)
  const int vbase = (int)(uintptr_t)(lds + V_OFF) + v_rd_base(lane);
  f32x16 pA0, pA1, pB0, pB1; bf16x8 pa0 = {}, pa1 = {}, pa2 = {}, pa3 = {};
  s16x4 la[4], ha[4], lb[4] = {}, hb[4] = {};
  DMA_K(0, 0); DMA_K(1, 1); DMA_V(0, 0);
  WAITBAR();
  DMA_K(2, 2); DMA_V(1, 1);
  qkt_l(pA0, pA1, (LAS const char*)(lds + K_OFF), qr, r32, hi); fsm_first(pA0, pA1, negMC);
  WAITBAR();
  int a = 1;
  for (int t = 1; t + 1 < NT; t += 2) {
    { const int kd = (a + 2) % 3, vd = (a + 1) % 3;
      SBAR(); __builtin_amdgcn_s_setprio(1); qk_fsm(pB0, pB1, (int)(uintptr_t)(lds + K_OFF) + a * SHM_K, qr, r32, hi, pA0, pA1, l_reg, pa0, pa1, pa2, pa3, DMAT(t + 2, kd, t + 1, vd), la, ha, vbase + kd * SHM_V, o[3], lb, hb); __builtin_amdgcn_s_setprio(0); SBAR();
      pv_fsm(o, vbase + kd * SHM_V, pa0, pa1, pa2, pa3, pB0, pB1, negMC, la, ha, lb, hb);
      WAITBAR(); a = (a + 1) % 3; }
    { const int kd = (a + 2) % 3, vd = (a + 1) % 3;
      SBAR(); __builtin_amdgcn_s_setprio(1); qk_fsm(pA0, pA1, (int)(uintptr_t)(lds + K_OFF) + a * SHM_K, qr, r32, hi, pB0, pB1, l_reg, pa0, pa1, pa2, pa3, DMAT(t + 3, kd, t + 2, vd), la, ha, vbase + kd * SHM_V, o[3], lb, hb); __builtin_amdgcn_s_setprio(0); SBAR();
      pv_fsm(o, vbase + kd * SHM_V, pa0, pa1, pa2, pa3, pA0, pA1, negMC, la, ha, lb, hb);
      WAITBAR(); a = (a + 1) % 3; }
  }
  { const int kd = (a + 2) % 3, vd = (a + 1) % 3;
    SBAR(); __builtin_amdgcn_s_setprio(1); qk_fsm(pB0, pB1, (int)(uintptr_t)(lds + K_OFF) + a * SHM_K, qr, r32, hi, pA0, pA1, l_reg, pa0, pa1, pa2, pa3, DMAT(NT - 1, kd, NT - 1, vd), la, ha, vbase + kd * SHM_V, o[3], lb, hb); __builtin_amdgcn_s_setprio(0); SBAR();
    pv_fsm(o, vbase + kd * SHM_V, pa0, pa1, pa2, pa3, pB0, pB1, negMC, la, ha, lb, hb);
      WAITBAR(); a = (a + 1) % 3; }
  { const int kd = (a + 2) % 3;
#define PKX(L, H) (bf16x8){L[0], L[1], L[2], L[3], H[0], H[1], H[2], H[3]}
    o[3] = __builtin_amdgcn_mfma_f32_32x32x16_bf16(pa0, PKX(lb[0], hb[0]), o[3], 0, 0, 0); o[3] = __builtin_amdgcn_mfma_f32_32x32x16_bf16(pa1, PKX(lb[1], hb[1]), o[3], 0, 0, 0);
    o[3] = __builtin_amdgcn_mfma_f32_32x32x16_bf16(pa2, PKX(lb[2], hb[2]), o[3], 0, 0, 0); o[3] = __builtin_amdgcn_mfma_f32_32x32x16_bf16(pa3, PKX(lb[3], hb[3]), o[3], 0, 0, 0);
#undef PKX
    asm volatile("" : "+v"(o[3]));
    fsm_finish(pB0, pB1, l_reg, pa0, pa1, pa2, pa3); SBAR();
    pv_d0_pipe(o, vbase + kd * SHM_V, pa0, pa1, pa2, pa3); }
  int lne; asm volatile("v_mbcnt_lo_u32_b32 %0, -1, 0\n\tv_mbcnt_hi_u32_b32 %0, -1, %0" : "=v"(lne));
  const int r32e = lne & 31, hie = lne >> 5;
  if (hie == 0) li_l[r32e] = l_reg; asm volatile("s_waitcnt lgkmcnt(0)" ::: "memory");
  float rli[16];
#pragma unroll
  for (int r = 0; r < 16; ++r) rli[r] = __builtin_amdgcn_rcpf(li_l[crow(r, hie)]);
  bf16_t* Ow = Ob + (long)(wid * QBLK) * LDO;
#pragma unroll
  for (int r = 0; r < 16; ++r) { int orow = crow(r, hie);
#pragma unroll
    for (int d0 = 0; d0 < 4; ++d0) Ow[(long)orow * LDO + d0 * 32 + r32e] = f2bf(o[d0][r] * rli[r]); }
  asm volatile("s_waitcnt vmcnt(0) lgkmcnt(0)" ::: "memory"); __builtin_amdgcn_s_barrier(); asm volatile("" ::: "memory");
#undef DMA_K
#undef KOFF
#undef DMAT
#undef DMA_V
#undef WAITBAR
}
}

namespace sg {
using att::v_st; using att::v_rd_base; using att::pv_d0; using att::crow;
template <int KK> __device__ __forceinline__ void load_b(bf16x8* v, const bf16_t* Bsrc, size_t ldb, const int tid) {
    const int n = (tid & 15) * 8;
#pragma unroll
    for (int i = 0; i < KK / 32; ++i) { const int k = (tid >> 4) + 32 * i; v[i] = *(const bf16x8*)(Bsrc + (size_t)k * ldb + n); }
}
template <int KK> __device__ __forceinline__ void write_b(const bf16x8* v, char* lds, const int tid) {
    const int n = (tid & 15) * 8;
#pragma unroll
    for (int i = 0; i < KK / 32; ++i) { const int k = (tid >> 4) + 32 * i; *(bf16x8*)(lds + (k >> 6) * 16384 + v_st(k & 63, n)) = v[i]; }
}
template <int KK> __device__ __forceinline__ void stage_b(const bf16_t* Bsrc, size_t ldb, char* lds, const int tid) { bf16x8 v[KK / 32]; load_b<KK>(v, Bsrc, ldb, tid); write_b<KK>(v, lds, tid); }
constexpr int OST_PITCH = 272, OST_WAVE = 32 * OST_PITCH, OST_OFF = 65536;
template <class RowPtr>
__device__ __forceinline__ void store_tile(const f32x16* o, LAS unsigned char* ost, int lane, const RowPtr& rowptr) {
    const int r32 = lane & 31, hi = lane >> 5; const bool odd = lane & 1;
#pragma unroll
    for (int pr = 0; pr < 8; ++pr)
#pragma unroll
        for (int d0 = 0; d0 < 4; ++d0) { const float a = o[d0][2 * pr], b = o[d0][2 * pr + 1];
            const float x = odd ? a : b;
            const float y = __int_as_float(__builtin_amdgcn_mov_dpp(__float_as_int(x), 0xB1, 0xf, 0xf, true));
            const unsigned w = odd ? cvt_pk_bf16(y, b) : cvt_pk_bf16(a, y);
            const int row = crow(odd ? 2 * pr + 1 : 2 * pr, hi);
            *(LAS unsigned*)(ost + row * OST_PITCH + (32 * d0 + (r32 & ~1)) * 2) = w; }
    asm volatile("s_waitcnt lgkmcnt(0)" ::: "memory");
#pragma unroll
    for (int j = 0; j < 8; ++j) { const int i = (lane >> 4) + 4 * j; const u32x4 v = *(const LAS u32x4*)(ost + i * OST_PITCH + (lane & 15) * 16);
        *(u32x4*)(rowptr(i) + (lane & 15) * 8) = v; }
    asm volatile("s_waitcnt lgkmcnt(0)" ::: "memory");
}
struct RowF1 { bf16_t* a1; int wave, s2, cc; __device__ __forceinline__ bf16_t* operator()(int i) const { return a1 + ((size_t)(32 * wave + i) * 128 + s2) * 1024 + cc * 128; } };
struct RowF2 { bf16_t* yc; int wave, k1, g; __device__ __forceinline__ bf16_t* operator()(int i) const { const int m = 32 * wave + i; return yc + (size_t)(k1 + 128 * (m & 127)) * 2048 + g * 256 + (m >> 7) * 128; } };
struct RowF3 { bf16_t* hb; int wave, tt, g; __device__ __forceinline__ bf16_t* operator()(int i) const { return hb + (size_t)(256 * tt + 32 * wave + i) * 2048 + 1024 + g * 128; } };
template <int KK> __device__ __forceinline__ void mm(f32x16* o, const bf16x8* A, char* lds, int lane) {
    const int vb0 = (int)(uintptr_t)lds + v_rd_base(lane);
#pragma unroll
    for (int t = 0; t < KK / 64; ++t) pv_d0(o, vb0 + t * 16384, A[4 * t], A[4 * t + 1], A[4 * t + 2], A[4 * t + 3]);
}
}

struct Args { const void* in[24]; float* out; unsigned char* ws; int ph_lo, ph_hi; };

__device__ __forceinline__ u32x2 pack4(f32x4 v) { u32x2 w; w.x = cvt_pk_bf16(v[0], v[1]); w.y = cvt_pk_bf16(v[2], v[3]); return w; }

template <bool FP8, bool TILED = false>
__device__ __forceinline__ void cvt_pair(const float* W, int N, void* WT, int ldd, int k0, int n0, int drow0, float scale, LAS float* scr, int lane) {
    const int lr = lane >> 4, lc = (lane & 15) * 4;
    f32x4 v[2][16];
#pragma unroll
    for (int t = 0; t < 2; ++t)
#pragma unroll
        for (int i = 0; i < 16; ++i) v[t][i] = *(const f32x4*)(W + (size_t)(k0 + 64 * t + 4 * i + lr) * N + n0 + lc);
    const int c = lane & 7;
#pragma unroll
    for (int t = 0; t < 2; ++t) {
#pragma unroll
        for (int i = 0; i < 16; ++i) { LAS float* s = scr + (4 * i + lr) * 65 + lc; s[0] = v[t][i][0]; s[1] = v[t][i][1]; s[2] = v[t][i][2]; s[3] = v[t][i][3]; }
        LDS_WAIT(); asm volatile("" ::: "memory");
#pragma unroll
        for (int j = 0; j < 8; ++j) { const int n = (lane >> 3) + 8 * j; const LAS float* s = scr + (8 * c) * 65 + n;
            if constexpr (!FP8) { u32x4 o; o.x = cvt_pk_bf16(s[0 * 65], s[1 * 65]); o.y = cvt_pk_bf16(s[2 * 65], s[3 * 65]); o.z = cvt_pk_bf16(s[4 * 65], s[5 * 65]); o.w = cvt_pk_bf16(s[6 * 65], s[7 * 65]);
                *(u32x4*)((bf16_t*)WT + (size_t)(drow0 + n) * ldd + k0 + 64 * t + 8 * c) = o; }
            else { int w0 = 0, w1 = 0;
                w0 = __builtin_amdgcn_cvt_pk_fp8_f32(pg8::clamp448(s[0 * 65] * scale), pg8::clamp448(s[1 * 65] * scale), w0, false); w0 = __builtin_amdgcn_cvt_pk_fp8_f32(pg8::clamp448(s[2 * 65] * scale), pg8::clamp448(s[3 * 65] * scale), w0, true);
                w1 = __builtin_amdgcn_cvt_pk_fp8_f32(pg8::clamp448(s[4 * 65] * scale), pg8::clamp448(s[5 * 65] * scale), w1, false); w1 = __builtin_amdgcn_cvt_pk_fp8_f32(pg8::clamp448(s[6 * 65] * scale), pg8::clamp448(s[7 * 65] * scale), w1, true);
                u32x2 o; o.x = (unsigned)w0; o.y = (unsigned)w1;
                if constexpr (TILED) { const int dr = drow0 + n;
                    *(u32x2*)((unsigned char*)WT + ((size_t)(dr >> 8) * (ldd >> 7) + (k0 >> 7)) * 32768 + (dr & 255) * 128 + 64 * t + 8 * c) = o; }
                else *(u32x2*)((unsigned char*)WT + (size_t)(drow0 + n) * ldd + k0 + 64 * t + 8 * c) = o; } }
        LDS_WAIT(); asm volatile("" ::: "memory");
    }
}

typedef __attribute__((address_space(4))) const char* karg_cptr;
__device__ __forceinline__ void* karg_ptr(int k) {
    karg_cptr p = (karg_cptr)__builtin_amdgcn_kernarg_segment_ptr();
    asm volatile("" : "+s"(p));
    typedef void* voidp_t; typedef __attribute__((address_space(4))) const voidp_t* karg_vpp;
    return *(karg_vpp)(p + 8 * k);
}
__global__ void __launch_bounds__(NTHR, 2) mk_fwd(Args args) {
    extern __shared__ __attribute__((aligned(16))) unsigned char lds_raw[];
    LAS unsigned char* lds = (LAS unsigned char*)lds_raw;
    volatile LAS unsigned* MISC = (volatile LAS unsigned*)(lds + LDS_MISC);
    const int wave0 = __builtin_amdgcn_readfirstlane((int)threadIdx.x >> 6);
    const int G = gridDim.x, bx0 = blockIdx.x, NGW = G * NWAVES;
#define PHASE_IDS() int lane_; asm volatile("v_mbcnt_lo_u32_b32 %0, -1, 0\n\tv_mbcnt_hi_u32_b32 %0, -1, %0" : "=v"(lane_)); int wave_ = wave0; asm volatile("" : "+s"(wave_)); \
    int bx = bx0; asm volatile("" : "+s"(bx)); int tid = wave_ * 64 + lane_; \
    const int lane = lane_, wave = wave_; \
    const int vcu = (G % 8 == 0) ? (bx % 8) * (G / 8) + bx / 8 : bx; const int gw = vcu * NWAVES + wave; (void)lane; (void)gw
    for (int u = threadIdx.x; u < 64; u += NTHR) MISC[u] = 0u;
    __syncthreads();
    unsigned* const barw = (unsigned*)((unsigned char*)karg_ptr(25) + WS_CTL) + CW_BAR;
    XcdBarrier bar; bar.bar = barw; bar.x = 0; bar.st = nullptr;
#if !MK_MULTI
    bar = xcd_barrier_post(barw, MISC + 8);
#endif
    const int lo = args.ph_lo, hi = args.ph_hi;
#ifndef PH_MASK
#define PH_MASK 0xffffffffu
#endif
#define IN(k) (lo <= (k) && (k) < hi && ((PH_MASK >> ((k) > 15 ? (k) - 16 : (k))) & 1u))
#if MK_MULTI
#define SEAM(k) do { } while (0)
#else
#ifndef TIME_MASK
#define TIME_MASK 0ull
#endif
#ifndef TIME_BAR
#define TIME_BAR 0
#endif
#ifndef TIME_SCALE
#define TIME_SCALE 0.001f
#endif
#if 0
#endif
#define IS_T0() ({ int l0_; asm volatile("v_mbcnt_lo_u32_b32 %0, -1, 0\n\tv_mbcnt_hi_u32_b32 %0, -1, %0" : "=v"(l0_)); (wave0 == 0) && (l0_ == 0); })
    if (TIME_MASK != 0ull && IS_T0()) { MISC[40] = 0u; MISC[41] = (unsigned)__builtin_amdgcn_s_memrealtime(); }
#define TPROBE(k) do { if (TIME_MASK != 0ull && IS_T0()) { const unsigned now_ = (unsigned)__builtin_amdgcn_s_memrealtime(); if ((TIME_MASK >> (k)) & 1ull) MISC[40] += now_ - MISC[41]; MISC[41] = now_; } } while (0)
#define SEAM(k) do { if (TIME_BAR && TIME_MASK != 0ull) { asm volatile("s_waitcnt vmcnt(0)" ::: "memory"); if (IS_T0()) MISC[41] = (unsigned)__builtin_amdgcn_s_memrealtime(); } if ((k) + 1 < hi) xcd_barrier(bar); TPROBE(k); } while (0)
#endif
#define KARG(k) (karg_ptr(k))
#define x_in ((const float*)KARG(0))
#define c_in ((const float*)KARG(1))
#define pos_in ((const int*)KARG(2))
#define ada_w ((const float*)KARG(3))
#define ada_b ((const float*)KARG(4))
#define mix_norm ((const float*)KARG(5))
#define w_in ((const float*)KARG(6))
#define cq_norm ((const float*)KARG(7))
#define ckv_norm ((const float*)KARG(8))
#define w_uq ((const float*)KARG(9))
#define w_ukv ((const float*)KARG(10))
#define q_norm ((const float*)KARG(11))
#define k_norm ((const float*)KARG(12))
#define w_fnet ((const float*)KARG(13))
#define out_norm ((const float*)KARG(14))
#define w_out ((const float*)KARG(15))
#define ffn_norm ((const float*)KARG(16))
#define dw_gate ((const float*)KARG(17))
#define dw_up ((const float*)KARG(18))
#define dw_down ((const float*)KARG(19))
#define router_w ((const float*)KARG(20))
#define mw_gate ((const float*)KARG(21))
#define mw_up ((const float*)KARG(22))
#define mw_down ((const float*)KARG(23))
#define out ((float*)KARG(24))
#define WSB ((unsigned char*)KARG(25))
#define ctl ((unsigned*)(WSB + WS_CTL))
#define MODP ((float*)(WSB + WS_ARENA))
#define MODV ((float*)(WSB + WS_MODV))
#define COS ((float*)(WSB + WS_COS))
#define SIN ((float*)(WSB + WS_SIN))
#define TW ((f32x2*)(WSB + WS_TW))
#define FM ((bf16_t*)(WSB + WS_FM))
#define GM ((bf16_t*)(WSB + WS_GM))
#define M12 ((bf16_t*)(WSB + WS_M12))
#define TOKINFO ((int*)(WSB + WS_TOKINFO))
#define TOKPOS ((int*)(WSB + WS_TOKPOS))
#define BLKCNT ((int*)(WSB + WS_TOKPOS + (size_t)SEQ * 8))
#define ROWTOK ((int*)(WSB + CTL_ROWTOK))
#define WIN ((bf16_t*)(WSB + WS_WIN))
#define WUQ ((bf16_t*)(WSB + WS_WUQ))
#define WUKV ((bf16_t*)(WSB + WS_WUKV))
#define WOUT ((bf16_t*)(WSB + WS_WOUT))
#define WGUD ((bf16_t*)(WSB + WS_WGUD))
#define WDND ((bf16_t*)(WSB + WS_WDND))
#define WGUM ((bf16_t*)(WSB + WS_WGUM))
#define WDNM ((bf16_t*)(WSB + WS_WDNM))
#define HB ((bf16_t*)(WSB + WS_H))
#define YB ((bf16_t*)(WSB + WS_Y))
#define ZB ((bf16_t*)(WSB + WS_Z))
#define QB ((bf16_t*)(WSB + WS_QB))
#define KVB ((bf16_t*)(WSB + WS_KVB))
#define KB ((bf16_t*)(WSB + WS_KB))
#define A1 ((bf16_t*)(WSB + WS_A1))
#define YC ((bf16_t*)(WSB + WS_YC))
#define HID ((bf16_t*)(WSB + WS_HID))
#define YPART ((bf16_t*)(WSB + WS_ARENA + 256 * MiB))

    if (IN(0)) {
        PHASE_IDS();
        LAS float* cond = (LAS float*)(lds + LDS_COND); LAS float* trig = (LAS float*)(lds + LDS_TRIG);
        for (int i = tid; i < DM; i += NTHR) { const float c = c_in[i]; cond[i] = c / (1.0f + __expf(-c)); }
        if (tid < 128) { trig[tid] = (float)cospi(2.0 * tid / 128.0); trig[128 + tid] = (float)sinpi(2.0 * tid / 128.0); }
        __syncthreads();
        LAS float* scr = (LAS float*)(lds + wave * 16640);
        constexpr int I_GEMV = 2 * 48 * 64;
        constexpr int I_WIN = 16 * 29, I_WUQ = 4 * 24, I_WUKV = 2 * 32, I_WOUT = 16 * 32;
        constexpr int I_DGU = 16 * 88, I_DDN = 44 * 32, I_MGU = 16 * 112, I_MDN = 56 * 32;
        constexpr int I_ZERO = 2 * 192;
        constexpr int I_ROPE = SEQ * 32 / 64;
        constexpr int I_TW = 16384 / 64, I_FM = 32768 / 64, I_GM = 65536 / 64, I_M12 = 2 * 8 * 256 * 128 / 64;
        constexpr int NITEMS = I_GEMV + 2 * (I_WIN + I_WUQ + I_WUKV + I_WOUT) + 2 * I_DGU + I_DDN + 16 * I_MGU + 8 * I_MDN + I_ZERO + I_ROPE + I_TW + I_FM + I_GM + I_M12;
        for (int it = gw; it < NITEMS; it += NGW) {
            int r = it;
            if (r < I_GEMV) {
                const int kc = r & 63, cb = r >> 6, l = cb / 48, n0 = (cb % 48) * 256 + 4 * lane;
                const float* W = ada_w + ((size_t)l * DM + kc * 32) * 12288 + n0;
                f32x4 a = {0.f, 0.f, 0.f, 0.f};
                f32x4 v[32];
#pragma unroll
                for (int k = 0; k < 32; ++k) v[k] = *(const f32x4*)(W + (size_t)k * 12288);
#pragma unroll
                for (int k = 0; k < 32; ++k) a += v[k] * cond[kc * 32 + k];
                *(f32x4*)(MODP + ((size_t)kc * 2 + l) * 12288 + n0) = a;
                continue;
            } r -= I_GEMV;
            bool done = false;
#pragma unroll 1
            for (int l = 0; l < 2 && !done; ++l) {
                if (r < I_WIN) { const int kb = r / 29, nb = r % 29; cvt_pair<false>(w_in + (size_t)l * DM * DIN, DIN, WIN + (size_t)l * DINP * DM, DM, 128 * kb, 64 * nb, 64 * nb, 1.f, scr, lane); done = true; break; } r -= I_WIN;
                if (r < I_WUQ) { const int kb = r / 24, nb = r % 24; cvt_pair<false>(w_uq + (size_t)l * QLR * 1536, 1536, WUQ + (size_t)l * 1536 * QLR, QLR, 128 * kb, 64 * nb, 64 * nb, 1.f, scr, lane); done = true; break; } r -= I_WUQ;
                if (r < I_WUKV) { const int kb = r / 32, nb = r % 32; cvt_pair<false>(w_ukv + (size_t)l * KVLR * 2048, 2048, WUKV + (size_t)l * 2048 * KVLR, KVLR, 128 * kb, 64 * nb, 64 * nb, 1.f, scr, lane); done = true; break; } r -= I_WUKV;
                if (r < I_WOUT) { const int kb = r / 32, nb = r % 32; cvt_pair<false>(w_out + (size_t)l * DM * DM, DM, WOUT + (size_t)l * DM * DM, DM, 128 * kb, 64 * nb, 64 * nb, 1.f, scr, lane); done = true; break; } r -= I_WOUT;
            }
            if (done) continue;
            if (r < 2 * I_DGU) { const int up = r / I_DGU, rr = r % I_DGU, kb = rr / 88, nb = rr % 88, n0 = 64 * nb;
                cvt_pair<false>(up ? dw_up : dw_gate, DFF, WGUD, DM, 128 * kb, n0, (n0 >> 7) * 256 + (n0 & 127) + up * 128, 1.f, scr, lane); continue; } r -= 2 * I_DGU;
            if (r < I_DDN) { const int kb = r / 32, nb = r % 32; cvt_pair<false>(dw_down, DM, WDND, DFF, 128 * kb, 64 * nb, 64 * nb, 1.f, scr, lane); continue; } r -= I_DDN;
            if (r < 16 * I_MGU) { const int e = r / (2 * I_MGU), r2 = r % (2 * I_MGU), up = r2 / I_MGU, rr = r2 % I_MGU, kb = rr / 112, nb = rr % 112, n0 = 64 * nb;
                cvt_pair<true, true>((up ? mw_up : mw_gate) + (size_t)e * DM * DFE, DFE, (unsigned char*)WGUM + (size_t)e * 14336 * DM, DM, 128 * kb, n0, (n0 >> 7) * 256 + (n0 & 127) + up * 128, S8_WGU, scr, lane); continue; } r -= 16 * I_MGU;
            if (r < 8 * I_MDN) { const int e = r / I_MDN, rr = r % I_MDN, kb = rr / 32, nb = rr % 32;
                cvt_pair<true, true>(mw_down + (size_t)e * DFE * DM, DM, (unsigned char*)WDNM + (size_t)e * DM * DFE, DFE, 128 * kb, 64 * nb, 64 * nb, S8_WDN, scr, lane); continue; } r -= 8 * I_MDN;
            if (r < I_ZERO) { const int l = r / 192, row = 1856 + r % 192; u32x4 z = {0u, 0u, 0u, 0u};
#pragma unroll
                for (int j = 0; j < 4; ++j) *(u32x4*)(WIN + ((size_t)l * DINP + row) * DM + (lane + 64 * j) * 8) = z;
                continue; } r -= I_ZERO;
            if (r < I_ROPE) { const int idx = r * 64 + lane, t = idx >> 5, i = idx & 31;
                const double inv = exp2(-(double)i * (13.287712379549449 / 32.0));
                const double ang = (double)pos_in[t] * inv; double sn, cs; sincos(ang, &sn, &cs);
                COS[idx] = (float)cs; SIN[idx] = (float)sn; continue; } r -= I_ROPE;
            if (r < I_TW) { const int idx = r * 64 + lane, s2 = idx >> 7, k1 = idx & 127; const int m = (s2 * k1) & 16383;
                double sn, cs; sincospi(2.0 * (double)m / 16384.0, &sn, &cs); TW[idx] = (f32x2){(float)cs, (float)(-sn)}; continue; } r -= I_TW;
            if (r < I_FM) { const int idx = r * 64 + lane, m = idx >> 7, s1 = idx & 127, k1 = m >> 1, ri = m & 1; const int ph = (k1 * s1) & 127;
                const float v = (ri ? -trig[128 + ph] : trig[ph]) * 0.08838834764831845f; FM[idx] = f2bf(v); continue; } r -= I_FM;
            if (r < I_GM) { const int idx = r * 64 + lane, m = idx >> 8, k = idx & 255, ro = m >> 7, k2 = m & 127, rin = k >> 7, s2 = k & 127; const int ph = (k2 * s2) & 127;
                float v = (ro == rin) ? trig[ph] : (ro == 0 ? trig[128 + ph] : -trig[128 + ph]);
                GM[idx] = f2bf(v * 0.08838834764831845f); continue; } r -= I_GM;
            {
                const int idx = r * 64 + lane, d = idx & 127, kk = (idx >> 7) & 255, lg = idx >> 15, ri = kk >> 7, c = kk & 127;
                const float* Wf = w_fnet + (size_t)lg * 128 * 128 + d; float a = 0.f;
                for (int m = 0; m < 128; ++m) a += trig[ri * 128 + ((m * c) & 127)] * Wf[m * 128];
                M12[idx] = f2bf(a * 0.08838834764831845f);
            }
        }
        SEAM(0);
    }
    if (IN(1)) {
        PHASE_IDS();
        for (int i = (bx * NTHR + tid); i < 2 * 12288; i += G * NTHR) { float a = ada_b[i];
#pragma unroll
            for (int k = 0; k < 64; ++k) a += MODP[(size_t)k * 2 * 12288 + i];
            MODV[i] = a; }
        SEAM(1);
    }

#pragma unroll 1
    for (int l = 0; l < 2; ++l) {
        const int pb = 2 + 16 * l;
#define modv (MODV + (size_t)l * 12288)
#define xcur ((l == 0) ? x_in : (const float*)out)
#pragma unroll 1
        for (int sub = 0; sub < 2; ++sub) {
            const int ph = pb + (sub ? 8 : 0);
            if (IN(ph)) {
                PHASE_IDS();
                const float* xs = sub ? (const float*)out : xcur;
                const float* gain = (sub ? ffn_norm : mix_norm) + (size_t)l * DM;
                const float* shv = modv + (sub ? 3 : 0) * DM; const float* scv = modv + (sub ? 4 : 1) * DM;
                const bool router = (sub == 1 && l == 1);
                LAS float* wr_l = (LAS float*)lds;
                LAS int* etab = (LAS int*)(lds + 65536); LAS int* rtab = (LAS int*)(lds + 65536 + 4096);
                if (router) { etab[tid] = 0xffff;
                    for (int i = tid; i < DM * NE / 4; i += NTHR) ((LAS f32x4*)wr_l)[i] = ((const f32x4*)router_w)[i]; }
                __syncthreads();
                f32x4 av[8], bv[8];
#pragma unroll
                for (int j = 0; j < 8; ++j) { const f32x4 g4 = ((const f32x4*)gain)[lane + 64 * j], s4 = ((const f32x4*)scv)[lane + 64 * j]; av[j] = g4 * (1.0f + s4); bv[j] = ((const f32x4*)shv)[lane + 64 * j]; }
                int my_e0 = 0, my_e1 = 0, my_tok = -1; float my_w0 = 0.f, my_w1 = 0.f; int itn = 0;
                f32x4 vnx[8];
#pragma unroll
                for (int j = 0; j < 8; ++j) vnx[j] = ((const f32x4*)(xs + (size_t)(gw < SEQ ? gw : 0) * DM))[lane + 64 * j];
                for (int m = gw; m < SEQ; m += NGW, ++itn) {
                    f32x4 v[8]; float ss = 0.f;
#pragma unroll
                    for (int j = 0; j < 8; ++j) v[j] = vnx[j];
                    { const int mn = m + NGW < SEQ ? m + NGW : m;
#pragma unroll
                      for (int j = 0; j < 8; ++j) vnx[j] = ((const f32x4*)(xs + (size_t)mn * DM))[lane + 64 * j]; }
#pragma unroll
                    for (int j = 0; j < 8; ++j) ss += (v[j][0] * v[j][0] + v[j][1] * v[j][1]) + (v[j][2] * v[j][2] + v[j][3] * v[j][3]);
                    const float rstd = 1.0f / sqrtf(wave_sum(ss) * (1.0f / DM) + RMS_EPS);
#pragma unroll
                    for (int j = 0; j < 8; ++j) { v[j] = v[j] * rstd * av[j] + bv[j];
                        if (router) { int w8 = 0; w8 = __builtin_amdgcn_cvt_pk_fp8_f32(pg8::clamp448(v[j][0] * S8_H), pg8::clamp448(v[j][1] * S8_H), w8, false); w8 = __builtin_amdgcn_cvt_pk_fp8_f32(pg8::clamp448(v[j][2] * S8_H), pg8::clamp448(v[j][3] * S8_H), w8, true);
                            *(unsigned*)((unsigned char*)HB + (size_t)m * DM + 4 * lane + 256 * j) = (unsigned)w8; }
                        else *(u32x2*)(HB + (size_t)m * DM + 4 * lane + 256 * j) = pack4(v[j]); }
                    if (router) {
                        float lg[8] = {0.f, 0.f, 0.f, 0.f, 0.f, 0.f, 0.f, 0.f};
#pragma unroll
                        for (int j = 0; j < 8; ++j)
#pragma unroll
                            for (int q = 0; q < 4; ++q) { const int k = 4 * lane + 256 * j + q; const f32x4 w0 = *(const LAS f32x4*)(wr_l + k * 8), w1 = *(const LAS f32x4*)(wr_l + k * 8 + 4); const float hv = v[j][q];
                                lg[0] += hv * w0[0]; lg[1] += hv * w0[1]; lg[2] += hv * w0[2]; lg[3] += hv * w0[3]; lg[4] += hv * w1[0]; lg[5] += hv * w1[1]; lg[6] += hv * w1[2]; lg[7] += hv * w1[3]; }
#pragma unroll
                        for (int e = 0; e < 8; ++e) lg[e] = wave_sum(lg[e]);
                        int e0 = 0; float l0 = lg[0];
#pragma unroll
                        for (int e = 1; e < 8; ++e) if (lg[e] > l0) { l0 = lg[e]; e0 = e; }
                        int e1 = -1; float l1 = -3.0e38f;
#pragma unroll
                        for (int e = 0; e < 8; ++e) if (e != e0 && lg[e] > l1) { l1 = lg[e]; e1 = e; }
                        const float w1 = 1.0f / (1.0f + __expf(l0 - l1)), w0 = 1.0f - w1;
                        if (lane == 0) etab[itn * NWAVES + wave] = e0 | (e1 << 8);
                        if (lane == itn) { my_e0 = e0; my_e1 = e1; my_w0 = w0; my_w1 = w1; my_tok = m; }
                    }
                }
                if (router) {
                    __syncthreads();
                    const int nent = ((SEQ + NGW - 1) / NGW) * NWAVES;
                    if (tid < nent) {
                        const int me = etab[tid], a0 = me & 255, a1 = me >> 8; int c0 = 0, c1 = 0;
                        for (int q = 0; q < tid; ++q) { const int o = etab[q], b0 = o & 255, b1 = o >> 8; c0 += (b0 == a0) + (b1 == a0); c1 += (b0 == a1) + (b1 == a1); }
                        rtab[2 * tid] = c0; rtab[2 * tid + 1] = c1; }
                    if (tid >= 512 - 8) { const int e = tid - (512 - 8); int c = 0;
                        for (int q = 0; q < nent; ++q) { const int o = etab[q]; c += ((o & 255) == e) + ((o >> 8) == e); }
                        BLKCNT[bx * 8 + e] = c; }
                    __syncthreads();
                    if (my_tok >= 0) { int* ti = TOKINFO + (size_t)my_tok * 8; ti[0] = my_e0; ti[1] = my_e1; ti[2] = __float_as_int(my_w0); ti[3] = __float_as_int(my_w1);
                        ti[4] = rtab[2 * (lane * NWAVES + wave)]; ti[5] = rtab[2 * (lane * NWAVES + wave) + 1]; ti[6] = bx; }
                }
                __syncthreads();
                SEAM(ph);
            }
            if (sub == 0) {
            if (IN(pb + 1)) {
                PHASE_IDS();
                pg8::Gemm g{HB, WIN + (size_t)l * DINP * DM, DM, DM, DM, 0, nullptr}; pg8::TileOrder S; S.init(SEQ / 256, DINP / 256, G, bx);
                pg8::EpiBf16 E{ZB, DINP, 1.0f};
                pg8::gemm_phase<pg8::EpiBf16, pg8::TileOrder, false>(tid, lds, g, S, E);
                SEAM(pb + 1);
            }
            if (IN(pb + 2)) {
                PHASE_IDS();
                f32x4 gq0 = ((const f32x4*)(cq_norm + (size_t)l * QLR))[2 * lane], gq1 = ((const f32x4*)(cq_norm + (size_t)l * QLR))[2 * lane + 1];
                f32x4 gk = ((const f32x4*)(ckv_norm + (size_t)l * KVLR))[lane];
                for (int m = gw; m < SEQ; m += NGW) {
                    bf16_t* zr = ZB + (size_t)m * DINP;
                    const bf16x8 q8 = *(const bf16x8*)(zr + ZQ + 8 * lane); const s16x4 k4 = *(const s16x4*)(zr + ZKV + 4 * lane);
                    float qf[8], kf[4], sq = 0.f, sk = 0.f;
#pragma unroll
                    for (int j = 0; j < 8; ++j) { qf[j] = bf2f((unsigned short)q8[j]); sq += qf[j] * qf[j]; }
#pragma unroll
                    for (int j = 0; j < 4; ++j) { kf[j] = bf2f((unsigned short)k4[j]); sk += kf[j] * kf[j]; }
                    const float rq = 1.0f / sqrtf(wave_sum(sq) * (1.0f / QLR) + RMS_EPS), rk = 1.0f / sqrtf(wave_sum(sk) * (1.0f / KVLR) + RMS_EPS);
                    u32x4 wq; wq.x = cvt_pk_bf16(qf[0] * rq * gq0[0], qf[1] * rq * gq0[1]); wq.y = cvt_pk_bf16(qf[2] * rq * gq0[2], qf[3] * rq * gq0[3]);
                    wq.z = cvt_pk_bf16(qf[4] * rq * gq1[0], qf[5] * rq * gq1[1]); wq.w = cvt_pk_bf16(qf[6] * rq * gq1[2], qf[7] * rq * gq1[3]);
                    u32x2 wk; wk.x = cvt_pk_bf16(kf[0] * rk * gk[0], kf[1] * rk * gk[1]); wk.y = cvt_pk_bf16(kf[2] * rk * gk[2], kf[3] * rk * gk[3]);
                    *(u32x4*)(zr + ZQ + 8 * lane) = wq; *(u32x2*)(zr + ZKV + 4 * lane) = wk;
                }
                {   PHASE_IDS();
                    const int r32 = lane & 31, hi = lane >> 5;
                    LAS unsigned char* ost = lds + sg::OST_OFF + wave * sg::OST_WAVE;
                    bf16x8 Af[8];
#pragma unroll
                    for (int s = 0; s < 8; ++s) Af[s] = *(const bf16x8*)(FM + (size_t)(32 * wave + r32) * 128 + 16 * s + 8 * hi);
                    for (int it = bx; it < 1024; it += G) {
                        const int s2 = it >> 3, cc = it & 7;
                        __syncthreads();
                        sg::stage_b<128>(ZB + (size_t)s2 * DINP + ZU + cc * 128, (size_t)128 * DINP, (char*)lds_raw, tid);
                        __syncthreads();
                        f32x16 o[4] = {};
                        sg::mm<128>(o, Af, (char*)lds_raw, lane);
#pragma unroll
                        for (int p = 0; p < 8; ++p) { const int k1 = 16 * wave + (p & 1) + 4 * (p >> 1) + 2 * hi; const f32x2 tw = TW[s2 * 128 + k1];
#pragma unroll
                            for (int d0 = 0; d0 < 4; ++d0) { const float re = o[d0][2 * p], im = o[d0][2 * p + 1];
                                o[d0][2 * p] = re * tw[0] - im * tw[1]; o[d0][2 * p + 1] = re * tw[1] + im * tw[0]; } }
                        sg::store_tile(o, ost, lane, sg::RowF1{A1, wave, s2, cc});
                    }
                    __syncthreads();
                }
                SEAM(pb + 2);
            }
            if (IN(pb + 3)) {
                PHASE_IDS();
                { pg8::Gemm g{ZB + ZQ, WUQ + (size_t)l * 1536 * QLR, DINP, QLR, QLR, 0, nullptr}; pg8::TileOrder S; S.init(SEQ / 256, 1536 / 256, G, bx);
                  pg8::EpiBf16 E{QB, 1536, 1.0f}; pg8::gemm_phase<pg8::EpiBf16, pg8::TileOrder, false>(tid, lds, g, S, E); }
                { pg8::Gemm g{ZB + ZKV, WUKV + (size_t)l * 2048 * KVLR, DINP, KVLR, KVLR, 0, nullptr}; pg8::TileOrder S; S.init(SEQ / 256, 2048 / 256, G, bx);
                  pg8::EpiBf16 E{KVB, 2048, 1.0f}; pg8::gemm_phase<pg8::EpiBf16, pg8::TileOrder, false>(tid, lds, g, S, E); }
                {   PHASE_IDS();
                    const int r32 = lane & 31, hi = lane >> 5;
                    LAS unsigned char* ost = lds + sg::OST_OFF + wave * sg::OST_WAVE;
                    bf16x8 Af[16];
#pragma unroll
                    for (int s = 0; s < 16; ++s) Af[s] = *(const bf16x8*)(GM + (size_t)(32 * wave + r32) * 256 + 16 * s + 8 * hi);
                    for (;;) {
                        __syncthreads();
                        if (tid == 0) MISC[32] = atomicAdd(ctl + CW_F3CTR + 128 + 64 * l, 1u);
                        __syncthreads();
                        const int it = (int)MISC[32]; if (it >= 1024) break;
                        const int k1 = it >> 3, gidx = it & 7;
                        sg::stage_b<256>(A1 + (size_t)k1 * 256 * 1024 + gidx * 128, 1024, (char*)lds_raw, tid);
                        __syncthreads();
                        f32x16 o[4] = {};
                        sg::mm<256>(o, Af, (char*)lds_raw, lane);
                        sg::store_tile(o, ost, lane, sg::RowF2{YC, wave, k1, gidx});
                    }
                    __syncthreads();
                }
                SEAM(pb + 3);
            }
            if (IN(pb + 4)) {
                PHASE_IDS();
                {
                    const int hd = lane >> 3, j8 = lane & 7;
                    const float* qg = q_norm + (size_t)l * QKD; const float* kg = k_norm + (size_t)l * QKD;
                    f32x4 qgn[4], kgn[4], qgr[2], kgr[2];
#pragma unroll
                    for (int j = 0; j < 4; ++j) { qgn[j] = *(const f32x4*)(qg + 16 * j8 + 4 * j); kgn[j] = *(const f32x4*)(kg + 16 * j8 + 4 * j); }
                    qgr[0] = *(const f32x4*)(qg + NOPE + 4 * j8); qgr[1] = *(const f32x4*)(qg + NOPE + 32 + 4 * j8);
                    kgr[0] = *(const f32x4*)(kg + NOPE + 4 * j8); kgr[1] = *(const f32x4*)(kg + NOPE + 32 + 4 * j8);
                    for (int m = gw; m < SEQ; m += NGW) {
                        const f32x4 cs = *(const f32x4*)(COS + (size_t)m * 32 + 4 * j8), sn = *(const f32x4*)(SIN + (size_t)m * 32 + 4 * j8);
                        const bf16_t* kp = KVB + (size_t)m * 2048 + hd * 256; const bf16_t* krp = ZB + (size_t)m * DINP + ZKR;
                        const bf16x8 kn0 = *(const bf16x8*)(kp + 16 * j8), kn1 = *(const bf16x8*)(kp + 16 * j8 + 8);
                        const s16x4 kra = *(const s16x4*)(krp + 4 * j8), krb = *(const s16x4*)(krp + 32 + 4 * j8);
                        {
                            bf16_t* qp = QB + (size_t)m * 1536 + hd * QKD;
                            const bf16x8 n0 = *(const bf16x8*)(qp + 16 * j8), n1 = *(const bf16x8*)(qp + 16 * j8 + 8);
                            const s16x4 ra = *(const s16x4*)(qp + NOPE + 4 * j8), rb = *(const s16x4*)(qp + NOPE + 32 + 4 * j8);
                            float f[16], x1[4], x2[4], ss = 0.f;
#pragma unroll
                            for (int j = 0; j < 8; ++j) { f[j] = bf2f((unsigned short)n0[j]); f[8 + j] = bf2f((unsigned short)n1[j]); }
#pragma unroll
                            for (int j = 0; j < 16; ++j) ss += f[j] * f[j];
#pragma unroll
                            for (int j = 0; j < 4; ++j) { x1[j] = bf2f((unsigned short)ra[j]); x2[j] = bf2f((unsigned short)rb[j]); ss += x1[j] * x1[j] + x2[j] * x2[j]; }
                            ss += swz_xor<1>(ss); ss += swz_xor<2>(ss); ss += swz_xor<4>(ss);
                            const float rs = 1.0f / sqrtf(ss * (1.0f / QKD) + RMS_EPS);
                            u32x4 w0, w1;
                            w0.x = cvt_pk_bf16(f[0] * rs * qgn[0][0], f[1] * rs * qgn[0][1]); w0.y = cvt_pk_bf16(f[2] * rs * qgn[0][2], f[3] * rs * qgn[0][3]);
                            w0.z = cvt_pk_bf16(f[4] * rs * qgn[1][0], f[5] * rs * qgn[1][1]); w0.w = cvt_pk_bf16(f[6] * rs * qgn[1][2], f[7] * rs * qgn[1][3]);
                            w1.x = cvt_pk_bf16(f[8] * rs * qgn[2][0], f[9] * rs * qgn[2][1]); w1.y = cvt_pk_bf16(f[10] * rs * qgn[2][2], f[11] * rs * qgn[2][3]);
                            w1.z = cvt_pk_bf16(f[12] * rs * qgn[3][0], f[13] * rs * qgn[3][1]); w1.w = cvt_pk_bf16(f[14] * rs * qgn[3][2], f[15] * rs * qgn[3][3]);
                            float o1[4], o2[4];
#pragma unroll
                            for (int j = 0; j < 4; ++j) { const float a = x1[j] * rs * qgr[0][j], b = x2[j] * rs * qgr[1][j]; o1[j] = a * cs[j] - b * sn[j]; o2[j] = b * cs[j] + a * sn[j]; }
                            u32x2 wa, wb; wa.x = cvt_pk_bf16(o1[0], o1[1]); wa.y = cvt_pk_bf16(o1[2], o1[3]); wb.x = cvt_pk_bf16(o2[0], o2[1]); wb.y = cvt_pk_bf16(o2[2], o2[3]);
                            *(u32x4*)(qp + 16 * j8) = w0; *(u32x4*)(qp + 16 * j8 + 8) = w1; *(u32x2*)(qp + NOPE + 4 * j8) = wa; *(u32x2*)(qp + NOPE + 32 + 4 * j8) = wb;
                        }
                        {
                            bf16_t* ko = KB + (size_t)m * 1536 + hd * QKD;
                            const bf16x8 n0 = kn0, n1 = kn1; const s16x4 ra = kra, rb = krb;
                            float f[16], x1[4], x2[4], ss = 0.f;
#pragma unroll
                            for (int j = 0; j < 8; ++j) { f[j] = bf2f((unsigned short)n0[j]); f[8 + j] = bf2f((unsigned short)n1[j]); }
#pragma unroll
                            for (int j = 0; j < 16; ++j) ss += f[j] * f[j];
#pragma unroll
                            for (int j = 0; j < 4; ++j) { x1[j] = bf2f((unsigned short)ra[j]); x2[j] = bf2f((unsigned short)rb[j]); ss += x1[j] * x1[j] + x2[j] * x2[j]; }
                            ss += swz_xor<1>(ss); ss += swz_xor<2>(ss); ss += swz_xor<4>(ss);
                            const float rs = 1.0f / sqrtf(ss * (1.0f / QKD) + RMS_EPS);
                            u32x4 w0, w1;
                            w0.x = cvt_pk_bf16(f[0] * rs * kgn[0][0], f[1] * rs * kgn[0][1]); w0.y = cvt_pk_bf16(f[2] * rs * kgn[0][2], f[3] * rs * kgn[0][3]);
                            w0.z = cvt_pk_bf16(f[4] * rs * kgn[1][0], f[5] * rs * kgn[1][1]); w0.w = cvt_pk_bf16(f[6] * rs * kgn[1][2], f[7] * rs * kgn[1][3]);
                            w1.x = cvt_pk_bf16(f[8] * rs * kgn[2][0], f[9] * rs * kgn[2][1]); w1.y = cvt_pk_bf16(f[10] * rs * kgn[2][2], f[11] * rs * kgn[2][3]);
                            w1.z = cvt_pk_bf16(f[12] * rs * kgn[3][0], f[13] * rs * kgn[3][1]); w1.w = cvt_pk_bf16(f[14] * rs * kgn[3][2], f[15] * rs * kgn[3][3]);
                            float o1[4], o2[4];
#pragma unroll
                            for (int j = 0; j < 4; ++j) { const float a = x1[j] * rs * kgr[0][j], b = x2[j] * rs * kgr[1][j]; o1[j] = a * cs[j] - b * sn[j]; o2[j] = b * cs[j] + a * sn[j]; }
                            u32x2 wa, wb; wa.x = cvt_pk_bf16(o1[0], o1[1]); wa.y = cvt_pk_bf16(o1[2], o1[3]); wb.x = cvt_pk_bf16(o2[0], o2[1]); wb.y = cvt_pk_bf16(o2[2], o2[3]);
                            *(u32x4*)(ko + 16 * j8) = w0; *(u32x4*)(ko + 16 * j8 + 8) = w1; *(u32x2*)(ko + NOPE + 4 * j8) = wa; *(u32x2*)(ko + NOPE + 32 + 4 * j8) = wb;
                        }
                    }
                }
                SEAM(pb + 4);
            }
            if (IN(pb + 5)) {
                PHASE_IDS();
                float gq = 0.f, gk = 0.f;
#pragma unroll
                for (int j = 0; j < 3; ++j) { gq = fmaxf(gq, fabsf(q_norm[(size_t)l * QKD + lane + 64 * j])); gk = fmaxf(gk, fabsf(k_norm[(size_t)l * QKD + lane + 64 * j])); }
                gq = fmaxf(gq, swz_xor<1>(gq)); gq = fmaxf(gq, swz_xor<2>(gq)); gq = fmaxf(gq, swz_xor<4>(gq)); gq = fmaxf(gq, swz_xor<8>(gq)); gq = fmaxf(gq, swz_xor<16>(gq));
                gk = fmaxf(gk, swz_xor<1>(gk)); gk = fmaxf(gk, swz_xor<2>(gk)); gk = fmaxf(gk, swz_xor<4>(gk)); gk = fmaxf(gk, swz_xor<8>(gk)); gk = fmaxf(gk, swz_xor<16>(gk));
                { auto rq = __builtin_amdgcn_permlane32_swap(__float_as_uint(gq), __float_as_uint(gq), false, false); gq = fmaxf(__uint_as_float(rq[0]), __uint_as_float(rq[1]));
                  auto rk = __builtin_amdgcn_permlane32_swap(__float_as_uint(gk), __float_as_uint(gk), false, false); gk = fmaxf(__uint_as_float(rk[0]), __uint_as_float(rk[1])); }
                const int negMC = __builtin_amdgcn_readfirstlane(__builtin_bit_cast(int, -fminf(13.856406460551018f * gq * gk, 60.f) * 1.4426950408889634f));
                for (int u = bx; u < NH * (SEQ / 256); u += G) {
                    const int h = u & 7, qb = u >> 3;
                    int ln_u; asm volatile("v_mbcnt_lo_u32_b32 %0, -1, 0\n\tv_mbcnt_hi_u32_b32 %0, -1, %0" : "=v"(ln_u));
                    const int tid_u = wave * 64 + ln_u;
                    att::attn_unit2(QB + (size_t)(qb * 256) * 1536 + h * QKD, KB + h * QKD, KVB + h * 256 + NOPE, HB + (size_t)(qb * 256) * DM + h * VHD, SEQ, lds, tid_u, negMC);
                }
                {   PHASE_IDS();
                    const int r32 = lane & 31, hi = lane >> 5;
                    LAS unsigned char* ost = lds + sg::OST_OFF + wave * sg::OST_WAVE;
                    for (;;) {
                        __syncthreads();
                        if (tid == 0) MISC[32] = atomicAdd(ctl + CW_F3CTR + 64 * l, 1u);
                        __syncthreads();
                        const int it = (int)MISC[32]; if (it >= 512) break;
                        const int tt = it >> 3, gidx = it & 7;
                        bf16x8 Af[16];
                        const bf16_t* ar = YC + (size_t)(256 * tt + 32 * wave + r32) * 2048 + gidx * 256 + 8 * hi;
#pragma unroll
                        for (int s = 0; s < 16; ++s) Af[s] = *(const bf16x8*)(ar + 16 * s);
                        __syncthreads();
                        sg::stage_b<256>(M12 + (size_t)(l * 8 + gidx) * 256 * 128, 128, (char*)lds_raw, tid);
                        __syncthreads();
                        f32x16 o[4] = {};
                        sg::mm<256>(o, Af, (char*)lds_raw, lane);
                        sg::store_tile(o, ost, lane, sg::RowF3{HB, wave, tt, gidx});
                    }
                    __syncthreads();
                }
                SEAM(pb + 5);
            }
            if (IN(pb + 6)) {
                PHASE_IDS();
                const float* og = out_norm + (size_t)l * DM;
                f32x4 ga[4], gf[4];
#pragma unroll
                for (int j = 0; j < 4; ++j) { ga[j] = *(const f32x4*)(og + 16 * lane + 4 * j); gf[j] = *(const f32x4*)(og + 1024 + 16 * lane + 4 * j); }
                bf16x8 nx[4];
                { const bf16_t* p0 = HB + (size_t)(gw < SEQ ? gw : 0) * DM + 16 * lane; nx[0] = *(const bf16x8*)p0; nx[1] = *(const bf16x8*)(p0 + 8); nx[2] = *(const bf16x8*)(p0 + 1024); nx[3] = *(const bf16x8*)(p0 + 1032); }
                for (int m = gw; m < SEQ; m += NGW) {
                    bf16_t* rp = HB + (size_t)m * DM;
                    bf16x8 cu[4];
#pragma unroll
                    for (int j = 0; j < 4; ++j) cu[j] = nx[j];
                    { const bf16_t* p0 = HB + (size_t)(m + NGW < SEQ ? m + NGW : m) * DM + 16 * lane; nx[0] = *(const bf16x8*)p0; nx[1] = *(const bf16x8*)(p0 + 8); nx[2] = *(const bf16x8*)(p0 + 1024); nx[3] = *(const bf16x8*)(p0 + 1032); }
#pragma unroll
                    for (int half = 0; half < 2; ++half) {
                        bf16_t* p = rp + half * 1024 + 16 * lane;
                        const bf16x8 a0 = cu[2 * half], a1 = cu[2 * half + 1];
                        float f[16], ss = 0.f;
#pragma unroll
                        for (int j = 0; j < 8; ++j) { f[j] = bf2f((unsigned short)a0[j]); f[8 + j] = bf2f((unsigned short)a1[j]); }
#pragma unroll
                        for (int j = 0; j < 16; ++j) ss += f[j] * f[j];
                        const float rs = 1.0f / sqrtf(wave_sum(ss) * (1.0f / 1024) + RMS_EPS);
                        u32x4 w0, w1;
#define GG(j) (half ? gf[(j) >> 2][(j) & 3] : ga[(j) >> 2][(j) & 3])
                        w0.x = cvt_pk_bf16(f[0] * rs * GG(0), f[1] * rs * GG(1)); w0.y = cvt_pk_bf16(f[2] * rs * GG(2), f[3] * rs * GG(3));
                        w0.z = cvt_pk_bf16(f[4] * rs * GG(4), f[5] * rs * GG(5)); w0.w = cvt_pk_bf16(f[6] * rs * GG(6), f[7] * rs * GG(7));
                        w1.x = cvt_pk_bf16(f[8] * rs * GG(8), f[9] * rs * GG(9)); w1.y = cvt_pk_bf16(f[10] * rs * GG(10), f[11] * rs * GG(11));
                        w1.z = cvt_pk_bf16(f[12] * rs * GG(12), f[13] * rs * GG(13)); w1.w = cvt_pk_bf16(f[14] * rs * GG(14), f[15] * rs * GG(15));
#undef GG
                        *(u32x4*)p = w0; *(u32x4*)(p + 8) = w1;
                    }
                }
                SEAM(pb + 6);
            }
            if (IN(pb + 7)) {
                PHASE_IDS();
                pg8::Gemm g{HB, WOUT + (size_t)l * DM * DM, DM, DM, DM, 0, nullptr}; pg8::TileOrder S; S.init(SEQ / 256, DM / 256, G, bx);
                pg8::EpiRes E{xcur, out, modv + 2 * DM, DM};
                pg8::gemm_phase<pg8::EpiRes, pg8::TileOrder, false>(tid, lds, g, S, E);
                SEAM(pb + 7);
            }
            }
        }
        if (l == 0) {
            if (IN(pb + 9)) {
                PHASE_IDS();
                pg8::Gemm g{HB, WGUD, DM, DM, DM, 0, nullptr}; pg8::TileOrder S; S.init(SEQ / 256, 2 * DFF / 256, G, bx);
                pg8::EpiSwiGLU E{HID, DFF};
                pg8::gemm_phase<pg8::EpiSwiGLU, pg8::TileOrder, false>(tid, lds, g, S, E);
                SEAM(pb + 9);
            }
            if (IN(pb + 10)) {
                PHASE_IDS();
                pg8::Gemm g{HID, WDND, DFF, DFF, DFF, 0, nullptr}; pg8::TileOrder S; S.init(SEQ / 256, DM / 256, G, bx);
                pg8::EpiRes E{out, out, modv + 5 * DM, DM};
                pg8::gemm_phase<pg8::EpiRes, pg8::TileOrder, false>(tid, lds, g, S, E);
                SEAM(pb + 10);
            }
        } else {
#define LOAD_TS() int ts[9]; ts[0] = 0; _Pragma("unroll") for (int e = 0; e < 8; ++e) { const int c = __builtin_amdgcn_readfirstlane((int)__hip_atomic_load(ctl + CW_ECNT + 64 * e, RLX_AGENT)); ts[e + 1] = ts[e] + ((c + 255) >> 8); }
            if (IN(pb + 9)) {
                PHASE_IDS();
                LAS int* pref = (LAS int*)lds; LAS int* tot = pref + G * 8;
                for (int i = tid; i < G * 8; i += NTHR) pref[i] = BLKCNT[i];
                __syncthreads();
                if (tid < 8) { int run = 0; for (int b = 0; b < G; ++b) { const int c = pref[b * 8 + tid]; pref[b * 8 + tid] = run; run += c; } tot[tid] = run;
                    if (bx == 0) __hip_atomic_store(ctl + CW_ECNT + 64 * tid, (unsigned)run, RLX_AGENT); }
                __syncthreads();
                int ts[9]; ts[0] = 0;
#pragma unroll
                for (int e = 0; e < 8; ++e) ts[e + 1] = ts[e] + ((tot[e] + 255) >> 8);
                for (int t = bx * NTHR + tid; t < SEQ; t += G * NTHR) {
                    const int* ti = TOKINFO + (size_t)t * 8; const int e0 = ti[0], e1 = ti[1], b = ti[6];
                    int p0 = ti[4] + pref[b * 8 + e0], p1 = ti[5] + pref[b * 8 + e1];
#pragma unroll
                    for (int e = 0; e < 8; ++e) { if (e0 == e) p0 += 256 * ts[e]; if (e1 == e) p1 += 256 * ts[e]; }
                    ROWTOK[p0] = t; ROWTOK[p1] = t; TOKPOS[2 * t] = p0; TOKPOS[2 * t + 1] = p1;
                }
                __syncthreads();
                SEAM(pb + 9);
            }
            if (IN(pb + 10)) {
                PHASE_IDS(); LOAD_TS();
                pg8::Gemm g{HB, WGUM, DM, DM, DM, (size_t)14336 * DM, ROWTOK}; pg8::TileOrder S; S.init(ts[8], 2 * DFE / 256, G, bx); S.moe = true;
#pragma unroll
                for (int e = 0; e < 9; ++e) S.ts[e] = ts[e];
                pg8::EpiSwiGLU8 E{(unsigned char*)HID, DFE, 1.0f / (S8_H * S8_WGU), S8_HID};
                pg8::gemm_phase<pg8::EpiSwiGLU8, pg8::TileOrder, true, true, true>(tid, lds, g, S, E);
                SEAM(pb + 10);
            }
            if (IN(pb + 11)) {
                PHASE_IDS(); LOAD_TS();
                const int nmain = ts[8] < 128 ? ts[8] : 128;
                pg8::EpiBf16 E{YB, DM, 1.0f / (S8_HID * S8_WDN), YPART - (size_t)32768 * DM, (size_t)2048 * DM};
                { pg8::Gemm g{HID, WDNM, DFE, DFE, DFE, (size_t)DM * DFE, nullptr}; pg8::TileOrder S; S.init(nmain, DM / 256, G, bx); S.moe = true;
#pragma unroll
                  for (int e = 0; e < 9; ++e) S.ts[e] = ts[e];
                  pg8::gemm_phase<pg8::EpiBf16, pg8::TileOrder, false, true, true>(tid, lds, g, S, E); }
                if (ts[8] > 128) { asm volatile("" : "+v"(tid));
                  pg8::Gemm g{HID, WDNM, DFE, DFE, DFE / 4, (size_t)DM * DFE, nullptr, DFE / 128}; pg8::TailOrder S; S.nsub = (ts[8] - 128) * 32; S.G = G; S.c = bx; S.pm0 = 128;
#pragma unroll
                  for (int e = 0; e < 9; ++e) S.ts[e] = ts[e];
                  pg8::gemm_phase<pg8::EpiBf16, pg8::TailOrder, false, true, true>(tid, lds, g, S, E); }
                SEAM(pb + 11);
            }
            if (IN(pb + 12)) {
                PHASE_IDS();
                const float* g2 = modv + 5 * DM;
                f32x4 gv[8];
#pragma unroll
                for (int j = 0; j < 8; ++j) gv[j] = ((const f32x4*)g2)[lane + 64 * j];
                int pn0 = 0, pn1 = 0; float wn0 = 0.f, wn1 = 0.f;
                { const int m0 = gw < SEQ ? gw : 0; const int* ti = TOKINFO + (size_t)m0 * 8; wn0 = __int_as_float(ti[2]); wn1 = __int_as_float(ti[3]); pn0 = TOKPOS[2 * m0]; pn1 = TOKPOS[2 * m0 + 1]; }
                for (int m = gw; m < SEQ; m += NGW) {
                    const float w0 = wn0, w1 = wn1; const int p0 = pn0, p1 = pn1;
                    { const int mn = m + NGW < SEQ ? m + NGW : m; const int* ti = TOKINFO + (size_t)mn * 8; wn0 = __int_as_float(ti[2]); wn1 = __int_as_float(ti[3]); pn0 = TOKPOS[2 * mn]; pn1 = TOKPOS[2 * mn + 1]; }
                    const bf16_t* y0 = YB + (size_t)p0 * DM; const bf16_t* y1 = YB + (size_t)p1 * DM; float* op = out + (size_t)m * DM;
                    s16x4 ya4[8], yb4[8]; f32x4 xv[8];
#pragma unroll
                    for (int j = 0; j < 8; ++j) { ya4[j] = *(const s16x4*)(y0 + 4 * lane + 256 * j); yb4[j] = *(const s16x4*)(y1 + 4 * lane + 256 * j); xv[j] = ((const f32x4*)op)[lane + 64 * j]; }
                    f32x4 ya[8], yb[8];
#pragma unroll
                    for (int j = 0; j < 8; ++j)
#pragma unroll
                        for (int q = 0; q < 4; ++q) { ya[j][q] = bf2f((unsigned short)ya4[j][q]); yb[j][q] = bf2f((unsigned short)yb4[j][q]); }
                    if (p0 >= 32768) {
#pragma unroll
                        for (int kq = 0; kq < 3; ++kq)
#pragma unroll
                            for (int j = 0; j < 8; ++j) { const s16x4 e = *(const s16x4*)(YPART + ((size_t)kq * 2048 + (p0 - 32768)) * DM + 4 * lane + 256 * j);
#pragma unroll
                                for (int q = 0; q < 4; ++q) ya[j][q] += bf2f((unsigned short)e[q]); } }
                    if (p1 >= 32768) {
#pragma unroll
                        for (int kq = 0; kq < 3; ++kq)
#pragma unroll
                            for (int j = 0; j < 8; ++j) { const s16x4 e = *(const s16x4*)(YPART + ((size_t)kq * 2048 + (p1 - 32768)) * DM + 4 * lane + 256 * j);
#pragma unroll
                                for (int q = 0; q < 4; ++q) yb[j][q] += bf2f((unsigned short)e[q]); } }
#pragma unroll
                    for (int j = 0; j < 8; ++j) {
#pragma unroll
                        for (int q = 0; q < 4; ++q) xv[j][q] += gv[j][q] * (w0 * ya[j][q] + w1 * yb[j][q]);
                        ((f32x4*)op)[lane + 64 * j] = xv[j]; }
                }
            }
        }
    }
    TPROBE(30);
    if (TIME_MASK != 0ull && bx0 == 0 && IS_T0()) out[0] = (float)MISC[40] * TIME_SCALE;
#undef IN
#undef SEAM
#undef LOAD_TS
#undef modv
#undef xcur
#undef out
#undef ctl
}

extern "C" void kernel_launch(void* const* d_in, const int* in_sizes, int n_in, void* d_out, int out_size, void* d_ws, size_t ws_size, hipStream_t stream) {
    static int grid = 0;
    if (grid == 0) {
        if (n_in != 24 || out_size != SEQ * DM || ws_size < WS_END) { fprintf(stderr, "kernel_launch: unexpected shapes n_in %d out %d ws %zu (need %zu)\n", n_in, out_size, ws_size, (size_t)WS_END); grid = -1; return; }
        int dev = 0, cus = 0, per_cu = 0;
        if (hipGetDevice(&dev) != hipSuccess || hipDeviceGetAttribute(&cus, hipDeviceAttributeMultiprocessorCount, dev) != hipSuccess) { grid = -1; return; }
        if (hipFuncSetAttribute((const void*)mk_fwd, hipFuncAttributeMaxDynamicSharedMemorySize, LDS_BYTES) != hipSuccess) { fprintf(stderr, "kernel_launch: hipFuncSetAttribute failed\n"); grid = -1; return; }
        if (hipOccupancyMaxActiveBlocksPerMultiprocessor(&per_cu, (const void*)mk_fwd, NTHR, LDS_BYTES) != hipSuccess || per_cu < 1) fprintf(stderr, "kernel_launch: occupancy query says %d\n", per_cu);
        (void)hipGetLastError();
        grid = cus;
    }
    if (grid < 0) return;
    (void)hipMemsetAsync((char*)d_ws + WS_CTL, 0, CTL_BYTES, stream);
    Args a{};
    for (int i = 0; i < 24; ++i) a.in[i] = d_in[i];
    a.out = (float*)d_out; a.ws = (unsigned char*)d_ws;
#if MK_MULTI
    static const int phases[] = {0, 1, 2, 3, 4, 5, 6, 7, 8, 9, 10, 11, 12, 18, 19, 20, 21, 22, 23, 24, 25, 26, 27, 28, 29, 30};
    for (int p : phases) { a.ph_lo = p; a.ph_hi = p + 1; hipLaunchKernelGGL(mk_fwd, dim3(grid), dim3(NTHR), LDS_BYTES, stream, a); }
#else
    a.ph_lo = 0; a.ph_hi = 31;
    hipLaunchKernelGGL(mk_fwd, dim3(grid), dim3(NTHR), LDS_BYTES, stream, a);
#endif
    const hipError_t le = hipPeekAtLastError();
    if (le != hipSuccess) fprintf(stderr, "kernel_launch: launch failed: %s\n", hipGetErrorName(le));
}
```

```cpp
#include <hip/hip_runtime.h>
#include <cstdio>
#include <cstdint>

#ifndef MK_MULTI
#define MK_MULTI 0
#endif

#define GAS __attribute__((address_space(1)))
#define LAS __attribute__((address_space(3)))
typedef unsigned short bf16_t;
typedef short bf16x8 __attribute__((ext_vector_type(8)));
typedef short s16x4 __attribute__((ext_vector_type(4)));
typedef float f32x4 __attribute__((ext_vector_type(4)));
typedef float f32x2 __attribute__((ext_vector_type(2)));
typedef float f32x16 __attribute__((ext_vector_type(16)));
typedef unsigned u32x4 __attribute__((ext_vector_type(4)));
typedef unsigned u32x2 __attribute__((ext_vector_type(2)));

constexpr int SEQ = 16384, DM = 2048, DIN = 1856, DINP = 2048;
constexpr int QLR = 512, KVLR = 256, ROPE = 64, NOPE = 128, VHD = 128, QKD = 192, NH = 8;
constexpr int ZQ = 0, ZKV = 512, ZKR = 768, ZU = 832;
constexpr int FNW = 1024, FG = 8;
constexpr int DFF = 5632, NE = 8, DFE = 7168;
constexpr int MAXT = 136;
constexpr float RMS_EPS = 1e-6f;
constexpr float S8_H = 8.f, S8_WGU = 64.f, S8_HID = 8.f, S8_WDN = 128.f;
constexpr int NWAVES = 8, NTHR = 512;

constexpr size_t MiB = 1u << 20;
constexpr size_t WS_CTL = 0, CTL_BYTES = 1 * MiB;
constexpr int CW_BAR = 4096;
constexpr int CW_ECNT = 8192;
constexpr int CW_F3CTR = 12288;
constexpr size_t CTL_ROWTOK = 256 * 1024;
constexpr size_t WS_MODP = 1 * MiB;
constexpr size_t WS_MODV = WS_MODP + 16 * 2 * 12288 * 4;
constexpr size_t WS_COS = 3 * MiB, WS_SIN = 5 * MiB;
constexpr size_t WS_TW = 7 * MiB;
constexpr size_t WS_FM = WS_TW + 131072;
constexpr size_t WS_GM = WS_FM + 65536;
constexpr size_t WS_M12 = 8 * MiB;
constexpr size_t WS_TOKINFO = 9 * MiB;
constexpr size_t WS_TOKPOS = WS_TOKINFO + (size_t)SEQ * 32;
constexpr size_t WS_WIN = 10 * MiB;
constexpr size_t WS_WUQ = WS_WIN + 2 * 8 * MiB;
constexpr size_t WS_WUKV = WS_WUQ + 2 * 1536 * 512 * 2;
constexpr size_t WS_WOUT = WS_WUKV + 2 * 2048 * 256 * 2;
constexpr size_t WS_WGUD = WS_WOUT + 2 * 8 * MiB;
constexpr size_t WS_WDND = WS_WGUD + (size_t)11264 * 2048 * 2;
constexpr size_t WS_WGUM = WS_WDND + (size_t)2048 * 5632 * 2;
constexpr size_t WS_WDNM = WS_WGUM + (size_t)8 * 14336 * 2048 * 2;
constexpr size_t WS_H = WS_WDNM + (size_t)8 * 2048 * 7168 * 2;
constexpr size_t WS_Y = WS_H + (size_t)SEQ * 2048 * 2;
constexpr size_t WS_ARENA = WS_Y + (size_t)MAXT * 256 * 2048 * 2;
constexpr size_t WS_Z = WS_ARENA;
constexpr size_t WS_QB = WS_Z + (size_t)SEQ * 2048 * 2;
constexpr size_t WS_KVB = WS_QB + (size_t)SEQ * 1536 * 2;
constexpr size_t WS_KB = WS_KVB + (size_t)SEQ * 2048 * 2;
constexpr size_t WS_A1 = WS_KB + (size_t)SEQ * 1536 * 2;
constexpr size_t WS_YC = WS_A1 + (size_t)SEQ * 2048 * 2;
constexpr size_t WS_HID = WS_ARENA;
constexpr size_t WS_END = WS_ARENA + (size_t)MAXT * 256 * 7168 * 2;
static_assert(WS_YC + (size_t)SEQ * 2048 * 2 <= WS_END, "arena");
static_assert(WS_END <= (size_t)1900 * MiB, "workspace budget");

constexpr int RING_BYTES = 133120;
constexpr int LDS_COND = RING_BYTES;
constexpr int LDS_TRIG = LDS_COND + 8192;
constexpr int LDS_MISC = LDS_TRIG + 1024;
constexpr int LDS_BYTES = 147456;
static_assert(LDS_MISC + 256 <= LDS_BYTES, "LDS map");

#define LDS_WAIT() asm volatile("s_waitcnt lgkmcnt(0)" ::: "memory")
#define VM_WAIT() asm volatile("s_waitcnt vmcnt(0)" ::: "memory")
#define RLX_AGENT __ATOMIC_RELAXED, __HIP_MEMORY_SCOPE_AGENT

__device__ __forceinline__ unsigned cvt_pk_bf16(float lo, float hi) { unsigned r; asm volatile("v_cvt_pk_bf16_f32 %0, %1, %2" : "=v"(r) : "v"(lo), "v"(hi)); return r; }
__device__ __forceinline__ float bf2f(unsigned short b) { return __uint_as_float(((unsigned)b) << 16); }
__device__ __forceinline__ bf16_t f2bf(float f) { return (bf16_t)(cvt_pk_bf16(f, 0.f) & 0xffffu); }
template <int XM> __device__ __forceinline__ float swz_xor(float v) { return __int_as_float(__builtin_amdgcn_ds_swizzle(__float_as_int(v), (XM << 10) | 0x1f)); }
__device__ __forceinline__ float wave_sum(float v) {
    v += swz_xor<1>(v); v += swz_xor<2>(v); v += swz_xor<4>(v); v += swz_xor<8>(v); v += swz_xor<16>(v);
    auto rr = __builtin_amdgcn_permlane32_swap(__float_as_uint(v), __float_as_uint(v), false, false);
    return __uint_as_float(rr[0]) + __uint_as_float(rr[1]);
}

#define XB_TMO      128
#define XB_XCNT(j)  (256  + 64 * (j))
#define XB_XSUB(j)  (1280 + 64 * (j))
#define XB_XGEN(j)  (2304 + 64 * (j))
#define XB_TOP      3328
#define XB_TOPGEN   3392
#define XCD_BAR_WORDS 3456
#define XB_SPIN_CAP (1u << 18)
__device__ __forceinline__ unsigned xb_ld(unsigned* p)              { return __hip_atomic_load(p, __ATOMIC_RELAXED, __HIP_MEMORY_SCOPE_AGENT); }
__device__ __forceinline__ unsigned xb_add(unsigned* p, unsigned v) { return __hip_atomic_fetch_add(p, v, __ATOMIC_RELAXED, __HIP_MEMORY_SCOPE_AGENT); }
__device__ __forceinline__ unsigned xb_xcc_id() { return (unsigned)__builtin_amdgcn_s_getreg((3 << 11) | 20) & 0xFu; }
#define XB_SPIN(cond, bar) do { unsigned _sp = 0; while (cond) { __builtin_amdgcn_s_sleep(1); \
    if ((++_sp & 255u) == 0u) { if (xb_ld(&(bar)[XB_TMO])) break; if (_sp > XB_SPIN_CAP) { atomicAdd(&(bar)[XB_TMO], 1u); break; } } } } while (0)
struct XcdBarrier { unsigned* bar; unsigned x; volatile LAS unsigned* st; };
__device__ __forceinline__ XcdBarrier xcd_barrier_post(unsigned* bar, volatile LAS unsigned* st) {
    XcdBarrier b; b.bar = bar; b.x = xb_xcc_id(); b.st = st;
    if (threadIdx.x == 0) (void)xb_add(&bar[XB_XCNT(b.x)], 1u);
    return b;
}
__device__ __forceinline__ void xcd_barrier_complete(unsigned* bar, unsigned x, unsigned& nloc, unsigned& nx) {
    const unsigned G = gridDim.x * gridDim.y * gridDim.z;
    unsigned sum, cnt, mine, sp = 0u;
    for (;;) {
        sum = 0u; cnt = 0u; mine = 0u;
#pragma unroll
        for (unsigned j = 0; j < 16; ++j) { const unsigned c = xb_ld(&bar[XB_XCNT(j)]); sum += c; cnt += (c > 0u) ? 1u : 0u; mine = (j == x) ? c : mine; }
        if (sum == G) break;
        __builtin_amdgcn_s_sleep(1);
        if ((++sp & 255u) == 0u) { if (xb_ld(&bar[XB_TMO])) break; if (sp > XB_SPIN_CAP) { atomicAdd(&bar[XB_TMO], 1u); break; } }
    }
    nloc = mine > 0u ? mine : 1u; nx = cnt > 0u ? cnt : 1u;
}
__device__ __forceinline__ void xcd_barrier(const XcdBarrier& b) {
    asm volatile("s_waitcnt vmcnt(0)" ::: "memory");
    __syncthreads();
    if (threadIdx.x == 0) {
        unsigned* bar = b.bar;
        __builtin_amdgcn_s_waitcnt(0);
        unsigned nloc = b.st[0], nx = b.st[1];
        if (nloc == 0u) { xcd_barrier_complete(bar, b.x, nloc, nx); b.st[0] = nloc; b.st[1] = nx; }
        const unsigned old = xb_add(&bar[XB_XSUB(b.x)], 1u);
        const unsigned gen = old / nloc;
        if (old + 1u == (gen + 1u) * nloc) {
            __builtin_amdgcn_fence(__ATOMIC_RELEASE, "agent");
            asm volatile("s_waitcnt vmcnt(0)" ::: "memory");
            const unsigned og = xb_add(&bar[XB_TOP], 1u);
            const unsigned tg = og / nx;
            if (og + 1u == (tg + 1u) * nx) xb_add(&bar[XB_TOPGEN], 1u);
            else XB_SPIN(xb_ld(&bar[XB_TOPGEN]) == tg, bar);
            __builtin_amdgcn_fence(__ATOMIC_ACQUIRE, "agent");
            xb_add(&bar[XB_XGEN(b.x)], 1u);
            asm volatile("s_waitcnt vmcnt(0)" ::: "memory");
        } else {
            XB_SPIN(xb_ld(&bar[XB_XGEN(b.x)]) == gen, bar);
            __builtin_amdgcn_fence(__ATOMIC_ACQUIRE, "agent");
            asm volatile("s_waitcnt vmcnt(0)" ::: "memory");
        }
    }
    __syncthreads();
}

namespace pg8 {
constexpr int BM = 256, BK = 64, HALF = 128, HTB = HALF * BK * 2, STAGE_BYTES = 8 * HTB, NXCD = 8, WGM = 8;
__host__ __device__ __forceinline__ int lds_byte(int r, int c) { const int st = (r >> 4) * 2 + (c >> 5), rr = r & 15, cc = c & 31, ob = rr * 64 + cc * 2; return st * 1024 + (ob ^ (((ob >> 9) & 1) << 5)); }
__host__ __device__ __forceinline__ void stage_rc(int b, int& R, int& C) { const int st = b / 1024, sb = b % 1024, swz = sb ^ (((sb >> 9) & 1) << 5); R = (st >> 1) * 16 + swz / 64; C = (st & 1) * 32 + (swz % 64) / 2; }
__host__ __device__ __forceinline__ int perm32(int rho) { const int n = rho >> 4, i = rho & 15; return 8 * (i >> 2) + 4 * n + (i & 3); }

struct Unit { int pm, pn, e, kq; };
struct Gemm { const void* A; const void* Bt; int lda, ldb, K; size_t estrideB; const int* rowmap; int ktB = 0; const float* ssq = nullptr; };

struct TileOrder {
    int nM, nN, nwg, G, c; int ts[9]; bool moe;
    __device__ __forceinline__ void init(int nM_, int nN_, int G_, int c_) { nM = nM_; nN = nN_; nwg = nM * nN; G = G_; c = c_; moe = false; }
    __device__ __forceinline__ bool next(int i, Unit& u) const {
        const long L = (long)i * G + c; if (L >= nwg) return false;
        int wgid = (int)L; { const int q = nwg / NXCD, r = nwg % NXCD, xcd = wgid % NXCD, off = wgid / NXCD; wgid = (xcd < r ? xcd * (q + 1) : r * (q + 1) + (xcd - r) * q) + off; }
        const int nig = WGM * nN, gid = wgid / nig, fm = gid * WGM, gsz = (nM - fm) < WGM ? (nM - fm) : WGM;
        u.pm = fm + ((wgid % nig) % gsz); u.pn = (wgid % nig) / gsz; u.e = 0; u.kq = 0;
        if (moe) {
#pragma unroll
            for (int j = 1; j < 8; ++j) if (u.pm >= ts[j]) u.e = j;
        }
        return true;
    }
};

struct TailOrder {
    int nsub, G, c, pm0; int ts[9];
    __device__ __forceinline__ bool next(int i, Unit& u) const {
        const int L = i * G + c; if (L >= nsub) return false;
        u.kq = L & 3; u.pn = (L >> 2) & 7; u.pm = pm0 + (L >> 5); u.e = 0;
#pragma unroll
        for (int j = 1; j < 8; ++j) if (u.pm >= ts[j]) u.e = j;
        return true;
    }
};
struct EpiBf16 {
    static constexpr bool PERM = true;
    bf16_t* O; int ldc; float scale; bf16_t* O2 = nullptr; size_t kqstride = 0;
    __device__ __forceinline__ void operator()(const f32x4 (&acc)[2][2][4][2], const Unit& u, int wr, int wc, int fr, int fq) const {
        const int row0 = u.pm * BM + wr * 64 + fr, col0 = u.pn * BM + wc * 32 + 8 * fq;
        bf16_t* const Ob = u.kq ? O2 + (size_t)(u.kq - 1) * kqstride : O;
#pragma unroll
        for (int ai = 0; ai < 2; ++ai)
#pragma unroll
            for (int m = 0; m < 4; ++m) { bf16_t* rowp = Ob + (size_t)(row0 + ai * HALF + m * 16) * ldc + col0;
#pragma unroll
                for (int bj = 0; bj < 2; ++bj) { const f32x4 v0 = acc[ai][bj][m][0] * scale, v1 = acc[ai][bj][m][1] * scale;
                    u32x4 w; w.x = cvt_pk_bf16(v0[0], v0[1]); w.y = cvt_pk_bf16(v0[2], v0[3]); w.z = cvt_pk_bf16(v1[0], v1[1]); w.w = cvt_pk_bf16(v1[2], v1[3]);
                    *(u32x4*)(rowp + bj * HALF) = w; } }
    }
};
__device__ __forceinline__ float silu_f(float x) { return x * __builtin_amdgcn_rcpf(1.0f + __builtin_amdgcn_exp2f(-1.4426950408889634f * x)); }
struct EpiSwiGLU {
    static constexpr bool PERM = true;
    bf16_t* O; int ldc;
    __device__ __forceinline__ void operator()(const f32x4 (&acc)[2][2][4][2], const Unit& u, int wr, int wc, int fr, int fq) const {
        const int row0 = u.pm * BM + wr * 64 + fr, col0 = u.pn * HALF + wc * 32 + 8 * fq;
#pragma unroll
        for (int ai = 0; ai < 2; ++ai)
#pragma unroll
            for (int m = 0; m < 4; ++m) { bf16_t* rowp = O + (size_t)(row0 + ai * HALF + m * 16) * ldc + col0;
                f32x4 v0, v1;
#pragma unroll
                for (int j = 0; j < 4; ++j) { v0[j] = silu_f(acc[ai][0][m][0][j]) * acc[ai][1][m][0][j]; v1[j] = silu_f(acc[ai][0][m][1][j]) * acc[ai][1][m][1][j]; }
                u32x4 w; w.x = cvt_pk_bf16(v0[0], v0[1]); w.y = cvt_pk_bf16(v0[2], v0[3]); w.z = cvt_pk_bf16(v1[0], v1[1]); w.w = cvt_pk_bf16(v1[2], v1[3]);
                *(u32x4*)rowp = w; }
    }
};
__device__ __forceinline__ float clamp448(float x) { return __builtin_amdgcn_fmed3f(x, -448.f, 448.f); }
struct EpiSwiGLU8 {
    static constexpr bool PERM = true;
    unsigned char* O; int ldc; float iscale, oscale;
    __device__ __forceinline__ void operator()(const f32x4 (&acc)[2][2][4][2], const Unit& u, int wr, int wc, int fr, int fq) const {
        const int row0 = u.pm * BM + wr * 64 + fr, col0 = u.pn * HALF + wc * 32 + 8 * fq;
#pragma unroll
        for (int ai = 0; ai < 2; ++ai)
#pragma unroll
            for (int m = 0; m < 4; ++m) { unsigned char* rowp = O + (size_t)(row0 + ai * HALF + m * 16) * ldc + col0;
                f32x4 v0, v1;
#pragma unroll
                for (int j = 0; j < 4; ++j) { v0[j] = clamp448(silu_f(acc[ai][0][m][0][j] * iscale) * (acc[ai][1][m][0][j] * (iscale * oscale)));
                                              v1[j] = clamp448(silu_f(acc[ai][0][m][1][j] * iscale) * (acc[ai][1][m][1][j] * (iscale * oscale))); }
                int w0 = 0, w1 = 0;
                w0 = __builtin_amdgcn_cvt_pk_fp8_f32(v0[0], v0[1], w0, false); w0 = __builtin_amdgcn_cvt_pk_fp8_f32(v0[2], v0[3], w0, true);
                w1 = __builtin_amdgcn_cvt_pk_fp8_f32(v1[0], v1[1], w1, false); w1 = __builtin_amdgcn_cvt_pk_fp8_f32(v1[2], v1[3], w1, true);
                u32x2 w; w.x = (unsigned)w0; w.y = (unsigned)w1; *(u32x2*)rowp = w; }
    }
};
struct EpiRes {
    static constexpr bool PERM = false;
    const float* X; float* O; const float* gate; int ldc; const LAS float* fac = nullptr;
    __device__ __forceinline__ void operator()(const f32x4 (&acc)[2][2][4][2], const Unit& u, int wr, int wc, int fr, int fq) const {
        const int row0 = u.pm * BM + wr * 64 + fr, col0 = u.pn * BM + wc * 32 + 4 * fq;
        f32x4 gv[2][2];
#pragma unroll
        for (int bj = 0; bj < 2; ++bj)
#pragma unroll
            for (int n = 0; n < 2; ++n) gv[bj][n] = *(const f32x4*)(gate + col0 + bj * HALF + n * 16);
        f32x4 xv[3][2][2];
#define EPR_LD(g_) do { const size_t off_ = (size_t)(row0 + ((g_) >> 2) * HALF + ((g_) & 3) * 16) * ldc + col0; _Pragma("unroll") for (int bj = 0; bj < 2; ++bj) _Pragma("unroll") for (int n = 0; n < 2; ++n) \
            xv[(g_) % 3][bj][n] = *(const f32x4*)(X + off_ + bj * HALF + n * 16); } while (0)
        EPR_LD(0); EPR_LD(1); EPR_LD(2);
#pragma unroll
        for (int g = 0; g < 8; ++g) { const int ai = g >> 2, m = g & 3; const size_t off = (size_t)(row0 + ai * HALF + m * 16) * ldc + col0;
            const float rsc = fac ? fac[(u.e * BM + wr * 64 + fr + ai * HALF + m * 16) * 2 + 1] : 1.f;
            asm volatile("" ::: "memory");
#pragma unroll
            for (int bj = 0; bj < 2; ++bj)
#pragma unroll
                for (int n = 0; n < 2; ++n) *(f32x4*)(O + off + bj * HALF + n * 16) = xv[g % 3][bj][n] + gv[bj][n] * (acc[ai][bj][m][n] * rsc);
            asm volatile("" ::: "memory");
            if (g + 3 < 8) EPR_LD(g + 3); }
#undef EPR_LD
    }
};

typedef int v8i __attribute__((ext_vector_type(8)));
typedef unsigned u32x8 __attribute__((ext_vector_type(8)));
template <class Epi, class Sched, bool GATHER, bool FP8 = false, bool TILEDB = false, bool ROWSC = false>
__device__ __forceinline__ void gemm_phase(const int tid, LAS unsigned char* lds, const Gemm g, const Sched& S, const Epi& E) {
    const int wid = __builtin_amdgcn_readfirstlane(tid >> 6), lane = tid & 63, wr = wid >> 2, wc = wid & 3, fr = lane & 15, fq = lane >> 4;
    constexpr int ESZ = FP8 ? 1 : 2;
    const int nt = g.K * ESZ / (BK * 2);
    unsigned voffA[2], voffB[2];
#pragma unroll
    for (int i = 0; i < 2; ++i) { int R, C; stage_rc(tid * 16 + i * 8192, R, C); const int Rb = Epi::PERM ? ((R & ~31) + perm32(R & 31)) : R;
        voffA[i] = (unsigned)(R * g.lda * ESZ + C * 2); voffB[i] = TILEDB ? (unsigned)(Rb * 128 + C * 2) : (unsigned)(Rb * g.ldb * ESZ + C * 2); }
    const size_t kstep = (size_t)(BK * 2);
    const size_t hstepA = (size_t)HALF * g.lda * ESZ, tstepA = 2 * hstepA;
    const size_t kstepB = TILEDB ? (size_t)32768 : kstep;
    const size_t hstepB = TILEDB ? (size_t)16384 : (size_t)HALF * g.ldb * ESZ, tstepB = TILEDB ? (size_t)(g.ktB ? g.ktB : nt) * 32768 : 2 * hstepB;
    const size_t kqA = (size_t)nt * kstep, kqB = (size_t)nt * kstepB;
    const unsigned ldsw = (unsigned)wid * 1024u;
    const int aoff = lds_byte(wr * 64 + fr, fq * 8), boff = lds_byte(wc * 32 + fr, fq * 8);
#define PG8_SA(b, h) (((b) * 2 + (h)) * HTB)
#define PG8_SB(b, h) ((4 + (b) * 2 + (h)) * HTB)
#define PG8_STAGE(bufoff, gbase, voff) do { _Pragma("unroll") for (int _i = 0; _i < 2; ++_i) \
        __builtin_amdgcn_global_load_lds((const unsigned*)((const char*)(gbase) + (voff)[_i]), (LAS unsigned*)(lds + (bufoff) + ldsw + _i * 8192), 16, 0, 0); } while (0)
#define PG8_STAGE_A(bufoff, UB, h, kb, V0, V1) do { if constexpr (GATHER) { if (h) PG8_STAGE(bufoff, gA + (kb), V1); else PG8_STAGE(bufoff, gA + (kb), V0); } \
        else PG8_STAGE(bufoff, (UB) + (h) * hstepA + (kb), voffA); } while (0)
#define PG8_LD8(P) __builtin_shufflevector(*(const LAS u32x4*)(P), *(const LAS u32x4*)((P) + 1024), 0, 1, 2, 3, 4, 5, 6, 7)
#define PG8_LDA(dst, b, h) do { if constexpr (FP8) { _Pragma("unroll") for (int m = 0; m < 4; ++m) dst##8[m] = PG8_LD8(lds + PG8_SA(b, h) + aoff + m * 2048); } \
        else { _Pragma("unroll") for (int m = 0; m < 4; ++m) _Pragma("unroll") for (int k = 0; k < 2; ++k) dst[m][k] = *(const LAS bf16x8*)(lds + PG8_SA(b, h) + aoff + m * 2048 + k * 1024); } } while (0)
#define PG8_LDB(dst, b, h) do { if constexpr (FP8) { _Pragma("unroll") for (int n = 0; n < 2; ++n) dst##8[n] = PG8_LD8(lds + PG8_SB(b, h) + boff + n * 2048); } \
        else { _Pragma("unroll") for (int n = 0; n < 2; ++n) _Pragma("unroll") for (int k = 0; k < 2; ++k) dst[n][k] = *(const LAS bf16x8*)(lds + PG8_SB(b, h) + boff + n * 2048 + k * 1024); } } while (0)
#define PG8_MMA(ai, bj, At, Bt) do { __builtin_amdgcn_s_setprio(1); _Pragma("unroll") for (int m = 0; m < 4; ++m) _Pragma("unroll") for (int n = 0; n < 2; ++n) { \
        if constexpr (FP8) { asm("v_mfma_scale_f32_16x16x128_f8f6f4 %0, %1, %2, %0, %3, %3 op_sel_hi:[0,0,0]" : "+v"(acc[ai][bj][m][n]) : "v"(Bt##8[n]), "v"(At##8[m]), "v"(sc8)); } \
        else { _Pragma("unroll") for (int k = 0; k < 2; ++k) acc[ai][bj][m][n] = __builtin_amdgcn_mfma_f32_16x16x32_bf16(Bt[n][k], At[m][k], acc[ai][bj][m][n], 0, 0, 0); } } \
        __builtin_amdgcn_s_setprio(0); } while (0)
#define PG8_WAIT_V(n) asm volatile("s_waitcnt vmcnt(" #n ")" ::: "memory")
#define PG8_WAIT_L(n) asm volatile("s_waitcnt lgkmcnt(" #n ")" ::: "memory")
#define PG8_BAR __builtin_amdgcn_s_barrier()
#define PG8_SCHED __builtin_amdgcn_sched_barrier(0)
#define PG8_AOFFS(U, V0, V1) do { _Pragma("unroll") for (int _i = 0; _i < 2; ++_i) { int R_, C_; stage_rc(tid * 16 + _i * 8192, R_, C_); \
        const int r0 = g.rowmap[(U).pm * BM + R_], r1 = g.rowmap[(U).pm * BM + HALF + R_]; \
        V0[_i] = (unsigned)(r0 * g.lda * ESZ + C_ * 2); V1[_i] = (unsigned)(r1 * g.lda * ESZ + C_ * 2); } } while (0)
    Unit cur, nxt; int ui = 0;
    if constexpr (ROWSC) {
        LAS float* fac = (LAS float*)(lds + LDS_COND);
        { Unit uu; const int i_ = tid >> 8; if (S.next(i_, uu)) { const f32x4* p = (const f32x4*)(g.ssq + (size_t)(uu.pm * BM + (tid & 255)) * 16);
            const f32x4 a0 = p[0], a1 = p[1], f0 = p[2], f1 = p[3];
            const float sa = ((a0[0] + a0[1]) + (a0[2] + a0[3])) + ((a1[0] + a1[1]) + (a1[2] + a1[3])), sf = ((f0[0] + f0[1]) + (f0[2] + f0[3])) + ((f1[0] + f1[1]) + (f1[2] + f1[3]));
            const float ra = 1.0f / sqrtf(sa * (1.0f / 1024) + RMS_EPS), rf = 1.0f / sqrtf(sf * (1.0f / 1024) + RMS_EPS);
            fac[tid * 2] = ra / rf; fac[tid * 2 + 1] = rf; } }
        __syncthreads();
    }
    if (!S.next(0, cur)) return;
    f32x4 acc[2][2][4][2];
#pragma unroll
    for (int a = 0; a < 2; ++a)
#pragma unroll
        for (int b = 0; b < 2; ++b)
#pragma unroll
            for (int m = 0; m < 4; ++m)
#pragma unroll
                for (int n = 0; n < 2; ++n) acc[a][b][m][n] = (f32x4){0.f, 0.f, 0.f, 0.f};
    const unsigned sc8 = 0x7f7f7f7fu; (void)sc8;
    bf16x8 At[4][2], B0[2][2], B1[2][2]; u32x8 At8[4], B08[2], B18[2]; (void)At; (void)B0; (void)B1; (void)At8; (void)B08; (void)B18;
    unsigned vc0[2] = {0u, 0u}, vc1[2] = {0u, 0u}, vn0[2] = {0u, 0u}, vn1[2] = {0u, 0u};
    if constexpr (GATHER) PG8_AOFFS(cur, vc0, vc1);
    const char* gA = (const char*)g.A;
    const char* cA = gA + (size_t)cur.pm * tstepA + (size_t)cur.kq * kqA;
    const char* cB = (const char*)g.Bt + (size_t)cur.e * g.estrideB * ESZ + (size_t)cur.pn * tstepB + (size_t)cur.kq * kqB;
    PG8_STAGE(PG8_SB(0, 0), cB, voffB); PG8_STAGE(PG8_SB(0, 1), cB + hstepB, voffB); PG8_STAGE_A(PG8_SA(0, 0), cA, 0, 0, vc0, vc1); PG8_STAGE_A(PG8_SA(0, 1), cA, 1, 0, vc0, vc1);
    if (wr == 1) PG8_BAR;
    PG8_WAIT_V(2); PG8_BAR;
    PG8_STAGE(PG8_SB(1, 0), cB + kstepB, voffB); PG8_STAGE_A(PG8_SA(1, 0), cA, 0, kstep, vc0, vc1); PG8_STAGE(PG8_SB(1, 1), cB + hstepB + kstepB, voffB);
    PG8_WAIT_V(6); PG8_BAR;
    for (;;) {
        const bool has_next = S.next(ui + 1, nxt);
        const char* nA = cA; const char* nB = cB;
        if (has_next) { nA = gA + (size_t)nxt.pm * tstepA + (size_t)nxt.kq * kqA; nB = (const char*)g.Bt + (size_t)nxt.e * g.estrideB * ESZ + (size_t)nxt.pn * tstepB + (size_t)nxt.kq * kqB; }
        if constexpr (GATHER) { if (has_next) PG8_AOFFS(nxt, vn0, vn1); else {
#pragma unroll
            for (int _i = 0; _i < 2; ++_i) { vn0[_i] = vc0[_i]; vn1[_i] = vc1[_i]; } } }
        for (int t = 0; t < nt; t += 2) {
            if constexpr (ROWSC) { if (t == nt / 2) { const LAS float* fac = (const LAS float*)(lds + LDS_COND) + (ui * BM + wr * 64 + fr) * 2;
#pragma unroll
                for (int a = 0; a < 2; ++a)
#pragma unroll
                    for (int m = 0; m < 4; ++m) { const float rt = fac[(a * HALF + m * 16) * 2];
#pragma unroll
                        for (int b = 0; b < 2; ++b)
#pragma unroll
                            for (int n = 0; n < 2; ++n) acc[a][b][m][n] *= rt; } } }
            const bool last = (t == nt - 2);
            const size_t k1 = (size_t)(t + 1) * kstep, k2 = last ? 0 : (size_t)(t + 2) * kstep, k3 = k2 + kstep;
            const char* u2 = last ? nA : cA; const char* b2 = (last ? nB : cB) + (last ? 0 : (size_t)(t + 2) * kstepB); const char* b3 = b2 + kstepB;
            unsigned va0[2] = {0u, 0u}, va1[2] = {0u, 0u};
            if constexpr (GATHER) {
#pragma unroll
                for (int _i = 0; _i < 2; ++_i) { va0[_i] = last ? vn0[_i] : vc0[_i]; va1[_i] = last ? vn1[_i] : vc1[_i]; } }
            PG8_LDB(B0, 0, 0); PG8_LDB(B1, 0, 1); PG8_SCHED; PG8_LDA(At, 0, 0); PG8_STAGE_A(PG8_SA(1, 1), cA, 1, k1, vc0, vc1);
            PG8_WAIT_V(8); PG8_WAIT_L(0); PG8_BAR; PG8_MMA(0, 0, At, B0); PG8_MMA(0, 1, At, B1); PG8_BAR; PG8_SCHED;
            PG8_LDA(At, 0, 1); PG8_STAGE(PG8_SB(0, 0), b2, voffB); PG8_STAGE(PG8_SB(0, 1), b2 + hstepB, voffB); PG8_STAGE_A(PG8_SA(0, 0), u2, 0, k2, va0, va1);
            PG8_WAIT_V(8); PG8_WAIT_L(0); PG8_BAR; PG8_MMA(1, 0, At, B0); PG8_MMA(1, 1, At, B1); PG8_BAR; PG8_SCHED;
            PG8_LDB(B0, 1, 0); PG8_LDB(B1, 1, 1); PG8_SCHED; PG8_LDA(At, 1, 0); PG8_STAGE_A(PG8_SA(0, 1), u2, 1, k2, va0, va1);
            PG8_WAIT_V(8); PG8_WAIT_L(0); PG8_BAR; PG8_MMA(0, 0, At, B0); PG8_MMA(0, 1, At, B1); PG8_BAR; PG8_SCHED;
            PG8_LDA(At, 1, 1); PG8_STAGE(PG8_SB(1, 0), b3, voffB); PG8_STAGE(PG8_SB(1, 1), b3 + hstepB, voffB); PG8_STAGE_A(PG8_SA(1, 0), u2, 0, k3, va0, va1);
            PG8_WAIT_V(8); PG8_WAIT_L(0); PG8_BAR; PG8_MMA(1, 0, At, B0); PG8_MMA(1, 1, At, B1); PG8_BAR; PG8_SCHED;
        }
        if constexpr (FP8) asm volatile("s_nop 15\n\ts_nop 15" ::: "memory");
        if (wr == 0) PG8_BAR;
        if constexpr (ROWSC) cur.e = ui;
        { int fr_ = fr, fq_ = fq; asm volatile("" : "+v"(fr_), "+v"(fq_)); E(acc, cur, wr, wc, fr_, fq_); }
        if (!has_next) break;
#pragma unroll
        for (int a = 0; a < 2; ++a)
#pragma unroll
            for (int b = 0; b < 2; ++b)
#pragma unroll
                for (int m = 0; m < 4; ++m)
#pragma unroll
                    for (int n = 0; n < 2; ++n) acc[a][b][m][n] = (f32x4){0.f, 0.f, 0.f, 0.f};
        cur = nxt; cA = nA; cB = nB; ++ui;
        if constexpr (GATHER) {
#pragma unroll
            for (int _i = 0; _i < 2; ++_i) { vc0[_i] = vn0[_i]; vc1[_i] = vn1[_i]; } }
        if (wr == 1) PG8_BAR;
    }
    PG8_WAIT_V(0);
    PG8_BAR;
#undef PG8_SA
#undef PG8_SB
#undef PG8_STAGE
#undef PG8_STAGE_A
#undef PG8_LDA
#undef PG8_LD8
#undef PG8_LDB
#undef PG8_MMA
#undef PG8_WAIT_V
#undef PG8_WAIT_L
#undef PG8_BAR
#undef PG8_SCHED
#undef PG8_AOFFS
}
}

namespace att {
constexpr int NW = 8, QBLK = 32, KVBLK = 64, DQ = QKD, DV = VHD;
constexpr float SCALE = 0.07216878364870322f;
constexpr float THR = 8.f;
constexpr int LDQ = 1536, LDK = 1536, LDV = 2048, LDO = 2048;
constexpr int SHM_V = KVBLK * DV * 2, SHM_K = KVBLK * DQ * 2, SHM_ATTN = 2 * SHM_V + 2 * SHM_K + NW * 64 * 4;
#define KSWZ(row, colB) ((row) * 384 + ((colB) ^ ((((row) >> 1) & 7) << 4)))
#define SBAR() __builtin_amdgcn_sched_barrier(0)
__device__ __forceinline__ int crow(int r, int hi) { return (r & 3) + 8 * (r >> 2) + 4 * hi; }
__device__ __forceinline__ void partialSM(f32x16& p0, f32x16& p1, float& m_reg, float& mn, float& alpha) {
  constexpr float C = SCALE * 1.4426950408889634f;
  float pmax = p0[0];
#pragma unroll
  for (int r = 1; r < 16; ++r) pmax = fmaxf(pmax, p0[r]);
#pragma unroll
  for (int r = 0; r < 16; ++r) pmax = fmaxf(pmax, p1[r]);
  { auto rr = __builtin_amdgcn_permlane32_swap(__float_as_uint(pmax), __float_as_uint(pmax), false, false);
    pmax = fmaxf(__uint_as_float(rr[0]), __uint_as_float(rr[1])); }
  if (__builtin_expect(__all(pmax - m_reg <= THR / SCALE), 1)) { mn = m_reg; alpha = 1.f; }
  else { mn = fmaxf(m_reg, pmax); alpha = __builtin_amdgcn_exp2f((m_reg - mn) * C); m_reg = mn; }
  float mnC = -mn * C;
#pragma unroll
  for (int r = 0; r < 16; ++r) p0[r] = fmaf(p0[r], C, mnC);
#pragma unroll
  for (int r = 0; r < 16; ++r) p1[r] = fmaf(p1[r], C, mnC);
#pragma unroll
  for (int r = 0; r < 16; ++r) p0[r] = __builtin_amdgcn_exp2f(p0[r]);
}
__device__ __forceinline__ void finishSM(f32x16& p0, f32x16& p1, float alpha, float& l_reg, bf16x8& pa0, bf16x8& pa1, bf16x8& pa2, bf16x8& pa3) {
#pragma unroll
  for (int r = 0; r < 16; ++r) p1[r] = __builtin_amdgcn_exp2f(p1[r]);
  float ps = 0;
#pragma unroll
  for (int r = 0; r < 16; ++r) ps += p0[r];
#pragma unroll
  for (int r = 0; r < 16; ++r) ps += p1[r];
  { auto rr = __builtin_amdgcn_permlane32_swap(__float_as_uint(ps), __float_as_uint(ps), false, false);
    ps = __uint_as_float(rr[0]) + __uint_as_float(rr[1]); }
  l_reg = l_reg * alpha + ps;
#define PK4(P, BASE, OUT) do { unsigned a0 = cvt_pk_bf16(P[BASE + 0], P[BASE + 1]), a1 = cvt_pk_bf16(P[BASE + 2], P[BASE + 3]);   \
    unsigned b0 = cvt_pk_bf16(P[BASE + 4], P[BASE + 5]), b1 = cvt_pk_bf16(P[BASE + 6], P[BASE + 7]);                              \
    auto r0 = __builtin_amdgcn_permlane32_swap(a0, b0, false, false); auto r1 = __builtin_amdgcn_permlane32_swap(a1, b1, false, false); \
    u32x4 w = {r0[0], r1[0], r0[1], r1[1]}; OUT = *reinterpret_cast<bf16x8*>(&w); } while (0)
  PK4(p0, 0, pa0); PK4(p0, 8, pa1); PK4(p1, 0, pa2); PK4(p1, 8, pa3);
#undef PK4
}
__device__ __forceinline__ void qkt(f32x16& p0, f32x16& p1, const char* Ks, const bf16x8* qr, int r32, int hi) {
  p0 = f32x16{}; p1 = f32x16{};
#pragma unroll
  for (int d0 = 0; d0 < DQ / 16; ++d0) { int cb = (d0 * 16 + hi * 8) * 2;
    bf16x8 b0 = *reinterpret_cast<const bf16x8*>(Ks + KSWZ(r32, cb));
    bf16x8 b1 = *reinterpret_cast<const bf16x8*>(Ks + KSWZ(32 + r32, cb));
    p0 = __builtin_amdgcn_mfma_f32_32x32x16_bf16(b0, qr[d0], p0, 0, 0, 0);
    p1 = __builtin_amdgcn_mfma_f32_32x32x16_bf16(b1, qr[d0], p1, 0, 0, 0);
    if ((d0 & 3) == 3) SBAR(); }
}
__device__ __forceinline__ int v_st(int k, int c) { const int kk = (k & ~0xC) | ((k & 4) << 1) | ((k & 8) >> 1); return ((kk >> 3) * 4 + (c >> 5)) * 512 + ((kk & 7) * 32 + (c & 31)) * 2; }
__device__ __forceinline__ int v_rd_base(int lane) { return ((lane & 3) << 3) | (((lane >> 2) & 3) << 6) | (((lane >> 4) & 1) << 5) | (((lane >> 5) & 1) << 8); }
constexpr int v_rd_off(int d0, int ks, int half) { return d0 * 512 + ks * 4096 + half * 2048; }
template <int OFF> __device__ __forceinline__ s16x4 tr_read(int vb) {
  s16x4 r; asm volatile("ds_read_b64_tr_b16 %0, %1 offset:%2" : "=&v"(r) : "v"(vb), "i"(OFF) : "memory"); return r;
}
template <int D0> __device__ __forceinline__ void pv_one(f32x16& od, int vb, bf16x8 pa0, bf16x8 pa1, bf16x8 pa2, bf16x8 pa3) {
  const s16x4 l0 = tr_read<v_rd_off(D0, 0, 0)>(vb), h0 = tr_read<v_rd_off(D0, 0, 1)>(vb), l1 = tr_read<v_rd_off(D0, 1, 0)>(vb), h1 = tr_read<v_rd_off(D0, 1, 1)>(vb);
  const s16x4 l2 = tr_read<v_rd_off(D0, 2, 0)>(vb), h2 = tr_read<v_rd_off(D0, 2, 1)>(vb), l3 = tr_read<v_rd_off(D0, 3, 0)>(vb), h3 = tr_read<v_rd_off(D0, 3, 1)>(vb);
  asm volatile("s_waitcnt lgkmcnt(0)" ::: "memory"); SBAR();
#define PK(L, H) (bf16x8){L[0], L[1], L[2], L[3], H[0], H[1], H[2], H[3]}
  od = __builtin_amdgcn_mfma_f32_32x32x16_bf16(pa0, PK(l0, h0), od, 0, 0, 0);
  od = __builtin_amdgcn_mfma_f32_32x32x16_bf16(pa1, PK(l1, h1), od, 0, 0, 0);
  od = __builtin_amdgcn_mfma_f32_32x32x16_bf16(pa2, PK(l2, h2), od, 0, 0, 0);
  od = __builtin_amdgcn_mfma_f32_32x32x16_bf16(pa3, PK(l3, h3), od, 0, 0, 0);
#undef PK
}
#define PV_RD(D0, L, H) do { L[0] = tr_read<v_rd_off(D0, 0, 0)>(vb); H[0] = tr_read<v_rd_off(D0, 0, 1)>(vb); L[1] = tr_read<v_rd_off(D0, 1, 0)>(vb); H[1] = tr_read<v_rd_off(D0, 1, 1)>(vb); \
    L[2] = tr_read<v_rd_off(D0, 2, 0)>(vb); H[2] = tr_read<v_rd_off(D0, 2, 1)>(vb); L[3] = tr_read<v_rd_off(D0, 3, 0)>(vb); H[3] = tr_read<v_rd_off(D0, 3, 1)>(vb); } while (0)
#define PV_MM(OD, L, H) do { OD = __builtin_amdgcn_mfma_f32_32x32x16_bf16(pa0, PKX(L[0], H[0]), OD, 0, 0, 0); OD = __builtin_amdgcn_mfma_f32_32x32x16_bf16(pa1, PKX(L[1], H[1]), OD, 0, 0, 0); \
    OD = __builtin_amdgcn_mfma_f32_32x32x16_bf16(pa2, PKX(L[2], H[2]), OD, 0, 0, 0); OD = __builtin_amdgcn_mfma_f32_32x32x16_bf16(pa3, PKX(L[3], H[3]), OD, 0, 0, 0); } while (0)
#define PKX(L, H) (bf16x8){L[0], L[1], L[2], L[3], H[0], H[1], H[2], H[3]}
__device__ __forceinline__ void pv_d0_pipe(f32x16* o, int vb, bf16x8 pa0, bf16x8 pa1, bf16x8 pa2, bf16x8 pa3) {
  s16x4 la[4], ha[4], lb[4], hb[4];
  PV_RD(0, la, ha);
#define PV_PIN(OD) asm volatile("" : "+v"(OD))
  PV_RD(1, lb, hb); asm volatile("s_waitcnt lgkmcnt(8)" ::: "memory"); SBAR(); PV_MM(o[0], la, ha); PV_PIN(o[0]);
  PV_RD(2, la, ha); asm volatile("s_waitcnt lgkmcnt(8)" ::: "memory"); SBAR(); PV_MM(o[1], lb, hb); PV_PIN(o[1]);
  PV_RD(3, lb, hb); asm volatile("s_waitcnt lgkmcnt(8)" ::: "memory"); SBAR(); PV_MM(o[2], la, ha); PV_PIN(o[2]);
  asm volatile("s_waitcnt lgkmcnt(0)" ::: "memory"); SBAR(); PV_MM(o[3], lb, hb); PV_PIN(o[3]);
#undef PV_PIN
}
__device__ __forceinline__ void pv_fsm(f32x16* o, int vb, bf16x8 pa0, bf16x8 pa1, bf16x8 pa2, bf16x8 pa3, f32x16& p0, f32x16& p1, int negMCbits, s16x4* la, s16x4* ha, s16x4* lb, s16x4* hb) {
  constexpr float C = SCALE * 1.4426950408889634f;
  int nb_ = __builtin_amdgcn_readfirstlane(negMCbits); asm volatile("" : "+s"(nb_)); const float negMC = __builtin_bit_cast(float, nb_);
#define FSQ(q) do { _Pragma("unroll") for (int r_ = (q); r_ < 16; r_ += 4) { float x_ = p1[r_]; asm("" : "+v"(x_)); p0[r_] = fmaf(p0[r_], C, negMC); p1[r_] = fmaf(x_, C, negMC); p0[r_] = __builtin_amdgcn_exp2f(p0[r_]); } } while (0)
#define PV_PIN(OD, q) asm volatile("" :: "v"(OD), "v"(p0[q]), "v"(p0[q + 4]), "v"(p0[q + 8]), "v"(p0[q + 12]), "v"(p1[q]), "v"(p1[q + 4]), "v"(p1[q + 8]), "v"(p1[q + 12]))
#define PV_WAIT(N, L, H) asm volatile("s_waitcnt lgkmcnt(" #N ")" : "+v"(L[0]), "+v"(H[0]), "+v"(L[1]), "+v"(H[1]), "+v"(L[2]), "+v"(H[2]), "+v"(L[3]), "+v"(H[3]) :: "memory")
  PV_RD(1, lb, hb); PV_WAIT(8, la, ha); SBAR(); PV_MM(o[0], la, ha); FSQ(0); PV_PIN(o[0], 0);
  PV_RD(2, la, ha); PV_WAIT(8, lb, hb); SBAR(); PV_MM(o[1], lb, hb); FSQ(1); PV_PIN(o[1], 1);
  PV_RD(3, lb, hb); PV_WAIT(8, la, ha); SBAR(); PV_MM(o[2], la, ha); FSQ(2); FSQ(3); PV_PIN(o[2], 2); PV_PIN(o[2], 3);
  PV_WAIT(0, lb, hb);
#undef FSQ
#undef PV_PIN
#undef PV_WAIT
}
#undef PV_RD
#undef PV_MM
#undef PKX
__device__ __forceinline__ void pv_d0(f32x16* o, int vb, bf16x8 pa0, bf16x8 pa1, bf16x8 pa2, bf16x8 pa3) {
  pv_one<0>(o[0], vb, pa0, pa1, pa2, pa3); pv_one<1>(o[1], vb, pa0, pa1, pa2, pa3); pv_one<2>(o[2], vb, pa0, pa1, pa2, pa3); pv_one<3>(o[3], vb, pa0, pa1, pa2, pa3);
}


constexpr int K_OFF = 0, V_OFF = 3 * SHM_K, WS_OFF = V_OFF + 3 * SHM_V, SHM_ATTN2 = WS_OFF + NW * 64 * 4;
constexpr int KOFS_OFF = SHM_ATTN2;
__device__ __forceinline__ void qkt_l(f32x16& p0, f32x16& p1, LAS const char* Ks, const bf16x8* qr, int r32, int hi) {
  p0 = f32x16{}; p1 = f32x16{};
  __builtin_amdgcn_s_setprio(1);
  const int swz = ((r32 >> 1) & 7) << 4, rowb = r32 * 384;
  LAS const char* ar[4];
#pragma unroll
  for (int r = 0; r < 4; ++r) ar[r] = Ks + rowb + ((32 * r + 16 * hi) ^ swz);
#pragma unroll
  for (int q = 0; q < DQ / 64; ++q)
#pragma unroll
    for (int r = 0; r < 4; ++r) { const int d0 = 4 * q + r;
      bf16x8 b0 = *reinterpret_cast<LAS const bf16x8*>(ar[r] + 128 * q);
      bf16x8 b1 = *reinterpret_cast<LAS const bf16x8*>(ar[r] + 128 * q + 32 * 384);
      p0 = __builtin_amdgcn_mfma_f32_32x32x16_bf16(b0, qr[d0], p0, 0, 0, 0);
      p1 = __builtin_amdgcn_mfma_f32_32x32x16_bf16(b1, qr[d0], p1, 0, 0, 0);
      if (r == 3 && d0 != DQ / 16 - 1) SBAR(); }
  __builtin_amdgcn_s_setprio(0);
}
__device__ __forceinline__ void qkt_l2(f32x16& p0, f32x16& p1, LAS const char* Ks, const bf16x8* qr, int r32, int hi) {
  p0 = f32x16{}; p1 = f32x16{};
  const int swz = ((r32 >> 1) & 7) << 4, rowb = r32 * 384;
  LAS const char* ar[4];
#pragma unroll
  for (int r = 0; r < 4; ++r) ar[r] = Ks + rowb + ((32 * r + 16 * hi) ^ swz);
#pragma unroll
  for (int q = 0; q < DQ / 64; ++q)
#pragma unroll
    for (int r = 0; r < 4; ++r) { const int d0 = 4 * q + r;
      bf16x8 b0 = *reinterpret_cast<LAS const bf16x8*>(ar[r] + 128 * q);
      bf16x8 b1 = *reinterpret_cast<LAS const bf16x8*>(ar[r] + 128 * q + 32 * 384);
      p0 = __builtin_amdgcn_mfma_f32_32x32x16_bf16(b0, qr[d0], p0, 0, 0, 0);
      p1 = __builtin_amdgcn_mfma_f32_32x32x16_bf16(b1, qr[d0], p1, 0, 0, 0);
    }
}
__device__ __forceinline__ float psm_max(const f32x16& p) { float m = p[0];
#pragma unroll
  for (int r = 1; r < 16; ++r) m = fmaxf(m, p[r]);
  return m; }
__device__ __forceinline__ void psm_decide(float pmax, float& m_reg, float& mnC, float& alpha) {
  constexpr float C = SCALE * 1.4426950408889634f;
  { auto rr = __builtin_amdgcn_permlane32_swap(__float_as_uint(pmax), __float_as_uint(pmax), false, false);
    pmax = fmaxf(__uint_as_float(rr[0]), __uint_as_float(rr[1])); }
  float mn;
  if (__builtin_expect(__all(pmax - m_reg <= THR / SCALE), 1)) { mn = m_reg; alpha = 1.f; }
  else { mn = fmaxf(m_reg, pmax); alpha = __builtin_amdgcn_exp2f((m_reg - mn) * C); m_reg = mn; }
  mnC = -mn * C;
}
__device__ __forceinline__ void psm_scale(f32x16& p, float mnC) { constexpr float C = SCALE * 1.4426950408889634f;
#pragma unroll
  for (int r = 0; r < 16; ++r) p[r] = fmaf(p[r], C, mnC); }
__device__ __forceinline__ void psm_exp(f32x16& p) {
#pragma unroll
  for (int r = 0; r < 16; ++r) p[r] = __builtin_amdgcn_exp2f(p[r]); }

__device__ __forceinline__ void fsm_first(f32x16& p0, f32x16& p1, int negMCbits) {
  constexpr float C = SCALE * 1.4426950408889634f;
  int nb_ = __builtin_amdgcn_readfirstlane(negMCbits); asm volatile("" : "+s"(nb_)); const float negMC = __builtin_bit_cast(float, nb_);
#pragma unroll
  for (int r = 0; r < 16; ++r) p0[r] = fmaf(p0[r], C, negMC);
#pragma unroll
  for (int r = 0; r < 16; ++r) p1[r] = fmaf(p1[r], C, negMC);
#pragma unroll
  for (int r = 0; r < 16; ++r) p0[r] = __builtin_amdgcn_exp2f(p0[r]);
}
__device__ __forceinline__ void fsm_finish(f32x16& p0, f32x16& p1, float& l_reg, bf16x8& pa0, bf16x8& pa1, bf16x8& pa2, bf16x8& pa3) {
#pragma unroll
  for (int r = 0; r < 16; ++r) p1[r] = __builtin_amdgcn_exp2f(p1[r]);
  float ps = 0;
#pragma unroll
  for (int r = 0; r < 16; ++r) ps += p0[r];
#pragma unroll
  for (int r = 0; r < 16; ++r) ps += p1[r];
  { auto rr = __builtin_amdgcn_permlane32_swap(__float_as_uint(ps), __float_as_uint(ps), false, false);
    ps = __uint_as_float(rr[0]) + __uint_as_float(rr[1]); }
  l_reg += ps;
#define PK4(P, BASE, OUT) do { unsigned a0 = cvt_pk_bf16(P[BASE + 0], P[BASE + 1]), a1 = cvt_pk_bf16(P[BASE + 2], P[BASE + 3]);   \
    unsigned b0 = cvt_pk_bf16(P[BASE + 4], P[BASE + 5]), b1 = cvt_pk_bf16(P[BASE + 6], P[BASE + 7]);                              \
    auto r0 = __builtin_amdgcn_permlane32_swap(a0, b0, false, false); auto r1 = __builtin_amdgcn_permlane32_swap(a1, b1, false, false); \
    u32x4 w = {r0[0], r1[0], r0[1], r1[1]}; OUT = *reinterpret_cast<bf16x8*>(&w); } while (0)
  PK4(p0, 0, pa0); PK4(p0, 8, pa1); PK4(p1, 0, pa2); PK4(p1, 8, pa3);
#undef PK4
}
struct DmaT { const char* gK; const char* gV; LAS unsigned char* lK; LAS unsigned char* lV; int kofs; unsigned v0, v1; };
__device__ __forceinline__ void qk_fsm(f32x16& p0, f32x16& p1, int ksb, const bf16x8* qr, int r32, int hi, f32x16& f0, f32x16& f1, float& l_reg, bf16x8& pa0, bf16x8& pa1, bf16x8& pa2, bf16x8& pa3, const DmaT d, s16x4* la, s16x4* ha, int vb, f32x16& o3, const s16x4* lb, const s16x4* hb) {
  const int swz = ((r32 >> 1) & 7) << 4, rowb = r32 * 384;
  int ar[4];
#pragma unroll
  for (int r = 0; r < 4; ++r) ar[r] = ksb + rowb + ((32 * r + 16 * hi) ^ swz);
  bf16x8 ka[4], kb[4];
#define KRD(dst, d0, h) asm volatile("ds_read_b128 %0, %1 offset:%2" : "=v"(dst) : "v"(ar[(d0) & 3]), "i"(128 * ((d0) >> 2) + 12288 * (h)))
#define KRD4(B, s) do { KRD(B[0], 2 * (s), 0); KRD(B[1], 2 * (s), 1); KRD(B[2], 2 * (s) + 1, 0); KRD(B[3], 2 * (s) + 1, 1); } while (0)
#define KWAIT(N, B) asm volatile("s_waitcnt lgkmcnt(" #N ")" : "+v"(B[0]), "+v"(B[1]), "+v"(B[2]), "+v"(B[3]))
#define KMM(B, s) do { p0 = __builtin_amdgcn_mfma_f32_32x32x16_bf16(B[0], qr[2 * (s)], p0, 0, 0, 0); p1 = __builtin_amdgcn_mfma_f32_32x32x16_bf16(B[1], qr[2 * (s)], p1, 0, 0, 0); \
    p0 = __builtin_amdgcn_mfma_f32_32x32x16_bf16(B[2], qr[2 * (s) + 1], p0, 0, 0, 0); p1 = __builtin_amdgcn_mfma_f32_32x32x16_bf16(B[3], qr[2 * (s) + 1], p1, 0, 0, 0); } while (0)
#define PK4(P, BASE, OUT) do { unsigned a0 = cvt_pk_bf16(P[BASE + 0], P[BASE + 1]), a1 = cvt_pk_bf16(P[BASE + 2], P[BASE + 3]);   \
    unsigned b0 = cvt_pk_bf16(P[BASE + 4], P[BASE + 5]), b1 = cvt_pk_bf16(P[BASE + 6], P[BASE + 7]);                              \
    auto r0 = __builtin_amdgcn_permlane32_swap(a0, b0, false, false); auto r1 = __builtin_amdgcn_permlane32_swap(a1, b1, false, false); \
    u32x4 w = {r0[0], r1[0], r0[1], r1[1]}; OUT = *reinterpret_cast<bf16x8*>(&w); } while (0)
  p0 = f32x16{}; p1 = f32x16{};
  u32x4 ko; asm volatile("ds_read_b128 %0, %1" : "=v"(ko) : "v"(d.kofs));
#define DMA_PK(i_) __builtin_amdgcn_global_load_lds((const unsigned*)(d.gK + ko[i_]), (LAS unsigned*)(d.lK + 8192 * (i_)), 16, 0, 0)
#define DMA_PV(i_, vo_) __builtin_amdgcn_global_load_lds((const unsigned*)(d.gV + (vo_)), (LAS unsigned*)(d.lV + 8192 * (i_)), 16, 0, 0)
  KRD4(ka, 0); KRD4(kb, 1);
#define PKX(L, H) (bf16x8){L[0], L[1], L[2], L[3], H[0], H[1], H[2], H[3]}
  o3 = __builtin_amdgcn_mfma_f32_32x32x16_bf16(pa0, PKX(lb[0], hb[0]), o3, 0, 0, 0); o3 = __builtin_amdgcn_mfma_f32_32x32x16_bf16(pa1, PKX(lb[1], hb[1]), o3, 0, 0, 0);
  o3 = __builtin_amdgcn_mfma_f32_32x32x16_bf16(pa2, PKX(lb[2], hb[2]), o3, 0, 0, 0); o3 = __builtin_amdgcn_mfma_f32_32x32x16_bf16(pa3, PKX(lb[3], hb[3]), o3, 0, 0, 0);
#undef PKX
#pragma unroll
  for (int r = 0; r < 16; ++r) f1[r] = __builtin_amdgcn_exp2f(f1[r]);
  asm volatile("" :: "v"(o3), "v"(f1[0]), "v"(f1[1]), "v"(f1[2]), "v"(f1[3]), "v"(f1[4]), "v"(f1[5]), "v"(f1[6]), "v"(f1[7]), "v"(f1[8]), "v"(f1[9]), "v"(f1[10]), "v"(f1[11]), "v"(f1[12]), "v"(f1[13]), "v"(f1[14]), "v"(f1[15]));
  KWAIT(4, ka); asm volatile("" : "+v"(ko)); KMM(ka, 0);
  DMA_PK(0);
  asm volatile("" :: "v"(p0), "v"(p1));
  KRD4(ka, 2); KWAIT(4, kb); KMM(kb, 1);
  DMA_PK(1);
  float ps = 0;
#pragma unroll
  for (int r = 0; r < 8; ++r) ps += f0[r];
  asm volatile("" :: "v"(p0), "v"(p1), "v"(ps));
  KRD4(kb, 3); KWAIT(4, ka); KMM(ka, 2);
  DMA_PK(2);
#pragma unroll
  for (int r = 8; r < 16; ++r) ps += f0[r];
  asm volatile("" :: "v"(p0), "v"(p1), "v"(ps));
  KRD4(ka, 4); KWAIT(4, kb); KMM(kb, 3);
  DMA_PV(0, d.v0);
#pragma unroll
  for (int r = 0; r < 16; ++r) ps += f1[r];
  { auto rr = __builtin_amdgcn_permlane32_swap(__float_as_uint(ps), __float_as_uint(ps), false, false);
    ps = __uint_as_float(rr[0]) + __uint_as_float(rr[1]); }
  l_reg += ps;
  asm volatile("" :: "v"(p0), "v"(p1), "v"(l_reg));
  KRD4(kb, 5); KWAIT(4, ka); KMM(ka, 4);
  DMA_PV(1, d.v1);
  PK4(f0, 0, pa0); PK4(f0, 8, pa1);
  asm volatile("" :: "v"(p0), "v"(p1), "v"(pa0), "v"(pa1));
  KWAIT(0, kb);
  la[0] = tr_read<v_rd_off(0, 0, 0)>(vb); ha[0] = tr_read<v_rd_off(0, 0, 1)>(vb); la[1] = tr_read<v_rd_off(0, 1, 0)>(vb); ha[1] = tr_read<v_rd_off(0, 1, 1)>(vb);
  la[2] = tr_read<v_rd_off(0, 2, 0)>(vb); ha[2] = tr_read<v_rd_off(0, 2, 1)>(vb); la[3] = tr_read<v_rd_off(0, 3, 0)>(vb); ha[3] = tr_read<v_rd_off(0, 3, 1)>(vb);
  KMM(kb, 5);
  PK4(f1, 0, pa2); PK4(f1, 8, pa3);
  asm volatile("" :: "v"(p0), "v"(p1), "v"(pa2), "v"(pa3));
#undef KRD
#undef KRD4
#undef KWAIT
#undef KMM
#undef PK4
#undef DMA_PK
#undef DMA_PV
}
__device__ __forceinline__ void attn_unit2(const bf16_t* __restrict__ Qb, const bf16_t* __restrict__ Kh, const bf16_t* __restrict__ Vh, bf16_t* __restrict__ Ob, int seq, LAS unsigned char* lds, const int tid, const int negMC, float* __restrict__ ssq) {
  const int wid = __builtin_amdgcn_readfirstlane(tid >> 6), lane = tid & 63, r32 = lane & 31, hi = lane >> 5;
  LAS float* ws = (LAS float*)(lds + WS_OFF) + wid * 64; LAS float* li_l = ws; LAS float* al_l = ws + 32;
  float l_reg = 0; f32x16 o[4] = {}; bf16x8 qr[DQ / 16];
  const bf16_t* Qw = Qb + (long)(wid * QBLK + r32) * LDQ + hi * 8;
#pragma unroll
  for (int d0 = 0; d0 < DQ / 16; ++d0) qr[d0] = *reinterpret_cast<const bf16x8*>(Qw + d0 * 16);
#define KOFF(i_, ln_) ({ const int b_ = 1024 * (wid + 8 * (i_)) + 16 * (ln_), row_ = b_ / 384, x_ = b_ % 384; (unsigned)(row_ * LDK * 2 + (x_ ^ (((row_ >> 1) & 7) << 4))); })
  unsigned voff[2];
#pragma unroll
  for (int i = 0; i < 2; ++i) { const int b = 1024 * (wid + 8 * i) + 16 * lane, st = b >> 9, off = b & 511, kk = (st >> 2) * 8 + (off >> 6), c = (st & 3) * 32 + ((off & 63) >> 1);
    const int k = (kk & ~0xC) | ((kk & 4) << 1) | ((kk & 8) >> 1); voff[i] = (unsigned)(k * LDV * 2 + c * 2); }
  const int NT = seq / KVBLK;
  const int kofs = (int)(uintptr_t)(lds + KOFS_OFF) + tid * 16;
  { u32x4 kv_ = {KOFF(0, lane), KOFF(1, lane), KOFF(2, lane), 0u}; asm volatile("ds_write_b128 %0, %1" :: "v"(kofs), "v"(kv_) : "memory"); }
#define DMAT(tk, ks, tv, vs) att::DmaT{(const char*)Kh + (size_t)((tk) < NT ? (tk) : NT - 1) * (KVBLK * LDK * 2), (const char*)Vh + (size_t)((tv) < NT ? (tv) : NT - 1) * (KVBLK * LDV * 2), \
    lds + K_OFF + (ks) * SHM_K + wid * 1024, lds + V_OFF + (vs) * SHM_V + wid * 1024, kofs, voff[0], voff[1]}
#define DMA_K(t, slot) do { const int t_ = (t) < NT ? (t) : NT - 1; const char* g_ = (const char*)Kh + (size_t)t_ * (KVBLK * LDK * 2); int ln_ = lane; asm volatile("" : "+v"(ln_)); _Pragma("unroll") for (int i_ = 0; i_ < 3; ++i_) \
    __builtin_amdgcn_global_load_lds((const unsigned*)(g_ + KOFF(i_, ln_)), (LAS unsigned*)(lds + K_OFF + (slot) * SHM_K + (wid + 8 * i_) * 1024), 16, 0, 0); } while (0)
#define DMA_V(t, slot) do { const int t_ = (t) < NT ? (t) : NT - 1; const char* g_ = (const char*)Vh + (size_t)t_ * (KVBLK * LDV * 2); _Pragma("unroll") for (int i_ = 0; i_ < 2; ++i_) \
    __builtin_amdgcn_global_load_lds((const unsigned*)(g_ + voff[i_]), (LAS unsigned*)(lds + V_OFF + (slot) * SHM_V + (wid + 8 * i_) * 1024), 16, 0, 0); } while (0)
#define QK_PACE() do { _Pragma("unroll") for (int g_ = 0; g_ < 12; ++g_) { __builtin_amdgcn_sched_group_barrier(0x100, 2, 0); __builtin_amdgcn_sched_group_barrier(0x008, 2, 0); __builtin_amdgcn_sched_group_barrier(0x002, 8, 0); } } while (0)
#define WAITBAR() do { asm volatile("s_waitcnt vmcnt(5) lgkmcnt(0)" ::: "memory"); __builtin_amdgcn_s_barrier(); asm volatile("" ::: "memory"); } while (0)
  const int vbase = (int)(uintptr_t)(lds + V_OFF) + v_rd_base(lane);
  f32x16 pA0, pA1, pB0, pB1; bf16x8 pa0 = {}, pa1 = {}, pa2 = {}, pa3 = {};
  s16x4 la[4], ha[4], lb[4] = {}, hb[4] = {};
  DMA_K(0, 0); DMA_K(1, 1); DMA_V(0, 0);
  WAITBAR();
  DMA_K(2, 2); DMA_V(1, 1);
  qkt_l(pA0, pA1, (LAS const char*)(lds + K_OFF), qr, r32, hi); fsm_first(pA0, pA1, negMC);
  WAITBAR();
  int a = 1;
  for (int t = 1; t + 1 < NT; t += 2) {
    { const int kd = (a + 2) % 3, vd = (a + 1) % 3;
      SBAR(); __builtin_amdgcn_s_setprio(1); qk_fsm(pB0, pB1, (int)(uintptr_t)(lds + K_OFF) + a * SHM_K, qr, r32, hi, pA0, pA1, l_reg, pa0, pa1, pa2, pa3, DMAT(t + 2, kd, t + 1, vd), la, ha, vbase + kd * SHM_V, o[3], lb, hb); __builtin_amdgcn_s_setprio(0); SBAR();
      pv_fsm(o, vbase + kd * SHM_V, pa0, pa1, pa2, pa3, pB0, pB1, negMC, la, ha, lb, hb);
      WAITBAR(); a = (a + 1) % 3; }
    { const int kd = (a + 2) % 3, vd = (a + 1) % 3;
      SBAR(); __builtin_amdgcn_s_setprio(1); qk_fsm(pA0, pA1, (int)(uintptr_t)(lds + K_OFF) + a * SHM_K, qr, r32, hi, pB0, pB1, l_reg, pa0, pa1, pa2, pa3, DMAT(t + 3, kd, t + 2, vd), la, ha, vbase + kd * SHM_V, o[3], lb, hb); __builtin_amdgcn_s_setprio(0); SBAR();
      pv_fsm(o, vbase + kd * SHM_V, pa0, pa1, pa2, pa3, pA0, pA1, negMC, la, ha, lb, hb);
      WAITBAR(); a = (a + 1) % 3; }
  }
  { const int kd = (a + 2) % 3, vd = (a + 1) % 3;
    SBAR(); __builtin_amdgcn_s_setprio(1); qk_fsm(pB0, pB1, (int)(uintptr_t)(lds + K_OFF) + a * SHM_K, qr, r32, hi, pA0, pA1, l_reg, pa0, pa1, pa2, pa3, DMAT(NT - 1, kd, NT - 1, vd), la, ha, vbase + kd * SHM_V, o[3], lb, hb); __builtin_amdgcn_s_setprio(0); SBAR();
    pv_fsm(o, vbase + kd * SHM_V, pa0, pa1, pa2, pa3, pB0, pB1, negMC, la, ha, lb, hb);
      WAITBAR(); a = (a + 1) % 3; }
  { const int kd = (a + 2) % 3;
#define PKX(L, H) (bf16x8){L[0], L[1], L[2], L[3], H[0], H[1], H[2], H[3]}
    o[3] = __builtin_amdgcn_mfma_f32_32x32x16_bf16(pa0, PKX(lb[0], hb[0]), o[3], 0, 0, 0); o[3] = __builtin_amdgcn_mfma_f32_32x32x16_bf16(pa1, PKX(lb[1], hb[1]), o[3], 0, 0, 0);
    o[3] = __builtin_amdgcn_mfma_f32_32x32x16_bf16(pa2, PKX(lb[2], hb[2]), o[3], 0, 0, 0); o[3] = __builtin_amdgcn_mfma_f32_32x32x16_bf16(pa3, PKX(lb[3], hb[3]), o[3], 0, 0, 0);
#undef PKX
    asm volatile("" : "+v"(o[3]));
    fsm_finish(pB0, pB1, l_reg, pa0, pa1, pa2, pa3); SBAR();
    pv_d0_pipe(o, vbase + kd * SHM_V, pa0, pa1, pa2, pa3); }
  int lne; asm volatile("v_mbcnt_lo_u32_b32 %0, -1, 0\n\tv_mbcnt_hi_u32_b32 %0, -1, %0" : "=v"(lne));
  const int r32e = lne & 31, hie = lne >> 5;
  if (hie == 0) li_l[r32e] = l_reg; asm volatile("s_waitcnt lgkmcnt(0)" ::: "memory");
  float rli[16];
#pragma unroll
  for (int r = 0; r < 16; ++r) rli[r] = __builtin_amdgcn_rcpf(li_l[crow(r, hie)]);
  bf16_t* Ow = Ob + (long)(wid * QBLK) * LDO;
#pragma unroll
  for (int r = 0; r < 16; ++r) { int orow = crow(r, hie);
#pragma unroll
    for (int d0 = 0; d0 < 4; ++d0) Ow[(long)orow * LDO + d0 * 32 + r32e] = f2bf(o[d0][r] * rli[r]); }
#pragma unroll
  for (int r = 0; r < 16; ++r) { float v = 0.f;
#pragma unroll
    for (int d0 = 0; d0 < 4; ++d0) { const float x = o[d0][r] * rli[r]; v = fmaf(x, x, v); }
    v += swz_xor<1>(v); v += swz_xor<2>(v); v += swz_xor<4>(v); v += swz_xor<8>(v); v += swz_xor<16>(v);
    if (r32e == r) ssq[(long)(wid * QBLK + crow(r, hie)) * 16] = v; }
  asm volatile("s_waitcnt vmcnt(0) lgkmcnt(0)" ::: "memory"); __builtin_amdgcn_s_barrier(); asm volatile("" ::: "memory");
#undef DMA_K
#undef KOFF
#undef DMAT
#undef DMA_V
#undef WAITBAR
}
}

namespace sg {
using att::v_st; using att::v_rd_base; using att::pv_d0; using att::crow;
template <int KK> __device__ __forceinline__ void load_b(bf16x8* v, const bf16_t* Bsrc, size_t ldb, const int tid) {
    const int n = (tid & 15) * 8;
#pragma unroll
    for (int i = 0; i < KK / 32; ++i) { const int k = (tid >> 4) + 32 * i; v[i] = *(const bf16x8*)(Bsrc + (size_t)k * ldb + n); }
}
template <int KK> __device__ __forceinline__ void write_b(const bf16x8* v, char* lds, const int tid) {
    const int n = (tid & 15) * 8;
#pragma unroll
    for (int i = 0; i < KK / 32; ++i) { const int k = (tid >> 4) + 32 * i; *(bf16x8*)(lds + (k >> 6) * 16384 + v_st(k & 63, n)) = v[i]; }
}
template <int KK> __device__ __forceinline__ void stage_b(const bf16_t* Bsrc, size_t ldb, char* lds, const int tid) { bf16x8 v[KK / 32]; load_b<KK>(v, Bsrc, ldb, tid); write_b<KK>(v, lds, tid); }
constexpr int OST_PITCH = 272, OST_WAVE = 32 * OST_PITCH, OST_OFF = 65536;
template <class RowPtr>
__device__ __forceinline__ void store_tile(const f32x16* o, LAS unsigned char* ost, int lane, const RowPtr& rowptr) {
    const int r32 = lane & 31, hi = lane >> 5; const bool odd = lane & 1;
#pragma unroll
    for (int pr = 0; pr < 8; ++pr)
#pragma unroll
        for (int d0 = 0; d0 < 4; ++d0) { const float a = o[d0][2 * pr], b = o[d0][2 * pr + 1];
            const float x = odd ? a : b;
            const float y = __int_as_float(__builtin_amdgcn_mov_dpp(__float_as_int(x), 0xB1, 0xf, 0xf, true));
            const unsigned w = odd ? cvt_pk_bf16(y, b) : cvt_pk_bf16(a, y);
            const int row = crow(odd ? 2 * pr + 1 : 2 * pr, hi);
            *(LAS unsigned*)(ost + row * OST_PITCH + (32 * d0 + (r32 & ~1)) * 2) = w; }
    asm volatile("s_waitcnt lgkmcnt(0)" ::: "memory");
#pragma unroll
    for (int j = 0; j < 8; ++j) { const int i = (lane >> 4) + 4 * j; const u32x4 v = *(const LAS u32x4*)(ost + i * OST_PITCH + (lane & 15) * 16);
        *(u32x4*)(rowptr(i) + (lane & 15) * 8) = v; }
    asm volatile("s_waitcnt lgkmcnt(0)" ::: "memory");
}
struct RowF1 { bf16_t* a1; int wave, s2, cc; __device__ __forceinline__ bf16_t* operator()(int i) const { return a1 + ((size_t)(32 * wave + i) * 128 + s2) * 1024 + cc * 128; } };
struct RowF2 { bf16_t* yc; int wave, k1, g; __device__ __forceinline__ bf16_t* operator()(int i) const { const int m = 32 * wave + i; return yc + (size_t)(k1 + 128 * (m & 127)) * 2048 + g * 256 + (m >> 7) * 128; } };
struct RowF3 { bf16_t* hb; int wave, tt, g; __device__ __forceinline__ bf16_t* operator()(int i) const { return hb + (size_t)(256 * tt + 32 * wave + i) * 2048 + 1024 + g * 128; } };
template <int KK> __device__ __forceinline__ void mm(f32x16* o, const bf16x8* A, char* lds, int lane) {
    const int vb0 = (int)(uintptr_t)lds + v_rd_base(lane);
#pragma unroll
    for (int t = 0; t < KK / 64; ++t) pv_d0(o, vb0 + t * 16384, A[4 * t], A[4 * t + 1], A[4 * t + 2], A[4 * t + 3]);
}
}

struct Args { const void* in[24]; float* out; unsigned char* ws; int ph_lo, ph_hi; };

__device__ __forceinline__ u32x2 pack4(f32x4 v) { u32x2 w; w.x = cvt_pk_bf16(v[0], v[1]); w.y = cvt_pk_bf16(v[2], v[3]); return w; }

template <bool FP8, bool TILED = false>
__device__ __forceinline__ void cvt_pair(const float* W, int N, void* WT, int ldd, int k0, int n0, int drow0, float scale, LAS float* scr, int lane, const float* ksc = nullptr) {
    const int lr = lane >> 4, lc = (lane & 15) * 4;
    f32x4 v[2][16];
#pragma unroll
    for (int t = 0; t < 2; ++t)
#pragma unroll
        for (int i = 0; i < 16; ++i) v[t][i] = *(const f32x4*)(W + (size_t)(k0 + 64 * t + 4 * i + lr) * N + n0 + lc);
    const int c = lane & 7;
#pragma unroll
    for (int t = 0; t < 2; ++t) {
#pragma unroll
        for (int i = 0; i < 16; ++i) { LAS float* s = scr + (4 * i + lr) * 65 + lc; const float kf = ksc ? ksc[k0 + 64 * t + 4 * i + lr] : 1.f; s[0] = v[t][i][0] * kf; s[1] = v[t][i][1] * kf; s[2] = v[t][i][2] * kf; s[3] = v[t][i][3] * kf; }
        LDS_WAIT(); asm volatile("" ::: "memory");
#pragma unroll
        for (int j = 0; j < 8; ++j) { const int n = (lane >> 3) + 8 * j; const LAS float* s = scr + (8 * c) * 65 + n;
            if constexpr (!FP8) { u32x4 o; o.x = cvt_pk_bf16(s[0 * 65], s[1 * 65]); o.y = cvt_pk_bf16(s[2 * 65], s[3 * 65]); o.z = cvt_pk_bf16(s[4 * 65], s[5 * 65]); o.w = cvt_pk_bf16(s[6 * 65], s[7 * 65]);
                *(u32x4*)((bf16_t*)WT + (size_t)(drow0 + n) * ldd + k0 + 64 * t + 8 * c) = o; }
            else { int w0 = 0, w1 = 0;
                w0 = __builtin_amdgcn_cvt_pk_fp8_f32(pg8::clamp448(s[0 * 65] * scale), pg8::clamp448(s[1 * 65] * scale), w0, false); w0 = __builtin_amdgcn_cvt_pk_fp8_f32(pg8::clamp448(s[2 * 65] * scale), pg8::clamp448(s[3 * 65] * scale), w0, true);
                w1 = __builtin_amdgcn_cvt_pk_fp8_f32(pg8::clamp448(s[4 * 65] * scale), pg8::clamp448(s[5 * 65] * scale), w1, false); w1 = __builtin_amdgcn_cvt_pk_fp8_f32(pg8::clamp448(s[6 * 65] * scale), pg8::clamp448(s[7 * 65] * scale), w1, true);
                u32x2 o; o.x = (unsigned)w0; o.y = (unsigned)w1;
                if constexpr (TILED) { const int dr = drow0 + n;
                    *(u32x2*)((unsigned char*)WT + ((size_t)(dr >> 8) * (ldd >> 7) + (k0 >> 7)) * 32768 + (dr & 255) * 128 + 64 * t + 8 * c) = o; }
                else *(u32x2*)((unsigned char*)WT + (size_t)(drow0 + n) * ldd + k0 + 64 * t + 8 * c) = o; } }
        LDS_WAIT(); asm volatile("" ::: "memory");
    }
}

typedef __attribute__((address_space(4))) const char* karg_cptr;
__device__ __forceinline__ void* karg_ptr(int k) {
    karg_cptr p = (karg_cptr)__builtin_amdgcn_kernarg_segment_ptr();
    asm volatile("" : "+s"(p));
    typedef void* voidp_t; typedef __attribute__((address_space(4))) const voidp_t* karg_vpp;
    return *(karg_vpp)(p + 8 * k);
}
__global__ void __launch_bounds__(NTHR, 2) mk_fwd(Args args) {
    extern __shared__ __attribute__((aligned(16))) unsigned char lds_raw[];
    LAS unsigned char* lds = (LAS unsigned char*)lds_raw;
    volatile LAS unsigned* MISC = (volatile LAS unsigned*)(lds + LDS_MISC);
    const int wave0 = __builtin_amdgcn_readfirstlane((int)threadIdx.x >> 6);
    const int G = gridDim.x, bx0 = blockIdx.x, NGW = G * NWAVES;
#define PHASE_IDS() int lane_; asm volatile("v_mbcnt_lo_u32_b32 %0, -1, 0\n\tv_mbcnt_hi_u32_b32 %0, -1, %0" : "=v"(lane_)); int wave_ = wave0; asm volatile("" : "+s"(wave_)); \
    int bx = bx0; asm volatile("" : "+s"(bx)); int tid = wave_ * 64 + lane_; \
    const int lane = lane_, wave = wave_; \
    const int vcu = (G % 8 == 0) ? (bx % 8) * (G / 8) + bx / 8 : bx; const int gw = vcu * NWAVES + wave; (void)lane; (void)gw
    for (int u = threadIdx.x; u < 64; u += NTHR) MISC[u] = 0u;
    __syncthreads();
    unsigned* const barw = (unsigned*)((unsigned char*)karg_ptr(25) + WS_CTL) + CW_BAR;
    XcdBarrier bar; bar.bar = barw; bar.x = 0; bar.st = nullptr;
#if !MK_MULTI
    bar = xcd_barrier_post(barw, MISC + 8);
#endif
    const int lo = args.ph_lo, hi = args.ph_hi;
#ifndef PH_MASK
#define PH_MASK 0xffffffffu
#endif
#define IN(k) (lo <= (k) && (k) < hi && ((PH_MASK >> ((k) > 15 ? (k) - 16 : (k))) & 1u))
#if MK_MULTI
#define SEAM(k) do { } while (0)
#else
#ifndef TIME_MASK
#define TIME_MASK 0ull
#endif
#ifndef TIME_BAR
#define TIME_BAR 0
#endif
#ifndef TIME_SCALE
#define TIME_SCALE 0.001f
#endif
#if 0
#endif
#define IS_T0() ({ int l0_; asm volatile("v_mbcnt_lo_u32_b32 %0, -1, 0\n\tv_mbcnt_hi_u32_b32 %0, -1, %0" : "=v"(l0_)); (wave0 == 0) && (l0_ == 0); })
    if (TIME_MASK != 0ull && IS_T0()) { MISC[40] = 0u; MISC[41] = (unsigned)__builtin_amdgcn_s_memrealtime(); }
#define TPROBE(k) do { if (TIME_MASK != 0ull && IS_T0()) { const unsigned now_ = (unsigned)__builtin_amdgcn_s_memrealtime(); if ((TIME_MASK >> (k)) & 1ull) MISC[40] += now_ - MISC[41]; MISC[41] = now_; } } while (0)
#define SEAM(k) do { if (TIME_BAR && TIME_MASK != 0ull) { asm volatile("s_waitcnt vmcnt(0)" ::: "memory"); if (IS_T0()) MISC[41] = (unsigned)__builtin_amdgcn_s_memrealtime(); } if ((k) + 1 < hi) xcd_barrier(bar); TPROBE(k); } while (0)
#endif
#define KARG(k) (karg_ptr(k))
#define x_in ((const float*)KARG(0))
#define c_in ((const float*)KARG(1))
#define pos_in ((const int*)KARG(2))
#define ada_w ((const float*)KARG(3))
#define ada_b ((const float*)KARG(4))
#define mix_norm ((const float*)KARG(5))
#define w_in ((const float*)KARG(6))
#define cq_norm ((const float*)KARG(7))
#define ckv_norm ((const float*)KARG(8))
#define w_uq ((const float*)KARG(9))
#define w_ukv ((const float*)KARG(10))
#define q_norm ((const float*)KARG(11))
#define k_norm ((const float*)KARG(12))
#define w_fnet ((const float*)KARG(13))
#define out_norm ((const float*)KARG(14))
#define w_out ((const float*)KARG(15))
#define ffn_norm ((const float*)KARG(16))
#define dw_gate ((const float*)KARG(17))
#define dw_up ((const float*)KARG(18))
#define dw_down ((const float*)KARG(19))
#define router_w ((const float*)KARG(20))
#define mw_gate ((const float*)KARG(21))
#define mw_up ((const float*)KARG(22))
#define mw_down ((const float*)KARG(23))
#define out ((float*)KARG(24))
#define WSB ((unsigned char*)KARG(25))
#define ctl ((unsigned*)(WSB + WS_CTL))
#define MODP ((float*)(WSB + WS_ARENA))
#define MODV ((float*)(WSB + WS_MODV))
#define COS ((float*)(WSB + WS_COS))
#define SIN ((float*)(WSB + WS_SIN))
#define TW ((f32x2*)(WSB + WS_TW))
#define FM ((bf16_t*)(WSB + WS_FM))
#define GM ((bf16_t*)(WSB + WS_GM))
#define M12 ((bf16_t*)(WSB + WS_M12))
#define TOKINFO ((int*)(WSB + WS_TOKINFO))
#define TOKPOS ((int*)(WSB + WS_TOKPOS))
#define BLKCNT ((int*)(WSB + WS_TOKPOS + (size_t)SEQ * 8))
#define ROWTOK ((int*)(WSB + CTL_ROWTOK))
#define WIN ((bf16_t*)(WSB + WS_WIN))
#define WUQ ((bf16_t*)(WSB + WS_WUQ))
#define WUKV ((bf16_t*)(WSB + WS_WUKV))
#define WOUT ((bf16_t*)(WSB + WS_WOUT))
#define WGUD ((bf16_t*)(WSB + WS_WGUD))
#define WDND ((bf16_t*)(WSB + WS_WDND))
#define WGUM ((bf16_t*)(WSB + WS_WGUM))
#define WDNM ((bf16_t*)(WSB + WS_WDNM))
#define HB ((bf16_t*)(WSB + WS_H))
#define YB ((bf16_t*)(WSB + WS_Y))
#define ZB ((bf16_t*)(WSB + WS_Z))
#define QB ((bf16_t*)(WSB + WS_QB))
#define KVB ((bf16_t*)(WSB + WS_KVB))
#define KB ((bf16_t*)(WSB + WS_KB))
#define A1 ((bf16_t*)(WSB + WS_A1))
#define SSQ ((float*)(WSB + WS_A1))
#define YC ((bf16_t*)(WSB + WS_YC))
#define HID ((bf16_t*)(WSB + WS_HID))
#define YPART ((bf16_t*)(WSB + WS_ARENA + 256 * MiB))

    if (IN(0)) {
        PHASE_IDS();
        LAS float* cond = (LAS float*)(lds + LDS_COND); LAS float* trig = (LAS float*)(lds + LDS_TRIG);
        for (int i = tid; i < DM; i += NTHR) { const float c = c_in[i]; cond[i] = c / (1.0f + __expf(-c)); }
        if (tid < 128) { trig[tid] = (float)cospi(2.0 * tid / 128.0); trig[128 + tid] = (float)sinpi(2.0 * tid / 128.0); }
        __syncthreads();
        LAS float* scr = (LAS float*)(lds + wave * 16640);
        constexpr int I_GEMV = 2 * 48 * 64;
        constexpr int I_WIN = 16 * 29, I_WUQ = 4 * 24, I_WUKV = 2 * 32, I_WOUT = 16 * 32;
        constexpr int I_DGU = 16 * 88, I_DDN = 44 * 32, I_MGU = 16 * 112, I_MDN = 56 * 32;
        constexpr int I_ZERO = 2 * 192;
        constexpr int I_ROPE = SEQ * 32 / 64;
        constexpr int I_TW = 16384 / 64, I_FM = 32768 / 64, I_GM = 65536 / 64, I_M12 = 2 * 8 * 256 * 128 / 64;
        constexpr int NITEMS = I_GEMV + 2 * (I_WIN + I_WUQ + I_WUKV + I_WOUT) + 2 * I_DGU + I_DDN + 16 * I_MGU + 8 * I_MDN + I_ZERO + I_ROPE + I_TW + I_FM + I_GM + I_M12;
        for (int it = gw; it < NITEMS; it += NGW) {
            int r = it;
            if (r < I_GEMV) {
                const int kc = r & 63, cb = r >> 6, l = cb / 48, n0 = (cb % 48) * 256 + 4 * lane;
                const float* W = ada_w + ((size_t)l * DM + kc * 32) * 12288 + n0;
                f32x4 a = {0.f, 0.f, 0.f, 0.f};
                f32x4 v[32];
#pragma unroll
                for (int k = 0; k < 32; ++k) v[k] = *(const f32x4*)(W + (size_t)k * 12288);
#pragma unroll
                for (int k = 0; k < 32; ++k) a += v[k] * cond[kc * 32 + k];
                *(f32x4*)(MODP + ((size_t)kc * 2 + l) * 12288 + n0) = a;
                continue;
            } r -= I_GEMV;
            bool done = false;
#pragma unroll 1
            for (int l = 0; l < 2 && !done; ++l) {
                if (r < I_WIN) { const int kb = r / 29, nb = r % 29; cvt_pair<false>(w_in + (size_t)l * DM * DIN, DIN, WIN + (size_t)l * DINP * DM, DM, 128 * kb, 64 * nb, 64 * nb, 1.f, scr, lane); done = true; break; } r -= I_WIN;
                if (r < I_WUQ) { const int kb = r / 24, nb = r % 24; cvt_pair<false>(w_uq + (size_t)l * QLR * 1536, 1536, WUQ + (size_t)l * 1536 * QLR, QLR, 128 * kb, 64 * nb, 64 * nb, 1.f, scr, lane); done = true; break; } r -= I_WUQ;
                if (r < I_WUKV) { const int kb = r / 32, nb = r % 32; cvt_pair<false>(w_ukv + (size_t)l * KVLR * 2048, 2048, WUKV + (size_t)l * 2048 * KVLR, KVLR, 128 * kb, 64 * nb, 64 * nb, 1.f, scr, lane); done = true; break; } r -= I_WUKV;
                if (r < I_WOUT) { const int kb = r / 32, nb = r % 32; cvt_pair<false>(w_out + (size_t)l * DM * DM, DM, WOUT + (size_t)l * DM * DM, DM, 128 * kb, 64 * nb, 64 * nb, 1.f, scr, lane, out_norm + (size_t)l * DM); done = true; break; } r -= I_WOUT;
            }
            if (done) continue;
            if (r < 2 * I_DGU) { const int up = r / I_DGU, rr = r % I_DGU, kb = rr / 88, nb = rr % 88, n0 = 64 * nb;
                cvt_pair<false>(up ? dw_up : dw_gate, DFF, WGUD, DM, 128 * kb, n0, (n0 >> 7) * 256 + (n0 & 127) + up * 128, 1.f, scr, lane); continue; } r -= 2 * I_DGU;
            if (r < I_DDN) { const int kb = r / 32, nb = r % 32; cvt_pair<false>(dw_down, DM, WDND, DFF, 128 * kb, 64 * nb, 64 * nb, 1.f, scr, lane); continue; } r -= I_DDN;
            if (r < 16 * I_MGU) { const int e = r / (2 * I_MGU), r2 = r % (2 * I_MGU), up = r2 / I_MGU, rr = r2 % I_MGU, kb = rr / 112, nb = rr % 112, n0 = 64 * nb;
                cvt_pair<true, true>((up ? mw_up : mw_gate) + (size_t)e * DM * DFE, DFE, (unsigned char*)WGUM + (size_t)e * 14336 * DM, DM, 128 * kb, n0, (n0 >> 7) * 256 + (n0 & 127) + up * 128, S8_WGU, scr, lane); continue; } r -= 16 * I_MGU;
            if (r < 8 * I_MDN) { const int e = r / I_MDN, rr = r % I_MDN, kb = rr / 32, nb = rr % 32;
                cvt_pair<true, true>(mw_down + (size_t)e * DFE * DM, DM, (unsigned char*)WDNM + (size_t)e * DM * DFE, DFE, 128 * kb, 64 * nb, 64 * nb, S8_WDN, scr, lane); continue; } r -= 8 * I_MDN;
            if (r < I_ZERO) { const int l = r / 192, row = 1856 + r % 192; u32x4 z = {0u, 0u, 0u, 0u};
#pragma unroll
                for (int j = 0; j < 4; ++j) *(u32x4*)(WIN + ((size_t)l * DINP + row) * DM + (lane + 64 * j) * 8) = z;
                continue; } r -= I_ZERO;
            if (r < I_ROPE) { const int idx = r * 64 + lane, t = idx >> 5, i = idx & 31;
                const double inv = exp2(-(double)i * (13.287712379549449 / 32.0));
                const double ang = (double)pos_in[t] * inv; double sn, cs; sincos(ang, &sn, &cs);
                COS[idx] = (float)cs; SIN[idx] = (float)sn; continue; } r -= I_ROPE;
            if (r < I_TW) { const int idx = r * 64 + lane, s2 = idx >> 7, k1 = idx & 127; const int m = (s2 * k1) & 16383;
                double sn, cs; sincospi(2.0 * (double)m / 16384.0, &sn, &cs); TW[idx] = (f32x2){(float)cs, (float)(-sn)}; continue; } r -= I_TW;
            if (r < I_FM) { const int idx = r * 64 + lane, m = idx >> 7, s1 = idx & 127, k1 = m >> 1, ri = m & 1; const int ph = (k1 * s1) & 127;
                const float v = (ri ? -trig[128 + ph] : trig[ph]) * 0.08838834764831845f; FM[idx] = f2bf(v); continue; } r -= I_FM;
            if (r < I_GM) { const int idx = r * 64 + lane, m = idx >> 8, k = idx & 255, ro = m >> 7, k2 = m & 127, rin = k >> 7, s2 = k & 127; const int ph = (k2 * s2) & 127;
                float v = (ro == rin) ? trig[ph] : (ro == 0 ? trig[128 + ph] : -trig[128 + ph]);
                GM[idx] = f2bf(v * 0.08838834764831845f); continue; } r -= I_GM;
            {
                const int idx = r * 64 + lane, d = idx & 127, kk = (idx >> 7) & 255, lg = idx >> 15, ri = kk >> 7, c = kk & 127;
                const float* Wf = w_fnet + (size_t)lg * 128 * 128 + d; float a = 0.f;
                for (int m = 0; m < 128; ++m) a += trig[ri * 128 + ((m * c) & 127)] * Wf[m * 128];
                M12[idx] = f2bf(a * 0.08838834764831845f);
            }
        }
        SEAM(0);
    }
    if (IN(1)) {
        PHASE_IDS();
        for (int i = (bx * NTHR + tid); i < 2 * 12288; i += G * NTHR) { float a = ada_b[i];
#pragma unroll
            for (int k = 0; k < 64; ++k) a += MODP[(size_t)k * 2 * 12288 + i];
            MODV[i] = a; }
        SEAM(1);
    }

#pragma unroll 1
    for (int l = 0; l < 2; ++l) {
        const int pb = 2 + 16 * l;
#define modv (MODV + (size_t)l * 12288)
#define xcur ((l == 0) ? x_in : (const float*)out)
#pragma unroll 1
        for (int sub = 0; sub < 2; ++sub) {
            const int ph = pb + (sub ? 8 : 0);
            if (IN(ph)) {
                PHASE_IDS();
                const float* xs = sub ? (const float*)out : xcur;
                const float* gain = (sub ? ffn_norm : mix_norm) + (size_t)l * DM;
                const float* shv = modv + (sub ? 3 : 0) * DM; const float* scv = modv + (sub ? 4 : 1) * DM;
                const bool router = (sub == 1 && l == 1);
                LAS float* wr_l = (LAS float*)lds;
                LAS int* etab = (LAS int*)(lds + 65536); LAS int* rtab = (LAS int*)(lds + 65536 + 4096);
                if (router) { etab[tid] = 0xffff;
                    for (int i = tid; i < DM * NE / 4; i += NTHR) ((LAS f32x4*)wr_l)[i] = ((const f32x4*)router_w)[i]; }
                __syncthreads();
                f32x4 av[8], bv[8];
#pragma unroll
                for (int j = 0; j < 8; ++j) { const f32x4 g4 = ((const f32x4*)gain)[lane + 64 * j], s4 = ((const f32x4*)scv)[lane + 64 * j]; av[j] = g4 * (1.0f + s4); bv[j] = ((const f32x4*)shv)[lane + 64 * j]; }
                int my_e0 = 0, my_e1 = 0, my_tok = -1; float my_w0 = 0.f, my_w1 = 0.f; int itn = 0;
                f32x4 vnx[8];
#pragma unroll
                for (int j = 0; j < 8; ++j) vnx[j] = ((const f32x4*)(xs + (size_t)(gw < SEQ ? gw : 0) * DM))[lane + 64 * j];
                for (int m = gw; m < SEQ; m += NGW, ++itn) {
                    f32x4 v[8]; float ss = 0.f;
#pragma unroll
                    for (int j = 0; j < 8; ++j) v[j] = vnx[j];
                    { const int mn = m + NGW < SEQ ? m + NGW : m;
#pragma unroll
                      for (int j = 0; j < 8; ++j) vnx[j] = ((const f32x4*)(xs + (size_t)mn * DM))[lane + 64 * j]; }
#pragma unroll
                    for (int j = 0; j < 8; ++j) ss += (v[j][0] * v[j][0] + v[j][1] * v[j][1]) + (v[j][2] * v[j][2] + v[j][3] * v[j][3]);
                    const float rstd = 1.0f / sqrtf(wave_sum(ss) * (1.0f / DM) + RMS_EPS);
#pragma unroll
                    for (int j = 0; j < 8; ++j) { v[j] = v[j] * rstd * av[j] + bv[j];
                        if (router) { int w8 = 0; w8 = __builtin_amdgcn_cvt_pk_fp8_f32(pg8::clamp448(v[j][0] * S8_H), pg8::clamp448(v[j][1] * S8_H), w8, false); w8 = __builtin_amdgcn_cvt_pk_fp8_f32(pg8::clamp448(v[j][2] * S8_H), pg8::clamp448(v[j][3] * S8_H), w8, true);
                            *(unsigned*)((unsigned char*)HB + (size_t)m * DM + 4 * lane + 256 * j) = (unsigned)w8; }
                        else *(u32x2*)(HB + (size_t)m * DM + 4 * lane + 256 * j) = pack4(v[j]); }
                    if (router) {
                        float lg[8] = {0.f, 0.f, 0.f, 0.f, 0.f, 0.f, 0.f, 0.f};
#pragma unroll
                        for (int j = 0; j < 8; ++j)
#pragma unroll
                            for (int q = 0; q < 4; ++q) { const int k = 4 * lane + 256 * j + q; const f32x4 w0 = *(const LAS f32x4*)(wr_l + k * 8), w1 = *(const LAS f32x4*)(wr_l + k * 8 + 4); const float hv = v[j][q];
                                lg[0] += hv * w0[0]; lg[1] += hv * w0[1]; lg[2] += hv * w0[2]; lg[3] += hv * w0[3]; lg[4] += hv * w1[0]; lg[5] += hv * w1[1]; lg[6] += hv * w1[2]; lg[7] += hv * w1[3]; }
#pragma unroll
                        for (int e = 0; e < 8; ++e) lg[e] = wave_sum(lg[e]);
                        int e0 = 0; float l0 = lg[0];
#pragma unroll
                        for (int e = 1; e < 8; ++e) if (lg[e] > l0) { l0 = lg[e]; e0 = e; }
                        int e1 = -1; float l1 = -3.0e38f;
#pragma unroll
                        for (int e = 0; e < 8; ++e) if (e != e0 && lg[e] > l1) { l1 = lg[e]; e1 = e; }
                        const float w1 = 1.0f / (1.0f + __expf(l0 - l1)), w0 = 1.0f - w1;
                        if (lane == 0) etab[itn * NWAVES + wave] = e0 | (e1 << 8);
                        if (lane == itn) { my_e0 = e0; my_e1 = e1; my_w0 = w0; my_w1 = w1; my_tok = m; }
                    }
                }
                if (router) {
                    __syncthreads();
                    const int nent = ((SEQ + NGW - 1) / NGW) * NWAVES;
                    if (tid < nent) {
                        const int me = etab[tid], a0 = me & 255, a1 = me >> 8; int c0 = 0, c1 = 0;
                        for (int q = 0; q < tid; ++q) { const int o = etab[q], b0 = o & 255, b1 = o >> 8; c0 += (b0 == a0) + (b1 == a0); c1 += (b0 == a1) + (b1 == a1); }
                        rtab[2 * tid] = c0; rtab[2 * tid + 1] = c1; }
                    if (tid >= 512 - 8) { const int e = tid - (512 - 8); int c = 0;
                        for (int q = 0; q < nent; ++q) { const int o = etab[q]; c += ((o & 255) == e) + ((o >> 8) == e); }
                        BLKCNT[bx * 8 + e] = c; }
                    __syncthreads();
                    if (my_tok >= 0) { int* ti = TOKINFO + (size_t)my_tok * 8; ti[0] = my_e0; ti[1] = my_e1; ti[2] = __float_as_int(my_w0); ti[3] = __float_as_int(my_w1);
                        ti[4] = rtab[2 * (lane * NWAVES + wave)]; ti[5] = rtab[2 * (lane * NWAVES + wave) + 1]; ti[6] = bx; }
                }
                __syncthreads();
                SEAM(ph);
            }
            if (sub == 0) {
            if (IN(pb + 1)) {
                PHASE_IDS();
                pg8::Gemm g{HB, WIN + (size_t)l * DINP * DM, DM, DM, DM, 0, nullptr}; pg8::TileOrder S; S.init(SEQ / 256, DINP / 256, G, bx);
                pg8::EpiBf16 E{ZB, DINP, 1.0f};
                pg8::gemm_phase<pg8::EpiBf16, pg8::TileOrder, false>(tid, lds, g, S, E);
                SEAM(pb + 1);
            }
            if (IN(pb + 2)) {
                PHASE_IDS();
                f32x4 gq0 = ((const f32x4*)(cq_norm + (size_t)l * QLR))[2 * lane], gq1 = ((const f32x4*)(cq_norm + (size_t)l * QLR))[2 * lane + 1];
                f32x4 gk = ((const f32x4*)(ckv_norm + (size_t)l * KVLR))[lane];
                for (int m = gw; m < SEQ; m += NGW) {
                    bf16_t* zr = ZB + (size_t)m * DINP;
                    const bf16x8 q8 = *(const bf16x8*)(zr + ZQ + 8 * lane); const s16x4 k4 = *(const s16x4*)(zr + ZKV + 4 * lane);
                    float qf[8], kf[4], sq = 0.f, sk = 0.f;
#pragma unroll
                    for (int j = 0; j < 8; ++j) { qf[j] = bf2f((unsigned short)q8[j]); sq += qf[j] * qf[j]; }
#pragma unroll
                    for (int j = 0; j < 4; ++j) { kf[j] = bf2f((unsigned short)k4[j]); sk += kf[j] * kf[j]; }
                    const float rq = 1.0f / sqrtf(wave_sum(sq) * (1.0f / QLR) + RMS_EPS), rk = 1.0f / sqrtf(wave_sum(sk) * (1.0f / KVLR) + RMS_EPS);
                    u32x4 wq; wq.x = cvt_pk_bf16(qf[0] * rq * gq0[0], qf[1] * rq * gq0[1]); wq.y = cvt_pk_bf16(qf[2] * rq * gq0[2], qf[3] * rq * gq0[3]);
                    wq.z = cvt_pk_bf16(qf[4] * rq * gq1[0], qf[5] * rq * gq1[1]); wq.w = cvt_pk_bf16(qf[6] * rq * gq1[2], qf[7] * rq * gq1[3]);
                    u32x2 wk; wk.x = cvt_pk_bf16(kf[0] * rk * gk[0], kf[1] * rk * gk[1]); wk.y = cvt_pk_bf16(kf[2] * rk * gk[2], kf[3] * rk * gk[3]);
                    *(u32x4*)(zr + ZQ + 8 * lane) = wq; *(u32x2*)(zr + ZKV + 4 * lane) = wk;
                }
                {   PHASE_IDS();
                    const int r32 = lane & 31, hi = lane >> 5;
                    LAS unsigned char* ost = lds + sg::OST_OFF + wave * sg::OST_WAVE;
                    bf16x8 Af[8];
#pragma unroll
                    for (int s = 0; s < 8; ++s) Af[s] = *(const bf16x8*)(FM + (size_t)(32 * wave + r32) * 128 + 16 * s + 8 * hi);
                    for (int it = bx; it < 1024; it += G) {
                        const int s2 = it >> 3, cc = it & 7;
                        __syncthreads();
                        sg::stage_b<128>(ZB + (size_t)s2 * DINP + ZU + cc * 128, (size_t)128 * DINP, (char*)lds_raw, tid);
                        __syncthreads();
                        f32x16 o[4] = {};
                        sg::mm<128>(o, Af, (char*)lds_raw, lane);
#pragma unroll
                        for (int p = 0; p < 8; ++p) { const int k1 = 16 * wave + (p & 1) + 4 * (p >> 1) + 2 * hi; const f32x2 tw = TW[s2 * 128 + k1];
#pragma unroll
                            for (int d0 = 0; d0 < 4; ++d0) { const float re = o[d0][2 * p], im = o[d0][2 * p + 1];
                                o[d0][2 * p] = re * tw[0] - im * tw[1]; o[d0][2 * p + 1] = re * tw[1] + im * tw[0]; } }
                        sg::store_tile(o, ost, lane, sg::RowF1{A1, wave, s2, cc});
                    }
                    __syncthreads();
                }
                SEAM(pb + 2);
            }
            if (IN(pb + 3)) {
                PHASE_IDS();
                { pg8::Gemm g{ZB + ZQ, WUQ + (size_t)l * 1536 * QLR, DINP, QLR, QLR, 0, nullptr}; pg8::TileOrder S; S.init(SEQ / 256, 1536 / 256, G, bx);
                  pg8::EpiBf16 E{QB, 1536, 1.0f}; pg8::gemm_phase<pg8::EpiBf16, pg8::TileOrder, false>(tid, lds, g, S, E); }
                { pg8::Gemm g{ZB + ZKV, WUKV + (size_t)l * 2048 * KVLR, DINP, KVLR, KVLR, 0, nullptr}; pg8::TileOrder S; S.init(SEQ / 256, 2048 / 256, G, bx);
                  pg8::EpiBf16 E{KVB, 2048, 1.0f}; pg8::gemm_phase<pg8::EpiBf16, pg8::TileOrder, false>(tid, lds, g, S, E); }
                {   PHASE_IDS();
                    const int r32 = lane & 31, hi = lane >> 5;
                    LAS unsigned char* ost = lds + sg::OST_OFF + wave * sg::OST_WAVE;
                    bf16x8 Af[16];
#pragma unroll
                    for (int s = 0; s < 16; ++s) Af[s] = *(const bf16x8*)(GM + (size_t)(32 * wave + r32) * 256 + 16 * s + 8 * hi);
                    for (;;) {
                        __syncthreads();
                        if (tid == 0) MISC[32] = atomicAdd(ctl + CW_F3CTR + 128 + 64 * l, 1u);
                        __syncthreads();
                        const int it = (int)MISC[32]; if (it >= 1024) break;
                        const int k1 = it >> 3, gidx = it & 7;
                        sg::stage_b<256>(A1 + (size_t)k1 * 256 * 1024 + gidx * 128, 1024, (char*)lds_raw, tid);
                        __syncthreads();
                        f32x16 o[4] = {};
                        sg::mm<256>(o, Af, (char*)lds_raw, lane);
                        sg::store_tile(o, ost, lane, sg::RowF2{YC, wave, k1, gidx});
                    }
                    __syncthreads();
                }
                SEAM(pb + 3);
            }
            if (IN(pb + 4)) {
                PHASE_IDS();
                {
                    const int hd = lane >> 3, j8 = lane & 7;
                    const float* qg = q_norm + (size_t)l * QKD; const float* kg = k_norm + (size_t)l * QKD;
                    f32x4 qgn[4], kgn[4], qgr[2], kgr[2];
#pragma unroll
                    for (int j = 0; j < 4; ++j) { qgn[j] = *(const f32x4*)(qg + 16 * j8 + 4 * j); kgn[j] = *(const f32x4*)(kg + 16 * j8 + 4 * j); }
                    qgr[0] = *(const f32x4*)(qg + NOPE + 4 * j8); qgr[1] = *(const f32x4*)(qg + NOPE + 32 + 4 * j8);
                    kgr[0] = *(const f32x4*)(kg + NOPE + 4 * j8); kgr[1] = *(const f32x4*)(kg + NOPE + 32 + 4 * j8);
                    for (int m = gw; m < SEQ; m += NGW) {
                        const f32x4 cs = *(const f32x4*)(COS + (size_t)m * 32 + 4 * j8), sn = *(const f32x4*)(SIN + (size_t)m * 32 + 4 * j8);
                        const bf16_t* kp = KVB + (size_t)m * 2048 + hd * 256; const bf16_t* krp = ZB + (size_t)m * DINP + ZKR;
                        const bf16x8 kn0 = *(const bf16x8*)(kp + 16 * j8), kn1 = *(const bf16x8*)(kp + 16 * j8 + 8);
                        const s16x4 kra = *(const s16x4*)(krp + 4 * j8), krb = *(const s16x4*)(krp + 32 + 4 * j8);
                        {
                            bf16_t* qp = QB + (size_t)m * 1536 + hd * QKD;
                            const bf16x8 n0 = *(const bf16x8*)(qp + 16 * j8), n1 = *(const bf16x8*)(qp + 16 * j8 + 8);
                            const s16x4 ra = *(const s16x4*)(qp + NOPE + 4 * j8), rb = *(const s16x4*)(qp + NOPE + 32 + 4 * j8);
                            float f[16], x1[4], x2[4], ss = 0.f;
#pragma unroll
                            for (int j = 0; j < 8; ++j) { f[j] = bf2f((unsigned short)n0[j]); f[8 + j] = bf2f((unsigned short)n1[j]); }
#pragma unroll
                            for (int j = 0; j < 16; ++j) ss += f[j] * f[j];
#pragma unroll
                            for (int j = 0; j < 4; ++j) { x1[j] = bf2f((unsigned short)ra[j]); x2[j] = bf2f((unsigned short)rb[j]); ss += x1[j] * x1[j] + x2[j] * x2[j]; }
                            ss += swz_xor<1>(ss); ss += swz_xor<2>(ss); ss += swz_xor<4>(ss);
                            const float rs = 1.0f / sqrtf(ss * (1.0f / QKD) + RMS_EPS);
                            u32x4 w0, w1;
                            w0.x = cvt_pk_bf16(f[0] * rs * qgn[0][0], f[1] * rs * qgn[0][1]); w0.y = cvt_pk_bf16(f[2] * rs * qgn[0][2], f[3] * rs * qgn[0][3]);
                            w0.z = cvt_pk_bf16(f[4] * rs * qgn[1][0], f[5] * rs * qgn[1][1]); w0.w = cvt_pk_bf16(f[6] * rs * qgn[1][2], f[7] * rs * qgn[1][3]);
                            w1.x = cvt_pk_bf16(f[8] * rs * qgn[2][0], f[9] * rs * qgn[2][1]); w1.y = cvt_pk_bf16(f[10] * rs * qgn[2][2], f[11] * rs * qgn[2][3]);
                            w1.z = cvt_pk_bf16(f[12] * rs * qgn[3][0], f[13] * rs * qgn[3][1]); w1.w = cvt_pk_bf16(f[14] * rs * qgn[3][2], f[15] * rs * qgn[3][3]);
                            float o1[4], o2[4];
#pragma unroll
                            for (int j = 0; j < 4; ++j) { const float a = x1[j] * rs * qgr[0][j], b = x2[j] * rs * qgr[1][j]; o1[j] = a * cs[j] - b * sn[j]; o2[j] = b * cs[j] + a * sn[j]; }
                            u32x2 wa, wb; wa.x = cvt_pk_bf16(o1[0], o1[1]); wa.y = cvt_pk_bf16(o1[2], o1[3]); wb.x = cvt_pk_bf16(o2[0], o2[1]); wb.y = cvt_pk_bf16(o2[2], o2[3]);
                            *(u32x4*)(qp + 16 * j8) = w0; *(u32x4*)(qp + 16 * j8 + 8) = w1; *(u32x2*)(qp + NOPE + 4 * j8) = wa; *(u32x2*)(qp + NOPE + 32 + 4 * j8) = wb;
                        }
                        {
                            bf16_t* ko = KB + (size_t)m * 1536 + hd * QKD;
                            const bf16x8 n0 = kn0, n1 = kn1; const s16x4 ra = kra, rb = krb;
                            float f[16], x1[4], x2[4], ss = 0.f;
#pragma unroll
                            for (int j = 0; j < 8; ++j) { f[j] = bf2f((unsigned short)n0[j]); f[8 + j] = bf2f((unsigned short)n1[j]); }
#pragma unroll
                            for (int j = 0; j < 16; ++j) ss += f[j] * f[j];
#pragma unroll
                            for (int j = 0; j < 4; ++j) { x1[j] = bf2f((unsigned short)ra[j]); x2[j] = bf2f((unsigned short)rb[j]); ss += x1[j] * x1[j] + x2[j] * x2[j]; }
                            ss += swz_xor<1>(ss); ss += swz_xor<2>(ss); ss += swz_xor<4>(ss);
                            const float rs = 1.0f / sqrtf(ss * (1.0f / QKD) + RMS_EPS);
                            u32x4 w0, w1;
                            w0.x = cvt_pk_bf16(f[0] * rs * kgn[0][0], f[1] * rs * kgn[0][1]); w0.y = cvt_pk_bf16(f[2] * rs * kgn[0][2], f[3] * rs * kgn[0][3]);
                            w0.z = cvt_pk_bf16(f[4] * rs * kgn[1][0], f[5] * rs * kgn[1][1]); w0.w = cvt_pk_bf16(f[6] * rs * kgn[1][2], f[7] * rs * kgn[1][3]);
                            w1.x = cvt_pk_bf16(f[8] * rs * kgn[2][0], f[9] * rs * kgn[2][1]); w1.y = cvt_pk_bf16(f[10] * rs * kgn[2][2], f[11] * rs * kgn[2][3]);
                            w1.z = cvt_pk_bf16(f[12] * rs * kgn[3][0], f[13] * rs * kgn[3][1]); w1.w = cvt_pk_bf16(f[14] * rs * kgn[3][2], f[15] * rs * kgn[3][3]);
                            float o1[4], o2[4];
#pragma unroll
                            for (int j = 0; j < 4; ++j) { const float a = x1[j] * rs * kgr[0][j], b = x2[j] * rs * kgr[1][j]; o1[j] = a * cs[j] - b * sn[j]; o2[j] = b * cs[j] + a * sn[j]; }
                            u32x2 wa, wb; wa.x = cvt_pk_bf16(o1[0], o1[1]); wa.y = cvt_pk_bf16(o1[2], o1[3]); wb.x = cvt_pk_bf16(o2[0], o2[1]); wb.y = cvt_pk_bf16(o2[2], o2[3]);
                            *(u32x4*)(ko + 16 * j8) = w0; *(u32x4*)(ko + 16 * j8 + 8) = w1; *(u32x2*)(ko + NOPE + 4 * j8) = wa; *(u32x2*)(ko + NOPE + 32 + 4 * j8) = wb;
                        }
                    }
                }
                SEAM(pb + 4);
            }
            if (IN(pb + 5)) {
                PHASE_IDS();
                float gq = 0.f, gk = 0.f;
#pragma unroll
                for (int j = 0; j < 3; ++j) { gq = fmaxf(gq, fabsf(q_norm[(size_t)l * QKD + lane + 64 * j])); gk = fmaxf(gk, fabsf(k_norm[(size_t)l * QKD + lane + 64 * j])); }
                gq = fmaxf(gq, swz_xor<1>(gq)); gq = fmaxf(gq, swz_xor<2>(gq)); gq = fmaxf(gq, swz_xor<4>(gq)); gq = fmaxf(gq, swz_xor<8>(gq)); gq = fmaxf(gq, swz_xor<16>(gq));
                gk = fmaxf(gk, swz_xor<1>(gk)); gk = fmaxf(gk, swz_xor<2>(gk)); gk = fmaxf(gk, swz_xor<4>(gk)); gk = fmaxf(gk, swz_xor<8>(gk)); gk = fmaxf(gk, swz_xor<16>(gk));
                { auto rq = __builtin_amdgcn_permlane32_swap(__float_as_uint(gq), __float_as_uint(gq), false, false); gq = fmaxf(__uint_as_float(rq[0]), __uint_as_float(rq[1]));
                  auto rk = __builtin_amdgcn_permlane32_swap(__float_as_uint(gk), __float_as_uint(gk), false, false); gk = fmaxf(__uint_as_float(rk[0]), __uint_as_float(rk[1])); }
                const int negMC = __builtin_amdgcn_readfirstlane(__builtin_bit_cast(int, -fminf(13.856406460551018f * gq * gk, 60.f) * 1.4426950408889634f));
                for (int u = bx; u < NH * (SEQ / 256); u += G) {
                    const int h = u & 7, qb = u >> 3;
                    int ln_u; asm volatile("v_mbcnt_lo_u32_b32 %0, -1, 0\n\tv_mbcnt_hi_u32_b32 %0, -1, %0" : "=v"(ln_u));
                    const int tid_u = wave * 64 + ln_u;
                    att::attn_unit2(QB + (size_t)(qb * 256) * 1536 + h * QKD, KB + h * QKD, KVB + h * 256 + NOPE, HB + (size_t)(qb * 256) * DM + h * VHD, SEQ, lds, tid_u, negMC, SSQ + (size_t)(qb * 256) * 16 + h);
                }
                {   PHASE_IDS();
                    const int r32 = lane & 31, hi = lane >> 5;
                    LAS unsigned char* ost = lds + sg::OST_OFF + wave * sg::OST_WAVE;
                    for (;;) {
                        __syncthreads();
                        if (tid == 0) MISC[32] = atomicAdd(ctl + CW_F3CTR + 64 * l, 1u);
                        __syncthreads();
                        const int it = (int)MISC[32]; if (it >= 512) break;
                        const int tt = it >> 3, gidx = it & 7;
                        bf16x8 Af[16];
                        const bf16_t* ar = YC + (size_t)(256 * tt + 32 * wave + r32) * 2048 + gidx * 256 + 8 * hi;
#pragma unroll
                        for (int s = 0; s < 16; ++s) Af[s] = *(const bf16x8*)(ar + 16 * s);
                        __syncthreads();
                        sg::stage_b<256>(M12 + (size_t)(l * 8 + gidx) * 256 * 128, 128, (char*)lds_raw, tid);
                        __syncthreads();
                        f32x16 o[4] = {};
                        sg::mm<256>(o, Af, (char*)lds_raw, lane);
#pragma unroll
                        for (int r = 0; r < 16; ++r) { float v = 0.f;
#pragma unroll
                            for (int d0 = 0; d0 < 4; ++d0) v = fmaf(o[d0][r], o[d0][r], v);
                            v += swz_xor<1>(v); v += swz_xor<2>(v); v += swz_xor<4>(v); v += swz_xor<8>(v); v += swz_xor<16>(v);
                            if (r32 == r) SSQ[(size_t)(256 * tt + 32 * wave + att::crow(r, hi)) * 16 + 8 + gidx] = v; }
                        sg::store_tile(o, ost, lane, sg::RowF3{HB, wave, tt, gidx});
                    }
                    __syncthreads();
                }
                SEAM(pb + 5);
            }
            if (IN(pb + 7)) {
                PHASE_IDS();
                pg8::Gemm g{HB, WOUT + (size_t)l * DM * DM, DM, DM, DM, 0, nullptr, 0, SSQ}; pg8::TileOrder S; S.init(SEQ / 256, DM / 256, G, bx);
                pg8::EpiRes E{xcur, out, modv + 2 * DM, DM, (const LAS float*)(lds + LDS_COND)};
                pg8::gemm_phase<pg8::EpiRes, pg8::TileOrder, false, false, false, true>(tid, lds, g, S, E);
                SEAM(pb + 7);
            }
            }
        }
        if (l == 0) {
            if (IN(pb + 9)) {
                PHASE_IDS();
                pg8::Gemm g{HB, WGUD, DM, DM, DM, 0, nullptr}; pg8::TileOrder S; S.init(SEQ / 256, 2 * DFF / 256, G, bx);
                pg8::EpiSwiGLU E{HID, DFF};
                pg8::gemm_phase<pg8::EpiSwiGLU, pg8::TileOrder, false>(tid, lds, g, S, E);
                SEAM(pb + 9);
            }
            if (IN(pb + 10)) {
                PHASE_IDS();
                pg8::Gemm g{HID, WDND, DFF, DFF, DFF, 0, nullptr}; pg8::TileOrder S; S.init(SEQ / 256, DM / 256, G, bx);
                pg8::EpiRes E{out, out, modv + 5 * DM, DM};
                pg8::gemm_phase<pg8::EpiRes, pg8::TileOrder, false>(tid, lds, g, S, E);
                SEAM(pb + 10);
            }
        } else {
#define LOAD_TS() int ts[9]; ts[0] = 0; _Pragma("unroll") for (int e = 0; e < 8; ++e) { const int c = __builtin_amdgcn_readfirstlane((int)__hip_atomic_load(ctl + CW_ECNT + 64 * e, RLX_AGENT)); ts[e + 1] = ts[e] + ((c + 255) >> 8); }
            if (IN(pb + 9)) {
                PHASE_IDS();
                LAS int* pref = (LAS int*)lds; LAS int* tot = pref + G * 8;
                for (int i = tid; i < G * 8; i += NTHR) pref[i] = BLKCNT[i];
                __syncthreads();
                if (tid < 8) { int run = 0; for (int b = 0; b < G; ++b) { const int c = pref[b * 8 + tid]; pref[b * 8 + tid] = run; run += c; } tot[tid] = run;
                    if (bx == 0) __hip_atomic_store(ctl + CW_ECNT + 64 * tid, (unsigned)run, RLX_AGENT); }
                __syncthreads();
                int ts[9]; ts[0] = 0;
#pragma unroll
                for (int e = 0; e < 8; ++e) ts[e + 1] = ts[e] + ((tot[e] + 255) >> 8);
                for (int t = bx * NTHR + tid; t < SEQ; t += G * NTHR) {
                    const int* ti = TOKINFO + (size_t)t * 8; const int e0 = ti[0], e1 = ti[1], b = ti[6];
                    int p0 = ti[4] + pref[b * 8 + e0], p1 = ti[5] + pref[b * 8 + e1];
#pragma unroll
                    for (int e = 0; e < 8; ++e) { if (e0 == e) p0 += 256 * ts[e]; if (e1 == e) p1 += 256 * ts[e]; }
                    ROWTOK[p0] = t; ROWTOK[p1] = t; TOKPOS[2 * t] = p0; TOKPOS[2 * t + 1] = p1;
                }
                __syncthreads();
                SEAM(pb + 9);
            }
            if (IN(pb + 10)) {
                PHASE_IDS(); LOAD_TS();
                pg8::Gemm g{HB, WGUM, DM, DM, DM, (size_t)14336 * DM, ROWTOK}; pg8::TileOrder S; S.init(ts[8], 2 * DFE / 256, G, bx); S.moe = true;
#pragma unroll
                for (int e = 0; e < 9; ++e) S.ts[e] = ts[e];
                pg8::EpiSwiGLU8 E{(unsigned char*)HID, DFE, 1.0f / (S8_H * S8_WGU), S8_HID};
                pg8::gemm_phase<pg8::EpiSwiGLU8, pg8::TileOrder, true, true, true>(tid, lds, g, S, E);
                SEAM(pb + 10);
            }
            if (IN(pb + 11)) {
                PHASE_IDS(); LOAD_TS();
                const int nmain = ts[8] < 128 ? ts[8] : 128;
                pg8::EpiBf16 E{YB, DM, 1.0f / (S8_HID * S8_WDN), YPART - (size_t)32768 * DM, (size_t)2048 * DM};
                { pg8::Gemm g{HID, WDNM, DFE, DFE, DFE, (size_t)DM * DFE, nullptr}; pg8::TileOrder S; S.init(nmain, DM / 256, G, bx); S.moe = true;
#pragma unroll
                  for (int e = 0; e < 9; ++e) S.ts[e] = ts[e];
                  pg8::gemm_phase<pg8::EpiBf16, pg8::TileOrder, false, true, true>(tid, lds, g, S, E); }
                if (ts[8] > 128) { asm volatile("" : "+v"(tid));
                  pg8::Gemm g{HID, WDNM, DFE, DFE, DFE / 4, (size_t)DM * DFE, nullptr, DFE / 128}; pg8::TailOrder S; S.nsub = (ts[8] - 128) * 32; S.G = G; S.c = bx; S.pm0 = 128;
#pragma unroll
                  for (int e = 0; e < 9; ++e) S.ts[e] = ts[e];
                  pg8::gemm_phase<pg8::EpiBf16, pg8::TailOrder, false, true, true>(tid, lds, g, S, E); }
                SEAM(pb + 11);
            }
            if (IN(pb + 12)) {
                PHASE_IDS();
                const float* g2 = modv + 5 * DM;
                f32x4 gv[8];
#pragma unroll
                for (int j = 0; j < 8; ++j) gv[j] = ((const f32x4*)g2)[lane + 64 * j];
                int pn0 = 0, pn1 = 0; float wn0 = 0.f, wn1 = 0.f;
                { const int m0 = gw < SEQ ? gw : 0; const int* ti = TOKINFO + (size_t)m0 * 8; wn0 = __int_as_float(ti[2]); wn1 = __int_as_float(ti[3]); pn0 = TOKPOS[2 * m0]; pn1 = TOKPOS[2 * m0 + 1]; }
                for (int m = gw; m < SEQ; m += NGW) {
                    const float w0 = wn0, w1 = wn1; const int p0 = pn0, p1 = pn1;
                    { const int mn = m + NGW < SEQ ? m + NGW : m; const int* ti = TOKINFO + (size_t)mn * 8; wn0 = __int_as_float(ti[2]); wn1 = __int_as_float(ti[3]); pn0 = TOKPOS[2 * mn]; pn1 = TOKPOS[2 * mn + 1]; }
                    const bf16_t* y0 = YB + (size_t)p0 * DM; const bf16_t* y1 = YB + (size_t)p1 * DM; float* op = out + (size_t)m * DM;
                    s16x4 ya4[8], yb4[8]; f32x4 xv[8];
#pragma unroll
                    for (int j = 0; j < 8; ++j) { ya4[j] = *(const s16x4*)(y0 + 4 * lane + 256 * j); yb4[j] = *(const s16x4*)(y1 + 4 * lane + 256 * j); xv[j] = ((const f32x4*)op)[lane + 64 * j]; }
                    f32x4 ya[8], yb[8];
#pragma unroll
                    for (int j = 0; j < 8; ++j)
#pragma unroll
                        for (int q = 0; q < 4; ++q) { ya[j][q] = bf2f((unsigned short)ya4[j][q]); yb[j][q] = bf2f((unsigned short)yb4[j][q]); }
                    if (p0 >= 32768) {
#pragma unroll
                        for (int kq = 0; kq < 3; ++kq)
#pragma unroll
                            for (int j = 0; j < 8; ++j) { const s16x4 e = *(const s16x4*)(YPART + ((size_t)kq * 2048 + (p0 - 32768)) * DM + 4 * lane + 256 * j);
#pragma unroll
                                for (int q = 0; q < 4; ++q) ya[j][q] += bf2f((unsigned short)e[q]); } }
                    if (p1 >= 32768) {
#pragma unroll
                        for (int kq = 0; kq < 3; ++kq)
#pragma unroll
                            for (int j = 0; j < 8; ++j) { const s16x4 e = *(const s16x4*)(YPART + ((size_t)kq * 2048 + (p1 - 32768)) * DM + 4 * lane + 256 * j);
#pragma unroll
                                for (int q = 0; q < 4; ++q) yb[j][q] += bf2f((unsigned short)e[q]); } }
#pragma unroll
                    for (int j = 0; j < 8; ++j) {
#pragma unroll
                        for (int q = 0; q < 4; ++q) xv[j][q] += gv[j][q] * (w0 * ya[j][q] + w1 * yb[j][q]);
                        ((f32x4*)op)[lane + 64 * j] = xv[j]; }
                }
            }
        }
    }
    TPROBE(30);
    if (TIME_MASK != 0ull && bx0 == 0 && IS_T0()) out[0] = (float)MISC[40] * TIME_SCALE;
#undef IN
#undef SEAM
#undef LOAD_TS
#undef modv
#undef xcur
#undef out
#undef ctl
}

extern "C" void kernel_launch(void* const* d_in, const int* in_sizes, int n_in, void* d_out, int out_size, void* d_ws, size_t ws_size, hipStream_t stream) {
    static int grid = 0;
    if (grid == 0) {
        if (n_in != 24 || out_size != SEQ * DM || ws_size < WS_END) { fprintf(stderr, "kernel_launch: unexpected shapes n_in %d out %d ws %zu (need %zu)\n", n_in, out_size, ws_size, (size_t)WS_END); grid = -1; return; }
        int dev = 0, cus = 0, per_cu = 0;
        if (hipGetDevice(&dev) != hipSuccess || hipDeviceGetAttribute(&cus, hipDeviceAttributeMultiprocessorCount, dev) != hipSuccess) { grid = -1; return; }
        if (hipFuncSetAttribute((const void*)mk_fwd, hipFuncAttributeMaxDynamicSharedMemorySize, LDS_BYTES) != hipSuccess) { fprintf(stderr, "kernel_launch: hipFuncSetAttribute failed\n"); grid = -1; return; }
        if (hipOccupancyMaxActiveBlocksPerMultiprocessor(&per_cu, (const void*)mk_fwd, NTHR, LDS_BYTES) != hipSuccess || per_cu < 1) fprintf(stderr, "kernel_launch: occupancy query says %d\n", per_cu);
        (void)hipGetLastError();
        grid = cus;
    }
    if (grid < 0) return;
    (void)hipMemsetAsync((char*)d_ws + WS_CTL, 0, CTL_BYTES, stream);
    Args a{};
    for (int i = 0; i < 24; ++i) a.in[i] = d_in[i];
    a.out = (float*)d_out; a.ws = (unsigned char*)d_ws;
#if MK_MULTI
    static const int phases[] = {0, 1, 2, 3, 4, 5, 6, 7, 8, 9, 10, 11, 12, 18, 19, 20, 21, 22, 23, 24, 25, 26, 27, 28, 29, 30};
    for (int p : phases) { a.ph_lo = p; a.ph_hi = p + 1; hipLaunchKernelGGL(mk_fwd, dim3(grid), dim3(NTHR), LDS_BYTES, stream, a); }
#else
    a.ph_lo = 0; a.ph_hi = 31;
    hipLaunchKernelGGL(mk_fwd, dim3(grid), dim3(NTHR), LDS_BYTES, stream, a);
#endif
    const hipError_t le = hipPeekAtLastError();
    if (le != hipSuccess) fprintf(stderr, "kernel_launch: launch failed: %s\n", hipGetErrorName(le));
}
```
